# Optimizing an MI355X kernel written in HIP

```python
import math
import jax, jax.numpy as jnp
from jax import lax
import numpy as np

D_MODEL = 1024
BATCH = 4
SEQ = 4096
DEPTH = 1

N_META = 16
D_FF = 2816
D_CONV = 512
CONV_WIDTH = 31
D_SSM = 512
SSM_GROUP = 16
N_SSM_GROUPS = D_SSM // SSM_GROUP
SSM_STATE = 64
N_BRANCHES = 2
D_IN = 2 * D_CONV + D_SSM + N_BRANCHES * D_MODEL
DT_MIN = 1e-3
DT_MAX = 1e-1
EPS = 1e-6

kernel_name = "hybrid_meta_conformer_conv_s5_gated_macaron"


def rms_norm(x, g):
    xf = x.astype(jnp.float32)
    y = xf * lax.rsqrt(jnp.mean(xf * xf, axis=-1, keepdims=True) + EPS)
    return (y * g.astype(jnp.float32)).astype(x.dtype)


def swiglu_ffn(x, w1, w3, w2):
    return (jax.nn.silu(x @ w1) * (x @ w3)) @ w2


def conformer_conv_branch(a, dw, dw_b, ln_g, ln_b, w_proj):
    v, g = jnp.split(a, 2, axis=-1)
    z = v * jax.nn.sigmoid(g)
    z = lax.conv_general_dilated(
        z, dw[:, None, :].astype(z.dtype), window_strides=(1,),
        padding=((CONV_WIDTH - 1, 0),),
        dimension_numbers=("NWC", "WIO", "NWC"),
        feature_group_count=D_CONV) + dw_b
    zf = z.astype(jnp.float32)
    mu = jnp.mean(zf, axis=-1, keepdims=True)
    var = jnp.mean(jnp.square(zf - mu), axis=-1, keepdims=True)
    zf = (zf - mu) * lax.rsqrt(var + EPS) * ln_g.astype(jnp.float32) + ln_b.astype(jnp.float32)
    z = jax.nn.silu(zf).astype(a.dtype)
    return z @ w_proj


def s5_branch(u, lam_re, lam_im, log_dt, b_re, b_im, c_re, c_im, d_skip, w_v, w_g):
    bsz, seq_len, _ = u.shape
    uf = u.astype(jnp.float32).reshape(bsz, seq_len, N_SSM_GROUPS, SSM_GROUP)
    lam = lax.complex(lam_re.astype(jnp.float32), lam_im.astype(jnp.float32))
    dt = jnp.exp(log_dt.astype(jnp.float32))[:, None]
    lam_bar = jnp.exp(lam * dt)
    b = lax.complex(b_re.astype(jnp.float32), b_im.astype(jnp.float32))
    b_bar = ((lam_bar - 1.0) / lam)[..., None] * b
    bu = jnp.einsum("blgh,gph->blgp", uf.astype(jnp.complex64), b_bar)
    a = jnp.broadcast_to(lam_bar, bu.shape)

    def combine(e1, e2):
        a1, s1 = e1
        a2, s2 = e2
        return a1 * a2, a2 * s1 + s2

    _, states = lax.associative_scan(combine, (a, bu), axis=1)
    c = lax.complex(c_re.astype(jnp.float32), c_im.astype(jnp.float32))
    y = jnp.einsum("blgp,ghp->blgh", states, c).real \
        + d_skip.astype(jnp.float32).reshape(N_SSM_GROUPS, SSM_GROUP) * uf
    y = jax.nn.gelu(y.reshape(bsz, seq_len, D_SSM)).astype(u.dtype)
    return (y @ w_v) * jax.nn.sigmoid(y @ w_g)


def setup_inputs(seed: int = 0) -> dict:
    key = jax.random.key(seed)
    ks = jax.random.split(key, 32)
    f32 = jnp.float32
    nrm = lambda k, shape, scale: jax.random.normal(k, shape, f32) * scale
    gain = lambda k, shape: 1.0 + 0.02 * jax.random.normal(k, shape, f32)
    G, P, H = N_SSM_GROUPS, SSM_STATE, SSM_GROUP
    n_idx = jnp.arange(P, dtype=f32)
    return {
        "x": nrm(ks[0], (BATCH, SEQ, D_MODEL), 1.0),
        "meta_tokens": nrm(ks[1], (N_META, D_MODEL), 1.0),
        "ffn1_norm": gain(ks[2], (DEPTH, D_MODEL)),
        "ffn1_w1": nrm(ks[3], (DEPTH, D_MODEL, D_FF), D_MODEL ** -0.5),
        "ffn1_w3": nrm(ks[4], (DEPTH, D_MODEL, D_FF), D_MODEL ** -0.5),
        "ffn1_w2": nrm(ks[5], (DEPTH, D_FF, D_MODEL), D_FF ** -0.5),
        "mix_norm": gain(ks[6], (DEPTH, D_MODEL)),
        "w_in": nrm(ks[7], (DEPTH, D_MODEL, D_IN), D_MODEL ** -0.5),
        "b_gate": nrm(ks[8], (DEPTH, N_BRANCHES * D_MODEL), 0.01),
        "conv_dw": nrm(ks[9], (DEPTH, CONV_WIDTH, D_CONV), CONV_WIDTH ** -0.5),
        "conv_dw_b": nrm(ks[10], (DEPTH, D_CONV), 0.01),
        "conv_ln_g": gain(ks[11], (DEPTH, D_CONV)),
        "conv_ln_b": nrm(ks[12], (DEPTH, D_CONV), 0.01),
        "conv_proj": nrm(ks[13], (DEPTH, D_CONV, D_MODEL), D_CONV ** -0.5),
        "ssm_lam_re": -0.5 + 0.01 * jax.random.normal(ks[14], (DEPTH, G, P), f32),
        "ssm_lam_im": math.pi * n_idx + 0.01 * jax.random.normal(ks[15], (DEPTH, G, P), f32),
        "ssm_log_dt": jax.random.uniform(ks[16], (DEPTH, G), f32,
                                         minval=math.log(DT_MIN), maxval=math.log(DT_MAX)),
        "ssm_b_re": nrm(ks[17], (DEPTH, G, P, H), (2.0 * H) ** -0.5),
        "ssm_b_im": nrm(ks[18], (DEPTH, G, P, H), (2.0 * H) ** -0.5),
        "ssm_c_re": nrm(ks[19], (DEPTH, G, H, P), (2.0 * P) ** -0.5),
        "ssm_c_im": nrm(ks[20], (DEPTH, G, H, P), (2.0 * P) ** -0.5),
        "ssm_d": nrm(ks[21], (DEPTH, D_SSM), 1.0),
        "ssm_w_v": nrm(ks[22], (DEPTH, D_SSM, D_MODEL), D_SSM ** -0.5),
        "ssm_w_g": nrm(ks[23], (DEPTH, D_SSM, D_MODEL), D_SSM ** -0.5),
        "w_out": nrm(ks[24], (DEPTH, D_MODEL, D_MODEL), D_MODEL ** -0.5),
        "ffn2_norm": gain(ks[25], (DEPTH, D_MODEL)),
        "ffn2_w1": nrm(ks[26], (DEPTH, D_MODEL, D_FF), D_MODEL ** -0.5),
        "ffn2_w3": nrm(ks[27], (DEPTH, D_MODEL, D_FF), D_MODEL ** -0.5),
        "ffn2_w2": nrm(ks[28], (DEPTH, D_FF, D_MODEL), D_FF ** -0.5),
        "final_norm": gain(ks[29], (D_MODEL,)),
    }


def reference(x, meta_tokens, ffn1_norm, ffn1_w1, ffn1_w3, ffn1_w2, mix_norm, w_in, b_gate,
              conv_dw, conv_dw_b, conv_ln_g, conv_ln_b, conv_proj,
              ssm_lam_re, ssm_lam_im, ssm_log_dt, ssm_b_re, ssm_b_im, ssm_c_re, ssm_c_im,
              ssm_d, ssm_w_v, ssm_w_g, w_out, ffn2_norm, ffn2_w1, ffn2_w3, ffn2_w2, final_norm):
    bsz = x.shape[0]
    meta = jnp.broadcast_to(meta_tokens[None].astype(x.dtype), (bsz, N_META, D_MODEL))
    h = jnp.concatenate([meta, x], axis=1)
    for l in range(DEPTH):
        h = h + 0.5 * swiglu_ffn(rms_norm(h, ffn1_norm[l]), ffn1_w1[l], ffn1_w3[l], ffn1_w2[l])
        u = rms_norm(h, mix_norm[l])
        proj = u @ w_in[l]
        conv_in, ssm_in, gate_in = jnp.split(proj, [2 * D_CONV, 2 * D_CONV + D_SSM], axis=-1)
        y_conv = conformer_conv_branch(conv_in, conv_dw[l], conv_dw_b[l], conv_ln_g[l],
                                       conv_ln_b[l], conv_proj[l])
        y_ssm = s5_branch(ssm_in, ssm_lam_re[l], ssm_lam_im[l], ssm_log_dt[l], ssm_b_re[l],
                          ssm_b_im[l], ssm_c_re[l], ssm_c_im[l], ssm_d[l], ssm_w_v[l], ssm_w_g[l])
        g_conv, g_ssm = jnp.split(jax.nn.sigmoid(gate_in + b_gate[l]), 2, axis=-1)
        h = h + (g_conv * y_conv + g_ssm * y_ssm) @ w_out[l]
        h = h + 0.5 * swiglu_ffn(rms_norm(h, ffn2_norm[l]), ffn2_w1[l], ffn2_w3[l], ffn2_w2[l])
    h = rms_norm(h, final_norm)
    return h[:, N_META:]
```

```cpp
#include <hip/hip_runtime.h>
#include <cstdio>
#include <cstdint>
#include <cmath>

namespace nv {
constexpr int D = 1024, BATCH = 4, SEQ = 4096, NMETA = 16, DFF = 2816, DCONV = 512, CW = 31, DSSM = 512, HG = 16, NG = 32, PS = 64;
constexpr int DIN = 2 * DCONV + DSSM + 2 * D;
constexpr int MSEQ = BATCH * SEQ;
constexpr int MALL = MSEQ + NMETA;
constexpr float EPS = 1e-6f;

__device__ __forceinline__ float wave_sum(float v) {
#pragma unroll
    for (int o = 1; o < 64; o <<= 1) v += __shfl_xor(v, o);
    return v;
}
__device__ __forceinline__ float sigmoidf_(float x) { return 1.f / (1.f + expf(-x)); }
__device__ __forceinline__ float siluf_(float x) { return x / (1.f + expf(-x)); }
__device__ __forceinline__ float gelu_tanh(float x) { return 0.5f * x * (1.f + tanhf(0.7978845608028654f * (x + 0.044715f * x * x * x))); }

__global__ void k_build_h(const float* x, const float* meta, float* H) {
    const size_t n = (size_t)MALL * D;
    for (size_t i = (size_t)blockIdx.x * blockDim.x + threadIdx.x; i < n; i += (size_t)gridDim.x * blockDim.x)
        H[i] = i < (size_t)MSEQ * D ? x[i] : meta[i - (size_t)MSEQ * D];
}
__global__ void k_rmsnorm(const float* in, const float* g, float* out, int nrows) {
    const int row = blockIdx.x * (blockDim.x / 64) + (threadIdx.x >> 6), lane = threadIdx.x & 63;
    if (row >= nrows) return;
    const float* p = in + (size_t)row * D; float s = 0.f;
    for (int c = lane; c < D; c += 64) s += p[c] * p[c];
    s = wave_sum(s);
    const float r = rsqrtf(s * (1.f / D) + EPS);
    for (int c = lane; c < D; c += 64) out[(size_t)row * D + c] = p[c] * r * g[c];
}
__global__ void __launch_bounds__(256) k_gemm(const float* A, int lda, const float* B, int ldb, float* C, int ldc, const float* R, int ldr, float alpha, int M, int N, int K) {
    __shared__ float As[16][65]; __shared__ float Bs[16][64];
    const int tid = threadIdx.x, tx = tid & 15, ty = tid >> 4, row0 = blockIdx.y * 64, col0 = blockIdx.x * 64;
    float acc[4][4] = {};
    const int ar = tid >> 2, ac = (tid & 3) * 4, br = tid >> 4, bc = (tid & 15) * 4;
    for (int k0 = 0; k0 < K; k0 += 16) {
        float4 a = make_float4(0.f, 0.f, 0.f, 0.f);
        if (row0 + ar < M) a = *(const float4*)(A + (size_t)(row0 + ar) * lda + k0 + ac);
        As[ac + 0][ar] = a.x; As[ac + 1][ar] = a.y; As[ac + 2][ar] = a.z; As[ac + 3][ar] = a.w;
        const float4 b = *(const float4*)(B + (size_t)(k0 + br) * ldb + col0 + bc);
        Bs[br][bc + 0] = b.x; Bs[br][bc + 1] = b.y; Bs[br][bc + 2] = b.z; Bs[br][bc + 3] = b.w;
        __syncthreads();
#pragma unroll
        for (int kk = 0; kk < 16; ++kk) {
            float av[4], bv[4];
#pragma unroll
            for (int i = 0; i < 4; ++i) { av[i] = As[kk][ty * 4 + i]; bv[i] = Bs[kk][tx * 4 + i]; }
#pragma unroll
            for (int i = 0; i < 4; ++i)
#pragma unroll
                for (int j = 0; j < 4; ++j) acc[i][j] += av[i] * bv[j];
        }
        __syncthreads();
    }
#pragma unroll
    for (int i = 0; i < 4; ++i) { const int m = row0 + ty * 4 + i; if (m >= M) continue;
#pragma unroll
        for (int j = 0; j < 4; ++j) { const int n = col0 + tx * 4 + j; const float r = R ? R[(size_t)m * ldr + n] : 0.f; C[(size_t)m * ldc + n] = r + alpha * acc[i][j]; } }
}
__global__ void k_silu_mul(float* a, const float* b, size_t n) {
    for (size_t i = (size_t)blockIdx.x * blockDim.x + threadIdx.x; i < n; i += (size_t)gridDim.x * blockDim.x) a[i] = siluf_(a[i]) * b[i];
}
__global__ void k_glu(const float* P, float* Z, int rows) {
    const size_t n = (size_t)rows * DCONV;
    for (size_t i = (size_t)blockIdx.x * blockDim.x + threadIdx.x; i < n; i += (size_t)gridDim.x * blockDim.x) { const size_t r = i / DCONV, c = i % DCONV; Z[i] = P[r * 1024 + c] * sigmoidf_(P[r * 1024 + DCONV + c]); }
}
__device__ __forceinline__ int pos_row(int b, int pos) { return pos < NMETA ? MSEQ + pos : b * SEQ + pos - NMETA; }
__global__ void __launch_bounds__(512) k_conv_ln_silu(const float* Z, const float* dw, const float* dwb, const float* lng, const float* lnb, float* ZC) {
    __shared__ float red[16];
    const int row = blockIdx.x, b = row / SEQ, t = row % SEQ, pos = t + NMETA, c = threadIdx.x;
    float acc = dwb[c];
    for (int k = 0; k < CW; ++k) { const int p = pos - (CW - 1) + k; if (p >= 0) acc += dw[k * DCONV + c] * Z[(size_t)pos_row(b, p) * DCONV + c]; }
    float s = wave_sum(acc); if ((c & 63) == 0) red[c >> 6] = s; __syncthreads();
    float tot = 0.f; for (int i = 0; i < 8; ++i) tot += red[i];
    const float mu = tot * (1.f / DCONV), d = acc - mu;
    float q = wave_sum(d * d); if ((c & 63) == 0) red[8 + (c >> 6)] = q; __syncthreads();
    float qt = 0.f; for (int i = 0; i < 8; ++i) qt += red[8 + i];
    const float v = d * rsqrtf(qt * (1.f / DCONV) + EPS) * lng[c] + lnb[c];
    ZC[(size_t)row * DCONV + c] = siluf_(v);
}
__global__ void __launch_bounds__(64) k_ssm(const float* U, const float* lam_re, const float* lam_im, const float* log_dt, const float* b_re, const float* b_im, const float* c_re, const float* c_im, const float* dsk, float* Y) {
    const int b = blockIdx.x / NG, g = blockIdx.x % NG, p = threadIdx.x;
    const double lr = lam_re[g * PS + p], li = lam_im[g * PS + p], dt = exp((double)log_dt[g]);
    const double er = exp(lr * dt), ar = er * cos(li * dt), ai = er * sin(li * dt);
    const double nr = ar - 1.0, ni = ai, den = lr * lr + li * li, fr = (nr * lr + ni * li) / den, fi = (ni * lr - nr * li) / den;
    float Br[HG], Bi[HG], Cr[HG], Ci[HG];
#pragma unroll
    for (int h = 0; h < HG; ++h) { const double br = b_re[(g * PS + p) * HG + h], bi = b_im[(g * PS + p) * HG + h]; Br[h] = (float)(fr * br - fi * bi); Bi[h] = (float)(fr * bi + fi * br);
        Cr[h] = c_re[(g * HG + h) * PS + p]; Ci[h] = c_im[(g * HG + h) * PS + p]; }
    const float far = (float)ar, fai = (float)ai;
    const float dh = p < HG ? dsk[g * HG + p] : 0.f;
    float xr = 0.f, xi = 0.f;
    for (int pos = 0; pos < NMETA + SEQ; ++pos) {
        const int row = pos_row(b, pos);
        const float* up = U + (size_t)row * DSSM + g * HG;
        float u[HG];
#pragma unroll
        for (int h = 0; h < HG; ++h) u[h] = up[h];
        float sr = 0.f, si = 0.f;
#pragma unroll
        for (int h = 0; h < HG; ++h) { sr += Br[h] * u[h]; si += Bi[h] * u[h]; }
        const float nxr = far * xr - fai * xi + sr, nxi = far * xi + fai * xr + si; xr = nxr; xi = nxi;
        float mine = 0.f, um = 0.f;
#pragma unroll
        for (int h = 0; h < HG; ++h) { const float v = wave_sum(Cr[h] * xr - Ci[h] * xi); if (p == h) { mine = v; um = u[h]; } }
        if (pos >= NMETA && p < HG) Y[(size_t)row * DSSM + g * HG + p] = gelu_tanh(mine + dh * um);
    }
}
__global__ void k_merge(const float* G, const float* bg, const float* YC, const float* YV, const float* YG, float* MG, int rows) {
    const size_t n = (size_t)rows * D;
    for (size_t i = (size_t)blockIdx.x * blockDim.x + threadIdx.x; i < n; i += (size_t)gridDim.x * blockDim.x) { const size_t r = i / D, c = i % D;
        const float gc = sigmoidf_(G[r * 2048 + c] + bg[c]), gs = sigmoidf_(G[r * 2048 + D + c] + bg[D + c]);
        MG[i] = gc * YC[i] + gs * (YV[i] * sigmoidf_(YG[i])); }
}
}

extern "C" void kernel_launch(void* const* d_in, const int* in_sizes, int n_in, void* d_out, int out_size, void* d_ws, size_t ws_size, hipStream_t stream) {
    using namespace nv;
    const float* x = (const float*)d_in[0]; const float* meta = (const float*)d_in[1];
    const float* ffn1_norm = (const float*)d_in[2]; const float* ffn1_w1 = (const float*)d_in[3]; const float* ffn1_w3 = (const float*)d_in[4]; const float* ffn1_w2 = (const float*)d_in[5];
    const float* mix_norm = (const float*)d_in[6]; const float* w_in = (const float*)d_in[7]; const float* b_gate = (const float*)d_in[8];
    const float* conv_dw = (const float*)d_in[9]; const float* conv_dw_b = (const float*)d_in[10]; const float* conv_ln_g = (const float*)d_in[11]; const float* conv_ln_b = (const float*)d_in[12]; const float* conv_proj = (const float*)d_in[13];
    const float* lam_re = (const float*)d_in[14]; const float* lam_im = (const float*)d_in[15]; const float* log_dt = (const float*)d_in[16];
    const float* b_re = (const float*)d_in[17]; const float* b_im = (const float*)d_in[18]; const float* c_re = (const float*)d_in[19]; const float* c_im = (const float*)d_in[20];
    const float* ssm_d = (const float*)d_in[21]; const float* w_v = (const float*)d_in[22]; const float* w_g = (const float*)d_in[23]; const float* w_out = (const float*)d_in[24];
    const float* ffn2_norm = (const float*)d_in[25]; const float* ffn2_w1 = (const float*)d_in[26]; const float* ffn2_w3 = (const float*)d_in[27]; const float* ffn2_w2 = (const float*)d_in[28];
    const float* final_norm = (const float*)d_in[29];
    float* out = (float*)d_out;
    constexpr int RC = 1024;
    float* ws = (float*)d_ws; size_t o = 0;
    float* H = ws + o; o += (size_t)MALL * D;
    float* NB = ws + o; o += (size_t)RC * D;
    float* T1 = ws + o; o += (size_t)RC * DFF;
    float* T3 = ws + o; o += (size_t)RC * DFF;
    float* Z = ws + o; o += (size_t)MALL * DCONV;
    float* U = ws + o; o += (size_t)MALL * DSSM;
    float* ZC = ws + o; o += (size_t)MALL * DCONV;
    float* PRJ = ws + o; o += (size_t)RC * 2048;
    float* YC = ws + o; o += (size_t)RC * D;
    float* YV = ws + o; o += (size_t)RC * D;
    float* YG = ws + o; o += (size_t)RC * D;
    float* MG = ws + o; o += (size_t)RC * D;
    if (o * 4 > ws_size) { fprintf(stderr, "workspace too small: need %zu have %zu\n", o * 4, ws_size); return; }
    auto gemm = [&](const float* A, int lda, const float* B, int ldb, float* C, int ldc, const float* R, int ldr, float alpha, int M, int N, int K) {
        hipLaunchKernelGGL(k_gemm, dim3(N / 64, (M + 63) / 64), dim3(256), 0, stream, A, lda, B, ldb, C, ldc, R, ldr, alpha, M, N, K); };
    hipLaunchKernelGGL(k_build_h, dim3(2048), dim3(256), 0, stream, x, meta, H);
    auto ffn = [&](const float* gain, const float* w1, const float* w3, const float* w2, int nrows_total) {
        for (int r0 = 0; r0 < nrows_total; r0 += RC) { const int nr = (nrows_total - r0) < RC ? (nrows_total - r0) : RC;
            hipLaunchKernelGGL(k_rmsnorm, dim3((nr + 3) / 4), dim3(256), 0, stream, H + (size_t)r0 * D, gain, NB, nr);
            gemm(NB, D, w1, DFF, T1, DFF, nullptr, 0, 1.f, nr, DFF, D);
            gemm(NB, D, w3, DFF, T3, DFF, nullptr, 0, 1.f, nr, DFF, D);
            hipLaunchKernelGGL(k_silu_mul, dim3(2048), dim3(256), 0, stream, T1, T3, (size_t)nr * DFF);
            gemm(T1, DFF, w2, D, H + (size_t)r0 * D, D, H + (size_t)r0 * D, D, 0.5f, nr, D, DFF); } };
    ffn(ffn1_norm, ffn1_w1, ffn1_w3, ffn1_w2, MALL);
    for (int r0 = 0; r0 < MALL; r0 += RC) { const int nr = (MALL - r0) < RC ? (MALL - r0) : RC;
        hipLaunchKernelGGL(k_rmsnorm, dim3((nr + 3) / 4), dim3(256), 0, stream, H + (size_t)r0 * D, mix_norm, NB, nr);
        gemm(NB, D, w_in, DIN, PRJ, 1024, nullptr, 0, 1.f, nr, 1024, D);
        hipLaunchKernelGGL(k_glu, dim3(1024), dim3(256), 0, stream, PRJ, Z + (size_t)r0 * DCONV, nr);
        gemm(NB, D, w_in + 1024, DIN, U + (size_t)r0 * DSSM, DSSM, nullptr, 0, 1.f, nr, DSSM, D); }
    hipLaunchKernelGGL(k_conv_ln_silu, dim3(MSEQ), dim3(512), 0, stream, Z, conv_dw, conv_dw_b, conv_ln_g, conv_ln_b, ZC);
    hipLaunchKernelGGL(k_ssm, dim3(BATCH * NG), dim3(64), 0, stream, U, lam_re, lam_im, log_dt, b_re, b_im, c_re, c_im, ssm_d, U);
    for (int r0 = 0; r0 < MSEQ; r0 += RC) { const int nr = RC;
        hipLaunchKernelGGL(k_rmsnorm, dim3((nr + 3) / 4), dim3(256), 0, stream, H + (size_t)r0 * D, mix_norm, NB, nr);
        gemm(NB, D, w_in + 1536, DIN, PRJ, 2048, nullptr, 0, 1.f, nr, 2048, D);
        gemm(ZC + (size_t)r0 * DCONV, DCONV, conv_proj, D, YC, D, nullptr, 0, 1.f, nr, D, DCONV);
        gemm(U + (size_t)r0 * DSSM, DSSM, w_v, D, YV, D, nullptr, 0, 1.f, nr, D, DSSM);
        gemm(U + (size_t)r0 * DSSM, DSSM, w_g, D, YG, D, nullptr, 0, 1.f, nr, D, DSSM);
        hipLaunchKernelGGL(k_merge, dim3(1024), dim3(256), 0, stream, PRJ, b_gate, YC, YV, YG, MG, nr);
        gemm(MG, D, w_out, D, H + (size_t)r0 * D, D, H + (size_t)r0 * D, D, 1.f, nr, D, D); }
    ffn(ffn2_norm, ffn2_w1, ffn2_w3, ffn2_w2, MSEQ);
    hipLaunchKernelGGL(k_rmsnorm, dim3(MSEQ / 4), dim3(256), 0, stream, H, final_norm, out, MSEQ);
}
```

```cpp
#include <hip/hip_runtime.h>
#include <cstdio>
#include <cstdint>

#ifndef MK_N_LAUNCHES
#define MK_N_LAUNCHES 1
#endif

__device__ __forceinline__ int lane_id_opaque() { int l; asm volatile("v_mbcnt_lo_u32_b32 %0, -1, 0\n\tv_mbcnt_hi_u32_b32 %0, -1, %0" : "=v"(l)); return l; }
namespace pg8 {
#define PG8_LAS __attribute__((address_space(3)))
typedef unsigned short bf16_t;
typedef short bf16x8 __attribute__((ext_vector_type(8)));
typedef float f32x4 __attribute__((ext_vector_type(4)));
typedef unsigned u32x4 __attribute__((ext_vector_type(4)));
constexpr int BM = 256, BK = 64, HALF = 128, HTB = HALF * BK * 2, STAGE_BYTES = 8 * HTB, NXCD = 8, WGM = 8;

__host__ __device__ __forceinline__ int lds_byte(int r, int c) { const int st = (r >> 4) * 2 + (c >> 5), rr = r & 15, cc = c & 31, ob = rr * 64 + cc * 2; return st * 1024 + (ob ^ (((ob >> 9) & 1) << 5)); }
__host__ __device__ __forceinline__ void stage_rc(int b, int& R, int& C) { const int st = b / 1024, sb = b % 1024, swz = sb ^ (((sb >> 9) & 1) << 5); R = (st >> 1) * 16 + swz / 64; C = (st & 1) * 32 + (swz % 64) / 2; }
__host__ __device__ __forceinline__ int perm32(int rho) { const int n = rho >> 4, i = rho & 15; return 8 * (i >> 2) + 4 * n + (i & 3); }

struct Unit { int pm, pn, kind; const char* A; const char* B; };
struct Gemm { int lda, ldb, K; };

__device__ __forceinline__ bool static_tile(int i, int G, int c, int nM, int nN, int& pm, int& pn) {
    const int nwg = nM * nN; const long L = (long)i * G + c; if (L >= nwg) return false;
    int wgid = (int)L; { const int q = nwg / NXCD, r = nwg % NXCD, xcd = wgid % NXCD, off = wgid / NXCD; wgid = (xcd < r ? xcd * (q + 1) : r * (q + 1) + (xcd - r) * q) + off; }
    const int nig = WGM * nN, gid = wgid / nig, fm = gid * WGM, gsz = (nM - fm) < WGM ? (nM - fm) : WGM;
    pm = fm + ((wgid % nig) % gsz); pn = (wgid % nig) / gsz; return true;
}
struct GridOrder {
    int nM, nN, G, c; const char* A; const char* B; size_t tA, tB;
    __device__ __forceinline__ bool next(int i, Unit& u) const { int pm, pn; if (!static_tile(i, G, c, nM, nN, pm, pn)) return false; u.pm = pm; u.pn = pn; u.kind = 0; u.A = A + (size_t)pm * tA; u.B = B + (size_t)pn * tB; return true; }
    __device__ __forceinline__ void a_ready(const Unit&) const {}
    __device__ __forceinline__ void done(const Unit&) const {}
};

__device__ __forceinline__ unsigned cvt_pk_bf16(float lo, float hi) { unsigned r; asm volatile("v_cvt_pk_bf16_f32 %0, %1, %2" : "=v"(r) : "v"(lo), "v"(hi)); return r; }

template <class Epi, class Sched>
__device__ __forceinline__ void gemm_phase(PG8_LAS unsigned char* lds, const int wid  , const Gemm g, const Sched& S, const Epi& E) {
    const int lane = lane_id_opaque(), tid = wid * 64 + lane, wr = wid >> 2, wc = wid & 3, fr = lane & 15, fq = lane >> 4;
    const int K = g.K, nt = K / BK;
    unsigned voffA[2], voffB[2];
#pragma unroll
    for (int i = 0; i < 2; ++i) { int R, C; stage_rc(tid * 16 + i * 8192, R, C); const int Rb = (R & ~31) + perm32(R & 31);
        voffA[i] = (unsigned)(R * g.lda + C) * 2u; voffB[i] = (unsigned)(Rb * g.ldb + C) * 2u; }
    const size_t kstep = (size_t)(BK * 2);
    const size_t hstepA = (size_t)HALF * g.lda * 2, hstepB = (size_t)HALF * g.ldb * 2;
    const unsigned ldsw = (unsigned)wid * 1024u;
    const int aoff = lds_byte(wr * 64 + fr, fq * 8), boff = lds_byte(wc * 32 + fr, fq * 8);
#define PG8_SA(b, h) (((b) * 2 + (h)) * HTB)
#define PG8_SB(b, h) ((4 + (b) * 2 + (h)) * HTB)
#define PG8_STAGE(bufoff, gbase, voff) do { _Pragma("unroll") for (int _i = 0; _i < 2; ++_i) \
        __builtin_amdgcn_global_load_lds((const unsigned*)((const char*)(gbase) + (voff)[_i]), (PG8_LAS unsigned*)(lds + (bufoff) + ldsw + _i * 8192), 16, 0, 0); } while (0)
#define PG8_LDA(dst, b, h) do { _Pragma("unroll") for (int m = 0; m < 4; ++m) _Pragma("unroll") for (int k = 0; k < 2; ++k) dst[m][k] = *(const PG8_LAS bf16x8*)(lds + PG8_SA(b, h) + aoff + m * 2048 + k * 1024); } while (0)
#define PG8_LDB(dst, b, h) do { _Pragma("unroll") for (int n = 0; n < 2; ++n) _Pragma("unroll") for (int k = 0; k < 2; ++k) dst[n][k] = *(const PG8_LAS bf16x8*)(lds + PG8_SB(b, h) + boff + n * 2048 + k * 1024); } while (0)
#define PG8_MMA(ai, bj, At, Bt) do { __builtin_amdgcn_s_setprio(1); _Pragma("unroll") for (int m = 0; m < 4; ++m) _Pragma("unroll") for (int n = 0; n < 2; ++n) _Pragma("unroll") for (int k = 0; k < 2; ++k) \
        acc[ai][bj][m][n] = __builtin_amdgcn_mfma_f32_16x16x32_bf16(Bt[n][k], At[m][k], acc[ai][bj][m][n], 0, 0, 0); __builtin_amdgcn_s_setprio(0); } while (0)
#define PG8_WAIT_V(n) asm volatile("s_waitcnt vmcnt(" #n ")" ::: "memory")
#define PG8_WAIT_L(n) asm volatile("s_waitcnt lgkmcnt(" #n ")" ::: "memory")
#define PG8_BAR __builtin_amdgcn_s_barrier()
#define PG8_SCHED __builtin_amdgcn_sched_barrier(0)
    Unit cur, nxt; int ui = 0;
    if (!S.next(0, cur)) return;
    f32x4 acc[2][2][4][2];
#pragma unroll
    for (int a = 0; a < 2; ++a)
#pragma unroll
        for (int b = 0; b < 2; ++b)
#pragma unroll
            for (int m = 0; m < 4; ++m)
#pragma unroll
                for (int n = 0; n < 2; ++n) acc[a][b][m][n] = (f32x4){0.f, 0.f, 0.f, 0.f};
    bf16x8 At[4][2], B0[2][2], B1[2][2];
    const char* cA = cur.A; const char* cB = cur.B;
    S.a_ready(cur);
    PG8_STAGE(PG8_SB(0, 0), cB, voffB); PG8_STAGE(PG8_SB(0, 1), cB + hstepB, voffB); PG8_STAGE(PG8_SA(0, 0), cA, voffA); PG8_STAGE(PG8_SA(0, 1), cA + hstepA, voffA);
    if (wr == 1) PG8_BAR;
    PG8_WAIT_V(2); PG8_BAR;
    PG8_STAGE(PG8_SB(1, 0), cB + kstep, voffB); PG8_STAGE(PG8_SA(1, 0), cA + kstep, voffA); PG8_STAGE(PG8_SB(1, 1), cB + hstepB + kstep, voffB);
    PG8_WAIT_V(6); PG8_BAR;
    for (;;) {
        const bool has_next = S.next(ui + 1, nxt);
        const char* nA = has_next ? nxt.A : cA; const char* nB = has_next ? nxt.B : cB;
        for (int t = 0; t < nt; t += 2) {
            const bool last = (t == nt - 2);
            const char* a1 = cA + (size_t)(t + 1) * kstep;
            const char* a2 = last ? nA : cA + (size_t)(t + 2) * kstep; const char* b2 = last ? nB : cB + (size_t)(t + 2) * kstep;
            const char* a3 = a2 + kstep; const char* b3 = b2 + kstep;
            if (last && has_next) S.a_ready(nxt);
            PG8_LDB(B0, 0, 0); PG8_LDB(B1, 0, 1); PG8_SCHED; PG8_LDA(At, 0, 0); PG8_STAGE(PG8_SA(1, 1), a1 + hstepA, voffA);
            PG8_WAIT_V(8); PG8_WAIT_L(0); PG8_BAR; PG8_MMA(0, 0, At, B0); PG8_MMA(0, 1, At, B1); PG8_BAR; PG8_SCHED;
            PG8_LDA(At, 0, 1); PG8_STAGE(PG8_SB(0, 0), b2, voffB); PG8_STAGE(PG8_SB(0, 1), b2 + hstepB, voffB); PG8_STAGE(PG8_SA(0, 0), a2, voffA);
            PG8_WAIT_V(8); PG8_WAIT_L(0); PG8_BAR; PG8_MMA(1, 0, At, B0); PG8_MMA(1, 1, At, B1); PG8_BAR; PG8_SCHED;
            PG8_LDB(B0, 1, 0); PG8_LDB(B1, 1, 1); PG8_SCHED; PG8_LDA(At, 1, 0); PG8_STAGE(PG8_SA(0, 1), a2 + hstepA, voffA);
            PG8_WAIT_V(8); PG8_WAIT_L(0); PG8_BAR; PG8_MMA(0, 0, At, B0); PG8_MMA(0, 1, At, B1); PG8_BAR; PG8_SCHED;
            PG8_LDA(At, 1, 1); PG8_STAGE(PG8_SB(1, 0), b3, voffB); PG8_STAGE(PG8_SB(1, 1), b3 + hstepB, voffB); PG8_STAGE(PG8_SA(1, 0), a3, voffA);
            PG8_WAIT_V(8); PG8_WAIT_L(0); PG8_BAR; PG8_MMA(1, 0, At, B0); PG8_MMA(1, 1, At, B1); PG8_BAR; PG8_SCHED;
        }
        if (wr == 0) PG8_BAR;
        E(acc, cur, wr, wc); S.done(cur);
        if (!has_next) break;
#pragma unroll
        for (int a = 0; a < 2; ++a)
#pragma unroll
            for (int b = 0; b < 2; ++b)
#pragma unroll
                for (int m = 0; m < 4; ++m)
#pragma unroll
                    for (int n = 0; n < 2; ++n) acc[a][b][m][n] = (f32x4){0.f, 0.f, 0.f, 0.f};
        cur = nxt; cA = nA; cB = nB; ++ui;
        if (wr == 1) PG8_BAR;
    }
    PG8_WAIT_V(0);
    PG8_BAR;
#undef PG8_SA
#undef PG8_SB
#undef PG8_STAGE
#undef PG8_LDA
#undef PG8_LDB
#undef PG8_MMA
#undef PG8_WAIT_V
#undef PG8_WAIT_L
#undef PG8_BAR
#undef PG8_SCHED
}
}

constexpr int NWAVES = 8;
constexpr int D = 1024, BATCH = 4, SEQ = 4096, NMETA = 16, DFF = 2816, DCONV = 512, CWID = 31, DSSM = 512, HG = 16, NG = 32, PS = 64;
constexpr int DIN = 2 * DCONV + DSSM + 2 * D;
constexpr int M = BATCH * SEQ;
constexpr int NCH = M / 16;
constexpr int UXK = 384;
constexpr float EPS = 1e-6f;
constexpr int PER_PHASE = 11;
constexpr int N_LAUNCHES = MK_N_LAUNCHES;

constexpr size_t MiB = 1u << 20;
constexpr size_t WS_CTL = 0, CTL_ZERO_BYTES = 1 * MiB;
constexpr size_t WS_BS2 = 1 * MiB;
constexpr size_t WS_WSI = 7 * MiB;
constexpr size_t WS_SMALL = 9 * MiB;
constexpr size_t WS_LAMC = WS_SMALL;
constexpr size_t WS_SMETA = WS_SMALL + 16384;
constexpr size_t WS_SS0 = WS_SMALL + 32768;
constexpr size_t WS_HIDM = WS_SMALL + 32768 + 4 * 65536;
constexpr size_t WS_H1M = WS_HIDM + 16 * DFF * 4;
constexpr size_t WS_W13A = 11 * MiB, WS_W2A = 22 * MiB, WS_WIN = 28 * MiB, WS_WCAT = 35 * MiB, WS_WOUT = 38 * MiB, WS_W13B = 40 * MiB, WS_W2B = 51 * MiB;
constexpr size_t WS_AB = 57 * MiB;
constexpr size_t WS_H1 = 89 * MiB;
constexpr size_t WS_HID = 153 * MiB;
constexpr size_t WS_Z = WS_HID;
constexpr size_t WS_UX = WS_HID + 17 * MiB;
constexpr size_t WS_ZC = WS_HID + 42 * MiB;
constexpr size_t WS_Y = WS_HID + 58 * MiB;
constexpr size_t WS_MC = WS_HID;
constexpr size_t WS_S = WS_HID + 74 * MiB;
constexpr size_t WS_END = 256 * MiB;
static_assert(WS_H1M + 16 * D * 4 <= WS_W13A, "small tables");
static_assert(WS_W2B + (size_t)D * DFF * 2 <= WS_AB && WS_AB + (size_t)M * D * 2 <= WS_H1 && WS_H1 + (size_t)M * D * 4 <= WS_HID, "ws map 1");
static_assert(WS_Z + (size_t)(M + 16) * DCONV * 2 <= WS_UX && WS_UX + (size_t)NG * (NCH + 1) * UXK * 2 <= WS_ZC && WS_ZC + (size_t)M * DCONV * 2 <= WS_Y && WS_Y + (size_t)M * DSSM * 2 <= WS_S, "ws map 2");
static_assert(WS_MC + (size_t)M * D * 2 <= WS_ZC, "MC overlay");
static_assert(WS_HID + (size_t)M * DFF * 2 <= WS_END && WS_S + (size_t)NCH * NG * 128 * 4 <= WS_END, "ws end");
static_assert(WS_W13A + (size_t)2 * DFF * D * 2 <= WS_W2A && WS_W2A + (size_t)D * DFF * 2 <= WS_WIN && WS_WIN + (size_t)DIN * D * 2 <= WS_WCAT && WS_WCAT + (size_t)3072 * 512 * 2 <= WS_WOUT && WS_WOUT + (size_t)D * D * 2 <= WS_W13B && WS_W13B + (size_t)2 * DFF * D * 2 <= WS_W2B, "weights");
static_assert(WS_BS2 + (size_t)NG * 256 * UXK * 2 <= WS_WSI && WS_WSI + (size_t)NG * 128 * 256 * 2 <= WS_SMALL, "ssm mats");
constexpr int CW_BAR = 4096;

constexpr int RING_OFF = 0, RING_BYTES = 131072;
constexpr int LDSCTL_OFF = RING_BYTES, MISC_OFF = LDSCTL_OFF + 320;
constexpr int LDS_BYTES = 147456;

#define GAS __attribute__((address_space(1)))
#define LAS __attribute__((address_space(3)))
typedef unsigned short bf16;
typedef unsigned v4u __attribute__((ext_vector_type(4)));
typedef unsigned v2u __attribute__((ext_vector_type(2)));
typedef float f32x4 __attribute__((ext_vector_type(4)));
typedef float f32x2 __attribute__((ext_vector_type(2)));
typedef short bf16x8 __attribute__((ext_vector_type(8)));
typedef GAS unsigned gu32;
#define RLX_AGENT __ATOMIC_RELAXED, __HIP_MEMORY_SCOPE_AGENT
#define LDS_WAIT() asm volatile("s_waitcnt lgkmcnt(0)" ::: "memory")
#define VM_WAIT() asm volatile("s_waitcnt vmcnt(0)" ::: "memory")
__device__ __forceinline__ unsigned f2bf(float f) { unsigned u = __builtin_bit_cast(unsigned, f); return (u + 0x7fffu + ((u >> 16) & 1u)) >> 16; }
__device__ __forceinline__ unsigned pk2(float lo, float hi) { return f2bf(lo) | (f2bf(hi) << 16); }
__device__ __forceinline__ float bf2f(unsigned h) { return __builtin_bit_cast(float, h << 16); }
__device__ __forceinline__ float fsigmoid(float x) { return __builtin_amdgcn_rcpf(1.f + __builtin_amdgcn_exp2f(-1.44269504089f * x)); }
__device__ __forceinline__ float fsilu(float x) { return x * fsigmoid(x); }
__device__ __forceinline__ float fgelu_tanh(float x) { return x * fsigmoid(1.5957691216f * (x + 0.044715f * x * x * x)); }
__device__ __forceinline__ float wave_sum(float v) {
#pragma unroll
    for (int o = 1; o < 64; o <<= 1) v += __shfl_xor(v, o);
    return v;
}

#define XB_TMO      128
#define XB_XCNT(j)  (256  + 64 * (j))
#define XB_XSUB(j)  (1280 + 64 * (j))
#define XB_XGEN(j)  (2304 + 64 * (j))
#define XB_TOP      3328
#define XB_TOPGEN   3392
#define XCD_BAR_WORDS 3456
#define XB_SPIN_CAP (1u << 18)
__device__ __forceinline__ unsigned xb_ld(unsigned* p)              { return __hip_atomic_load(p, __ATOMIC_RELAXED, __HIP_MEMORY_SCOPE_AGENT); }
__device__ __forceinline__ unsigned xb_add(unsigned* p, unsigned v) { return __hip_atomic_fetch_add(p, v, __ATOMIC_RELAXED, __HIP_MEMORY_SCOPE_AGENT); }
__device__ __forceinline__ unsigned xb_xcc_id() { return (unsigned)__builtin_amdgcn_s_getreg((3 << 11) | 20) & 0xFu; }
#define XB_SPIN(cond, bar) do { unsigned _sp = 0; while (cond) { __builtin_amdgcn_s_sleep(1); \
    if ((++_sp & 255u) == 0u) { if (xb_ld(&(bar)[XB_TMO])) break; if (_sp > XB_SPIN_CAP) { atomicAdd(&(bar)[XB_TMO], 1u); break; } } } } while (0)
struct XcdBarrier { unsigned* bar; unsigned x; volatile LAS unsigned* st; };
__device__ __forceinline__ XcdBarrier xcd_barrier_post(unsigned* bar, volatile LAS unsigned* st) {
    XcdBarrier b; b.bar = bar; b.x = xb_xcc_id(); b.st = st;
    if (threadIdx.x == 0) (void)xb_add(&bar[XB_XCNT(b.x)], 1u);
    return b;
}
__device__ __forceinline__ void xcd_barrier_complete(unsigned* bar, unsigned x, unsigned& nloc, unsigned& nx) {
    const unsigned G = gridDim.x * gridDim.y * gridDim.z;
    unsigned sum, cnt, mine, sp = 0u;
    for (;;) {
        sum = 0u; cnt = 0u; mine = 0u;
#pragma unroll
        for (unsigned j = 0; j < 16; ++j) { const unsigned c = xb_ld(&bar[XB_XCNT(j)]); sum += c; cnt += (c > 0u) ? 1u : 0u; mine = (j == x) ? c : mine; }
        if (sum == G) break;
        __builtin_amdgcn_s_sleep(1);
        if ((++sp & 255u) == 0u) { if (xb_ld(&bar[XB_TMO])) break; if (sp > XB_SPIN_CAP) { atomicAdd(&bar[XB_TMO], 1u); break; } }
    }
    nloc = mine > 0u ? mine : 1u; nx = cnt > 0u ? cnt : 1u;
}
__device__ __forceinline__ void xcd_barrier(const XcdBarrier& b) {
    asm volatile("s_waitcnt vmcnt(0)" ::: "memory");
    __syncthreads();
    if (threadIdx.x == 0) {
        unsigned* bar = b.bar;
        __builtin_amdgcn_s_waitcnt(0);
        unsigned nloc = b.st[0], nx = b.st[1];
        if (nloc == 0u) { xcd_barrier_complete(bar, b.x, nloc, nx); b.st[0] = nloc; b.st[1] = nx; }
        const unsigned old = xb_add(&bar[XB_XSUB(b.x)], 1u);
        const unsigned gen = old / nloc;
        if (old + 1u == (gen + 1u) * nloc) {
            __builtin_amdgcn_fence(__ATOMIC_RELEASE, "agent");
            asm volatile("s_waitcnt vmcnt(0)" ::: "memory");
            const unsigned og = xb_add(&bar[XB_TOP], 1u);
            const unsigned tg = og / nx;
            if (og + 1u == (tg + 1u) * nx) xb_add(&bar[XB_TOPGEN], 1u);
            else XB_SPIN(xb_ld(&bar[XB_TOPGEN]) == tg, bar);
            __builtin_amdgcn_fence(__ATOMIC_ACQUIRE, "agent");
            xb_add(&bar[XB_XGEN(b.x)], 1u);
            asm volatile("s_waitcnt vmcnt(0)" ::: "memory");
        } else {
            XB_SPIN(xb_ld(&bar[XB_XGEN(b.x)]) == gen, bar);
            __builtin_amdgcn_fence(__ATOMIC_ACQUIRE, "agent");
            asm volatile("s_waitcnt vmcnt(0)" ::: "memory");
        }
    }
    __syncthreads();
}

struct Args { const float* in[30]; float* out; unsigned char* ws; int ph_lo, ph_hi, li, pad; };
struct Frame {
    LAS unsigned char* lds; volatile LAS unsigned* MISC; gu32* ctl;
    int tid, lane, wave, vcu, G;
    float* out; unsigned char* ws;
};
enum { I_X = 0, I_META, I_F1N, I_F1W1, I_F1W3, I_F1W2, I_MIXN, I_WIN, I_BGATE, I_DW, I_DWB, I_LNG, I_LNB, I_CPROJ, I_LRE, I_LIM, I_LDT, I_BRE, I_BIM, I_CRE, I_CIM, I_SD, I_WV, I_WG, I_WOUT, I_F2N, I_F2W1, I_F2W3, I_F2W2, I_FINN };

using pg8::Unit; using pg8::cvt_pk_bf16;
__device__ __forceinline__ v4u pack8(const f32x4 a, const f32x4 b) { v4u w; w.x = cvt_pk_bf16(a[0], a[1]); w.y = cvt_pk_bf16(a[2], a[3]); w.z = cvt_pk_bf16(b[0], b[1]); w.w = cvt_pk_bf16(b[2], b[3]); return w; }
__device__ __forceinline__ void unpack8(const v4u w, float (&o)[8]) { o[0] = bf2f(w.x & 0xffffu); o[1] = bf2f(w.x >> 16); o[2] = bf2f(w.y & 0xffffu); o[3] = bf2f(w.y >> 16); o[4] = bf2f(w.z & 0xffffu); o[5] = bf2f(w.z >> 16); o[6] = bf2f(w.w & 0xffffu); o[7] = bf2f(w.w >> 16); }
__device__ __forceinline__ float rs_of(const float* SS, int row) { return 1.0f / sqrtf(SS[row] * (1.0f / D) + EPS); }

struct EpiSwiglu {
    bf16* HID; const float* SS;
    __device__ __forceinline__ void operator()(const f32x4 (&acc)[2][2][4][2], const Unit& u, int wr, int wc) const {
        const int lane_ = lane_id_opaque(), fr = lane_ & 15, fq = lane_ >> 4;
        const int row0 = u.pm * 256 + wr * 64 + fr, col0 = u.pn * 128 + wc * 32 + 8 * fq;
#pragma unroll
        for (int ai = 0; ai < 2; ++ai)
#pragma unroll
            for (int m = 0; m < 4; ++m) { const int row = row0 + ai * 128 + m * 16; const float rs = rs_of(SS, row);
                f32x4 o0, o1;
#pragma unroll
                for (int j = 0; j < 4; ++j) { o0[j] = fsilu(acc[ai][0][m][0][j] * rs) * (acc[ai][1][m][0][j] * rs); o1[j] = fsilu(acc[ai][0][m][1][j] * rs) * (acc[ai][1][m][1][j] * rs); }
                *(v4u*)(HID + (size_t)row * DFF + col0) = pack8(o0, o1); }
    }
};
struct EpiResid {
    const float* R; float* OUT; bf16* OB; float* SS; float alpha;
    __device__ __forceinline__ void operator()(const f32x4 (&acc)[2][2][4][2], const Unit& u, int wr, int wc) const {
        const int lane_ = lane_id_opaque(), fr = lane_ & 15, fq = lane_ >> 4;
        const int row0 = u.pm * 256 + wr * 64 + fr, col0 = u.pn * 256 + wc * 32 + 8 * fq;
#pragma unroll
        for (int ai = 0; ai < 2; ++ai)
#pragma unroll
            for (int m = 0; m < 4; ++m) { const int row = row0 + ai * 128 + m * 16; float ss = 0.f;
#pragma unroll
                for (int bj = 0; bj < 2; ++bj) { const size_t off = (size_t)row * D + col0 + bj * 128;
                    const f32x4 r0 = *(const f32x4*)(R + off), r1 = *(const f32x4*)(R + off + 4);
                    const f32x4 o0 = r0 + acc[ai][bj][m][0] * alpha, o1 = r1 + acc[ai][bj][m][1] * alpha;
                    *(f32x4*)(OUT + off) = o0; *(f32x4*)(OUT + off + 4) = o1;
                    if (OB) *(v4u*)(OB + off) = pack8(o0, o1);
                    ss += (o0[0] * o0[0] + o0[1] * o0[1]) + (o0[2] * o0[2] + o0[3] * o0[3]) + (o1[0] * o1[0] + o1[1] * o1[1]) + (o1[2] * o1[2] + o1[3] * o1[3]); }
                ss += __shfl_xor(ss, 16); ss += __shfl_xor(ss, 32);
                if (fq == 0) atomicAdd(SS + row, ss); }
    }
};
struct EpiMix {
    const float* SS; bf16* Z; bf16* UX; bf16* G; const float* bgate;
    __device__ __forceinline__ void operator()(const f32x4 (&acc)[2][2][4][2], const Unit& u, int wr, int wc) const {
        const int lane_ = lane_id_opaque(), fr = lane_ & 15, fq = lane_ >> 4;
        const int row0 = u.pm * 256 + wr * 64 + fr;
        if (u.pn < 4) {
            const int col0 = u.pn * 128 + wc * 32 + 8 * fq;
#pragma unroll
            for (int ai = 0; ai < 2; ++ai)
#pragma unroll
                for (int m = 0; m < 4; ++m) { const int row = row0 + ai * 128 + m * 16; const float rs = rs_of(SS, row); f32x4 o0, o1;
#pragma unroll
                    for (int j = 0; j < 4; ++j) { o0[j] = (acc[ai][0][m][0][j] * rs) * fsigmoid(acc[ai][1][m][0][j] * rs); o1[j] = (acc[ai][0][m][1][j] * rs) * fsigmoid(acc[ai][1][m][1][j] * rs); }
                    *(v4u*)(Z + (size_t)row * DCONV + col0) = pack8(o0, o1); }
        } else if (u.pn < 6) {
#pragma unroll
            for (int ai = 0; ai < 2; ++ai)
#pragma unroll
                for (int m = 0; m < 4; ++m) { const int row = row0 + ai * 128 + m * 16; const float rs = rs_of(SS, row); const int ci = row >> 4, tt = row & 15;
#pragma unroll
                    for (int bj = 0; bj < 2; ++bj) { const int c = (u.pn - 4) * 256 + bj * 128 + wc * 32 + 8 * fq, g = c >> 4, h0 = c & 15;
                        *(v4u*)(UX + ((size_t)(g * (NCH + 1) + ci) * UXK + tt * 16 + h0)) = pack8(acc[ai][bj][m][0] * rs, acc[ai][bj][m][1] * rs); } }
        } else {
#pragma unroll
            for (int bj = 0; bj < 2; ++bj) { const int c = (u.pn - 6) * 256 + bj * 128 + wc * 32 + 8 * fq;
                const f32x4 b0 = *(const f32x4*)(bgate + c), b1 = *(const f32x4*)(bgate + c + 4);
#pragma unroll
                for (int ai = 0; ai < 2; ++ai)
#pragma unroll
                    for (int m = 0; m < 4; ++m) { const int row = row0 + ai * 128 + m * 16; const float rs = rs_of(SS, row); f32x4 o0, o1;
#pragma unroll
                        for (int j = 0; j < 4; ++j) { o0[j] = fsigmoid(acc[ai][bj][m][0][j] * rs + b0[j]); o1[j] = fsigmoid(acc[ai][bj][m][1][j] * rs + b1[j]); }
                        *(v4u*)(G + (size_t)row * 2048 + c) = pack8(o0, o1); } }
        }
    }
};
struct EpiSsmY {
    const bf16* UX; const float* dskip; bf16* Y;
    __device__ __forceinline__ void operator()(const f32x4 (&acc)[2][2][4][2], const Unit& u, int wr, int wc) const {
        const int lane_ = lane_id_opaque(), fr = lane_ & 15, fq = lane_ >> 4;
        const int b = u.pm, g = u.pn, h0 = 8 * (fq & 1);
        const f32x4 d0 = *(const f32x4*)(dskip + g * 16 + h0), d1 = *(const f32x4*)(dskip + g * 16 + h0 + 4);
#pragma unroll
        for (int ai = 0; ai < 2; ++ai)
#pragma unroll
            for (int m = 0; m < 4; ++m) { const int r = ai * 128 + wr * 64 + m * 16 + fr;
#pragma unroll
                for (int bj = 0; bj < 2; ++bj) { const int tt = 8 * bj + 2 * wc + (fq >> 1);
                    float uu[8]; unpack8(*(const v4u*)(UX + ((size_t)(g * (NCH + 1) + b * 256 + r) * UXK + tt * 16 + h0)), uu);
                    f32x4 o0, o1;
#pragma unroll
                    for (int j = 0; j < 4; ++j) { o0[j] = fgelu_tanh(acc[ai][bj][m][0][j] + d0[j] * uu[j]); o1[j] = fgelu_tanh(acc[ai][bj][m][1][j] + d1[j] * uu[4 + j]); }
                    *(v4u*)(Y + ((size_t)(b * SEQ + r * 16 + tt) * DSSM + g * 16 + h0)) = pack8(o0, o1); }
                asm volatile("" ::: "memory"); }
    }
};
struct EpiMerge {
    const bf16* G; bf16* MC; bf16* MG;
    __device__ __forceinline__ void operator()(const f32x4 (&acc)[2][2][4][2], const Unit& u, int wr, int wc) const {
        const int lane_ = lane_id_opaque(), fr = lane_ & 15, fq = lane_ >> 4;
        const int row0 = u.pm * 256 + wr * 64 + fr;
        if (u.kind == 0) {
#pragma unroll
            for (int ai = 0; ai < 2; ++ai)
#pragma unroll
                for (int m = 0; m < 4; ++m) { const int row = row0 + ai * 128 + m * 16;
#pragma unroll
                    for (int bj = 0; bj < 2; ++bj) { const int c = u.pn * 256 + bj * 128 + wc * 32 + 8 * fq;
                        float gg[8]; unpack8(*(const v4u*)(G + (size_t)row * 2048 + c), gg); f32x4 o0, o1;
#pragma unroll
                        for (int j = 0; j < 4; ++j) { o0[j] = gg[j] * acc[ai][bj][m][0][j]; o1[j] = gg[4 + j] * acc[ai][bj][m][1][j]; }
                        *(v4u*)(MC + (size_t)row * D + c) = pack8(o0, o1); } }
        } else {
            const int c = u.pn * 256 + (u.kind - 1) * 128 + wc * 32 + 8 * fq;
#pragma unroll
            for (int ai = 0; ai < 2; ++ai)
#pragma unroll
                for (int m = 0; m < 4; ++m) { const int row = row0 + ai * 128 + m * 16;
                    float gg[8], mc[8]; unpack8(*(const v4u*)(G + (size_t)row * 2048 + D + c), gg); unpack8(*(const v4u*)(MC + (size_t)row * D + c), mc); f32x4 o0, o1;
#pragma unroll
                    for (int j = 0; j < 4; ++j) { o0[j] = mc[j] + gg[j] * (acc[ai][0][m][0][j] * fsigmoid(acc[ai][1][m][0][j])); o1[j] = mc[4 + j] + gg[4 + j] * (acc[ai][0][m][1][j] * fsigmoid(acc[ai][1][m][1][j])); }
                    *(v4u*)(MG + (size_t)row * D + c) = pack8(o0, o1); }
        }
    }
};
struct SsmOrder {
    int G, c; const char* UX; const char* BS2;
    __device__ __forceinline__ bool next(int i, Unit& u) const { const int L = i * G + c; if (L >= BATCH * NG) return false; const int b = L / NG, g = L % NG; u.pm = b; u.pn = g; u.kind = 0;
        u.A = UX + ((size_t)(g * (NCH + 1) + b * 256) * UXK) * 2; u.B = BS2 + (size_t)g * 256 * UXK * 2; return true; }
    __device__ __forceinline__ void a_ready(const Unit&) const {}
    __device__ __forceinline__ void done(const Unit&) const {}
};
struct MergeOrder {
    int G, c; const char* ZC; const char* Y; const char* WCAT;
    __device__ __forceinline__ bool next(int i, Unit& u) const { int pm, pn; const int su = i / 3, k = i - 3 * su; if (!pg8::static_tile(su, G, c, M / 256, D / 256, pm, pn)) return false; u.pm = pm; u.pn = pn; u.kind = k;
        u.A = (k == 0 ? ZC : Y) + (size_t)pm * 256 * 512 * 2; u.B = WCAT + (size_t)(k == 0 ? pn * 256 : 1024 + (2 * pn + k - 1) * 256) * 512 * 2; return true; }
    __device__ __forceinline__ void a_ready(const Unit&) const {}
    __device__ __forceinline__ void done(const Unit& u) const { if (u.kind == 0) asm volatile("s_waitcnt vmcnt(0)" ::: "memory"); }
};

__device__ __forceinline__ void p0_transpose_item(const float* W, int K, int N, bf16* WT, const float* gain, LAS float* scr, int k0, int n0, int drow0, int lane) {
#pragma unroll 8
    for (int i = 0; i < 32; ++i) { const int kk = 2 * i + (lane >> 5); float v = W[(size_t)(k0 + kk) * N + n0 + (lane & 31)]; if (gain) v *= gain[k0 + kk]; scr[kk * 33 + (lane & 31)] = v; }
    LDS_WAIT(); asm volatile("" ::: "memory");
    const int c = lane & 7;
#pragma unroll
    for (int j = 0; j < 4; ++j) { const int n = (lane >> 3) + 8 * j; const LAS float* s = scr + (8 * c) * 33 + n;
        v4u o; o.x = pk2(s[0 * 33], s[1 * 33]); o.y = pk2(s[2 * 33], s[3 * 33]); o.z = pk2(s[4 * 33], s[5 * 33]); o.w = pk2(s[6 * 33], s[7 * 33]);
        *(GAS v4u*)(WT + (size_t)(drow0 + n) * K + k0 + 8 * c) = o; }
    LDS_WAIT(); asm volatile("" ::: "memory");
}
__device__ __forceinline__ int glu_row(int n) { return 256 * (n >> 7) + (n & 127); }

__device__ __forceinline__ void ssm_prep_job(Frame& F, const Args& args, int g) {
    LAS f32x2* lamP = (LAS f32x2*)(F.lds + RING_OFF);
    LAS f32x2* Bb = lamP + 17 * 64;
    LAS f32x2* Cc = Bb + 64 * 16;
    LAS float* Kk = (LAS float*)(Cc + 16 * 64);
    const float* lam_re = args.in[I_LRE]; const float* lam_im = args.in[I_LIM]; const float* log_dt = args.in[I_LDT];
    const float* b_re = args.in[I_BRE]; const float* b_im = args.in[I_BIM]; const float* c_re = args.in[I_CRE]; const float* c_im = args.in[I_CIM];
    const int tid = F.tid;
    const float dt = expf(log_dt[g]);
    if (tid < 64) { const int p = tid; const float a = lam_re[g * PS + p] * dt, bb = lam_im[g * PS + p] * dt, ea = expf(a), sb = sinf(bb), cb = cosf(bb);
        const float lx = ea * cb, ly = ea * sb; float px = 1.f, py = 0.f;
        for (int k = 0; k <= 16; ++k) { lamP[k * 64 + p] = (f32x2){px, py}; const float nx = px * lx - py * ly, ny = px * ly + py * lx; px = nx; py = ny; } }
    for (int i = tid; i < 1024; i += 512) { const int p = i >> 4;
        const float lr = lam_re[g * PS + p], li = lam_im[g * PS + p], a = lr * dt, bb = li * dt, ea = expf(a), sb = sinf(bb), cb = cosf(bb), sh = sinf(0.5f * bb);
        const float nr = expm1f(a) * cb - 2.f * sh * sh, ni = ea * sb, den = 1.f / (lr * lr + li * li), fr_ = (nr * lr + ni * li) * den, fi_ = (ni * lr - nr * li) * den;
        const float br = b_re[(size_t)g * 1024 + i], bi = b_im[(size_t)g * 1024 + i];
        Bb[i] = (f32x2){fr_ * br - fi_ * bi, fr_ * bi + fi_ * br};
        Cc[i] = (f32x2){c_re[(size_t)g * 1024 + i], c_im[(size_t)g * 1024 + i]}; }
    __syncthreads();
    for (int o = tid; o < 4096; o += 512) { const int k = o >> 8, h = (o >> 4) & 15, hp = o & 15; float s = 0.f;
        for (int p = 0; p < 64; ++p) { const f32x2 c = Cc[h * 64 + p], l = lamP[k * 64 + p], b = Bb[p * 16 + hp]; const float tr = l.x * b.x - l.y * b.y, ti = l.x * b.y + l.y * b.x; s += c.x * tr - c.y * ti; }
        Kk[o] = s; }
    __syncthreads();
    GAS unsigned* bs2 = (GAS unsigned*)(F.ws + WS_BS2) + (size_t)g * 256 * (UXK / 2);
    for (int i = tid; i < 256 * (UXK / 2); i += 512) { const int n = i / (UXK / 2), kp = (i % (UXK / 2)) * 2, t = n >> 4, h = n & 15; float v0, v1;
        if (kp < 256) { const int s = kp >> 4, hp = kp & 15; const bool on = s <= t; const int kb = (((t - s) & 15) << 8) + (h << 4) + hp; v0 = on ? Kk[kb] : 0.f; v1 = on ? Kk[kb + 1] : 0.f; }
        else { const int p = (kp - 256) >> 1; const f32x2 c = Cc[h * 64 + p], l = lamP[(t + 1) * 64 + p]; v0 = c.x * l.x - c.y * l.y; v1 = -(c.x * l.y + c.y * l.x); }
        bs2[i] = pk2(v0, v1); }
    GAS unsigned* wsi = (GAS unsigned*)(F.ws + WS_WSI) + (size_t)g * 128 * 128;
    for (int i = tid; i < 128 * 128; i += 512) { const int n = i >> 7, kp = (i & 127) * 2, p = n >> 1, c = n & 1, s = kp >> 4, h = kp & 15;
        const f32x2 l = lamP[(15 - s) * 64 + p], b0 = Bb[p * 16 + h], b1 = Bb[p * 16 + h + 1];
        const float v0 = c ? (l.x * b0.y + l.y * b0.x) : (l.x * b0.x - l.y * b0.y), v1 = c ? (l.x * b1.y + l.y * b1.x) : (l.x * b1.x - l.y * b1.y);
        wsi[i] = pk2(v0, v1); }
    if (tid < 64) ((GAS f32x2*)(F.ws + WS_LAMC))[g * 64 + tid] = lamP[16 * 64 + tid];
    __syncthreads();
}

template <int NS, bool NORM, class Fn>
__device__ __forceinline__ void meta_job(Frame& F, const float* A, int K, const float* gain, const float* W0, const float* W1, int ldw, const Fn& fn) {
    LAS float* red = (LAS float*)(F.lds + RING_OFF);
    LAS float* rsc = red + 8 * 16 * 32;
    const int lane = F.lane, w = F.wave, r = lane & 15, kq = lane >> 4;
    if (NORM) {
#pragma unroll
        for (int rr = 0; rr < 2; ++rr) { const int row = 2 * w + rr; float s = 0.f; for (int c = lane; c < D; c += 64) { const float v = A[(size_t)row * K + c]; s += v * v; } s = wave_sum(s); if (lane == 0) rsc[row] = 1.0f / sqrtf(s * (1.0f / D) + EPS); }
    } else if (F.tid < 16) rsc[F.tid] = 1.f;
    float acc[NS][16];
#pragma unroll
    for (int s = 0; s < NS; ++s)
#pragma unroll
        for (int j = 0; j < 16; ++j) acc[s][j] = 0.f;
    const int kw = K / 8, kbase = w * kw;
#pragma unroll 2
    for (int i = 0; i < kw / 4; ++i) { const int k = kbase + 4 * i + kq; float a = A[(size_t)r * K + k]; if (gain) a *= gain[k];
#pragma unroll
        for (int s = 0; s < NS; ++s) { const float* wp = (s == 0 ? W0 : W1) + (size_t)k * ldw;
#pragma unroll
            for (int q = 0; q < 4; ++q) { const f32x4 wv = *(const f32x4*)(wp + 4 * q);
#pragma unroll
                for (int j = 0; j < 4; ++j) acc[s][4 * q + j] += a * wv[j]; } } }
#pragma unroll
    for (int s = 0; s < NS; ++s)
#pragma unroll
        for (int j = 0; j < 16; ++j) { float v = acc[s][j]; v += __shfl_xor(v, 16); v += __shfl_xor(v, 32); if (kq == 0) red[(w * 16 + r) * 32 + s * 16 + j] = v; }
    __syncthreads();
    if (F.tid < 256) { const int rr = F.tid >> 4, j = F.tid & 15; float v0 = 0.f, v1 = 0.f;
#pragma unroll
        for (int ww = 0; ww < 8; ++ww) { v0 += red[(ww * 16 + rr) * 32 + j]; if (NS > 1) v1 += red[(ww * 16 + rr) * 32 + 16 + j]; }
        const float sc = rsc[rr]; fn(rr, j, v0 * sc, v1 * sc); }
    __syncthreads();
}

__device__ __forceinline__ void ssm_statein_job(Frame& F, int g, int cb) {
    const int lane = F.lane, w = F.wave, fr = lane & 15, fq = lane >> 4;
    const bf16* UX = (const bf16*)(F.ws + WS_UX); const bf16* Wb = (const bf16*)(F.ws + WS_WSI) + (size_t)g * 128 * 256;
    float* S = (float*)(F.ws + WS_S);
    const int ci0 = 256 * cb + 32 * w;
    const bf16* Ab = UX + (size_t)(g * (NCH + 1) + ci0) * UXK;
    f32x4 acc[2][8];
#pragma unroll
    for (int mt = 0; mt < 2; ++mt)
#pragma unroll
        for (int nt = 0; nt < 8; ++nt) acc[mt][nt] = (f32x4){0.f, 0.f, 0.f, 0.f};
#pragma unroll 2
    for (int ks = 0; ks < 8; ++ks) { bf16x8 a[2], b[8];
#pragma unroll
        for (int mt = 0; mt < 2; ++mt) a[mt] = *(const bf16x8*)(Ab + (size_t)(16 * mt + fr) * UXK + 32 * ks + 8 * fq);
#pragma unroll
        for (int nt = 0; nt < 8; ++nt) b[nt] = *(const bf16x8*)(Wb + (size_t)(16 * nt + fr) * 256 + 32 * ks + 8 * fq);
#pragma unroll
        for (int mt = 0; mt < 2; ++mt)
#pragma unroll
            for (int nt = 0; nt < 8; ++nt) acc[mt][nt] = __builtin_amdgcn_mfma_f32_16x16x32_bf16(b[nt], a[mt], acc[mt][nt], 0, 0, 0); }
#pragma unroll
    for (int mt = 0; mt < 2; ++mt)
#pragma unroll
        for (int nt = 0; nt < 8; ++nt) *(f32x4*)(S + ((size_t)(ci0 + 16 * mt + fr) * NG + g) * 128 + 16 * nt + 4 * fq) = acc[mt][nt];
    if (cb == 0 && w == 0) {
        const bf16* Am = UX + (size_t)(g * (NCH + 1) + NCH) * UXK; f32x4 am[8];
#pragma unroll
        for (int nt = 0; nt < 8; ++nt) am[nt] = (f32x4){0.f, 0.f, 0.f, 0.f};
#pragma unroll 2
        for (int ks = 0; ks < 8; ++ks) { const bf16x8 a = *(const bf16x8*)(Am + 32 * ks + 8 * fq);
#pragma unroll
            for (int nt = 0; nt < 8; ++nt) { const bf16x8 b = *(const bf16x8*)(Wb + (size_t)(16 * nt + fr) * 256 + 32 * ks + 8 * fq); am[nt] = __builtin_amdgcn_mfma_f32_16x16x32_bf16(b, a, am[nt], 0, 0, 0); } }
        if (fr == 0) {
#pragma unroll
            for (int nt = 0; nt < 8; ++nt) *(f32x4*)((float*)(F.ws + WS_SMETA) + g * 128 + 16 * nt + 4 * fq) = am[nt]; }
    }
}

__device__ __forceinline__ void conv_job(Frame& F, const Args& args, int jt) {
    LAS unsigned char* zs = F.lds + RING_OFF;
    LAS float* cs = (LAS float*)(F.lds + RING_OFF + 62 * 1024);
    const bf16* Z = (const bf16*)(F.ws + WS_Z); bf16* ZC = (bf16*)(F.ws + WS_ZC);
    const int tid = F.tid, row0 = 32 * jt, b = row0 / SEQ, t0 = row0 % SEQ;
    for (int i = tid; i < 62 * 64; i += 512) { const int ri = i >> 6, cb = (i & 63) * 16, ti = t0 - 30 + ri; v4u v = (v4u){0u, 0u, 0u, 0u};
        if (ti >= 0) v = *(const v4u*)((const char*)Z + (size_t)(b * SEQ + ti) * 1024 + cb);
        else if (ti >= -NMETA) v = *(const v4u*)((const char*)Z + (size_t)(M + NMETA + ti) * 1024 + cb);
        *(LAS v4u*)(zs + ri * 1024 + cb) = v; }
    const int cp = tid & 255, th = tid >> 8;
    const float* dw = args.in[I_DW]; f32x2 wgt[CWID];
#pragma unroll
    for (int k = 0; k < CWID; ++k) wgt[k] = *(const f32x2*)(dw + k * DCONV + 2 * cp);
    const f32x2 bias = *(const f32x2*)(args.in[I_DWB] + 2 * cp);
    __syncthreads();
#pragma unroll 1
    for (int hf = 0; hf < 2; ++hf) {
        f32x2 acc[8];
#pragma unroll
        for (int t = 0; t < 8; ++t) acc[t] = bias;
        const LAS unsigned char* zb = zs + (16 * th + 8 * hf) * 1024 + 4 * cp;
#pragma unroll
        for (int i = 0; i < 38; ++i) { const unsigned zz = *(const LAS unsigned*)(zb + i * 1024); const float z0 = bf2f(zz & 0xffffu), z1 = bf2f(zz >> 16);
#pragma unroll
            for (int t = 0; t < 8; ++t) { const int k = i - t; if (k >= 0 && k < CWID) { acc[t].x += wgt[k].x * z0; acc[t].y += wgt[k].y * z1; } } }
#pragma unroll
        for (int t = 0; t < 8; ++t) *(LAS f32x2*)(cs + (16 * th + 8 * hf + t) * 512 + 2 * cp) = acc[t];
    }
    __syncthreads();
    const int lane = F.lane, w = F.wave;
    const f32x4 g0 = *(const f32x4*)(args.in[I_LNG] + 4 * lane), g1 = *(const f32x4*)(args.in[I_LNG] + 256 + 4 * lane), b0 = *(const f32x4*)(args.in[I_LNB] + 4 * lane), b1 = *(const f32x4*)(args.in[I_LNB] + 256 + 4 * lane);
#pragma unroll
    for (int q = 0; q < 4; ++q) { const int t = 4 * w + q; const f32x4 x0 = *(const LAS f32x4*)(cs + t * 512 + 4 * lane), x1 = *(const LAS f32x4*)(cs + t * 512 + 256 + 4 * lane);
        const float mu = wave_sum((x0[0] + x0[1]) + (x0[2] + x0[3]) + (x1[0] + x1[1]) + (x1[2] + x1[3])) * (1.f / DCONV);
        const f32x4 d0 = x0 - mu, d1 = x1 - mu;
        const float var = wave_sum((d0[0] * d0[0] + d0[1] * d0[1]) + (d0[2] * d0[2] + d0[3] * d0[3]) + (d1[0] * d1[0] + d1[1] * d1[1]) + (d1[2] * d1[2] + d1[3] * d1[3])) * (1.f / DCONV);
        const float rstd = 1.0f / sqrtf(var + EPS); f32x4 o0 = d0 * rstd * g0 + b0, o1 = d1 * rstd * g1 + b1;
#pragma unroll
        for (int j = 0; j < 4; ++j) { o0[j] = fsilu(o0[j]); o1[j] = fsilu(o1[j]); }
        bf16* zr = ZC + (size_t)(row0 + t) * DCONV;
        *(v2u*)(zr + 4 * lane) = (v2u){cvt_pk_bf16(o0[0], o0[1]), cvt_pk_bf16(o0[2], o0[3])}; *(v2u*)(zr + 256 + 4 * lane) = (v2u){cvt_pk_bf16(o1[0], o1[1]), cvt_pk_bf16(o1[2], o1[3])}; }
    __syncthreads();
}

__device__ __forceinline__ void ssm_scan_job(Frame& F, int b, int g) {
    LAS f32x2* Sl = (LAS f32x2*)(F.lds + RING_OFF);
    const float* S = (const float*)(F.ws + WS_S); bf16* UX = (bf16*)(F.ws + WS_UX);
    const int lane = F.lane, w = F.wave;
#pragma unroll 8
    for (int i = 0; i < 32; ++i) { const int ci = 32 * w + i; Sl[ci * 64 + lane] = *(const f32x2*)(S + ((size_t)(b * 256 + ci) * NG + g) * 128 + 2 * lane); }
    __syncthreads();
    if (w == 0) { const f32x2 lc = ((const f32x2*)(F.ws + WS_LAMC))[g * 64 + lane]; f32x2 x = *(const f32x2*)((const float*)(F.ws + WS_SMETA) + g * 128 + 2 * lane);
        unsigned* xp = (unsigned*)(UX + (size_t)(g * (NCH + 1) + b * 256) * UXK + 256) + lane;
#pragma unroll 8
        for (int ci = 0; ci < 256; ++ci) { xp[(size_t)ci * (UXK / 2)] = pk2(x.x, x.y); const f32x2 s = Sl[ci * 64 + lane]; const float nx = lc.x * x.x - lc.y * x.y + s.x, ny = lc.x * x.y + lc.y * x.x + s.y; x.x = nx; x.y = ny; }
        VM_WAIT(); }
    __syncthreads();
}

__global__ void __launch_bounds__(NWAVES * 64, 2) hyb_fwd(Args args) {
    extern __shared__ __attribute__((aligned(16))) unsigned char lds[];
    Frame F;
    F.lds = (LAS unsigned char*)lds; F.MISC = (volatile LAS unsigned*)(F.lds + MISC_OFF);
    F.wave = __builtin_amdgcn_readfirstlane((int)threadIdx.x >> 6); F.lane = lane_id_opaque(); F.tid = F.wave * 64 + F.lane;
    F.G = gridDim.x; { const int bx = blockIdx.x; F.vcu = (F.G % 8 == 0) ? (bx % 8) * (F.G / 8) + bx / 8 : bx; }
    F.ws = args.ws; F.out = args.out; F.ctl = (gu32*)(args.ws + WS_CTL);
    for (int u = F.tid; u < (LDS_BYTES - LDSCTL_OFF) / 4; u += NWAVES * 64) ((LAS unsigned*)(F.lds + LDSCTL_OFF))[u] = 0u;
    __syncthreads();
    const int bli = (N_LAUNCHES == PER_PHASE) ? 0 : args.li;
    XcdBarrier bar; bar.bar = (unsigned*)(F.ctl + CW_BAR) + bli * XCD_BAR_WORDS; bar.x = 0; bar.st = nullptr;
    if (N_LAUNCHES != PER_PHASE) bar = xcd_barrier_post((unsigned*)(F.ctl + CW_BAR) + bli * XCD_BAR_WORDS, F.MISC + 8);
    const int lo = args.ph_lo, hi = args.ph_hi;
#ifndef PHMASK
#define PHMASK 0x7ff
#endif
#define IN(k) (((PHMASK >> (k)) & 1) && lo <= (k) && (k) < hi)
#define SEAM(k) do { if (IN(k) && IN((k) + 1)) xcd_barrier(bar); F.lane = lane_id_opaque(); F.tid = F.wave * 64 + F.lane; } while (0)
    unsigned char* ws = F.ws;
    bf16* W13A = (bf16*)(ws + WS_W13A); bf16* W2A = (bf16*)(ws + WS_W2A); bf16* WIN = (bf16*)(ws + WS_WIN); bf16* WCAT = (bf16*)(ws + WS_WCAT); bf16* WOUT = (bf16*)(ws + WS_WOUT);
    bf16* W13B = (bf16*)(ws + WS_W13B); bf16* W2B = (bf16*)(ws + WS_W2B);
    bf16* AB = (bf16*)(ws + WS_AB); float* H1 = (float*)(ws + WS_H1); bf16* HID = (bf16*)(ws + WS_HID);
    bf16* Zb = (bf16*)(ws + WS_Z); bf16* UXb = (bf16*)(ws + WS_UX); bf16* ZCb = (bf16*)(ws + WS_ZC); bf16* Yb = (bf16*)(ws + WS_Y); bf16* MCb = (bf16*)(ws + WS_MC);
    float* SS0 = (float*)(ws + WS_SS0); float* SS1 = SS0 + M; float* SS2 = SS1 + M; float* SS3 = SS2 + M;
    float* HIDM = (float*)(ws + WS_HIDM); float* H1M = (float*)(ws + WS_H1M);
    bf16* Gb = (bf16*)F.out;
    bf16* H2B = (bf16*)F.out;
    const int bx = (int)blockIdx.x;

    if (IN(0)) {
        if (bx < NG) ssm_prep_job(F, args, bx);
        for (int j = bx - NG; j >= 0 && j < DFF / 16; j += F.G) {
            float* hm = HIDM; const int c0 = 16 * j;
            meta_job<2, true>(F, args.in[I_META], D, args.in[I_F1N], args.in[I_F1W1] + c0, args.in[I_F1W3] + c0, DFF, [=](int r, int jj, float a, float b) { hm[r * DFF + c0 + jj] = fsilu(a) * b; });
        }
        LAS float* scr = (LAS float*)(F.lds + RING_OFF + F.wave * 16384);
        const int gw = F.vcu * NWAVES + F.wave, NGW = F.G * NWAVES;
        constexpr int I_UP = (D / 64) * (DFF / 32), I_DN = (DFF / 64) * (D / 32), I_IN = (D / 64) * (DIN / 32), I_CP = (DCONV / 64) * (D / 32), I_WO = (D / 64) * (D / 32);
        constexpr int NITEMS = 4 * I_UP + 2 * I_DN + I_IN + 3 * I_CP + I_WO;
        for (int it = gw; it < NITEMS; it += NGW) { int r = it;
            if (r < 4 * I_UP) { const int which = r / I_UP; r -= which * I_UP; const int nblk = DFF / 32, k0 = 64 * (r / nblk), n0 = 32 * (r % nblk);
                const float* W = which == 0 ? args.in[I_F1W1] : which == 1 ? args.in[I_F1W3] : which == 2 ? args.in[I_F2W1] : args.in[I_F2W3];
                p0_transpose_item(W, D, DFF, which < 2 ? W13A : W13B, which < 2 ? args.in[I_F1N] : args.in[I_F2N], scr, k0, n0, glu_row(n0) + (which & 1) * 128, F.lane); continue; }
            r -= 4 * I_UP;
            if (r < 2 * I_DN) { const int which = r / I_DN; r -= which * I_DN; const int nblk = D / 32, k0 = 64 * (r / nblk), n0 = 32 * (r % nblk);
                p0_transpose_item(which ? args.in[I_F2W2] : args.in[I_F1W2], DFF, D, which ? W2B : W2A, nullptr, scr, k0, n0, n0, F.lane); continue; }
            r -= 2 * I_DN;
            if (r < I_IN) { const int nblk = DIN / 32, k0 = 64 * (r / nblk), n0 = 32 * (r % nblk);
                const int dr = n0 < 512 ? glu_row(n0) : n0 < 1024 ? glu_row(n0 - 512) + 128 : n0;
                p0_transpose_item(args.in[I_WIN], D, DIN, WIN, args.in[I_MIXN], scr, k0, n0, dr, F.lane); continue; }
            r -= I_IN;
            if (r < 3 * I_CP) { const int which = r / I_CP; r -= which * I_CP; const int nblk = D / 32, k0 = 64 * (r / nblk), n0 = 32 * (r % nblk);
                const int dr = which == 0 ? n0 : 1024 + glu_row(n0) + (which == 2 ? 128 : 0);
                p0_transpose_item(which == 0 ? args.in[I_CPROJ] : which == 1 ? args.in[I_WV] : args.in[I_WG], DCONV, D, WCAT, nullptr, scr, k0, n0, dr, F.lane); continue; }
            r -= 3 * I_CP;
            { const int nblk = D / 32, k0 = 64 * (r / nblk), n0 = 32 * (r % nblk); p0_transpose_item(args.in[I_WOUT], D, D, WOUT, nullptr, scr, k0, n0, n0, F.lane); }
        }
        for (int m = gw; m < M; m += NGW) { const GAS f32x4* xr = (const GAS f32x4*)(args.in[I_X] + (size_t)m * D) + F.lane; f32x4 v[4]; float s = 0.f;
#pragma unroll
            for (int j = 0; j < 4; ++j) { v[j] = xr[64 * j]; s += (v[j].x * v[j].x + v[j].y * v[j].y) + (v[j].z * v[j].z + v[j].w * v[j].w); }
            s = wave_sum(s);
            GAS v2u* o8 = (GAS v2u*)(AB + (size_t)m * D) + F.lane;
#pragma unroll
            for (int j = 0; j < 4; ++j) o8[64 * j] = (v2u){pk2(v[j].x, v[j].y), pk2(v[j].z, v[j].w)};
            if (F.lane == 0) { SS0[m] = s; SS1[m] = 0.f; SS2[m] = 0.f; SS3[m] = 0.f; } }
    }
    SEAM(0);
    if (IN(1)) {
        pg8::Gemm g{D, D, D}; pg8::GridOrder S{M / 256, 2 * DFF / 256, F.G, bx, (const char*)AB, (const char*)W13A, (size_t)256 * D * 2, (size_t)256 * D * 2};
        EpiSwiglu E{HID, SS0};
        pg8::gemm_phase(F.lds + RING_OFF, F.wave, g, S, E);
        for (int j = bx - 128; j >= 0 && j < D / 16; j += F.G) { float* hm = H1M; const float* mt = args.in[I_META]; const int c0 = 16 * j;
            meta_job<1, false>(F, HIDM, DFF, nullptr, args.in[I_F1W2] + c0, nullptr, D, [=](int r, int jj, float a, float) { hm[r * D + c0 + jj] = mt[r * D + c0 + jj] + 0.5f * a; }); }
    }
    SEAM(1);
    if (IN(2)) {
        pg8::Gemm g{DFF, DFF, DFF}; pg8::GridOrder S{M / 256, D / 256, F.G, bx, (const char*)HID, (const char*)W2A, (size_t)256 * DFF * 2, (size_t)256 * DFF * 2};
        EpiResid E{args.in[I_X], H1, AB, SS1, 0.5f};
        pg8::gemm_phase(F.lds + RING_OFF, F.wave, g, S, E);
    }
    SEAM(2);
    if (IN(3)) {
        pg8::Gemm g{D, D, D}; pg8::GridOrder S{M / 256, DIN / 256, F.G, bx, (const char*)AB, (const char*)WIN, (size_t)256 * D * 2, (size_t)256 * D * 2};
        EpiMix E{SS1, Zb, UXb, Gb, args.in[I_BGATE]};
        pg8::gemm_phase(F.lds + RING_OFF, F.wave, g, S, E);
        for (int j = bx - 128; j >= 0 && j < 64; j += F.G) {
            if (j < 32) { bf16* zz = Zb; const int c0 = 16 * j;
                meta_job<2, true>(F, H1M, D, args.in[I_MIXN], args.in[I_WIN] + c0, args.in[I_WIN] + 512 + c0, DIN, [=](int r, int jj, float a, float b) { zz[(size_t)(M + r) * DCONV + c0 + jj] = (bf16)f2bf(a * fsigmoid(b)); });
            } else { bf16* ux = UXb; const int gg = j - 32;
                meta_job<1, true>(F, H1M, D, args.in[I_MIXN], args.in[I_WIN] + 1024 + 16 * gg, nullptr, DIN, [=](int r, int jj, float a, float) { ux[(size_t)(gg * (NCH + 1) + NCH) * UXK + r * 16 + jj] = (bf16)f2bf(a); }); }
        }
    }
    SEAM(3);
    if (IN(4)) {
        if (bx < 128) ssm_statein_job(F, bx & 31, bx >> 5);
        asm volatile("" ::: "memory");
        for (int j = bx; j < 512; j += F.G) conv_job(F, args, j);
    }
    SEAM(4);
    if (IN(5)) {
        if (bx < BATCH * NG) ssm_scan_job(F, bx / NG, bx % NG);
        pg8::Gemm g{UXK, UXK, UXK}; SsmOrder S{F.G >= BATCH * NG ? F.G : BATCH * NG, bx, (const char*)UXb, (const char*)(ws + WS_BS2)};
        EpiSsmY E{UXb, args.in[I_SD], Yb};
        pg8::gemm_phase(F.lds + RING_OFF, F.wave, g, S, E);
    }
    SEAM(5);
    if (IN(6)) {
        pg8::Gemm g{512, 512, 512}; MergeOrder S{F.G, bx, (const char*)ZCb, (const char*)Yb, (const char*)WCAT};
        EpiMerge E{Gb, MCb, AB};
        pg8::gemm_phase(F.lds + RING_OFF, F.wave, g, S, E);
    }
    SEAM(6);
    if (IN(7)) {
        pg8::Gemm g{D, D, D}; pg8::GridOrder S{M / 256, D / 256, F.G, bx, (const char*)AB, (const char*)WOUT, (size_t)256 * D * 2, (size_t)256 * D * 2};
        EpiResid E{H1, H1, H2B, SS2, 1.0f};
        pg8::gemm_phase(F.lds + RING_OFF, F.wave, g, S, E);
    }
    SEAM(7);
    if (IN(8)) {
        pg8::Gemm g{D, D, D}; pg8::GridOrder S{M / 256, 2 * DFF / 256, F.G, bx, (const char*)H2B, (const char*)W13B, (size_t)256 * D * 2, (size_t)256 * D * 2};
        EpiSwiglu E{HID, SS2};
        pg8::gemm_phase(F.lds + RING_OFF, F.wave, g, S, E);
    }
    SEAM(8);
    if (IN(9)) {
        pg8::Gemm g{DFF, DFF, DFF}; pg8::GridOrder S{M / 256, D / 256, F.G, bx, (const char*)HID, (const char*)W2B, (size_t)256 * DFF * 2, (size_t)256 * DFF * 2};
        EpiResid E{H1, F.out, nullptr, SS3, 0.5f};
        pg8::gemm_phase(F.lds + RING_OFF, F.wave, g, S, E);
    }
    SEAM(9);
    if (IN(10)) {
        const int gw = F.vcu * NWAVES + F.wave, NGW = F.G * NWAVES; const GAS f32x4* fn = (const GAS f32x4*)args.in[I_FINN] + F.lane;
        f32x4 gn[4];
#pragma unroll
        for (int j = 0; j < 4; ++j) gn[j] = fn[64 * j];
        for (int m = gw; m < M; m += NGW) { GAS f32x4* o = (GAS f32x4*)(F.out + (size_t)m * D) + F.lane; const float rs = 1.0f / sqrtf(SS3[m] * (1.0f / D) + EPS);
#pragma unroll
            for (int j = 0; j < 4; ++j) o[64 * j] = o[64 * j] * rs * gn[j]; }
    }
#undef IN
#undef SEAM
}

extern "C" void kernel_launch(void* const* d_in, const int* in_sizes, int n_in, void* d_out, int out_size, void* d_ws, size_t ws_size, hipStream_t stream) {
    static int grid = 0;
    if (grid == 0) {
        if (n_in != 30 || in_sizes[0] != M * D || out_size != M * D || ws_size < WS_END) { fprintf(stderr, "kernel_launch: unexpected problem shape (n_in %d, in0 %d, out %d, ws %zu); nothing launched\n", n_in, n_in > 0 ? in_sizes[0] : -1, out_size, ws_size); grid = -1; return; }
        int dev = 0, cus = 0, per_cu = 0;
        if (hipGetDevice(&dev) != hipSuccess || hipDeviceGetAttribute(&cus, hipDeviceAttributeMultiprocessorCount, dev) != hipSuccess) { grid = -1; return; }
        if (hipFuncSetAttribute((const void*)hyb_fwd, hipFuncAttributeMaxDynamicSharedMemorySize, LDS_BYTES) != hipSuccess) { fprintf(stderr, "kernel_launch: hipFuncSetAttribute failed\n"); grid = -1; return; }
        if (hipOccupancyMaxActiveBlocksPerMultiprocessor(&per_cu, (const void*)hyb_fwd, NWAVES * 64, LDS_BYTES) != hipSuccess || per_cu < 1)
            fprintf(stderr, "kernel_launch: note: occupancy query reports %d workgroups per CU\n", per_cu);
        (void)hipGetLastError();
        grid = cus;
    }
    if (grid < 0) return;
    if (hipMemsetAsync((char*)d_ws + WS_CTL, 0, CTL_ZERO_BYTES, stream) != hipSuccess) { fprintf(stderr, "kernel_launch: hipMemsetAsync failed\n"); return; }
    Args a{};
    for (int i = 0; i < 30; ++i) a.in[i] = (const float*)d_in[i];
    a.out = (float*)d_out; a.ws = (unsigned char*)d_ws;
    for (int li = 0; li < N_LAUNCHES; ++li) {
        a.ph_lo = (N_LAUNCHES == PER_PHASE) ? li : 0; a.ph_hi = (N_LAUNCHES == PER_PHASE) ? li + 1 : PER_PHASE; a.li = li;
        hipLaunchKernelGGL(hyb_fwd, dim3(grid), dim3(NWAVES * 64), LDS_BYTES, stream, a);
        const hipError_t le = hipPeekAtLastError();
        if (le != hipSuccess) { fprintf(stderr, "kernel_launch: launch %d failed: %s\n", li, hipGetErrorName(le)); break; }
    }
}
```

```cpp
#include <hip/hip_runtime.h>
#include <cstdio>
#include <cstdint>

#ifndef MK_N_LAUNCHES
#define MK_N_LAUNCHES 1
#endif
#ifndef DUPK
#define DUPK -1
#endif

__device__ __forceinline__ int lane_id_opaque() { int l; asm volatile("v_mbcnt_lo_u32_b32 %0, -1, 0\n\tv_mbcnt_hi_u32_b32 %0, -1, %0" : "=v"(l)); return l; }
namespace pg8 {
#define PG8_LAS __attribute__((address_space(3)))
typedef unsigned short bf16_t;
typedef short bf16x8 __attribute__((ext_vector_type(8)));
typedef float f32x4 __attribute__((ext_vector_type(4)));
typedef unsigned u32x4 __attribute__((ext_vector_type(4)));
constexpr int BM = 256, BK = 64, HALF = 128, HTB = HALF * BK * 2, STAGE_BYTES = 8 * HTB, NXCD = 8, WGM = 8;

__host__ __device__ __forceinline__ int lds_byte(int r, int c) { const int st = (r >> 4) * 2 + (c >> 5), rr = r & 15, cc = c & 31, ob = rr * 64 + cc * 2; return st * 1024 + (ob ^ (((ob >> 9) & 1) << 5)); }
__host__ __device__ __forceinline__ void stage_rc(int b, int& R, int& C) { const int st = b / 1024, sb = b % 1024, swz = sb ^ (((sb >> 9) & 1) << 5); R = (st >> 1) * 16 + swz / 64; C = (st & 1) * 32 + (swz % 64) / 2; }
__host__ __device__ __forceinline__ int perm32(int rho) { const int n = rho >> 4, i = rho & 15; return 8 * (i >> 2) + 4 * n + (i & 3); }

struct Unit { int pm, pn, kind; const char* A; const char* B; };
struct Gemm { int lda, ldb, K; };

__device__ __forceinline__ bool static_tile(int i, int G, int c, int nM, int nN, int& pm, int& pn) {
    const int nwg = nM * nN; const long L = (long)i * G + c; if (L >= nwg) return false;
    int wgid = (int)L; { const int q = nwg / NXCD, r = nwg % NXCD, xcd = wgid % NXCD, off = wgid / NXCD; wgid = (xcd < r ? xcd * (q + 1) : r * (q + 1) + (xcd - r) * q) + off; }
    const int nig = WGM * nN, gid = wgid / nig, fm = gid * WGM, gsz = (nM - fm) < WGM ? (nM - fm) : WGM;
    pm = fm + ((wgid % nig) % gsz); pn = (wgid % nig) / gsz; return true;
}
struct GridOrder {
    int nM, nN, G, c; const char* A; const char* B; size_t tA, tB;
    __device__ __forceinline__ bool next(int i, Unit& u) const { int pm, pn; if (!static_tile(i, G, c, nM, nN, pm, pn)) return false; u.pm = pm; u.pn = pn; u.kind = 0; u.A = A + (size_t)pm * tA; u.B = B + (size_t)pn * tB; return true; }
    __device__ __forceinline__ void a_ready(const Unit&) const {}
    __device__ __forceinline__ void done(const Unit&) const {}
};

__device__ __forceinline__ unsigned cvt_pk_bf16(float lo, float hi) { unsigned r; asm volatile("v_cvt_pk_bf16_f32 %0, %1, %2" : "=v"(r) : "v"(lo), "v"(hi)); return r; }

template <class Epi, class Sched>
__device__ __forceinline__ void gemm_phase(PG8_LAS unsigned char* lds, const int wid  , const Gemm g, const Sched& S, const Epi& E) {
    const int lane = lane_id_opaque(), tid = wid * 64 + lane, wr = wid >> 2, wc = wid & 3, fr = lane & 15, fq = lane >> 4;
    const int K = g.K, nt = K / BK;
    unsigned voffA[2], voffB[2];
#pragma unroll
    for (int i = 0; i < 2; ++i) { int R, C; stage_rc(tid * 16 + i * 8192, R, C); const int Rb = (R & ~31) + perm32(R & 31);
        voffA[i] = (unsigned)(R * g.lda + C) * 2u; voffB[i] = (unsigned)(Rb * g.ldb + C) * 2u; }
    const size_t kstep = (size_t)(BK * 2);
    const size_t hstepA = (size_t)HALF * g.lda * 2, hstepB = (size_t)HALF * g.ldb * 2;
    const unsigned ldsw = (unsigned)wid * 1024u;
    const int aoff = lds_byte(wr * 64 + fr, fq * 8), boff = lds_byte(wc * 32 + fr, fq * 8);
#define PG8_SA(b, h) (((b) * 2 + (h)) * HTB)
#define PG8_SB(b, h) ((4 + (b) * 2 + (h)) * HTB)
#define PG8_STAGE(bufoff, gbase, voff) do { _Pragma("unroll") for (int _i = 0; _i < 2; ++_i) \
        __builtin_amdgcn_global_load_lds((const unsigned*)((const char*)(gbase) + (voff)[_i]), (PG8_LAS unsigned*)(lds + (bufoff) + ldsw + _i * 8192), 16, 0, 0); } while (0)
#define PG8_LDA(dst, b, h) do { _Pragma("unroll") for (int m = 0; m < 4; ++m) _Pragma("unroll") for (int k = 0; k < 2; ++k) dst[m][k] = *(const PG8_LAS bf16x8*)(lds + PG8_SA(b, h) + aoff + m * 2048 + k * 1024); } while (0)
#define PG8_LDB(dst, b, h) do { _Pragma("unroll") for (int n = 0; n < 2; ++n) _Pragma("unroll") for (int k = 0; k < 2; ++k) dst[n][k] = *(const PG8_LAS bf16x8*)(lds + PG8_SB(b, h) + boff + n * 2048 + k * 1024); } while (0)
#define PG8_MMA(ai, bj, At, Bt) do { __builtin_amdgcn_s_setprio(1); _Pragma("unroll") for (int m = 0; m < 4; ++m) _Pragma("unroll") for (int n = 0; n < 2; ++n) _Pragma("unroll") for (int k = 0; k < 2; ++k) \
        acc[ai][bj][m][n] = __builtin_amdgcn_mfma_f32_16x16x32_bf16(Bt[n][k], At[m][k], acc[ai][bj][m][n], 0, 0, 0); __builtin_amdgcn_s_setprio(0); } while (0)
#define PG8_WAIT_V(n) asm volatile("s_waitcnt vmcnt(" #n ")" ::: "memory")
#define PG8_WAIT_L(n) asm volatile("s_waitcnt lgkmcnt(" #n ")" ::: "memory")
#define PG8_BAR __builtin_amdgcn_s_barrier()
#define PG8_SCHED __builtin_amdgcn_sched_barrier(0)
    Unit cur, nxt; int ui = 0;
    if (!S.next(0, cur)) return;
    f32x4 acc[2][2][4][2];
#pragma unroll
    for (int a = 0; a < 2; ++a)
#pragma unroll
        for (int b = 0; b < 2; ++b)
#pragma unroll
            for (int m = 0; m < 4; ++m)
#pragma unroll
                for (int n = 0; n < 2; ++n) acc[a][b][m][n] = (f32x4){0.f, 0.f, 0.f, 0.f};
    bf16x8 At[4][2], B0[2][2], B1[2][2];
    const char* cA = cur.A; const char* cB = cur.B;
    S.a_ready(cur);
    PG8_STAGE(PG8_SB(0, 0), cB, voffB); PG8_STAGE(PG8_SB(0, 1), cB + hstepB, voffB); PG8_STAGE(PG8_SA(0, 0), cA, voffA); PG8_STAGE(PG8_SA(0, 1), cA + hstepA, voffA);
    if (wr == 1) PG8_BAR;
    PG8_WAIT_V(2); PG8_BAR;
    PG8_STAGE(PG8_SB(1, 0), cB + kstep, voffB); PG8_STAGE(PG8_SA(1, 0), cA + kstep, voffA); PG8_STAGE(PG8_SB(1, 1), cB + hstepB + kstep, voffB);
    PG8_WAIT_V(6); PG8_BAR;
    for (;;) {
        const bool has_next = S.next(ui + 1, nxt);
        const char* nA = has_next ? nxt.A : cA; const char* nB = has_next ? nxt.B : cB;
        for (int t = 0; t < nt; t += 2) {
            const bool last = (t == nt - 2);
            const char* a1 = cA + (size_t)(t + 1) * kstep;
            const char* a2 = last ? nA : cA + (size_t)(t + 2) * kstep; const char* b2 = last ? nB : cB + (size_t)(t + 2) * kstep;
            const char* a3 = a2 + kstep; const char* b3 = b2 + kstep;
            if (last && has_next) S.a_ready(nxt);
            PG8_LDB(B0, 0, 0); PG8_LDB(B1, 0, 1); PG8_SCHED; PG8_LDA(At, 0, 0); PG8_STAGE(PG8_SA(1, 1), a1 + hstepA, voffA);
            PG8_WAIT_V(8); PG8_WAIT_L(0); PG8_BAR; PG8_MMA(0, 0, At, B0); PG8_MMA(0, 1, At, B1); PG8_BAR; PG8_SCHED;
            PG8_LDA(At, 0, 1); PG8_STAGE(PG8_SB(0, 0), b2, voffB); PG8_STAGE(PG8_SB(0, 1), b2 + hstepB, voffB); PG8_STAGE(PG8_SA(0, 0), a2, voffA);
            PG8_WAIT_V(8); PG8_WAIT_L(0); PG8_BAR; PG8_MMA(1, 0, At, B0); PG8_MMA(1, 1, At, B1); PG8_BAR; PG8_SCHED;
            PG8_LDB(B0, 1, 0); PG8_LDB(B1, 1, 1); PG8_SCHED; PG8_LDA(At, 1, 0); PG8_STAGE(PG8_SA(0, 1), a2 + hstepA, voffA);
            PG8_WAIT_V(8); PG8_WAIT_L(0); PG8_BAR; PG8_MMA(0, 0, At, B0); PG8_MMA(0, 1, At, B1); PG8_BAR; PG8_SCHED;
            PG8_LDA(At, 1, 1); PG8_STAGE(PG8_SB(1, 0), b3, voffB); PG8_STAGE(PG8_SB(1, 1), b3 + hstepB, voffB); PG8_STAGE(PG8_SA(1, 0), a3, voffA);
            PG8_WAIT_V(8); PG8_WAIT_L(0); PG8_BAR; PG8_MMA(1, 0, At, B0); PG8_MMA(1, 1, At, B1); PG8_BAR; PG8_SCHED;
        }
        if (wr == 0) PG8_BAR;
        E(acc, cur, wr, wc); S.done(cur);
        if (!has_next) break;
#pragma unroll
        for (int a = 0; a < 2; ++a)
#pragma unroll
            for (int b = 0; b < 2; ++b)
#pragma unroll
                for (int m = 0; m < 4; ++m)
#pragma unroll
                    for (int n = 0; n < 2; ++n) acc[a][b][m][n] = (f32x4){0.f, 0.f, 0.f, 0.f};
        cur = nxt; cA = nA; cB = nB; ++ui;
        if (wr == 1) PG8_BAR;
    }
    PG8_WAIT_V(0);
    PG8_BAR;
#undef PG8_SA
#undef PG8_SB
#undef PG8_STAGE
#undef PG8_LDA
#undef PG8_LDB
#undef PG8_MMA
#undef PG8_WAIT_V
#undef PG8_WAIT_L
#undef PG8_BAR
#undef PG8_SCHED
}
}

constexpr int NWAVES = 8;
constexpr int D = 1024, BATCH = 4, SEQ = 4096, NMETA = 16, DFF = 2816, DCONV = 512, CWID = 31, DSSM = 512, HG = 16, NG = 32, PS = 64;
constexpr int DIN = 2 * DCONV + DSSM + 2 * D;
constexpr int M = BATCH * SEQ;
constexpr int NCH = M / 16;
constexpr int UXK = 384;
constexpr float EPS = 1e-6f;
constexpr int PER_PHASE = 10;
constexpr int N_LAUNCHES = MK_N_LAUNCHES;

constexpr size_t MiB = 1u << 20;
constexpr size_t WS_CTL = 0, CTL_ZERO_BYTES = 1 * MiB;
constexpr size_t WS_BS2 = 1 * MiB;
constexpr size_t WS_WSI = 7 * MiB;
constexpr size_t WS_SMALL = 9 * MiB;
constexpr size_t WS_LAMC = WS_SMALL;
constexpr size_t WS_SMETA = WS_SMALL + 16384;
constexpr size_t WS_SS0 = WS_SMALL + 32768;
constexpr size_t WS_HIDM = WS_SMALL + 32768 + 4 * 65536;
constexpr size_t WS_H1M = WS_HIDM + 16 * DFF * 4;
constexpr size_t WS_SSD = WS_H1M + 16 * D * 4;
constexpr size_t WS_W13A = 11 * MiB, WS_W2A = 22 * MiB, WS_WIN = 28 * MiB, WS_WCAT = 35 * MiB, WS_WOUT = 38 * MiB, WS_W13B = 40 * MiB, WS_W2B = 51 * MiB;
constexpr size_t WS_AB = 57 * MiB;
constexpr size_t WS_H1 = 89 * MiB;
constexpr size_t WS_HID = 153 * MiB;
constexpr size_t WS_Z = WS_HID;
constexpr size_t WS_UX = WS_HID + 17 * MiB;
constexpr size_t WS_ZC = WS_HID + 42 * MiB;
constexpr size_t WS_Y = WS_HID + 58 * MiB;
constexpr size_t WS_MC = WS_HID;
constexpr size_t WS_S = WS_HID + 74 * MiB;
constexpr size_t WS_END = 256 * MiB;
static_assert(WS_SSD + 65536 <= WS_W13A, "small tables");
static_assert(WS_W2B + (size_t)D * DFF * 2 <= WS_AB && WS_AB + (size_t)M * D * 2 <= WS_H1 && WS_H1 + (size_t)M * D * 4 <= WS_HID, "ws map 1");
static_assert(WS_Z + (size_t)(M + 16) * DCONV * 2 <= WS_UX && WS_UX + (size_t)NG * (NCH + 1) * UXK * 2 <= WS_ZC && WS_ZC + (size_t)M * DCONV * 2 <= WS_Y && WS_Y + (size_t)M * DSSM * 2 <= WS_S, "ws map 2");
static_assert(WS_MC + (size_t)M * D * 2 <= WS_ZC, "MC overlay");
static_assert(WS_HID + (size_t)M * DFF * 2 <= WS_END && WS_S + (size_t)NCH * NG * 128 * 4 <= WS_END, "ws end");
static_assert(WS_W13A + (size_t)2 * DFF * D * 2 <= WS_W2A && WS_W2A + (size_t)D * DFF * 2 <= WS_WIN && WS_WIN + (size_t)DIN * D * 2 <= WS_WCAT && WS_WCAT + (size_t)3072 * 512 * 2 <= WS_WOUT && WS_WOUT + (size_t)D * D * 2 <= WS_W13B && WS_W13B + (size_t)2 * DFF * D * 2 <= WS_W2B, "weights");
static_assert(WS_BS2 + (size_t)NG * 256 * UXK * 2 <= WS_WSI && WS_WSI + (size_t)NG * 128 * 256 * 2 <= WS_SMALL, "ssm mats");
constexpr int CW_BAR = 4096;
constexpr int CW_FIN = 16384;

constexpr int RING_OFF = 0, RING_BYTES = 131072;
constexpr int LDSCTL_OFF = RING_BYTES, MISC_OFF = LDSCTL_OFF + 320;
constexpr int LDS_BYTES = 147456;

#define GAS __attribute__((address_space(1)))
#define LAS __attribute__((address_space(3)))
typedef unsigned short bf16;
typedef unsigned v4u __attribute__((ext_vector_type(4)));
typedef unsigned v2u __attribute__((ext_vector_type(2)));
typedef float f32x4 __attribute__((ext_vector_type(4)));
typedef float f32x2 __attribute__((ext_vector_type(2)));
typedef short bf16x8 __attribute__((ext_vector_type(8)));
typedef GAS unsigned gu32;
#define RLX_AGENT __ATOMIC_RELAXED, __HIP_MEMORY_SCOPE_AGENT
#define LDS_WAIT() asm volatile("s_waitcnt lgkmcnt(0)" ::: "memory")
#define VM_WAIT() asm volatile("s_waitcnt vmcnt(0)" ::: "memory")
__device__ __forceinline__ unsigned f2bf(float f) { unsigned u = __builtin_bit_cast(unsigned, f); return (u + 0x7fffu + ((u >> 16) & 1u)) >> 16; }
__device__ __forceinline__ unsigned pk2(float lo, float hi) { return f2bf(lo) | (f2bf(hi) << 16); }
__device__ __forceinline__ float bf2f(unsigned h) { return __builtin_bit_cast(float, h << 16); }
__device__ __forceinline__ float fsigmoid(float x) { return __builtin_amdgcn_rcpf(1.f + __builtin_amdgcn_exp2f(-1.44269504089f * x)); }
__device__ __forceinline__ float fsilu(float x) { return x * fsigmoid(x); }
__device__ __forceinline__ float fgelu_tanh(float x) { return x * fsigmoid(1.5957691216f * (x + 0.044715f * x * x * x)); }
__device__ __forceinline__ float wave_sum(float v) {
#pragma unroll
    for (int o = 1; o < 64; o <<= 1) v += __shfl_xor(v, o);
    return v;
}

#define XB_TMO      128
#define XB_XCNT(j)  (256  + 64 * (j))
#define XB_XSUB(j)  (1280 + 64 * (j))
#define XB_XGEN(j)  (2304 + 64 * (j))
#define XB_TOP      3328
#define XB_TOPGEN   3392
#define XCD_BAR_WORDS 3456
#define XB_SPIN_CAP (1u << 18)
__device__ __forceinline__ unsigned xb_ld(unsigned* p)              { return __hip_atomic_load(p, __ATOMIC_RELAXED, __HIP_MEMORY_SCOPE_AGENT); }
__device__ __forceinline__ unsigned xb_add(unsigned* p, unsigned v) { return __hip_atomic_fetch_add(p, v, __ATOMIC_RELAXED, __HIP_MEMORY_SCOPE_AGENT); }
__device__ __forceinline__ unsigned xb_xcc_id() { return (unsigned)__builtin_amdgcn_s_getreg((3 << 11) | 20) & 0xFu; }
#define XB_SPIN(cond, bar) do { unsigned _sp = 0; while (cond) { __builtin_amdgcn_s_sleep(1); \
    if ((++_sp & 255u) == 0u) { if (xb_ld(&(bar)[XB_TMO])) break; if (_sp > XB_SPIN_CAP) { atomicAdd(&(bar)[XB_TMO], 1u); break; } } } } while (0)
struct XcdBarrier { unsigned* bar; unsigned x; volatile LAS unsigned* st; };
__device__ __forceinline__ XcdBarrier xcd_barrier_post(unsigned* bar, volatile LAS unsigned* st) {
    XcdBarrier b; b.bar = bar; b.x = xb_xcc_id(); b.st = st;
    if (threadIdx.x == 0) (void)xb_add(&bar[XB_XCNT(b.x)], 1u);
    return b;
}
__device__ __forceinline__ void xcd_barrier_complete(unsigned* bar, unsigned x, unsigned& nloc, unsigned& nx) {
    const unsigned G = gridDim.x * gridDim.y * gridDim.z;
    unsigned sum, cnt, mine, sp = 0u;
    for (;;) {
        sum = 0u; cnt = 0u; mine = 0u;
#pragma unroll
        for (unsigned j = 0; j < 16; ++j) { const unsigned c = xb_ld(&bar[XB_XCNT(j)]); sum += c; cnt += (c > 0u) ? 1u : 0u; mine = (j == x) ? c : mine; }
        if (sum == G) break;
        __builtin_amdgcn_s_sleep(1);
        if ((++sp & 255u) == 0u) { if (xb_ld(&bar[XB_TMO])) break; if (sp > XB_SPIN_CAP) { atomicAdd(&bar[XB_TMO], 1u); break; } }
    }
    nloc = mine > 0u ? mine : 1u; nx = cnt > 0u ? cnt : 1u;
}
__device__ __forceinline__ void xcd_barrier(const XcdBarrier& b) {
    asm volatile("s_waitcnt vmcnt(0)" ::: "memory");
    __syncthreads();
    if (threadIdx.x == 0) {
        unsigned* bar = b.bar;
        __builtin_amdgcn_s_waitcnt(0);
        unsigned nloc = b.st[0], nx = b.st[1];
        if (nloc == 0u) { xcd_barrier_complete(bar, b.x, nloc, nx); b.st[0] = nloc; b.st[1] = nx; }
        const unsigned old = xb_add(&bar[XB_XSUB(b.x)], 1u);
        const unsigned gen = old / nloc;
        if (old + 1u == (gen + 1u) * nloc) {
            __builtin_amdgcn_fence(__ATOMIC_RELEASE, "agent");
            asm volatile("s_waitcnt vmcnt(0)" ::: "memory");
            const unsigned og = xb_add(&bar[XB_TOP], 1u);
            const unsigned tg = og / nx;
            if (og + 1u == (tg + 1u) * nx) xb_add(&bar[XB_TOPGEN], 1u);
            else XB_SPIN(xb_ld(&bar[XB_TOPGEN]) == tg, bar);
            __builtin_amdgcn_fence(__ATOMIC_ACQUIRE, "agent");
            xb_add(&bar[XB_XGEN(b.x)], 1u);
            asm volatile("s_waitcnt vmcnt(0)" ::: "memory");
        } else {
            XB_SPIN(xb_ld(&bar[XB_XGEN(b.x)]) == gen, bar);
            __builtin_amdgcn_fence(__ATOMIC_ACQUIRE, "agent");
            asm volatile("s_waitcnt vmcnt(0)" ::: "memory");
        }
    }
    __syncthreads();
}

struct Args { const float* in[30]; float* out; unsigned char* ws; int ph_lo, ph_hi, li, dupk; };
struct Frame {
    LAS unsigned char* lds; volatile LAS unsigned* MISC; gu32* ctl;
    int tid, lane, wave, vcu, G;
    float* out; unsigned char* ws;
};
enum { I_X = 0, I_META, I_F1N, I_F1W1, I_F1W3, I_F1W2, I_MIXN, I_WIN, I_BGATE, I_DW, I_DWB, I_LNG, I_LNB, I_CPROJ, I_LRE, I_LIM, I_LDT, I_BRE, I_BIM, I_CRE, I_CIM, I_SD, I_WV, I_WG, I_WOUT, I_F2N, I_F2W1, I_F2W3, I_F2W2, I_FINN };

using pg8::Unit; using pg8::cvt_pk_bf16;
__device__ __forceinline__ v4u pack8(const f32x4 a, const f32x4 b) { v4u w; w.x = cvt_pk_bf16(a[0], a[1]); w.y = cvt_pk_bf16(a[2], a[3]); w.z = cvt_pk_bf16(b[0], b[1]); w.w = cvt_pk_bf16(b[2], b[3]); return w; }
__device__ __forceinline__ void unpack8(const v4u w, float (&o)[8]) { o[0] = bf2f(w.x & 0xffffu); o[1] = bf2f(w.x >> 16); o[2] = bf2f(w.y & 0xffffu); o[3] = bf2f(w.y >> 16); o[4] = bf2f(w.z & 0xffffu); o[5] = bf2f(w.z >> 16); o[6] = bf2f(w.w & 0xffffu); o[7] = bf2f(w.w >> 16); }
__device__ __forceinline__ float rs_of(const float* SS, int row) { return 1.0f / sqrtf(SS[row] * (1.0f / D) + EPS); }

struct EpiSwiglu {
    bf16* HID; const float* SS;
    __device__ __forceinline__ void operator()(const f32x4 (&acc)[2][2][4][2], const Unit& u, int wr, int wc) const {
        const int lane_ = lane_id_opaque(), fr = lane_ & 15, fq = lane_ >> 4;
        const int row0 = u.pm * 256 + wr * 64 + fr, col0 = u.pn * 128 + wc * 32 + 8 * fq;
#pragma unroll
        for (int ai = 0; ai < 2; ++ai)
#pragma unroll
            for (int m = 0; m < 4; ++m) { const int row = row0 + ai * 128 + m * 16; const float rs = rs_of(SS, row);
                f32x4 o0, o1;
#pragma unroll
                for (int j = 0; j < 4; ++j) { o0[j] = fsilu(acc[ai][0][m][0][j] * rs) * (acc[ai][1][m][0][j] * rs); o1[j] = fsilu(acc[ai][0][m][1][j] * rs) * (acc[ai][1][m][1][j] * rs); }
                *(v4u*)(HID + (size_t)row * DFF + col0) = pack8(o0, o1); }
    }
};
template <bool RBF16> struct EpiResid {
    const void* R; bf16* OB; float* SS; float alpha;
    __device__ __forceinline__ void operator()(const f32x4 (&acc)[2][2][4][2], const Unit& u, int wr, int wc) const {
        const int lane_ = lane_id_opaque(), fr = lane_ & 15, fq = lane_ >> 4;
        const int row0 = u.pm * 256 + wr * 64 + fr, col0 = u.pn * 256 + wc * 32 + 8 * fq;
#pragma unroll
        for (int ai = 0; ai < 2; ++ai)
#pragma unroll
            for (int m = 0; m < 4; ++m) { const int row = row0 + ai * 128 + m * 16; float ss = 0.f;
#pragma unroll
                for (int bj = 0; bj < 2; ++bj) { const size_t off = (size_t)row * D + col0 + bj * 128; f32x4 r0, r1;
                    if (RBF16) { float t[8]; unpack8(*(const v4u*)((const bf16*)R + off), t); r0 = (f32x4){t[0], t[1], t[2], t[3]}; r1 = (f32x4){t[4], t[5], t[6], t[7]}; }
                    else { r0 = *(const f32x4*)((const float*)R + off); r1 = *(const f32x4*)((const float*)R + off + 4); }
                    const f32x4 o0 = r0 + acc[ai][bj][m][0] * alpha, o1 = r1 + acc[ai][bj][m][1] * alpha;
                    *(v4u*)(OB + off) = pack8(o0, o1);
                    ss += (o0[0] * o0[0] + o0[1] * o0[1]) + (o0[2] * o0[2] + o0[3] * o0[3]) + (o1[0] * o1[0] + o1[1] * o1[1]) + (o1[2] * o1[2] + o1[3] * o1[3]); }
                ss += __shfl_xor(ss, 16); ss += __shfl_xor(ss, 32);
                if (fq == 0) atomicAdd(SS + row, ss);
                asm volatile("" ::: "memory"); }
    }
};
struct EpiFinal {
    const bf16* R; float* OUT; float* SS; unsigned* cnt; const float* gain; float alpha;
    __device__ __forceinline__ void operator()(f32x4 (&acc)[2][2][4][2], const Unit& u, int wr, int wc) const {
        const int lane_ = lane_id_opaque(), fr = lane_ & 15, fq = lane_ >> 4;
        const int row0 = u.pm * 256 + wr * 64 + fr, col0 = u.pn * 256 + wc * 32 + 8 * fq;
#pragma unroll
        for (int ai = 0; ai < 2; ++ai)
#pragma unroll
            for (int m = 0; m < 4; ++m) { const int row = row0 + ai * 128 + m * 16; float ss = 0.f;
#pragma unroll
                for (int bj = 0; bj < 2; ++bj) { const size_t off = (size_t)row * D + col0 + bj * 128; float t[8]; unpack8(*(const v4u*)(R + off), t);
                    const f32x4 o0 = (f32x4){t[0], t[1], t[2], t[3]} + acc[ai][bj][m][0] * alpha, o1 = (f32x4){t[4], t[5], t[6], t[7]} + acc[ai][bj][m][1] * alpha;
                    acc[ai][bj][m][0] = o0; acc[ai][bj][m][1] = o1;
                    ss += (o0[0] * o0[0] + o0[1] * o0[1]) + (o0[2] * o0[2] + o0[3] * o0[3]) + (o1[0] * o1[0] + o1[1] * o1[1]) + (o1[2] * o1[2] + o1[3] * o1[3]); }
                ss += __shfl_xor(ss, 16); ss += __shfl_xor(ss, 32);
                if (fq == 0) atomicAdd(SS + row, ss);
                asm volatile("" ::: "memory"); }
        asm volatile("s_waitcnt vmcnt(0)" ::: "memory");
        unsigned* cw = cnt + 64 * u.pm;
        if (lane_ == 0) __hip_atomic_fetch_add(cw, 1u, __ATOMIC_RELAXED, __HIP_MEMORY_SCOPE_AGENT);
        { unsigned sp = 0; while ((unsigned)__builtin_amdgcn_readfirstlane((int)__hip_atomic_load(cw, __ATOMIC_RELAXED, __HIP_MEMORY_SCOPE_AGENT)) < 32u) { __builtin_amdgcn_s_sleep(2); if (++sp > (1u << 20)) break; } }
        f32x4 g[2][2];
#pragma unroll
        for (int bj = 0; bj < 2; ++bj) { g[bj][0] = *(const f32x4*)(gain + col0 + bj * 128); g[bj][1] = *(const f32x4*)(gain + col0 + bj * 128 + 4); }
#pragma unroll
        for (int ai = 0; ai < 2; ++ai)
#pragma unroll
            for (int m = 0; m < 4; ++m) { const int row = row0 + ai * 128 + m * 16;
                float tot = 0.f; if (fq == 0) tot = __hip_atomic_fetch_add(SS + row, 0.0f, __ATOMIC_RELAXED, __HIP_MEMORY_SCOPE_AGENT);
                tot = __shfl(tot, fr);
                const float rs = 1.0f / sqrtf(tot * (1.0f / D) + EPS);
#pragma unroll
                for (int bj = 0; bj < 2; ++bj) { const size_t off = (size_t)row * D + col0 + bj * 128;
                    *(f32x4*)(OUT + off) = acc[ai][bj][m][0] * rs * g[bj][0]; *(f32x4*)(OUT + off + 4) = acc[ai][bj][m][1] * rs * g[bj][1]; }
                asm volatile("" ::: "memory"); }
    }
};
struct EpiMix {
    const float* SS; bf16* Z; bf16* UX; bf16* G; const float* bgate;
    __device__ __forceinline__ void operator()(const f32x4 (&acc)[2][2][4][2], const Unit& u, int wr, int wc) const {
        const int lane_ = lane_id_opaque(), fr = lane_ & 15, fq = lane_ >> 4;
        const int row0 = u.pm * 256 + wr * 64 + fr;
        if (u.pn < 4) {
            const int col0 = u.pn * 128 + wc * 32 + 8 * fq;
#pragma unroll
            for (int ai = 0; ai < 2; ++ai)
#pragma unroll
                for (int m = 0; m < 4; ++m) { const int row = row0 + ai * 128 + m * 16; const float rs = rs_of(SS, row); f32x4 o0, o1;
#pragma unroll
                    for (int j = 0; j < 4; ++j) { o0[j] = (acc[ai][0][m][0][j] * rs) * fsigmoid(acc[ai][1][m][0][j] * rs); o1[j] = (acc[ai][0][m][1][j] * rs) * fsigmoid(acc[ai][1][m][1][j] * rs); }
                    *(v4u*)(Z + (size_t)row * DCONV + col0) = pack8(o0, o1); }
        } else if (u.pn < 6) {
#pragma unroll
            for (int ai = 0; ai < 2; ++ai)
#pragma unroll
                for (int m = 0; m < 4; ++m) { const int row = row0 + ai * 128 + m * 16; const float rs = rs_of(SS, row); const int ci = row >> 4, tt = row & 15;
#pragma unroll
                    for (int bj = 0; bj < 2; ++bj) { const int c = (u.pn - 4) * 256 + bj * 128 + wc * 32 + 8 * fq, g = c >> 4, h0 = c & 15;
                        *(v4u*)(UX + ((size_t)(g * (NCH + 1) + ci) * UXK + tt * 16 + h0)) = pack8(acc[ai][bj][m][0] * rs, acc[ai][bj][m][1] * rs); } }
        } else {
#pragma unroll
            for (int bj = 0; bj < 2; ++bj) { const int c = (u.pn - 6) * 256 + bj * 128 + wc * 32 + 8 * fq;
                const f32x4 b0 = *(const f32x4*)(bgate + c), b1 = *(const f32x4*)(bgate + c + 4);
#pragma unroll
                for (int ai = 0; ai < 2; ++ai)
#pragma unroll
                    for (int m = 0; m < 4; ++m) { const int row = row0 + ai * 128 + m * 16; const float rs = rs_of(SS, row); f32x4 o0, o1;
#pragma unroll
                        for (int j = 0; j < 4; ++j) { o0[j] = fsigmoid(acc[ai][bj][m][0][j] * rs + b0[j]); o1[j] = fsigmoid(acc[ai][bj][m][1][j] * rs + b1[j]); }
                        *(v4u*)(G + (size_t)row * 2048 + c) = pack8(o0, o1); } }
        }
    }
};
struct EpiSsmY {
    const bf16* UX; const float* dskip; bf16* Y;
    __device__ __forceinline__ void operator()(const f32x4 (&acc)[2][2][4][2], const Unit& u, int wr, int wc) const {
        const int lane_ = lane_id_opaque(), fr = lane_ & 15, fq = lane_ >> 4;
        const int b = u.pm, g = u.pn, h0 = 8 * (fq & 1);
        const f32x4 d0 = *(const f32x4*)(dskip + g * 16 + h0), d1 = *(const f32x4*)(dskip + g * 16 + h0 + 4);
#pragma unroll
        for (int ai = 0; ai < 2; ++ai)
#pragma unroll
            for (int m = 0; m < 4; ++m) { const int r = ai * 128 + wr * 64 + m * 16 + fr;
#pragma unroll
                for (int bj = 0; bj < 2; ++bj) { const int tt = 8 * bj + 2 * wc + (fq >> 1);
                    float uu[8]; unpack8(*(const v4u*)(UX + ((size_t)(g * (NCH + 1) + b * 256 + r) * UXK + tt * 16 + h0)), uu);
                    f32x4 o0, o1;
#pragma unroll
                    for (int j = 0; j < 4; ++j) { o0[j] = fgelu_tanh(acc[ai][bj][m][0][j] + d0[j] * uu[j]); o1[j] = fgelu_tanh(acc[ai][bj][m][1][j] + d1[j] * uu[4 + j]); }
                    *(v4u*)(Y + ((size_t)(b * SEQ + r * 16 + tt) * DSSM + g * 16 + h0)) = pack8(o0, o1); }
                asm volatile("" ::: "memory"); }
    }
};
struct EpiMerge {
    const bf16* G; bf16* MC; bf16* MG;
    __device__ __forceinline__ void operator()(const f32x4 (&acc)[2][2][4][2], const Unit& u, int wr, int wc) const {
        const int lane_ = lane_id_opaque(), fr = lane_ & 15, fq = lane_ >> 4;
        const int row0 = u.pm * 256 + wr * 64 + fr;
        if (u.kind == 0) {
#pragma unroll
            for (int ai = 0; ai < 2; ++ai)
#pragma unroll
                for (int m = 0; m < 4; ++m) { const int row = row0 + ai * 128 + m * 16;
#pragma unroll
                    for (int bj = 0; bj < 2; ++bj) { const int c = u.pn * 256 + bj * 128 + wc * 32 + 8 * fq;
                        float gg[8]; unpack8(*(const v4u*)(G + (size_t)row * 2048 + c), gg); f32x4 o0, o1;
#pragma unroll
                        for (int j = 0; j < 4; ++j) { o0[j] = gg[j] * acc[ai][bj][m][0][j]; o1[j] = gg[4 + j] * acc[ai][bj][m][1][j]; }
                        *(v4u*)(MC + (size_t)row * D + c) = pack8(o0, o1); } }
        } else {
            const int c = u.pn * 256 + (u.kind - 1) * 128 + wc * 32 + 8 * fq;
#pragma unroll
            for (int ai = 0; ai < 2; ++ai)
#pragma unroll
                for (int m = 0; m < 4; ++m) { const int row = row0 + ai * 128 + m * 16;
                    float gg[8], mc[8]; unpack8(*(const v4u*)(G + (size_t)row * 2048 + D + c), gg); unpack8(*(const v4u*)(MC + (size_t)row * D + c), mc); f32x4 o0, o1;
#pragma unroll
                    for (int j = 0; j < 4; ++j) { o0[j] = mc[j] + gg[j] * (acc[ai][0][m][0][j] * fsigmoid(acc[ai][1][m][0][j])); o1[j] = mc[4 + j] + gg[4 + j] * (acc[ai][0][m][1][j] * fsigmoid(acc[ai][1][m][1][j])); }
                    *(v4u*)(MG + (size_t)row * D + c) = pack8(o0, o1); }
        }
    }
};
struct SsmOrder {
    int G, c; const char* UX; const char* BS2;
    __device__ __forceinline__ bool next(int i, Unit& u) const { const int L = i * G + c; if (L >= BATCH * NG) return false; const int b = L / NG, g = L % NG; u.pm = b; u.pn = g; u.kind = 0;
        u.A = UX + ((size_t)(g * (NCH + 1) + b * 256) * UXK) * 2; u.B = BS2 + (size_t)g * 256 * UXK * 2; return true; }
    __device__ __forceinline__ void a_ready(const Unit&) const {}
    __device__ __forceinline__ void done(const Unit&) const {}
};
struct MergeOrder {
    int G, c; const char* ZC; const char* Y; const char* WCAT;
    __device__ __forceinline__ bool next(int i, Unit& u) const { int pm, pn; const int su = i / 3, k = i - 3 * su; if (!pg8::static_tile(su, G, c, M / 256, D / 256, pm, pn)) return false; u.pm = pm; u.pn = pn; u.kind = k;
        u.A = (k == 0 ? ZC : Y) + (size_t)pm * 256 * 512 * 2; u.B = WCAT + (size_t)(k == 0 ? pn * 256 : 1024 + (2 * pn + k - 1) * 256) * 512 * 2; return true; }
    __device__ __forceinline__ void a_ready(const Unit&) const {}
    __device__ __forceinline__ void done(const Unit& u) const { if (u.kind == 0) asm volatile("s_waitcnt vmcnt(0)" ::: "memory"); }
};

__device__ __forceinline__ void p0_transpose_item(const float* W, int K, int N, bf16* WT, const float* gain, LAS float* scr, int k0, int n0, int drow0, int lane) {
    float v[32];
    const float* src = W + (size_t)(k0 + (lane >> 5)) * N + n0 + (lane & 31);
#pragma unroll
    for (int i = 0; i < 32; ++i) v[i] = src[(size_t)(2 * i) * N];
#pragma unroll
    for (int i = 0; i < 32; ++i) scr[(2 * i + (lane >> 5)) * 33 + (lane & 31)] = v[i];
    LDS_WAIT(); asm volatile("" ::: "memory");
    const int c = lane & 7;
    f32x4 g0 = (f32x4){1.f, 1.f, 1.f, 1.f}, g1 = g0; if (gain) { g0 = *(const f32x4*)(gain + k0 + 8 * c); g1 = *(const f32x4*)(gain + k0 + 8 * c + 4); }
#pragma unroll
    for (int j = 0; j < 4; ++j) { const int n = (lane >> 3) + 8 * j; const LAS float* s = scr + (8 * c) * 33 + n;
        v4u o; o.x = pk2(s[0 * 33] * g0[0], s[1 * 33] * g0[1]); o.y = pk2(s[2 * 33] * g0[2], s[3 * 33] * g0[3]); o.z = pk2(s[4 * 33] * g1[0], s[5 * 33] * g1[1]); o.w = pk2(s[6 * 33] * g1[2], s[7 * 33] * g1[3]);
        *(GAS v4u*)(WT + (size_t)(drow0 + n) * K + k0 + 8 * c) = o; }
    LDS_WAIT(); asm volatile("" ::: "memory");
}
__device__ __forceinline__ int glu_row(int n) { return 256 * (n >> 7) + (n & 127); }

constexpr int I_UP = (D / 64) * (DFF / 32), I_DN = (DFF / 64) * (D / 32), I_INP = (D / 64) * (DIN / 32), I_CP = (DCONV / 64) * (D / 32), I_WO = (D / 64) * (D / 32);
constexpr int T_W13A = 2 * I_UP, T_W2A = T_W13A + I_DN, T_WIN = T_W2A + I_INP, T_WCAT = T_WIN + 3 * I_CP, T_WOUT = T_WCAT + I_WO, T_W13B = T_WOUT + 2 * I_UP, T_W2B = T_W13B + I_DN;
__device__ __forceinline__ void weight_item(const Args& args, unsigned char* ws, LAS float* scr, int it, int lane) {
    if (it < T_W13A || (it >= T_WOUT && it < T_W13B)) { const bool second = it >= T_WOUT; int r = it - (second ? T_WOUT : 0); const int which = r / I_UP; r -= which * I_UP; const int nblk = DFF / 32, k0 = 64 * (r / nblk), n0 = 32 * (r % nblk);
        const float* W = second ? (which ? args.in[I_F2W3] : args.in[I_F2W1]) : (which ? args.in[I_F1W3] : args.in[I_F1W1]);
        p0_transpose_item(W, D, DFF, (bf16*)(ws + (second ? WS_W13B : WS_W13A)), second ? args.in[I_F2N] : args.in[I_F1N], scr, k0, n0, glu_row(n0) + which * 128, lane); return; }
    if (it < T_W2A || it >= T_W13B) { const bool second = it >= T_W13B; const int r = it - (second ? T_W13B : T_W13A); const int nblk = D / 32, k0 = 64 * (r / nblk), n0 = 32 * (r % nblk);
        p0_transpose_item(second ? args.in[I_F2W2] : args.in[I_F1W2], DFF, D, (bf16*)(ws + (second ? WS_W2B : WS_W2A)), nullptr, scr, k0, n0, n0, lane); return; }
    if (it < T_WIN) { const int r = it - T_W2A; const int nblk = DIN / 32, k0 = 64 * (r / nblk), n0 = 32 * (r % nblk);
        const int dr = n0 < 512 ? glu_row(n0) : n0 < 1024 ? glu_row(n0 - 512) + 128 : n0;
        p0_transpose_item(args.in[I_WIN], D, DIN, (bf16*)(ws + WS_WIN), args.in[I_MIXN], scr, k0, n0, dr, lane); return; }
    if (it < T_WCAT) { int r = it - T_WIN; const int which = r / I_CP; r -= which * I_CP; const int nblk = D / 32, k0 = 64 * (r / nblk), n0 = 32 * (r % nblk);
        const int dr = which == 0 ? n0 : 1024 + glu_row(n0) + (which == 2 ? 128 : 0);
        p0_transpose_item(which == 0 ? args.in[I_CPROJ] : which == 1 ? args.in[I_WV] : args.in[I_WG], DCONV, D, (bf16*)(ws + WS_WCAT), nullptr, scr, k0, n0, dr, lane); return; }
    { const int r = it - T_WCAT; const int nblk = D / 32, k0 = 64 * (r / nblk), n0 = 32 * (r % nblk); p0_transpose_item(args.in[I_WOUT], D, D, (bf16*)(ws + WS_WOUT), nullptr, scr, k0, n0, n0, lane); }
}

__device__ __forceinline__ void ssm_prep_job(Frame& F, const Args& args, int g) {
    LAS f32x2* lamP = (LAS f32x2*)(F.lds + RING_OFF);
    LAS f32x2* Bb = lamP + 17 * 64;
    LAS f32x2* Cc = Bb + 64 * 16;
    LAS float* Kk = (LAS float*)(Cc + 16 * 64);
    const float* lam_re = args.in[I_LRE]; const float* lam_im = args.in[I_LIM]; const float* log_dt = args.in[I_LDT];
    const float* b_re = args.in[I_BRE]; const float* b_im = args.in[I_BIM]; const float* c_re = args.in[I_CRE]; const float* c_im = args.in[I_CIM];
    const int tid = F.tid;
    const float dt = expf(log_dt[g]);
    if (tid < 64) { const int p = tid; const float a = lam_re[g * PS + p] * dt, bb = lam_im[g * PS + p] * dt, ea = expf(a), sb = sinf(bb), cb = cosf(bb);
        const float lx = ea * cb, ly = ea * sb; float px = 1.f, py = 0.f;
        for (int k = 0; k <= 16; ++k) { lamP[k * 64 + p] = (f32x2){px, py}; const float nx = px * lx - py * ly, ny = px * ly + py * lx; px = nx; py = ny; } }
    for (int i = tid; i < 1024; i += 512) { const int p = i >> 4;
        const float lr = lam_re[g * PS + p], li = lam_im[g * PS + p], a = lr * dt, bb = li * dt, ea = expf(a), sb = sinf(bb), cb = cosf(bb), sh = sinf(0.5f * bb);
        const float nr = expm1f(a) * cb - 2.f * sh * sh, ni = ea * sb, den = 1.f / (lr * lr + li * li), fr_ = (nr * lr + ni * li) * den, fi_ = (ni * lr - nr * li) * den;
        const float br = b_re[(size_t)g * 1024 + i], bi = b_im[(size_t)g * 1024 + i];
        Bb[i] = (f32x2){fr_ * br - fi_ * bi, fr_ * bi + fi_ * br};
        Cc[i] = (f32x2){c_re[(size_t)g * 1024 + i], c_im[(size_t)g * 1024 + i]}; }
    __syncthreads();
    for (int o = tid; o < 4096; o += 512) { const int k = o >> 8, h = (o >> 4) & 15, hp = o & 15; float s = 0.f;
        for (int p = 0; p < 64; ++p) { const f32x2 c = Cc[h * 64 + p], l = lamP[k * 64 + p], b = Bb[p * 16 + hp]; const float tr = l.x * b.x - l.y * b.y, ti = l.x * b.y + l.y * b.x; s += c.x * tr - c.y * ti; }
        Kk[o] = s; }
    __syncthreads();
    GAS unsigned* bs2 = (GAS unsigned*)(F.ws + WS_BS2) + (size_t)g * 256 * (UXK / 2);
    for (int i = tid; i < 256 * (UXK / 2); i += 512) { const int n = i / (UXK / 2), kp = (i % (UXK / 2)) * 2, t = n >> 4, h = n & 15; float v0, v1;
        if (kp < 256) { const int s = kp >> 4, hp = kp & 15; const bool on = s <= t; const int kb = (((t - s) & 15) << 8) + (h << 4) + hp; v0 = on ? Kk[kb] : 0.f; v1 = on ? Kk[kb + 1] : 0.f; }
        else { const int p = (kp - 256) >> 1; const f32x2 c = Cc[h * 64 + p], l = lamP[(t + 1) * 64 + p]; v0 = c.x * l.x - c.y * l.y; v1 = -(c.x * l.y + c.y * l.x); }
        bs2[i] = pk2(v0, v1); }
    GAS unsigned* wsi = (GAS unsigned*)(F.ws + WS_WSI) + (size_t)g * 128 * 128;
    for (int i = tid; i < 128 * 128; i += 512) { const int n = i >> 7, kp = (i & 127) * 2, p = n >> 1, c = n & 1, s = kp >> 4, h = kp & 15;
        const f32x2 l = lamP[(15 - s) * 64 + p], b0 = Bb[p * 16 + h], b1 = Bb[p * 16 + h + 1];
        const float v0 = c ? (l.x * b0.y + l.y * b0.x) : (l.x * b0.x - l.y * b0.y), v1 = c ? (l.x * b1.y + l.y * b1.x) : (l.x * b1.x - l.y * b1.y);
        wsi[i] = pk2(v0, v1); }
    if (tid < 64) ((GAS f32x2*)(F.ws + WS_LAMC))[g * 64 + tid] = lamP[16 * 64 + tid];
    __syncthreads();
}

template <int NS, bool NORM, class Fn>
__device__ __forceinline__ void meta_job(Frame& F, const float* A, int K, const bf16* Bt0, const bf16* Bt1, const Fn& fn) {
    LAS float* red = (LAS float*)(F.lds + RING_OFF);
    LAS float* rsc = red + 8 * 16 * 32;
    const int lane = F.lane, w = F.wave, fr = lane & 15, fq = lane >> 4;
    if (NORM) {
#pragma unroll
        for (int rr = 0; rr < 2; ++rr) { const int row = 2 * w + rr; float s = 0.f; for (int c = lane; c < D; c += 64) { const float v = A[(size_t)row * K + c]; s += v * v; } s = wave_sum(s); if (lane == 0) rsc[row] = 1.0f / sqrtf(s * (1.0f / D) + EPS); }
    } else if (F.tid < 16) rsc[F.tid] = 1.f;
    f32x4 acc[NS];
#pragma unroll
    for (int s = 0; s < NS; ++s) acc[s] = (f32x4){0.f, 0.f, 0.f, 0.f};
    const int kw = K / 8, kbase = w * kw;
#pragma unroll 4
    for (int k = kbase; k < kbase + kw; k += 32) {
        const f32x4 a0 = *(const f32x4*)(A + (size_t)fr * K + k + 8 * fq), a1 = *(const f32x4*)(A + (size_t)fr * K + k + 8 * fq + 4);
        const v4u ap = pack8(a0, a1); const bf16x8 af = __builtin_bit_cast(bf16x8, ap);
#pragma unroll
        for (int s = 0; s < NS; ++s) { const bf16x8 bf = *(const bf16x8*)((s == 0 ? Bt0 : Bt1) + (size_t)fr * K + k + 8 * fq); acc[s] = __builtin_amdgcn_mfma_f32_16x16x32_bf16(bf, af, acc[s], 0, 0, 0); } }
#pragma unroll
    for (int s = 0; s < NS; ++s) *(LAS f32x4*)(red + (w * 16 + fr) * 32 + s * 16 + 4 * fq) = acc[s];
    __syncthreads();
    if (F.tid < 256) { const int rr = F.tid >> 4, j = F.tid & 15; float v0 = 0.f, v1 = 0.f;
#pragma unroll
        for (int ww = 0; ww < 8; ++ww) { v0 += red[(ww * 16 + rr) * 32 + j]; if (NS > 1) v1 += red[(ww * 16 + rr) * 32 + 16 + j]; }
        const float sc = rsc[rr]; fn(rr, j, v0 * sc, v1 * sc); }
    __syncthreads();
}

__device__ __forceinline__ void ssm_statein_job(Frame& F, int g, int cb) {
    const int lane = F.lane, w = F.wave, fr = lane & 15, fq = lane >> 4;
    const bf16* UX = (const bf16*)(F.ws + WS_UX); const bf16* Wb = (const bf16*)(F.ws + WS_WSI) + (size_t)g * 128 * 256;
    float* S = (float*)(F.ws + WS_S);
    const int ci0 = 256 * cb + 32 * w;
    const bf16* Ab = UX + (size_t)(g * (NCH + 1) + ci0) * UXK;
    f32x4 acc[2][8];
#pragma unroll
    for (int mt = 0; mt < 2; ++mt)
#pragma unroll
        for (int nt = 0; nt < 8; ++nt) acc[mt][nt] = (f32x4){0.f, 0.f, 0.f, 0.f};
#pragma unroll 2
    for (int ks = 0; ks < 8; ++ks) { bf16x8 a[2], b[8];
#pragma unroll
        for (int mt = 0; mt < 2; ++mt) a[mt] = *(const bf16x8*)(Ab + (size_t)(16 * mt + fr) * UXK + 32 * ks + 8 * fq);
#pragma unroll
        for (int nt = 0; nt < 8; ++nt) b[nt] = *(const bf16x8*)(Wb + (size_t)(16 * nt + fr) * 256 + 32 * ks + 8 * fq);
#pragma unroll
        for (int mt = 0; mt < 2; ++mt)
#pragma unroll
            for (int nt = 0; nt < 8; ++nt) acc[mt][nt] = __builtin_amdgcn_mfma_f32_16x16x32_bf16(b[nt], a[mt], acc[mt][nt], 0, 0, 0); }
#pragma unroll
    for (int mt = 0; mt < 2; ++mt)
#pragma unroll
        for (int nt = 0; nt < 8; ++nt) *(f32x4*)(S + ((size_t)(ci0 + 16 * mt + fr) * NG + g) * 128 + 16 * nt + 4 * fq) = acc[mt][nt];
    if (cb == 0 && w == 0) {
        const bf16* Am = UX + (size_t)(g * (NCH + 1) + NCH) * UXK; f32x4 am[8];
#pragma unroll
        for (int nt = 0; nt < 8; ++nt) am[nt] = (f32x4){0.f, 0.f, 0.f, 0.f};
#pragma unroll 2
        for (int ks = 0; ks < 8; ++ks) { const bf16x8 a = *(const bf16x8*)(Am + 32 * ks + 8 * fq);
#pragma unroll
            for (int nt = 0; nt < 8; ++nt) { const bf16x8 b = *(const bf16x8*)(Wb + (size_t)(16 * nt + fr) * 256 + 32 * ks + 8 * fq); am[nt] = __builtin_amdgcn_mfma_f32_16x16x32_bf16(b, a, am[nt], 0, 0, 0); } }
        if (fr == 0) {
#pragma unroll
            for (int nt = 0; nt < 8; ++nt) *(f32x4*)((float*)(F.ws + WS_SMETA) + g * 128 + 16 * nt + 4 * fq) = am[nt]; }
    }
}

__device__ __forceinline__ void conv_job(Frame& F, const Args& args, int jt) {
    LAS unsigned char* zs = F.lds + RING_OFF;
    LAS float* cs = (LAS float*)(F.lds + RING_OFF + 62 * 1024);
    const bf16* Z = (const bf16*)(F.ws + WS_Z); bf16* ZC = (bf16*)(F.ws + WS_ZC);
    const int tid = F.tid, row0 = 32 * jt, b = row0 / SEQ, t0 = row0 % SEQ;
    for (int i = tid; i < 62 * 64; i += 512) { const int ri = i >> 6, cb = (i & 63) * 16, ti = t0 - 30 + ri; v4u v = (v4u){0u, 0u, 0u, 0u};
        if (ti >= 0) v = *(const v4u*)((const char*)Z + (size_t)(b * SEQ + ti) * 1024 + cb);
        else if (ti >= -NMETA) v = *(const v4u*)((const char*)Z + (size_t)(M + NMETA + ti) * 1024 + cb);
        *(LAS v4u*)(zs + ri * 1024 + cb) = v; }
    const int cp = tid & 255, th = tid >> 8;
    const float* dw = args.in[I_DW]; f32x2 wgt[CWID];
#pragma unroll
    for (int k = 0; k < CWID; ++k) wgt[k] = *(const f32x2*)(dw + k * DCONV + 2 * cp);
    const f32x2 bias = *(const f32x2*)(args.in[I_DWB] + 2 * cp);
    __syncthreads();
#pragma unroll 1
    for (int hf = 0; hf < 2; ++hf) {
        f32x2 acc[8];
#pragma unroll
        for (int t = 0; t < 8; ++t) acc[t] = bias;
        const LAS unsigned char* zb = zs + (16 * th + 8 * hf) * 1024 + 4 * cp;
#pragma unroll
        for (int i = 0; i < 38; ++i) { const unsigned zz = *(const LAS unsigned*)(zb + i * 1024); const float z0 = bf2f(zz & 0xffffu), z1 = bf2f(zz >> 16);
#pragma unroll
            for (int t = 0; t < 8; ++t) { const int k = i - t; if (k >= 0 && k < CWID) { acc[t].x += wgt[k].x * z0; acc[t].y += wgt[k].y * z1; } } }
#pragma unroll
        for (int t = 0; t < 8; ++t) *(LAS f32x2*)(cs + (16 * th + 8 * hf + t) * 512 + 2 * cp) = acc[t];
    }
    __syncthreads();
    const int lane = F.lane, w = F.wave;
    const f32x4 g0 = *(const f32x4*)(args.in[I_LNG] + 4 * lane), g1 = *(const f32x4*)(args.in[I_LNG] + 256 + 4 * lane), b0 = *(const f32x4*)(args.in[I_LNB] + 4 * lane), b1 = *(const f32x4*)(args.in[I_LNB] + 256 + 4 * lane);
#pragma unroll
    for (int q = 0; q < 4; ++q) { const int t = 4 * w + q; const f32x4 x0 = *(const LAS f32x4*)(cs + t * 512 + 4 * lane), x1 = *(const LAS f32x4*)(cs + t * 512 + 256 + 4 * lane);
        const float mu = wave_sum((x0[0] + x0[1]) + (x0[2] + x0[3]) + (x1[0] + x1[1]) + (x1[2] + x1[3])) * (1.f / DCONV);
        const f32x4 d0 = x0 - mu, d1 = x1 - mu;
        const float var = wave_sum((d0[0] * d0[0] + d0[1] * d0[1]) + (d0[2] * d0[2] + d0[3] * d0[3]) + (d1[0] * d1[0] + d1[1] * d1[1]) + (d1[2] * d1[2] + d1[3] * d1[3])) * (1.f / DCONV);
        const float rstd = 1.0f / sqrtf(var + EPS); f32x4 o0 = d0 * rstd * g0 + b0, o1 = d1 * rstd * g1 + b1;
#pragma unroll
        for (int j = 0; j < 4; ++j) { o0[j] = fsilu(o0[j]); o1[j] = fsilu(o1[j]); }
        bf16* zr = ZC + (size_t)(row0 + t) * DCONV;
        *(v2u*)(zr + 4 * lane) = (v2u){cvt_pk_bf16(o0[0], o0[1]), cvt_pk_bf16(o0[2], o0[3])}; *(v2u*)(zr + 256 + 4 * lane) = (v2u){cvt_pk_bf16(o1[0], o1[1]), cvt_pk_bf16(o1[2], o1[3])}; }
    __syncthreads();
}

__device__ __forceinline__ void ssm_scan_job(Frame& F, int b, int g) {
    LAS f32x2* Sl = (LAS f32x2*)(F.lds + RING_OFF);
    const float* S = (const float*)(F.ws + WS_S); bf16* UX = (bf16*)(F.ws + WS_UX);
    const int lane = F.lane, w = F.wave;
#pragma unroll 8
    for (int i = 0; i < 32; ++i) { const int ci = 32 * w + i; Sl[ci * 64 + lane] = *(const f32x2*)(S + ((size_t)(b * 256 + ci) * NG + g) * 128 + 2 * lane); }
    __syncthreads();
    if (w == 0) { const f32x2 lc = ((const f32x2*)(F.ws + WS_LAMC))[g * 64 + lane]; f32x2 x = *(const f32x2*)((const float*)(F.ws + WS_SMETA) + g * 128 + 2 * lane);
        unsigned* xp = (unsigned*)(UX + (size_t)(g * (NCH + 1) + b * 256) * UXK + 256) + lane;
#pragma unroll 8
        for (int ci = 0; ci < 256; ++ci) { xp[(size_t)ci * (UXK / 2)] = pk2(x.x, x.y); const f32x2 s = Sl[ci * 64 + lane]; const float nx = lc.x * x.x - lc.y * x.y + s.x, ny = lc.x * x.y + lc.y * x.x + s.y; x.x = nx; x.y = ny; }
        VM_WAIT(); }
    __syncthreads();
}

__global__ void __launch_bounds__(NWAVES * 64, 2) hyb_fwd(Args args) {
    extern __shared__ __attribute__((aligned(16))) unsigned char lds[];
    Frame F;
    F.lds = (LAS unsigned char*)lds; F.MISC = (volatile LAS unsigned*)(F.lds + MISC_OFF);
    F.wave = __builtin_amdgcn_readfirstlane((int)threadIdx.x >> 6); F.lane = lane_id_opaque(); F.tid = F.wave * 64 + F.lane;
    F.G = gridDim.x; { const int bx = blockIdx.x; F.vcu = (F.G % 8 == 0) ? (bx % 8) * (F.G / 8) + bx / 8 : bx; }
    F.ws = args.ws; F.out = args.out; F.ctl = (gu32*)(args.ws + WS_CTL);
    for (int u = F.tid; u < (LDS_BYTES - LDSCTL_OFF) / 4; u += NWAVES * 64) ((LAS unsigned*)(F.lds + LDSCTL_OFF))[u] = 0u;
    __syncthreads();
    const int bli = (N_LAUNCHES == PER_PHASE) ? 0 : args.li;
    XcdBarrier bar; bar.bar = (unsigned*)(F.ctl + CW_BAR) + bli * XCD_BAR_WORDS; bar.x = 0; bar.st = nullptr;
    if (N_LAUNCHES != PER_PHASE) bar = xcd_barrier_post((unsigned*)(F.ctl + CW_BAR) + bli * XCD_BAR_WORDS, F.MISC + 8);
    const int lo = args.ph_lo, hi = args.ph_hi;
#ifndef PHMASK
#define PHMASK 0x7ff
#endif
#define IN(k) (((PHMASK >> (k)) & 1) && lo <= (k) && (k) < hi)
#define SEAM(k) do { if (IN(k) && IN((k) + 1)) xcd_barrier(bar); F.lane = lane_id_opaque(); F.tid = F.wave * 64 + F.lane; } while (0)
    unsigned char* ws = F.ws;
    bf16* W13A = (bf16*)(ws + WS_W13A); bf16* W2A = (bf16*)(ws + WS_W2A); bf16* WIN = (bf16*)(ws + WS_WIN); bf16* WCAT = (bf16*)(ws + WS_WCAT); bf16* WOUT = (bf16*)(ws + WS_WOUT);
    bf16* W13B = (bf16*)(ws + WS_W13B); bf16* W2B = (bf16*)(ws + WS_W2B);
    bf16* AB = (bf16*)(ws + WS_AB); bf16* H1B = (bf16*)(ws + WS_H1); bf16* H2B = (bf16*)(ws + WS_H1 + 32 * MiB); bf16* HID = (bf16*)(ws + WS_HID);
    bf16* Zb = (bf16*)(ws + WS_Z); bf16* UXb = (bf16*)(ws + WS_UX); bf16* ZCb = (bf16*)(ws + WS_ZC); bf16* Yb = (bf16*)(ws + WS_Y); bf16* MCb = (bf16*)(ws + WS_MC);
    float* SS0 = (float*)(ws + WS_SS0); float* SS1 = SS0 + M; float* SS2 = SS1 + M; float* SS3 = SS2 + M;
    float* HIDM = (float*)(ws + WS_HIDM); float* H1M = (float*)(ws + WS_H1M); float* SSD = (float*)(ws + WS_SSD);
    bf16* Gb = (bf16*)F.out;
    const int bx = (int)blockIdx.x;
    const int gw = F.vcu * NWAVES + F.wave, NGW = F.G * NWAVES;
    const int lb = bx - F.G / 2;
    const int lgw = lb * NWAVES + F.wave, NLGW = (F.G - F.G / 2) * NWAVES;

    if (IN(0)) {
        LAS float* scr = (LAS float*)(F.lds + RING_OFF + F.wave * 16384);
        for (int it = gw; it < T_W13A; it += NGW) weight_item(args, ws, scr, it, F.lane);
        for (int m = gw; m < M; m += NGW) { const GAS f32x4* xr = (const GAS f32x4*)(args.in[I_X] + (size_t)m * D) + F.lane; f32x4 v[4]; float s = 0.f;
#pragma unroll
            for (int j = 0; j < 4; ++j) { v[j] = xr[64 * j]; s += (v[j].x * v[j].x + v[j].y * v[j].y) + (v[j].z * v[j].z + v[j].w * v[j].w); }
            s = wave_sum(s);
            GAS v2u* o8 = (GAS v2u*)(AB + (size_t)m * D) + F.lane;
#pragma unroll
            for (int j = 0; j < 4; ++j) o8[64 * j] = (v2u){pk2(v[j].x, v[j].y), pk2(v[j].z, v[j].w)};
            if (F.lane == 0) { SS0[m] = s; SS1[m] = 0.f; SS2[m] = 0.f; SS3[m] = 0.f; } }
    }
    SEAM(0);
    if (IN(1)) {
        pg8::Gemm g{D, D, D}; pg8::GridOrder S{M / 256, 2 * DFF / 256, F.G, bx, (const char*)AB, (const char*)W13A, (size_t)256 * D * 2, (size_t)256 * D * 2};
        EpiSwiglu E{HID, SS0};
        pg8::gemm_phase(F.lds + RING_OFF, F.wave, g, S, E);
        if (lb >= 0) {
            F.lane = lane_id_opaque(); F.tid = F.wave * 64 + F.lane;
            if (lb < NG) ssm_prep_job(F, args, lb);
            for (int j = lb; j < DFF / 16; j += F.G - F.G / 2) { float* hm = HIDM; const int c0 = 16 * j; const bf16* b0 = W13A + (size_t)glu_row(c0) * D;
                meta_job<2, true>(F, args.in[I_META], D, b0, b0 + (size_t)128 * D, [=](int r, int jj, float a, float b) { hm[r * DFF + c0 + jj] = fsilu(a) * b; }); }
            LAS float* scr = (LAS float*)(F.lds + RING_OFF + F.wave * 16384);
            for (int it = T_W13A + lgw; it < T_WIN; it += NLGW) weight_item(args, ws, scr, it, F.lane);
        }
    }
    SEAM(1);
    if (IN(2)) {
        pg8::Gemm g{DFF, DFF, DFF}; pg8::GridOrder S{M / 256, D / 256, F.G, bx, (const char*)HID, (const char*)W2A, (size_t)256 * DFF * 2, (size_t)256 * DFF * 2};
        EpiResid<false> E{args.in[I_X], H1B, (args.dupk == 2) ? SSD : SS1, 0.5f};
        pg8::gemm_phase(F.lds + RING_OFF, F.wave, g, S, E);
        F.lane = lane_id_opaque(); F.tid = F.wave * 64 + F.lane;
        for (int j = bx; j < D / 16; j += F.G) { float* hm = H1M; const float* mt = args.in[I_META]; const int c0 = 16 * j;
            meta_job<1, false>(F, HIDM, DFF, W2A + (size_t)c0 * DFF, nullptr, [=](int r, int jj, float a, float) { hm[r * D + c0 + jj] = mt[r * D + c0 + jj] + 0.5f * a; }); }
    }
    SEAM(2);
    if (IN(3)) {
        pg8::Gemm g{D, D, D}; pg8::GridOrder S{M / 256, DIN / 256, F.G, bx, (const char*)H1B, (const char*)WIN, (size_t)256 * D * 2, (size_t)256 * D * 2};
        EpiMix E{SS1, Zb, UXb, Gb, args.in[I_BGATE]};
        pg8::gemm_phase(F.lds + RING_OFF, F.wave, g, S, E);
        if (lb >= 0) {
            F.lane = lane_id_opaque(); F.tid = F.wave * 64 + F.lane;
            for (int j = lb; j < 64; j += F.G - F.G / 2) {
                if (j < 32) { bf16* zz = Zb; const int c0 = 16 * j; const bf16* b0 = WIN + (size_t)glu_row(c0) * D;
                    meta_job<2, true>(F, H1M, D, b0, b0 + (size_t)128 * D, [=](int r, int jj, float a, float b) { zz[(size_t)(M + r) * DCONV + c0 + jj] = (bf16)f2bf(a * fsigmoid(b)); });
                } else { bf16* ux = UXb; const int gg = j - 32;
                    meta_job<1, true>(F, H1M, D, WIN + (size_t)(1024 + 16 * gg) * D, nullptr, [=](int r, int jj, float a, float) { ux[(size_t)(gg * (NCH + 1) + NCH) * UXK + r * 16 + jj] = (bf16)f2bf(a); }); }
            }
            LAS float* scr = (LAS float*)(F.lds + RING_OFF + F.wave * 16384);
            for (int it = T_WIN + lgw; it < T_W2B; it += NLGW) weight_item(args, ws, scr, it, F.lane);
        }
    }
    SEAM(3);
    if (IN(4)) {
        if (bx < 128) ssm_statein_job(F, bx & 31, bx >> 5);
        asm volatile("" ::: "memory");
        for (int j = bx; j < 512; j += F.G) conv_job(F, args, j);
    }
    SEAM(4);
    if (IN(5)) {
        if (bx < BATCH * NG) ssm_scan_job(F, bx / NG, bx % NG);
        pg8::Gemm g{UXK, UXK, UXK}; SsmOrder S{F.G >= BATCH * NG ? F.G : BATCH * NG, bx, (const char*)UXb, (const char*)(ws + WS_BS2)};
        EpiSsmY E{UXb, args.in[I_SD], Yb};
        pg8::gemm_phase(F.lds + RING_OFF, F.wave, g, S, E);
    }
    SEAM(5);
    if (IN(6)) {
        pg8::Gemm g{512, 512, 512}; MergeOrder S{F.G, bx, (const char*)ZCb, (const char*)Yb, (const char*)WCAT};
        EpiMerge E{Gb, MCb, AB};
        pg8::gemm_phase(F.lds + RING_OFF, F.wave, g, S, E);
    }
    SEAM(6);
    if (IN(7)) {
        pg8::Gemm g{D, D, D}; pg8::GridOrder S{M / 256, D / 256, F.G, bx, (const char*)AB, (const char*)WOUT, (size_t)256 * D * 2, (size_t)256 * D * 2};
        EpiResid<true> E{H1B, H2B, (args.dupk == 7) ? SSD : SS2, 1.0f};
        pg8::gemm_phase(F.lds + RING_OFF, F.wave, g, S, E);
    }
    SEAM(7);
    if (IN(8)) {
        pg8::Gemm g{D, D, D}; pg8::GridOrder S{M / 256, 2 * DFF / 256, F.G, bx, (const char*)H2B, (const char*)W13B, (size_t)256 * D * 2, (size_t)256 * D * 2};
        EpiSwiglu E{HID, SS2};
        pg8::gemm_phase(F.lds + RING_OFF, F.wave, g, S, E);
    }
    SEAM(8);
    if (IN(9)) {
        pg8::Gemm g{DFF, DFF, DFF}; pg8::GridOrder S{M / 256, D / 256, F.G, bx, (const char*)HID, (const char*)W2B, (size_t)256 * DFF * 2, (size_t)256 * DFF * 2};
        const bool dup9 = args.dupk == 9;
        EpiFinal E{H2B, F.out, dup9 ? SSD : SS3, (unsigned*)(F.ctl + CW_FIN) + (dup9 ? 64 * 64 : 0), args.in[I_FINN], 0.5f};
        pg8::gemm_phase(F.lds + RING_OFF, F.wave, g, S, E);
    }
#undef IN
#undef SEAM
}

extern "C" void kernel_launch(void* const* d_in, const int* in_sizes, int n_in, void* d_out, int out_size, void* d_ws, size_t ws_size, hipStream_t stream) {
    static int grid = 0;
    if (grid == 0) {
        if (n_in != 30 || in_sizes[0] != M * D || out_size != M * D || ws_size < WS_END) { fprintf(stderr, "kernel_launch: unexpected problem shape (n_in %d, in0 %d, out %d, ws %zu); nothing launched\n", n_in, n_in > 0 ? in_sizes[0] : -1, out_size, ws_size); grid = -1; return; }
        int dev = 0, cus = 0, per_cu = 0;
        if (hipGetDevice(&dev) != hipSuccess || hipDeviceGetAttribute(&cus, hipDeviceAttributeMultiprocessorCount, dev) != hipSuccess) { grid = -1; return; }
        if (hipFuncSetAttribute((const void*)hyb_fwd, hipFuncAttributeMaxDynamicSharedMemorySize, LDS_BYTES) != hipSuccess) { fprintf(stderr, "kernel_launch: hipFuncSetAttribute failed\n"); grid = -1; return; }
        if (hipOccupancyMaxActiveBlocksPerMultiprocessor(&per_cu, (const void*)hyb_fwd, NWAVES * 64, LDS_BYTES) != hipSuccess || per_cu < 1)
            fprintf(stderr, "kernel_launch: note: occupancy query reports %d workgroups per CU\n", per_cu);
        (void)hipGetLastError();
        grid = cus;
    }
    if (grid < 0) return;
    if (hipMemsetAsync((char*)d_ws + WS_CTL, 0, CTL_ZERO_BYTES, stream) != hipSuccess) { fprintf(stderr, "kernel_launch: hipMemsetAsync failed\n"); return; }
    Args a{};
    for (int i = 0; i < 30; ++i) a.in[i] = (const float*)d_in[i];
    a.out = (float*)d_out; a.ws = (unsigned char*)d_ws;
    constexpr int NL = (DUPK >= 0) ? 2 : N_LAUNCHES;
    for (int li = 0; li < NL; ++li) {
        if (DUPK >= 0) { a.ph_lo = li == 0 ? 0 : DUPK; a.ph_hi = li == 0 ? DUPK + 1 : PER_PHASE; a.dupk = li == 0 ? DUPK : -1; }
        else { a.ph_lo = (N_LAUNCHES == PER_PHASE) ? li : 0; a.ph_hi = (N_LAUNCHES == PER_PHASE) ? li + 1 : PER_PHASE; a.dupk = -1; }
        a.li = li;
        hipLaunchKernelGGL(hyb_fwd, dim3(grid), dim3(NWAVES * 64), LDS_BYTES, stream, a);
        const hipError_t le = hipPeekAtLastError();
        if (le != hipSuccess) { fprintf(stderr, "kernel_launch: launch %d failed: %s\n", li, hipGetErrorName(le)); break; }
    }
}
```

```cpp
#include <hip/hip_runtime.h>
#include <cstdio>
#include <cstdint>

#ifndef MK_N_LAUNCHES
#define MK_N_LAUNCHES 1
#endif
#ifndef DUPK
#define DUPK -1
#endif

__device__ __forceinline__ int lane_id_opaque() { int l; asm volatile("v_mbcnt_lo_u32_b32 %0, -1, 0\n\tv_mbcnt_hi_u32_b32 %0, -1, %0" : "=v"(l)); return l; }
namespace pg8 {
#define PG8_LAS __attribute__((address_space(3)))
typedef unsigned short bf16_t;
typedef short bf16x8 __attribute__((ext_vector_type(8)));
typedef float f32x4 __attribute__((ext_vector_type(4)));
typedef unsigned u32x4 __attribute__((ext_vector_type(4)));
constexpr int BM = 256, BK = 64, HALF = 128, HTB = HALF * BK * 2, STAGE_BYTES = 8 * HTB, NXCD = 8, WGM = 8;

__host__ __device__ __forceinline__ int lds_byte(int r, int c) { const int st = (r >> 4) * 2 + (c >> 5), rr = r & 15, cc = c & 31, ob = rr * 64 + cc * 2; return st * 1024 + (ob ^ (((ob >> 9) & 1) << 5)); }
__host__ __device__ __forceinline__ void stage_rc(int b, int& R, int& C) { const int st = b / 1024, sb = b % 1024, swz = sb ^ (((sb >> 9) & 1) << 5); R = (st >> 1) * 16 + swz / 64; C = (st & 1) * 32 + (swz % 64) / 2; }
__host__ __device__ __forceinline__ int perm32(int rho) { const int n = rho >> 4, i = rho & 15; return 8 * (i >> 2) + 4 * n + (i & 3); }

struct Unit { int pm, pn, kind; const char* A; const char* B; };
struct Gemm { int lda, ldb, K; };

__device__ __forceinline__ bool static_tile(int i, int G, int c, int nM, int nN, int& pm, int& pn) {
    const int nwg = nM * nN; const long L = (long)i * G + c; if (L >= nwg) return false;
    int wgid = (int)L; { const int q = nwg / NXCD, r = nwg % NXCD, xcd = wgid % NXCD, off = wgid / NXCD; wgid = (xcd < r ? xcd * (q + 1) : r * (q + 1) + (xcd - r) * q) + off; }
    const int nig = WGM * nN, gid = wgid / nig, fm = gid * WGM, gsz = (nM - fm) < WGM ? (nM - fm) : WGM;
    pm = fm + ((wgid % nig) % gsz); pn = (wgid % nig) / gsz; return true;
}
struct GridOrder {
    int nM, nN, G, c; const char* A; const char* B; size_t tA, tB;
    __device__ __forceinline__ bool next(int i, Unit& u) const { int pm, pn; if (!static_tile(i, G, c, nM, nN, pm, pn)) return false; u.pm = pm; u.pn = pn; u.kind = 0; u.A = A + (size_t)pm * tA; u.B = B + (size_t)pn * tB; return true; }
    __device__ __forceinline__ void a_ready(const Unit&) const {}
    __device__ __forceinline__ void done(const Unit&) const {}
};

__device__ __forceinline__ unsigned cvt_pk_bf16(float lo, float hi) { unsigned r; asm volatile("v_cvt_pk_bf16_f32 %0, %1, %2" : "=v"(r) : "v"(lo), "v"(hi)); return r; }

template <class Epi, class Sched>
__device__ __forceinline__ void gemm_phase(PG8_LAS unsigned char* lds, const int wid  , const Gemm g, const Sched& S, const Epi& E) {
    const int lane = lane_id_opaque(), tid = wid * 64 + lane, wr = wid >> 2, wc = wid & 3, fr = lane & 15, fq = lane >> 4;
    const int K = g.K, nt = K / BK;
    unsigned voffA[2], voffB[2];
#pragma unroll
    for (int i = 0; i < 2; ++i) { int R, C; stage_rc(tid * 16 + i * 8192, R, C); const int Rb = (R & ~31) + perm32(R & 31);
        voffA[i] = (unsigned)(R * g.lda + C) * 2u; voffB[i] = (unsigned)(Rb * g.ldb + C) * 2u; }
    const size_t kstep = (size_t)(BK * 2);
    const size_t hstepA = (size_t)HALF * g.lda * 2, hstepB = (size_t)HALF * g.ldb * 2;
    const unsigned ldsw = (unsigned)wid * 1024u;
    const int aoff = lds_byte(wr * 64 + fr, fq * 8), boff = lds_byte(wc * 32 + fr, fq * 8);
#define PG8_SA(b, h) (((b) * 2 + (h)) * HTB)
#define PG8_SB(b, h) ((4 + (b) * 2 + (h)) * HTB)
#define PG8_STAGE(bufoff, gbase, voff) do { _Pragma("unroll") for (int _i = 0; _i < 2; ++_i) \
        __builtin_amdgcn_global_load_lds((const unsigned*)((const char*)(gbase) + (voff)[_i]), (PG8_LAS unsigned*)(lds + (bufoff) + ldsw + _i * 8192), 16, 0, 0); } while (0)
#define PG8_LDA(dst, b, h) do { _Pragma("unroll") for (int m = 0; m < 4; ++m) _Pragma("unroll") for (int k = 0; k < 2; ++k) dst[m][k] = *(const PG8_LAS bf16x8*)(lds + PG8_SA(b, h) + aoff + m * 2048 + k * 1024); } while (0)
#define PG8_LDB(dst, b, h) do { _Pragma("unroll") for (int n = 0; n < 2; ++n) _Pragma("unroll") for (int k = 0; k < 2; ++k) dst[n][k] = *(const PG8_LAS bf16x8*)(lds + PG8_SB(b, h) + boff + n * 2048 + k * 1024); } while (0)
#define PG8_MMA(ai, bj, At, Bt) do { __builtin_amdgcn_s_setprio(1); _Pragma("unroll") for (int m = 0; m < 4; ++m) _Pragma("unroll") for (int n = 0; n < 2; ++n) _Pragma("unroll") for (int k = 0; k < 2; ++k) \
        acc[ai][bj][m][n] = __builtin_amdgcn_mfma_f32_16x16x32_bf16(Bt[n][k], At[m][k], acc[ai][bj][m][n], 0, 0, 0); __builtin_amdgcn_s_setprio(0); } while (0)
#define PG8_WAIT_V(n) asm volatile("s_waitcnt vmcnt(" #n ")" ::: "memory")
#define PG8_WAIT_L(n) asm volatile("s_waitcnt lgkmcnt(" #n ")" ::: "memory")
#define PG8_BAR __builtin_amdgcn_s_barrier()
#define PG8_SCHED __builtin_amdgcn_sched_barrier(0)
    Unit cur, nxt; int ui = 0;
    if (!S.next(0, cur)) return;
    f32x4 acc[2][2][4][2];
#pragma unroll
    for (int a = 0; a < 2; ++a)
#pragma unroll
        for (int b = 0; b < 2; ++b)
#pragma unroll
            for (int m = 0; m < 4; ++m)
#pragma unroll
                for (int n = 0; n < 2; ++n) acc[a][b][m][n] = (f32x4){0.f, 0.f, 0.f, 0.f};
    bf16x8 At[4][2], B0[2][2], B1[2][2];
    const char* cA = cur.A; const char* cB = cur.B;
    S.a_ready(cur);
    PG8_STAGE(PG8_SB(0, 0), cB, voffB); PG8_STAGE(PG8_SB(0, 1), cB + hstepB, voffB); PG8_STAGE(PG8_SA(0, 0), cA, voffA); PG8_STAGE(PG8_SA(0, 1), cA + hstepA, voffA);
    if (wr == 1) PG8_BAR;
    PG8_WAIT_V(2); PG8_BAR;
    PG8_STAGE(PG8_SB(1, 0), cB + kstep, voffB); PG8_STAGE(PG8_SA(1, 0), cA + kstep, voffA); PG8_STAGE(PG8_SB(1, 1), cB + hstepB + kstep, voffB);
    PG8_WAIT_V(6); PG8_BAR;
    for (;;) {
        const bool has_next = S.next(ui + 1, nxt);
        const char* nA = has_next ? nxt.A : cA; const char* nB = has_next ? nxt.B : cB;
        for (int t = 0; t < nt; t += 2) {
            const bool last = (t == nt - 2);
            const char* a1 = cA + (size_t)(t + 1) * kstep;
            const char* a2 = last ? nA : cA + (size_t)(t + 2) * kstep; const char* b2 = last ? nB : cB + (size_t)(t + 2) * kstep;
            const char* a3 = a2 + kstep; const char* b3 = b2 + kstep;
            if (last && has_next) S.a_ready(nxt);
            PG8_LDB(B0, 0, 0); PG8_LDB(B1, 0, 1); PG8_SCHED; PG8_LDA(At, 0, 0); PG8_STAGE(PG8_SA(1, 1), a1 + hstepA, voffA);
            PG8_WAIT_V(8); PG8_WAIT_L(0); PG8_BAR; PG8_MMA(0, 0, At, B0); PG8_MMA(0, 1, At, B1); PG8_BAR; PG8_SCHED;
            PG8_LDA(At, 0, 1); PG8_STAGE(PG8_SB(0, 0), b2, voffB); PG8_STAGE(PG8_SB(0, 1), b2 + hstepB, voffB); PG8_STAGE(PG8_SA(0, 0), a2, voffA);
            PG8_WAIT_V(8); PG8_WAIT_L(0); PG8_BAR; PG8_MMA(1, 0, At, B0); PG8_MMA(1, 1, At, B1); PG8_BAR; PG8_SCHED;
            PG8_LDB(B0, 1, 0); PG8_LDB(B1, 1, 1); PG8_SCHED; PG8_LDA(At, 1, 0); PG8_STAGE(PG8_SA(0, 1), a2 + hstepA, voffA);
            PG8_WAIT_V(8); PG8_WAIT_L(0); PG8_BAR; PG8_MMA(0, 0, At, B0); PG8_MMA(0, 1, At, B1); PG8_BAR; PG8_SCHED;
            PG8_LDA(At, 1, 1); PG8_STAGE(PG8_SB(1, 0), b3, voffB); PG8_STAGE(PG8_SB(1, 1), b3 + hstepB, voffB); PG8_STAGE(PG8_SA(1, 0), a3, voffA);
            PG8_WAIT_V(8); PG8_WAIT_L(0); PG8_BAR; PG8_MMA(1, 0, At, B0); PG8_MMA(1, 1, At, B1); PG8_BAR; PG8_SCHED;
        }
        if (wr == 0) PG8_BAR;
        E(acc, cur, wr, wc); S.done(cur);
        if (!has_next) break;
#pragma unroll
        for (int a = 0; a < 2; ++a)
#pragma unroll
            for (int b = 0; b < 2; ++b)
#pragma unroll
                for (int m = 0; m < 4; ++m)
#pragma unroll
                    for (int n = 0; n < 2; ++n) acc[a][b][m][n] = (f32x4){0.f, 0.f, 0.f, 0.f};
        cur = nxt; cA = nA; cB = nB; ++ui;
        if (wr == 1) PG8_BAR;
    }
    PG8_WAIT_V(0);
    PG8_BAR;
#undef PG8_SA
#undef PG8_SB
#undef PG8_STAGE
#undef PG8_LDA
#undef PG8_LDB
#undef PG8_MMA
#undef PG8_WAIT_V
#undef PG8_WAIT_L
#undef PG8_BAR
#undef PG8_SCHED
}
}

constexpr int NWAVES = 8;
constexpr int D = 1024, BATCH = 4, SEQ = 4096, NMETA = 16, DFF = 2816, DCONV = 512, CWID = 31, DSSM = 512, HG = 16, NG = 32, PS = 64;
constexpr int DIN = 2 * DCONV + DSSM + 2 * D;
constexpr int M = BATCH * SEQ;
constexpr int NCH = M / 16;
constexpr int UXK = 384;
constexpr float EPS = 1e-6f;
constexpr int PER_PHASE = 10;
constexpr int N_LAUNCHES = MK_N_LAUNCHES;

constexpr size_t MiB = 1u << 20;
constexpr size_t WS_CTL = 0, CTL_ZERO_BYTES = 1 * MiB;
constexpr size_t WS_BS2 = 1 * MiB;
constexpr size_t WS_WSI = 7 * MiB;
constexpr size_t WS_SMALL = 9 * MiB;
constexpr size_t WS_LAMC = WS_SMALL;
constexpr size_t WS_SMETA = WS_SMALL + 16384;
constexpr size_t WS_SS0 = WS_SMALL + 32768;
constexpr size_t WS_HIDM = WS_SMALL + 32768 + 4 * 65536;
constexpr size_t WS_H1M = WS_HIDM + 16 * DFF * 4;
constexpr size_t WS_SSD = WS_H1M + 16 * D * 4;
constexpr size_t WS_W13A = 11 * MiB, WS_W2A = 22 * MiB, WS_WIN = 28 * MiB, WS_WCAT = 35 * MiB, WS_WOUT = 38 * MiB, WS_W13B = 40 * MiB, WS_W2B = 51 * MiB;
constexpr size_t WS_AB = 57 * MiB;
constexpr size_t WS_H1 = 89 * MiB;
constexpr size_t WS_HID = 153 * MiB;
constexpr size_t WS_Z = WS_HID;
constexpr size_t WS_UX = WS_HID + 17 * MiB;
constexpr size_t WS_ZC = WS_HID + 42 * MiB;
constexpr size_t WS_Y = WS_HID + 58 * MiB;
constexpr size_t WS_MC = WS_HID;
constexpr size_t WS_S = WS_HID + 74 * MiB;
constexpr size_t WS_END = 256 * MiB;
static_assert(WS_SSD + 65536 <= WS_W13A, "small tables");
static_assert(WS_W2B + (size_t)D * DFF * 2 <= WS_AB && WS_AB + (size_t)M * D * 2 <= WS_H1 && WS_H1 + (size_t)M * D * 4 <= WS_HID, "ws map 1");
static_assert(WS_Z + (size_t)(M + 16) * DCONV * 2 <= WS_UX && WS_UX + (size_t)NG * (NCH + 1) * UXK * 2 <= WS_ZC && WS_ZC + (size_t)M * DCONV * 2 <= WS_Y && WS_Y + (size_t)M * DSSM * 2 <= WS_S, "ws map 2");
static_assert(WS_MC + (size_t)M * D * 2 <= WS_ZC, "MC overlay");
static_assert(WS_HID + (size_t)M * DFF * 2 <= WS_END && WS_S + (size_t)NCH * NG * 128 * 4 <= WS_END, "ws end");
static_assert(WS_W13A + (size_t)2 * DFF * D * 2 <= WS_W2A && WS_W2A + (size_t)D * DFF * 2 <= WS_WIN && WS_WIN + (size_t)DIN * D * 2 <= WS_WCAT && WS_WCAT + (size_t)3072 * 512 * 2 <= WS_WOUT && WS_WOUT + (size_t)D * D * 2 <= WS_W13B && WS_W13B + (size_t)2 * DFF * D * 2 <= WS_W2B, "weights");
static_assert(WS_BS2 + (size_t)NG * 256 * UXK * 2 <= WS_WSI && WS_WSI + (size_t)NG * 128 * 256 * 2 <= WS_SMALL, "ssm mats");
constexpr int CW_BAR = 4096;
constexpr int CW_FIN = 16384;

constexpr int RING_OFF = 0, RING_BYTES = 131072;
constexpr int LDSCTL_OFF = RING_BYTES, MISC_OFF = LDSCTL_OFF + 320;
constexpr int LDS_BYTES = 147456;

#define GAS __attribute__((address_space(1)))
#define LAS __attribute__((address_space(3)))
typedef unsigned short bf16;
typedef unsigned v4u __attribute__((ext_vector_type(4)));
typedef unsigned v2u __attribute__((ext_vector_type(2)));
typedef float f32x4 __attribute__((ext_vector_type(4)));
typedef float f32x2 __attribute__((ext_vector_type(2)));
typedef short bf16x8 __attribute__((ext_vector_type(8)));
typedef GAS unsigned gu32;
#define RLX_AGENT __ATOMIC_RELAXED, __HIP_MEMORY_SCOPE_AGENT
#define LDS_WAIT() asm volatile("s_waitcnt lgkmcnt(0)" ::: "memory")
#define VM_WAIT() asm volatile("s_waitcnt vmcnt(0)" ::: "memory")
__device__ __forceinline__ unsigned f2bf(float f) { unsigned u = __builtin_bit_cast(unsigned, f); return (u + 0x7fffu + ((u >> 16) & 1u)) >> 16; }
__device__ __forceinline__ unsigned pk2(float lo, float hi) { return f2bf(lo) | (f2bf(hi) << 16); }
__device__ __forceinline__ float bf2f(unsigned h) { return __builtin_bit_cast(float, h << 16); }
__device__ __forceinline__ float fsigmoid(float x) { return __builtin_amdgcn_rcpf(1.f + __builtin_amdgcn_exp2f(-1.44269504089f * x)); }
__device__ __forceinline__ float fsilu(float x) { return x * fsigmoid(x); }
__device__ __forceinline__ float fgelu_tanh(float x) { return x * fsigmoid(1.5957691216f * (x + 0.044715f * x * x * x)); }
__device__ __forceinline__ float wave_sum(float v) {
#pragma unroll
    for (int o = 1; o < 64; o <<= 1) v += __shfl_xor(v, o);
    return v;
}

#define XB_TMO      128
#define XB_XCNT(j)  (256  + 64 * (j))
#define XB_XSUB(j)  (1280 + 64 * (j))
#define XB_XGEN(j)  (2304 + 64 * (j))
#define XB_TOP      3328
#define XB_TOPGEN   3392
#define XCD_BAR_WORDS 3456
#define XB_SPIN_CAP (1u << 18)
__device__ __forceinline__ unsigned xb_ld(unsigned* p)              { return __hip_atomic_load(p, __ATOMIC_RELAXED, __HIP_MEMORY_SCOPE_AGENT); }
__device__ __forceinline__ unsigned xb_add(unsigned* p, unsigned v) { return __hip_atomic_fetch_add(p, v, __ATOMIC_RELAXED, __HIP_MEMORY_SCOPE_AGENT); }
__device__ __forceinline__ unsigned xb_xcc_id() { return (unsigned)__builtin_amdgcn_s_getreg((3 << 11) | 20) & 0xFu; }
#define XB_SPIN(cond, bar) do { unsigned _sp = 0; while (cond) { __builtin_amdgcn_s_sleep(1); \
    if ((++_sp & 255u) == 0u) { if (xb_ld(&(bar)[XB_TMO])) break; if (_sp > XB_SPIN_CAP) { atomicAdd(&(bar)[XB_TMO], 1u); break; } } } } while (0)
struct XcdBarrier { unsigned* bar; unsigned x; volatile LAS unsigned* st; };
__device__ __forceinline__ XcdBarrier xcd_barrier_post(unsigned* bar, volatile LAS unsigned* st) {
    XcdBarrier b; b.bar = bar; b.x = xb_xcc_id(); b.st = st;
    if (threadIdx.x == 0) (void)xb_add(&bar[XB_XCNT(b.x)], 1u);
    return b;
}
__device__ __forceinline__ void xcd_barrier_complete(unsigned* bar, unsigned x, unsigned& nloc, unsigned& nx) {
    const unsigned G = gridDim.x * gridDim.y * gridDim.z;
    unsigned sum, cnt, mine, sp = 0u;
    for (;;) {
        sum = 0u; cnt = 0u; mine = 0u;
#pragma unroll
        for (unsigned j = 0; j < 16; ++j) { const unsigned c = xb_ld(&bar[XB_XCNT(j)]); sum += c; cnt += (c > 0u) ? 1u : 0u; mine = (j == x) ? c : mine; }
        if (sum == G) break;
        __builtin_amdgcn_s_sleep(1);
        if ((++sp & 255u) == 0u) { if (xb_ld(&bar[XB_TMO])) break; if (sp > XB_SPIN_CAP) { atomicAdd(&bar[XB_TMO], 1u); break; } }
    }
    nloc = mine > 0u ? mine : 1u; nx = cnt > 0u ? cnt : 1u;
}
__device__ __forceinline__ void xcd_barrier(const XcdBarrier& b) {
    asm volatile("s_waitcnt vmcnt(0)" ::: "memory");
    __syncthreads();
    if (threadIdx.x == 0) {
        unsigned* bar = b.bar;
        __builtin_amdgcn_s_waitcnt(0);
        unsigned nloc = b.st[0], nx = b.st[1];
        if (nloc == 0u) { xcd_barrier_complete(bar, b.x, nloc, nx); b.st[0] = nloc; b.st[1] = nx; }
        const unsigned old = xb_add(&bar[XB_XSUB(b.x)], 1u);
        const unsigned gen = old / nloc;
        if (old + 1u == (gen + 1u) * nloc) {
            __builtin_amdgcn_fence(__ATOMIC_RELEASE, "agent");
            asm volatile("s_waitcnt vmcnt(0)" ::: "memory");
            const unsigned og = xb_add(&bar[XB_TOP], 1u);
            const unsigned tg = og / nx;
            if (og + 1u == (tg + 1u) * nx) xb_add(&bar[XB_TOPGEN], 1u);
            else XB_SPIN(xb_ld(&bar[XB_TOPGEN]) == tg, bar);
            __builtin_amdgcn_fence(__ATOMIC_ACQUIRE, "agent");
            xb_add(&bar[XB_XGEN(b.x)], 1u);
            asm volatile("s_waitcnt vmcnt(0)" ::: "memory");
        } else {
            XB_SPIN(xb_ld(&bar[XB_XGEN(b.x)]) == gen, bar);
            __builtin_amdgcn_fence(__ATOMIC_ACQUIRE, "agent");
            asm volatile("s_waitcnt vmcnt(0)" ::: "memory");
        }
    }
    __syncthreads();
}

struct Args { const float* in[30]; float* out; unsigned char* ws; int ph_lo, ph_hi, li, dupk; };
struct Frame {
    LAS unsigned char* lds; volatile LAS unsigned* MISC; gu32* ctl;
    int tid, lane, wave, vcu, G;
    float* out; unsigned char* ws;
};
enum { I_X = 0, I_META, I_F1N, I_F1W1, I_F1W3, I_F1W2, I_MIXN, I_WIN, I_BGATE, I_DW, I_DWB, I_LNG, I_LNB, I_CPROJ, I_LRE, I_LIM, I_LDT, I_BRE, I_BIM, I_CRE, I_CIM, I_SD, I_WV, I_WG, I_WOUT, I_F2N, I_F2W1, I_F2W3, I_F2W2, I_FINN };

using pg8::Unit; using pg8::cvt_pk_bf16;
__device__ __forceinline__ v4u pack8(const f32x4 a, const f32x4 b) { v4u w; w.x = cvt_pk_bf16(a[0], a[1]); w.y = cvt_pk_bf16(a[2], a[3]); w.z = cvt_pk_bf16(b[0], b[1]); w.w = cvt_pk_bf16(b[2], b[3]); return w; }
__device__ __forceinline__ void unpack8(const v4u w, float (&o)[8]) { o[0] = bf2f(w.x & 0xffffu); o[1] = bf2f(w.x >> 16); o[2] = bf2f(w.y & 0xffffu); o[3] = bf2f(w.y >> 16); o[4] = bf2f(w.z & 0xffffu); o[5] = bf2f(w.z >> 16); o[6] = bf2f(w.w & 0xffffu); o[7] = bf2f(w.w >> 16); }
__device__ __forceinline__ float rs_of(const float* SS, int row) { return 1.0f / sqrtf(SS[row] * (1.0f / D) + EPS); }

struct EpiSwiglu {
    bf16* HID; const float* SS;
    __device__ __forceinline__ void operator()(const f32x4 (&acc)[2][2][4][2], const Unit& u, int wr, int wc) const {
        const int lane_ = lane_id_opaque(), fr = lane_ & 15, fq = lane_ >> 4;
        const int row0 = u.pm * 256 + wr * 64 + fr, col0 = u.pn * 128 + wc * 32 + 8 * fq;
#pragma unroll
        for (int ai = 0; ai < 2; ++ai)
#pragma unroll
            for (int m = 0; m < 4; ++m) { const int row = row0 + ai * 128 + m * 16; const float rs = rs_of(SS, row);
                f32x4 o0, o1;
#pragma unroll
                for (int j = 0; j < 4; ++j) { o0[j] = fsilu(acc[ai][0][m][0][j] * rs) * (acc[ai][1][m][0][j] * rs); o1[j] = fsilu(acc[ai][0][m][1][j] * rs) * (acc[ai][1][m][1][j] * rs); }
                *(v4u*)(HID + (size_t)row * DFF + col0) = pack8(o0, o1); }
    }
};
template <bool RBF16> struct EpiResid {
    const void* R; bf16* OB; float* SS; float alpha;
    __device__ __forceinline__ void operator()(const f32x4 (&acc)[2][2][4][2], const Unit& u, int wr, int wc) const {
        const int lane_ = lane_id_opaque(), fr = lane_ & 15, fq = lane_ >> 4;
        const int row0 = u.pm * 256 + wr * 64 + fr, col0 = u.pn * 256 + wc * 32 + 8 * fq;
#pragma unroll
        for (int ai = 0; ai < 2; ++ai)
#pragma unroll
            for (int m = 0; m < 4; ++m) { const int row = row0 + ai * 128 + m * 16; float ss = 0.f;
#pragma unroll
                for (int bj = 0; bj < 2; ++bj) { const size_t off = (size_t)row * D + col0 + bj * 128; f32x4 r0, r1;
                    if (RBF16) { float t[8]; unpack8(*(const v4u*)((const bf16*)R + off), t); r0 = (f32x4){t[0], t[1], t[2], t[3]}; r1 = (f32x4){t[4], t[5], t[6], t[7]}; }
                    else { r0 = *(const f32x4*)((const float*)R + off); r1 = *(const f32x4*)((const float*)R + off + 4); }
                    const f32x4 o0 = r0 + acc[ai][bj][m][0] * alpha, o1 = r1 + acc[ai][bj][m][1] * alpha;
                    *(v4u*)(OB + off) = pack8(o0, o1);
                    ss += (o0[0] * o0[0] + o0[1] * o0[1]) + (o0[2] * o0[2] + o0[3] * o0[3]) + (o1[0] * o1[0] + o1[1] * o1[1]) + (o1[2] * o1[2] + o1[3] * o1[3]); }
                ss += __shfl_xor(ss, 16); ss += __shfl_xor(ss, 32);
                if (fq == 0) atomicAdd(SS + row, ss);
                asm volatile("" ::: "memory"); }
    }
};
struct EpiFinal {
    const bf16* R; float* OUT; float* SS; unsigned* cnt; const float* gain; float alpha;
    __device__ __forceinline__ void operator()(f32x4 (&acc)[2][2][4][2], const Unit& u, int wr, int wc) const {
        const int lane_ = lane_id_opaque(), fr = lane_ & 15, fq = lane_ >> 4;
        const int row0 = u.pm * 256 + wr * 64 + fr, col0 = u.pn * 256 + wc * 32 + 8 * fq;
#pragma unroll
        for (int ai = 0; ai < 2; ++ai)
#pragma unroll
            for (int m = 0; m < 4; ++m) { const int row = row0 + ai * 128 + m * 16; float ss = 0.f;
#pragma unroll
                for (int bj = 0; bj < 2; ++bj) { const size_t off = (size_t)row * D + col0 + bj * 128; float t[8]; unpack8(*(const v4u*)(R + off), t);
                    const f32x4 o0 = (f32x4){t[0], t[1], t[2], t[3]} + acc[ai][bj][m][0] * alpha, o1 = (f32x4){t[4], t[5], t[6], t[7]} + acc[ai][bj][m][1] * alpha;
                    acc[ai][bj][m][0] = o0; acc[ai][bj][m][1] = o1;
                    ss += (o0[0] * o0[0] + o0[1] * o0[1]) + (o0[2] * o0[2] + o0[3] * o0[3]) + (o1[0] * o1[0] + o1[1] * o1[1]) + (o1[2] * o1[2] + o1[3] * o1[3]); }
                ss += __shfl_xor(ss, 16); ss += __shfl_xor(ss, 32);
                if (fq == 0) atomicAdd(SS + row, ss);
                asm volatile("" ::: "memory"); }
        asm volatile("s_waitcnt vmcnt(0)" ::: "memory");
        unsigned* cw = cnt + 64 * u.pm;
        if (lane_ == 0) __hip_atomic_fetch_add(cw, 1u, __ATOMIC_RELAXED, __HIP_MEMORY_SCOPE_AGENT);
        { unsigned sp = 0; while ((unsigned)__builtin_amdgcn_readfirstlane((int)__hip_atomic_load(cw, __ATOMIC_RELAXED, __HIP_MEMORY_SCOPE_AGENT)) < 32u) { __builtin_amdgcn_s_sleep(2); if (++sp > (1u << 20)) break; } }
        f32x4 g[2][2];
#pragma unroll
        for (int bj = 0; bj < 2; ++bj) { g[bj][0] = *(const f32x4*)(gain + col0 + bj * 128); g[bj][1] = *(const f32x4*)(gain + col0 + bj * 128 + 4); }
#pragma unroll
        for (int ai = 0; ai < 2; ++ai)
#pragma unroll
            for (int m = 0; m < 4; ++m) { const int row = row0 + ai * 128 + m * 16;
                float tot = 0.f; if (fq == 0) tot = __hip_atomic_fetch_add(SS + row, 0.0f, __ATOMIC_RELAXED, __HIP_MEMORY_SCOPE_AGENT);
                tot = __shfl(tot, fr);
                const float rs = 1.0f / sqrtf(tot * (1.0f / D) + EPS);
#pragma unroll
                for (int bj = 0; bj < 2; ++bj) { const size_t off = (size_t)row * D + col0 + bj * 128;
                    *(f32x4*)(OUT + off) = acc[ai][bj][m][0] * rs * g[bj][0]; *(f32x4*)(OUT + off + 4) = acc[ai][bj][m][1] * rs * g[bj][1]; }
                asm volatile("" ::: "memory"); }
    }
};
struct EpiMix {
    const float* SS; bf16* Z; bf16* UX; bf16* G; const float* bgate;
    __device__ __forceinline__ void operator()(const f32x4 (&acc)[2][2][4][2], const Unit& u, int wr, int wc) const {
        const int lane_ = lane_id_opaque(), fr = lane_ & 15, fq = lane_ >> 4;
        const int row0 = u.pm * 256 + wr * 64 + fr;
        if (u.pn < 4) {
            const int col0 = u.pn * 128 + wc * 32 + 8 * fq;
#pragma unroll
            for (int ai = 0; ai < 2; ++ai)
#pragma unroll
                for (int m = 0; m < 4; ++m) { const int row = row0 + ai * 128 + m * 16; const float rs = rs_of(SS, row); f32x4 o0, o1;
#pragma unroll
                    for (int j = 0; j < 4; ++j) { o0[j] = (acc[ai][0][m][0][j] * rs) * fsigmoid(acc[ai][1][m][0][j] * rs); o1[j] = (acc[ai][0][m][1][j] * rs) * fsigmoid(acc[ai][1][m][1][j] * rs); }
                    *(v4u*)(Z + (size_t)row * DCONV + col0) = pack8(o0, o1); }
        } else if (u.pn < 6) {
#pragma unroll
            for (int ai = 0; ai < 2; ++ai)
#pragma unroll
                for (int m = 0; m < 4; ++m) { const int row = row0 + ai * 128 + m * 16; const float rs = rs_of(SS, row); const int ci = row >> 4, tt = row & 15;
#pragma unroll
                    for (int bj = 0; bj < 2; ++bj) { const int c = (u.pn - 4) * 256 + bj * 128 + wc * 32 + 8 * fq, g = c >> 4, h0 = c & 15;
                        *(v4u*)(UX + ((size_t)(g * (NCH + 1) + ci) * UXK + tt * 16 + h0)) = pack8(acc[ai][bj][m][0] * rs, acc[ai][bj][m][1] * rs); } }
        } else {
#pragma unroll
            for (int bj = 0; bj < 2; ++bj) { const int c = (u.pn - 6) * 256 + bj * 128 + wc * 32 + 8 * fq;
                const f32x4 b0 = *(const f32x4*)(bgate + c), b1 = *(const f32x4*)(bgate + c + 4);
#pragma unroll
                for (int ai = 0; ai < 2; ++ai)
#pragma unroll
                    for (int m = 0; m < 4; ++m) { const int row = row0 + ai * 128 + m * 16; const float rs = rs_of(SS, row); f32x4 o0, o1;
#pragma unroll
                        for (int j = 0; j < 4; ++j) { o0[j] = fsigmoid(acc[ai][bj][m][0][j] * rs + b0[j]); o1[j] = fsigmoid(acc[ai][bj][m][1][j] * rs + b1[j]); }
                        *(v4u*)(G + (size_t)row * 2048 + c) = pack8(o0, o1); } }
        }
    }
};
struct EpiSsmY {
    const bf16* UX; const float* dskip; bf16* Y;
    __device__ __forceinline__ void operator()(const f32x4 (&acc)[2][2][4][2], const Unit& u, int wr, int wc) const {
        const int lane_ = lane_id_opaque(), fr = lane_ & 15, fq = lane_ >> 4;
        const int b = u.pm, g = u.pn, h0 = 8 * (fq & 1);
        const f32x4 d0 = *(const f32x4*)(dskip + g * 16 + h0), d1 = *(const f32x4*)(dskip + g * 16 + h0 + 4);
#pragma unroll
        for (int ai = 0; ai < 2; ++ai)
#pragma unroll
            for (int m = 0; m < 4; ++m) { const int r = ai * 128 + wr * 64 + m * 16 + fr;
#pragma unroll
                for (int bj = 0; bj < 2; ++bj) { const int tt = 8 * bj + 2 * wc + (fq >> 1);
                    float uu[8]; unpack8(*(const v4u*)(UX + ((size_t)(g * (NCH + 1) + b * 256 + r) * UXK + tt * 16 + h0)), uu);
                    f32x4 o0, o1;
#pragma unroll
                    for (int j = 0; j < 4; ++j) { o0[j] = fgelu_tanh(acc[ai][bj][m][0][j] + d0[j] * uu[j]); o1[j] = fgelu_tanh(acc[ai][bj][m][1][j] + d1[j] * uu[4 + j]); }
                    *(v4u*)(Y + ((size_t)(b * SEQ + r * 16 + tt) * DSSM + g * 16 + h0)) = pack8(o0, o1); }
                asm volatile("" ::: "memory"); }
    }
};
struct EpiMerge {
    const bf16* G; bf16* MC; bf16* MG;
    __device__ __forceinline__ void operator()(const f32x4 (&acc)[2][2][4][2], const Unit& u, int wr, int wc) const {
        const int lane_ = lane_id_opaque(), fr = lane_ & 15, fq = lane_ >> 4;
        const int row0 = u.pm * 256 + wr * 64 + fr;
        if (u.kind == 0) {
#pragma unroll
            for (int ai = 0; ai < 2; ++ai)
#pragma unroll
                for (int m = 0; m < 4; ++m) { const int row = row0 + ai * 128 + m * 16;
#pragma unroll
                    for (int bj = 0; bj < 2; ++bj) { const int c = u.pn * 256 + bj * 128 + wc * 32 + 8 * fq;
                        float gg[8]; unpack8(*(const v4u*)(G + (size_t)row * 2048 + c), gg); f32x4 o0, o1;
#pragma unroll
                        for (int j = 0; j < 4; ++j) { o0[j] = gg[j] * acc[ai][bj][m][0][j]; o1[j] = gg[4 + j] * acc[ai][bj][m][1][j]; }
                        *(v4u*)(MC + (size_t)row * D + c) = pack8(o0, o1); } }
        } else {
            const int c = u.pn * 256 + (u.kind - 1) * 128 + wc * 32 + 8 * fq;
#pragma unroll
            for (int ai = 0; ai < 2; ++ai)
#pragma unroll
                for (int m = 0; m < 4; ++m) { const int row = row0 + ai * 128 + m * 16;
                    float gg[8], mc[8]; unpack8(*(const v4u*)(G + (size_t)row * 2048 + D + c), gg); unpack8(*(const v4u*)(MC + (size_t)row * D + c), mc); f32x4 o0, o1;
#pragma unroll
                    for (int j = 0; j < 4; ++j) { o0[j] = mc[j] + gg[j] * (acc[ai][0][m][0][j] * fsigmoid(acc[ai][1][m][0][j])); o1[j] = mc[4 + j] + gg[4 + j] * (acc[ai][0][m][1][j] * fsigmoid(acc[ai][1][m][1][j])); }
                    *(v4u*)(MG + (size_t)row * D + c) = pack8(o0, o1); }
        }
    }
};
struct SsmOrder {
    int G, c; const char* UX; const char* BS2;
    __device__ __forceinline__ bool next(int i, Unit& u) const { const int L = i * G + c; if (L >= BATCH * NG) return false; const int b = L / NG, g = L % NG; u.pm = b; u.pn = g; u.kind = 0;
        u.A = UX + ((size_t)(g * (NCH + 1) + b * 256) * UXK) * 2; u.B = BS2 + (size_t)g * 256 * UXK * 2; return true; }
    __device__ __forceinline__ void a_ready(const Unit&) const {}
    __device__ __forceinline__ void done(const Unit&) const {}
};
struct MergeOrder {
    int G, c; const char* ZC; const char* Y; const char* WCAT;
    __device__ __forceinline__ bool next(int i, Unit& u) const { int pm, pn; const int su = i / 3, k = i - 3 * su; if (!pg8::static_tile(su, G, c, M / 256, D / 256, pm, pn)) return false; u.pm = pm; u.pn = pn; u.kind = k;
        u.A = (k == 0 ? ZC : Y) + (size_t)pm * 256 * 512 * 2; u.B = WCAT + (size_t)(k == 0 ? pn * 256 : 1024 + (2 * pn + k - 1) * 256) * 512 * 2; return true; }
    __device__ __forceinline__ void a_ready(const Unit&) const {}
    __device__ __forceinline__ void done(const Unit& u) const { if (u.kind == 0) asm volatile("s_waitcnt vmcnt(0)" ::: "memory"); }
};

__device__ __forceinline__ void p0_transpose_item(const float* W, int K, int N, bf16* WT, const float* gain, LAS float* scr, int k0, int n0, int drow0, int lane) {
    float v[32];
    const float* src = W + (size_t)(k0 + (lane >> 5)) * N + n0 + (lane & 31);
#pragma unroll
    for (int i = 0; i < 32; ++i) v[i] = src[(size_t)(2 * i) * N];
#pragma unroll
    for (int i = 0; i < 32; ++i) scr[(2 * i + (lane >> 5)) * 33 + (lane & 31)] = v[i];
    LDS_WAIT(); asm volatile("" ::: "memory");
    const int c = lane & 7;
    f32x4 g0 = (f32x4){1.f, 1.f, 1.f, 1.f}, g1 = g0; if (gain) { g0 = *(const f32x4*)(gain + k0 + 8 * c); g1 = *(const f32x4*)(gain + k0 + 8 * c + 4); }
#pragma unroll
    for (int j = 0; j < 4; ++j) { const int n = (lane >> 3) + 8 * j; const LAS float* s = scr + (8 * c) * 33 + n;
        v4u o; o.x = pk2(s[0 * 33] * g0[0], s[1 * 33] * g0[1]); o.y = pk2(s[2 * 33] * g0[2], s[3 * 33] * g0[3]); o.z = pk2(s[4 * 33] * g1[0], s[5 * 33] * g1[1]); o.w = pk2(s[6 * 33] * g1[2], s[7 * 33] * g1[3]);
        *(GAS v4u*)(WT + (size_t)(drow0 + n) * K + k0 + 8 * c) = o; }
    LDS_WAIT(); asm volatile("" ::: "memory");
}
__device__ __forceinline__ int glu_row(int n) { return 256 * (n >> 7) + (n & 127); }

constexpr int I_UP = (D / 64) * (DFF / 32), I_DN = (DFF / 64) * (D / 32), I_INP = (D / 64) * (DIN / 32), I_CP = (DCONV / 64) * (D / 32), I_WO = (D / 64) * (D / 32);
constexpr int T_W13A = 2 * I_UP, T_W2A = T_W13A + I_DN, T_WIN = T_W2A + I_INP, T_WCAT = T_WIN + 3 * I_CP, T_WOUT = T_WCAT + I_WO, T_W13B = T_WOUT + 2 * I_UP, T_W2B = T_W13B + I_DN;
__device__ __forceinline__ void weight_item(const Args& args, unsigned char* ws, LAS float* scr, int it, int lane) {
    if (it < T_W13A || (it >= T_WOUT && it < T_W13B)) { const bool second = it >= T_WOUT; int r = it - (second ? T_WOUT : 0); const int which = r / I_UP; r -= which * I_UP; const int nblk = DFF / 32, k0 = 64 * (r / nblk), n0 = 32 * (r % nblk);
        const float* W = second ? (which ? args.in[I_F2W3] : args.in[I_F2W1]) : (which ? args.in[I_F1W3] : args.in[I_F1W1]);
        p0_transpose_item(W, D, DFF, (bf16*)(ws + (second ? WS_W13B : WS_W13A)), second ? args.in[I_F2N] : args.in[I_F1N], scr, k0, n0, glu_row(n0) + which * 128, lane); return; }
    if (it < T_W2A || it >= T_W13B) { const bool second = it >= T_W13B; const int r = it - (second ? T_W13B : T_W13A); const int nblk = D / 32, k0 = 64 * (r / nblk), n0 = 32 * (r % nblk);
        p0_transpose_item(second ? args.in[I_F2W2] : args.in[I_F1W2], DFF, D, (bf16*)(ws + (second ? WS_W2B : WS_W2A)), nullptr, scr, k0, n0, n0, lane); return; }
    if (it < T_WIN) { const int r = it - T_W2A; const int nblk = DIN / 32, k0 = 64 * (r / nblk), n0 = 32 * (r % nblk);
        const int dr = n0 < 512 ? glu_row(n0) : n0 < 1024 ? glu_row(n0 - 512) + 128 : n0;
        p0_transpose_item(args.in[I_WIN], D, DIN, (bf16*)(ws + WS_WIN), args.in[I_MIXN], scr, k0, n0, dr, lane); return; }
    if (it < T_WCAT) { int r = it - T_WIN; const int which = r / I_CP; r -= which * I_CP; const int nblk = D / 32, k0 = 64 * (r / nblk), n0 = 32 * (r % nblk);
        const int dr = which == 0 ? n0 : 1024 + glu_row(n0) + (which == 2 ? 128 : 0);
        p0_transpose_item(which == 0 ? args.in[I_CPROJ] : which == 1 ? args.in[I_WV] : args.in[I_WG], DCONV, D, (bf16*)(ws + WS_WCAT), nullptr, scr, k0, n0, dr, lane); return; }
    { const int r = it - T_WCAT; const int nblk = D / 32, k0 = 64 * (r / nblk), n0 = 32 * (r % nblk); p0_transpose_item(args.in[I_WOUT], D, D, (bf16*)(ws + WS_WOUT), nullptr, scr, k0, n0, n0, lane); }
}

__device__ __forceinline__ void ssm_prep_job(Frame& F, const Args& args, int g) {
    LAS f32x2* lamP = (LAS f32x2*)(F.lds + RING_OFF);
    LAS f32x2* Bb = lamP + 17 * 64;
    LAS f32x2* Cc = Bb + 64 * 16;
    LAS float* Kk = (LAS float*)(Cc + 16 * 64);
    const float* lam_re = args.in[I_LRE]; const float* lam_im = args.in[I_LIM]; const float* log_dt = args.in[I_LDT];
    const float* b_re = args.in[I_BRE]; const float* b_im = args.in[I_BIM]; const float* c_re = args.in[I_CRE]; const float* c_im = args.in[I_CIM];
    const int tid = F.tid;
    const float dt = expf(log_dt[g]);
    if (tid < 64) { const int p = tid; const float a = lam_re[g * PS + p] * dt, bb = lam_im[g * PS + p] * dt, ea = expf(a), sb = sinf(bb), cb = cosf(bb);
        const float lx = ea * cb, ly = ea * sb; float px = 1.f, py = 0.f;
        for (int k = 0; k <= 16; ++k) { lamP[k * 64 + p] = (f32x2){px, py}; const float nx = px * lx - py * ly, ny = px * ly + py * lx; px = nx; py = ny; } }
    for (int i = tid; i < 1024; i += 512) { const int p = i >> 4;
        const float lr = lam_re[g * PS + p], li = lam_im[g * PS + p], a = lr * dt, bb = li * dt, ea = expf(a), sb = sinf(bb), cb = cosf(bb), sh = sinf(0.5f * bb);
        const float nr = expm1f(a) * cb - 2.f * sh * sh, ni = ea * sb, den = 1.f / (lr * lr + li * li), fr_ = (nr * lr + ni * li) * den, fi_ = (ni * lr - nr * li) * den;
        const float br = b_re[(size_t)g * 1024 + i], bi = b_im[(size_t)g * 1024 + i];
        Bb[i] = (f32x2){fr_ * br - fi_ * bi, fr_ * bi + fi_ * br};
        Cc[i] = (f32x2){c_re[(size_t)g * 1024 + i], c_im[(size_t)g * 1024 + i]}; }
    __syncthreads();
    for (int o = tid; o < 4096; o += 512) { const int k = o >> 8, h = (o >> 4) & 15, hp = o & 15; float s = 0.f;
        for (int p = 0; p < 64; ++p) { const f32x2 c = Cc[h * 64 + p], l = lamP[k * 64 + p], b = Bb[p * 16 + hp]; const float tr = l.x * b.x - l.y * b.y, ti = l.x * b.y + l.y * b.x; s += c.x * tr - c.y * ti; }
        Kk[o] = s; }
    __syncthreads();
    GAS unsigned* bs2 = (GAS unsigned*)(F.ws + WS_BS2) + (size_t)g * 256 * (UXK / 2);
    for (int i = tid; i < 256 * (UXK / 2); i += 512) { const int n = i / (UXK / 2), kp = (i % (UXK / 2)) * 2, t = n >> 4, h = n & 15; float v0, v1;
        if (kp < 256) { const int s = kp >> 4, hp = kp & 15; const bool on = s <= t; const int kb = (((t - s) & 15) << 8) + (h << 4) + hp; v0 = on ? Kk[kb] : 0.f; v1 = on ? Kk[kb + 1] : 0.f; }
        else { const int p = (kp - 256) >> 1; const f32x2 c = Cc[h * 64 + p], l = lamP[(t + 1) * 64 + p]; v0 = c.x * l.x - c.y * l.y; v1 = -(c.x * l.y + c.y * l.x); }
        bs2[i] = pk2(v0, v1); }
    GAS unsigned* wsi = (GAS unsigned*)(F.ws + WS_WSI) + (size_t)g * 128 * 128;
    for (int i = tid; i < 128 * 128; i += 512) { const int n = i >> 7, kp = (i & 127) * 2, p = n >> 1, c = n & 1, s = kp >> 4, h = kp & 15;
        const f32x2 l = lamP[(15 - s) * 64 + p], b0 = Bb[p * 16 + h], b1 = Bb[p * 16 + h + 1];
        const float v0 = c ? (l.x * b0.y + l.y * b0.x) : (l.x * b0.x - l.y * b0.y), v1 = c ? (l.x * b1.y + l.y * b1.x) : (l.x * b1.x - l.y * b1.y);
        wsi[i] = pk2(v0, v1); }
    if (tid < 64) ((GAS f32x2*)(F.ws + WS_LAMC))[g * 64 + tid] = lamP[16 * 64 + tid];
    __syncthreads();
}

template <int NS, bool NORM, class Fn>
__device__ __forceinline__ void meta_job(Frame& F, const float* A, int K, const bf16* Bt0, const bf16* Bt1, const Fn& fn) {
    LAS float* red = (LAS float*)(F.lds + RING_OFF);
    LAS float* rsc = red + 8 * 16 * 32;
    const int lane = F.lane, w = F.wave, fr = lane & 15, fq = lane >> 4;
    if (NORM) {
#pragma unroll
        for (int rr = 0; rr < 2; ++rr) { const int row = 2 * w + rr; float s = 0.f; for (int c = lane; c < D; c += 64) { const float v = A[(size_t)row * K + c]; s += v * v; } s = wave_sum(s); if (lane == 0) rsc[row] = 1.0f / sqrtf(s * (1.0f / D) + EPS); }
    } else if (F.tid < 16) rsc[F.tid] = 1.f;
    f32x4 acc[NS];
#pragma unroll
    for (int s = 0; s < NS; ++s) acc[s] = (f32x4){0.f, 0.f, 0.f, 0.f};
    const int kw = K / 8, kbase = w * kw;
#pragma unroll 4
    for (int k = kbase; k < kbase + kw; k += 32) {
        const f32x4 a0 = *(const f32x4*)(A + (size_t)fr * K + k + 8 * fq), a1 = *(const f32x4*)(A + (size_t)fr * K + k + 8 * fq + 4);
        const v4u ap = pack8(a0, a1); const bf16x8 af = __builtin_bit_cast(bf16x8, ap);
#pragma unroll
        for (int s = 0; s < NS; ++s) { const bf16x8 bf = *(const bf16x8*)((s == 0 ? Bt0 : Bt1) + (size_t)fr * K + k + 8 * fq); acc[s] = __builtin_amdgcn_mfma_f32_16x16x32_bf16(bf, af, acc[s], 0, 0, 0); } }
#pragma unroll
    for (int s = 0; s < NS; ++s) *(LAS f32x4*)(red + (w * 16 + fr) * 32 + s * 16 + 4 * fq) = acc[s];
    __syncthreads();
    if (F.tid < 256) { const int rr = F.tid >> 4, j = F.tid & 15; float v0 = 0.f, v1 = 0.f;
#pragma unroll
        for (int ww = 0; ww < 8; ++ww) { v0 += red[(ww * 16 + rr) * 32 + j]; if (NS > 1) v1 += red[(ww * 16 + rr) * 32 + 16 + j]; }
        const float sc = rsc[rr]; fn(rr, j, v0 * sc, v1 * sc); }
    __syncthreads();
}

constexpr int WSI_PITCH = 528;
constexpr int SMETA_OFF = LDSCTL_OFF + 1024;
__device__ __forceinline__ void ssm_pre_job(Frame& F, int b, int g) {
    const int lane = F.lane, w = F.wave, tid = F.tid, fr = lane & 15, fq = lane >> 4;
    LAS unsigned char* Bl = F.lds + RING_OFF;
    LAS f32x2* Sl = (LAS f32x2*)(F.lds + RING_OFF);
    LAS float* smeta = (LAS float*)(F.lds + SMETA_OFF);
    bf16* UX = (bf16*)(F.ws + WS_UX); const bf16* Wg = (const bf16*)(F.ws + WS_WSI) + (size_t)g * 128 * 256;
    { v4u v[8];
#pragma unroll
      for (int i = 0; i < 8; ++i) { const int idx = tid + 512 * i; v[i] = *(const v4u*)(Wg + (size_t)(idx >> 5) * 256 + (idx & 31) * 8); }
#pragma unroll
      for (int i = 0; i < 8; ++i) { const int idx = tid + 512 * i; *(LAS v4u*)(Bl + (idx >> 5) * WSI_PITCH + (idx & 31) * 16) = v[i]; } }
    const bf16* Ab = UX + (size_t)(g * (NCH + 1) + 256 * b + 32 * w) * UXK;
    bf16x8 a[2][8], am[8];
#pragma unroll
    for (int mt = 0; mt < 2; ++mt)
#pragma unroll
        for (int ks = 0; ks < 8; ++ks) a[mt][ks] = *(const bf16x8*)(Ab + (size_t)(16 * mt + fr) * UXK + 32 * ks + 8 * fq);
    if (w == 7) {
#pragma unroll
        for (int ks = 0; ks < 8; ++ks) am[ks] = *(const bf16x8*)(UX + (size_t)(g * (NCH + 1) + NCH) * UXK + 32 * ks + 8 * fq); }
    f32x4 acc[2][8], accm[8];
#pragma unroll
    for (int nt = 0; nt < 8; ++nt) { acc[0][nt] = (f32x4){0.f, 0.f, 0.f, 0.f}; acc[1][nt] = acc[0][nt]; accm[nt] = acc[0][nt]; }
    __syncthreads();
#pragma unroll
    for (int ks = 0; ks < 8; ++ks)
#pragma unroll
        for (int nt = 0; nt < 8; ++nt) { const bf16x8 bfr = *(const LAS bf16x8*)(Bl + (16 * nt + fr) * WSI_PITCH + (32 * ks + 8 * fq) * 2);
            acc[0][nt] = __builtin_amdgcn_mfma_f32_16x16x32_bf16(bfr, a[0][ks], acc[0][nt], 0, 0, 0); acc[1][nt] = __builtin_amdgcn_mfma_f32_16x16x32_bf16(bfr, a[1][ks], acc[1][nt], 0, 0, 0);
            if (w == 7) accm[nt] = __builtin_amdgcn_mfma_f32_16x16x32_bf16(bfr, am[ks], accm[nt], 0, 0, 0); }
    __syncthreads();
#pragma unroll
    for (int mt = 0; mt < 2; ++mt)
#pragma unroll
        for (int nt = 0; nt < 8; ++nt) *(LAS f32x4*)(Sl + (32 * w + 16 * mt + fr) * 64 + 8 * nt + 2 * fq) = acc[mt][nt];
    if (w == 7 && fr == 0) {
#pragma unroll
        for (int nt = 0; nt < 8; ++nt) *(LAS f32x4*)(smeta + 16 * nt + 4 * fq) = accm[nt]; }
    __syncthreads();
    if (w == 0) { const f32x2 lc = ((const f32x2*)(F.ws + WS_LAMC))[g * 64 + lane]; f32x2 x = *(const LAS f32x2*)(smeta + 2 * lane);
        unsigned* xp = (unsigned*)(UX + (size_t)(g * (NCH + 1) + b * 256) * UXK + 256) + lane;
#pragma unroll 8
        for (int ci = 0; ci < 256; ++ci) { xp[(size_t)ci * (UXK / 2)] = cvt_pk_bf16(x.x, x.y); const f32x2 s = Sl[ci * 64 + lane]; const float nx = lc.x * x.x - lc.y * x.y + s.x, ny = lc.x * x.y + lc.y * x.x + s.y; x.x = nx; x.y = ny; }
        VM_WAIT(); }
    __syncthreads();
}

__device__ __forceinline__ void conv_job(Frame& F, const Args& args, int jt) {
    LAS unsigned char* zs = F.lds + RING_OFF;
    LAS float* cs = (LAS float*)(F.lds + RING_OFF + 62 * 1024);
    const bf16* Z = (const bf16*)(F.ws + WS_Z); bf16* ZC = (bf16*)(F.ws + WS_ZC);
    const int tid = F.tid, row0 = 32 * jt, b = row0 / SEQ, t0 = row0 % SEQ;
    { v4u v[8];
#pragma unroll
      for (int it = 0; it < 8; ++it) { const int i = tid + 512 * it, ri = i >> 6, cb = (i & 63) * 16, ti = t0 - 30 + ri; v[it] = (v4u){0u, 0u, 0u, 0u};
          if (i < 62 * 64) { if (ti >= 0) v[it] = *(const v4u*)((const char*)Z + (size_t)(b * SEQ + ti) * 1024 + cb); else if (ti >= -NMETA) v[it] = *(const v4u*)((const char*)Z + (size_t)(M + NMETA + ti) * 1024 + cb); } }
#pragma unroll
      for (int it = 0; it < 8; ++it) { const int i = tid + 512 * it; if (i < 62 * 64) *(LAS v4u*)(zs + (i >> 6) * 1024 + (i & 63) * 16) = v[it]; } }
    const int cp = tid & 255, th = tid >> 8;
    const float* dw = args.in[I_DW]; f32x2 wgt[CWID];
#pragma unroll
    for (int k = 0; k < CWID; ++k) wgt[k] = *(const f32x2*)(dw + k * DCONV + 2 * cp);
    const f32x2 bias = *(const f32x2*)(args.in[I_DWB] + 2 * cp);
    __syncthreads();
#pragma unroll 1
    for (int hf = 0; hf < 2; ++hf) {
        f32x2 acc[8];
#pragma unroll
        for (int t = 0; t < 8; ++t) acc[t] = bias;
        const LAS unsigned char* zb = zs + (16 * th + 8 * hf) * 1024 + 4 * cp;
#pragma unroll
        for (int i = 0; i < 38; ++i) { const unsigned zz = *(const LAS unsigned*)(zb + i * 1024); const float z0 = bf2f(zz & 0xffffu), z1 = bf2f(zz >> 16);
#pragma unroll
            for (int t = 0; t < 8; ++t) { const int k = i - t; if (k >= 0 && k < CWID) { acc[t].x += wgt[k].x * z0; acc[t].y += wgt[k].y * z1; } } }
#pragma unroll
        for (int t = 0; t < 8; ++t) *(LAS f32x2*)(cs + (16 * th + 8 * hf + t) * 512 + 2 * cp) = acc[t];
    }
    __syncthreads();
    const int lane = F.lane, w = F.wave;
    const f32x4 g0 = *(const f32x4*)(args.in[I_LNG] + 4 * lane), g1 = *(const f32x4*)(args.in[I_LNG] + 256 + 4 * lane), b0 = *(const f32x4*)(args.in[I_LNB] + 4 * lane), b1 = *(const f32x4*)(args.in[I_LNB] + 256 + 4 * lane);
#pragma unroll
    for (int q = 0; q < 4; ++q) { const int t = 4 * w + q; const f32x4 x0 = *(const LAS f32x4*)(cs + t * 512 + 4 * lane), x1 = *(const LAS f32x4*)(cs + t * 512 + 256 + 4 * lane);
        const float mu = wave_sum((x0[0] + x0[1]) + (x0[2] + x0[3]) + (x1[0] + x1[1]) + (x1[2] + x1[3])) * (1.f / DCONV);
        const f32x4 d0 = x0 - mu, d1 = x1 - mu;
        const float var = wave_sum((d0[0] * d0[0] + d0[1] * d0[1]) + (d0[2] * d0[2] + d0[3] * d0[3]) + (d1[0] * d1[0] + d1[1] * d1[1]) + (d1[2] * d1[2] + d1[3] * d1[3])) * (1.f / DCONV);
        const float rstd = 1.0f / sqrtf(var + EPS); f32x4 o0 = d0 * rstd * g0 + b0, o1 = d1 * rstd * g1 + b1;
#pragma unroll
        for (int j = 0; j < 4; ++j) { o0[j] = fsilu(o0[j]); o1[j] = fsilu(o1[j]); }
        bf16* zr = ZC + (size_t)(row0 + t) * DCONV;
        *(v2u*)(zr + 4 * lane) = (v2u){cvt_pk_bf16(o0[0], o0[1]), cvt_pk_bf16(o0[2], o0[3])}; *(v2u*)(zr + 256 + 4 * lane) = (v2u){cvt_pk_bf16(o1[0], o1[1]), cvt_pk_bf16(o1[2], o1[3])}; }
    __syncthreads();
}

__global__ void __launch_bounds__(NWAVES * 64, 2) hyb_fwd(Args args) {
    extern __shared__ __attribute__((aligned(16))) unsigned char lds[];
    Frame F;
    F.lds = (LAS unsigned char*)lds; F.MISC = (volatile LAS unsigned*)(F.lds + MISC_OFF);
    F.wave = __builtin_amdgcn_readfirstlane((int)threadIdx.x >> 6); F.lane = lane_id_opaque(); F.tid = F.wave * 64 + F.lane;
    F.G = gridDim.x; { const int bx = blockIdx.x; F.vcu = (F.G % 8 == 0) ? (bx % 8) * (F.G / 8) + bx / 8 : bx; }
    F.ws = args.ws; F.out = args.out; F.ctl = (gu32*)(args.ws + WS_CTL);
    for (int u = F.tid; u < (LDS_BYTES - LDSCTL_OFF) / 4; u += NWAVES * 64) ((LAS unsigned*)(F.lds + LDSCTL_OFF))[u] = 0u;
    __syncthreads();
    const int bli = (N_LAUNCHES == PER_PHASE) ? 0 : args.li;
    XcdBarrier bar; bar.bar = (unsigned*)(F.ctl + CW_BAR) + bli * XCD_BAR_WORDS; bar.x = 0; bar.st = nullptr;
    if (N_LAUNCHES != PER_PHASE) bar = xcd_barrier_post((unsigned*)(F.ctl + CW_BAR) + bli * XCD_BAR_WORDS, F.MISC + 8);
    const int lo = args.ph_lo, hi = args.ph_hi;
#ifndef PHMASK
#define PHMASK 0x7ff
#endif
#define IN(k) (((PHMASK >> (k)) & 1) && lo <= (k) && (k) < hi)
#define SEAM(k) do { if (IN(k) && IN((k) + 1)) xcd_barrier(bar); F.lane = lane_id_opaque(); F.tid = F.wave * 64 + F.lane; } while (0)
    unsigned char* ws = F.ws;
    bf16* W13A = (bf16*)(ws + WS_W13A); bf16* W2A = (bf16*)(ws + WS_W2A); bf16* WIN = (bf16*)(ws + WS_WIN); bf16* WCAT = (bf16*)(ws + WS_WCAT); bf16* WOUT = (bf16*)(ws + WS_WOUT);
    bf16* W13B = (bf16*)(ws + WS_W13B); bf16* W2B = (bf16*)(ws + WS_W2B);
    bf16* AB = (bf16*)(ws + WS_AB); bf16* H1B = (bf16*)(ws + WS_H1); bf16* H2B = (bf16*)(ws + WS_H1 + 32 * MiB); bf16* HID = (bf16*)(ws + WS_HID);
    bf16* Zb = (bf16*)(ws + WS_Z); bf16* UXb = (bf16*)(ws + WS_UX); bf16* ZCb = (bf16*)(ws + WS_ZC); bf16* Yb = (bf16*)(ws + WS_Y); bf16* MCb = (bf16*)(ws + WS_MC);
    float* SS0 = (float*)(ws + WS_SS0); float* SS1 = SS0 + M; float* SS2 = SS1 + M; float* SS3 = SS2 + M;
    float* HIDM = (float*)(ws + WS_HIDM); float* H1M = (float*)(ws + WS_H1M); float* SSD = (float*)(ws + WS_SSD);
    bf16* Gb = (bf16*)F.out;
    const int bx = (int)blockIdx.x;
    const int gw = F.vcu * NWAVES + F.wave, NGW = F.G * NWAVES;
    const int lb = bx - F.G / 2;
    const int lgw = lb * NWAVES + F.wave, NLGW = (F.G - F.G / 2) * NWAVES;

    if (IN(0)) {
        LAS float* scr = (LAS float*)(F.lds + RING_OFF + F.wave * 16384);
        for (int it = gw; it < T_W13A; it += NGW) weight_item(args, ws, scr, it, F.lane);
        for (int m = gw; m < M; m += NGW) { const GAS f32x4* xr = (const GAS f32x4*)(args.in[I_X] + (size_t)m * D) + F.lane; f32x4 v[4]; float s = 0.f;
#pragma unroll
            for (int j = 0; j < 4; ++j) { v[j] = xr[64 * j]; s += (v[j].x * v[j].x + v[j].y * v[j].y) + (v[j].z * v[j].z + v[j].w * v[j].w); }
            s = wave_sum(s);
            GAS v2u* o8 = (GAS v2u*)(AB + (size_t)m * D) + F.lane;
#pragma unroll
            for (int j = 0; j < 4; ++j) o8[64 * j] = (v2u){pk2(v[j].x, v[j].y), pk2(v[j].z, v[j].w)};
            if (F.lane == 0) { SS0[m] = s; SS1[m] = 0.f; SS2[m] = 0.f; SS3[m] = 0.f; } }
    }
    SEAM(0);
    if (IN(1)) {
        pg8::Gemm g{D, D, D}; pg8::GridOrder S{M / 256, 2 * DFF / 256, F.G, bx, (const char*)AB, (const char*)W13A, (size_t)256 * D * 2, (size_t)256 * D * 2};
        EpiSwiglu E{HID, SS0};
        pg8::gemm_phase(F.lds + RING_OFF, F.wave, g, S, E);
        if (lb >= 0) {
            F.lane = lane_id_opaque(); F.tid = F.wave * 64 + F.lane;
            if (lb < NG) ssm_prep_job(F, args, lb);
            for (int j = lb; j < DFF / 16; j += F.G - F.G / 2) { float* hm = HIDM; const int c0 = 16 * j; const bf16* b0 = W13A + (size_t)glu_row(c0) * D;
                meta_job<2, true>(F, args.in[I_META], D, b0, b0 + (size_t)128 * D, [=](int r, int jj, float a, float b) { hm[r * DFF + c0 + jj] = fsilu(a) * b; }); }
            LAS float* scr = (LAS float*)(F.lds + RING_OFF + F.wave * 16384);
            for (int it = T_W13A + lgw; it < T_WIN; it += NLGW) weight_item(args, ws, scr, it, F.lane);
        }
    }
    SEAM(1);
    if (IN(2)) {
        pg8::Gemm g{DFF, DFF, DFF}; pg8::GridOrder S{M / 256, D / 256, F.G, bx, (const char*)HID, (const char*)W2A, (size_t)256 * DFF * 2, (size_t)256 * DFF * 2};
        EpiResid<false> E{args.in[I_X], H1B, (args.dupk == 2) ? SSD : SS1, 0.5f};
        pg8::gemm_phase(F.lds + RING_OFF, F.wave, g, S, E);
        F.lane = lane_id_opaque(); F.tid = F.wave * 64 + F.lane;
        for (int j = bx; j < D / 16; j += F.G) { float* hm = H1M; const float* mt = args.in[I_META]; const int c0 = 16 * j;
            meta_job<1, false>(F, HIDM, DFF, W2A + (size_t)c0 * DFF, nullptr, [=](int r, int jj, float a, float) { hm[r * D + c0 + jj] = mt[r * D + c0 + jj] + 0.5f * a; }); }
    }
    SEAM(2);
    if (IN(3)) {
        pg8::Gemm g{D, D, D}; pg8::GridOrder S{M / 256, DIN / 256, F.G, bx, (const char*)H1B, (const char*)WIN, (size_t)256 * D * 2, (size_t)256 * D * 2};
        EpiMix E{SS1, Zb, UXb, Gb, args.in[I_BGATE]};
        pg8::gemm_phase(F.lds + RING_OFF, F.wave, g, S, E);
        if (lb >= 0) {
            F.lane = lane_id_opaque(); F.tid = F.wave * 64 + F.lane;
            for (int j = lb; j < 64; j += F.G - F.G / 2) {
                if (j < 32) { bf16* zz = Zb; const int c0 = 16 * j; const bf16* b0 = WIN + (size_t)glu_row(c0) * D;
                    meta_job<2, true>(F, H1M, D, b0, b0 + (size_t)128 * D, [=](int r, int jj, float a, float b) { zz[(size_t)(M + r) * DCONV + c0 + jj] = (bf16)f2bf(a * fsigmoid(b)); });
                } else { bf16* ux = UXb; const int gg = j - 32;
                    meta_job<1, true>(F, H1M, D, WIN + (size_t)(1024 + 16 * gg) * D, nullptr, [=](int r, int jj, float a, float) { ux[(size_t)(gg * (NCH + 1) + NCH) * UXK + r * 16 + jj] = (bf16)f2bf(a); }); }
            }
            LAS float* scr = (LAS float*)(F.lds + RING_OFF + F.wave * 16384);
            for (int it = T_WIN + lgw; it < T_W2B; it += NLGW) weight_item(args, ws, scr, it, F.lane);
        }
    }
    SEAM(3);
    if (IN(4)) {
        if (bx < BATCH * NG) {
            ssm_pre_job(F, bx / NG, bx % NG);
            pg8::Gemm g{UXK, UXK, UXK}; SsmOrder S{1 << 20, bx, (const char*)UXb, (const char*)(ws + WS_BS2)};
            EpiSsmY E{UXb, args.in[I_SD], Yb};
            pg8::gemm_phase(F.lds + RING_OFF, F.wave, g, S, E);
        } else {
            for (int j = bx - BATCH * NG; j < 512; j += F.G - BATCH * NG) conv_job(F, args, j);
        }
    }
    SEAM(4);
    if (IN(6)) {
        pg8::Gemm g{512, 512, 512}; MergeOrder S{F.G, bx, (const char*)ZCb, (const char*)Yb, (const char*)WCAT};
        EpiMerge E{Gb, MCb, AB};
        pg8::gemm_phase(F.lds + RING_OFF, F.wave, g, S, E);
    }
    SEAM(6);
    if (IN(7)) {
        pg8::Gemm g{D, D, D}; pg8::GridOrder S{M / 256, D / 256, F.G, bx, (const char*)AB, (const char*)WOUT, (size_t)256 * D * 2, (size_t)256 * D * 2};
        EpiResid<true> E{H1B, H2B, (args.dupk == 7) ? SSD : SS2, 1.0f};
        pg8::gemm_phase(F.lds + RING_OFF, F.wave, g, S, E);
    }
    SEAM(7);
    if (IN(8)) {
        pg8::Gemm g{D, D, D}; pg8::GridOrder S{M / 256, 2 * DFF / 256, F.G, bx, (const char*)H2B, (const char*)W13B, (size_t)256 * D * 2, (size_t)256 * D * 2};
        EpiSwiglu E{HID, SS2};
        pg8::gemm_phase(F.lds + RING_OFF, F.wave, g, S, E);
    }
    SEAM(8);
    if (IN(9)) {
        pg8::Gemm g{DFF, DFF, DFF}; pg8::GridOrder S{M / 256, D / 256, F.G, bx, (const char*)HID, (const char*)W2B, (size_t)256 * DFF * 2, (size_t)256 * DFF * 2};
        const bool dup9 = args.dupk == 9;
        EpiFinal E{H2B, F.out, dup9 ? SSD : SS3, (unsigned*)(F.ctl + CW_FIN) + (dup9 ? 64 * 64 : 0), args.in[I_FINN], 0.5f};
        pg8::gemm_phase(F.lds + RING_OFF, F.wave, g, S, E);
    }
#undef IN
#undef SEAM
}

extern "C" void kernel_launch(void* const* d_in, const int* in_sizes, int n_in, void* d_out, int out_size, void* d_ws, size_t ws_size, hipStream_t stream) {
    static int grid = 0;
    if (grid == 0) {
        if (n_in != 30 || in_sizes[0] != M * D || out_size != M * D || ws_size < WS_END) { fprintf(stderr, "kernel_launch: unexpected problem shape (n_in %d, in0 %d, out %d, ws %zu); nothing launched\n", n_in, n_in > 0 ? in_sizes[0] : -1, out_size, ws_size); grid = -1; return; }
        int dev = 0, cus = 0, per_cu = 0;
        if (hipGetDevice(&dev) != hipSuccess || hipDeviceGetAttribute(&cus, hipDeviceAttributeMultiprocessorCount, dev) != hipSuccess) { grid = -1; return; }
        if (hipFuncSetAttribute((const void*)hyb_fwd, hipFuncAttributeMaxDynamicSharedMemorySize, LDS_BYTES) != hipSuccess) { fprintf(stderr, "kernel_launch: hipFuncSetAttribute failed\n"); grid = -1; return; }
        if (hipOccupancyMaxActiveBlocksPerMultiprocessor(&per_cu, (const void*)hyb_fwd, NWAVES * 64, LDS_BYTES) != hipSuccess || per_cu < 1)
            fprintf(stderr, "kernel_launch: note: occupancy query reports %d workgroups per CU\n", per_cu);
        (void)hipGetLastError();
        grid = cus;
    }
    if (grid < 0) return;
    if (hipMemsetAsync((char*)d_ws + WS_CTL, 0, CTL_ZERO_BYTES, stream) != hipSuccess) { fprintf(stderr, "kernel_launch: hipMemsetAsync failed\n"); return; }
    Args a{};
    for (int i = 0; i < 30; ++i) a.in[i] = (const float*)d_in[i];
    a.out = (float*)d_out; a.ws = (unsigned char*)d_ws;
    constexpr int NL = (DUPK >= 0) ? 2 : N_LAUNCHES;
    for (int li = 0; li < NL; ++li) {
        if (DUPK >= 0) { a.ph_lo = li == 0 ? 0 : DUPK; a.ph_hi = li == 0 ? DUPK + 1 : PER_PHASE; a.dupk = li == 0 ? DUPK : -1; }
        else { a.ph_lo = (N_LAUNCHES == PER_PHASE) ? li : 0; a.ph_hi = (N_LAUNCHES == PER_PHASE) ? li + 1 : PER_PHASE; a.dupk = -1; }
        a.li = li;
        hipLaunchKernelGGL(hyb_fwd, dim3(grid), dim3(NWAVES * 64), LDS_BYTES, stream, a);
        const hipError_t le = hipPeekAtLastError();
        if (le != hipSuccess) { fprintf(stderr, "kernel_launch: launch %d failed: %s\n", li, hipGetErrorName(le)); break; }
    }
}
```

```cpp
#include <hip/hip_runtime.h>
#include <cstdio>
#include <cstdint>

#ifndef MK_N_LAUNCHES
#define MK_N_LAUNCHES 1
#endif
#ifndef DUPK
#define DUPK -1
#endif

__device__ __forceinline__ int lane_id_opaque() { int l; asm volatile("v_mbcnt_lo_u32_b32 %0, -1, 0\n\tv_mbcnt_hi_u32_b32 %0, -1, %0" : "=v"(l)); return l; }
namespace pg8 {
#define PG8_LAS __attribute__((address_space(3)))
typedef unsigned short bf16_t;
typedef short bf16x8 __attribute__((ext_vector_type(8)));
typedef float f32x4 __attribute__((ext_vector_type(4)));
typedef unsigned u32x4 __attribute__((ext_vector_type(4)));
constexpr int BM = 256, BK = 64, HALF = 128, HTB = HALF * BK * 2, STAGE_BYTES = 8 * HTB, NXCD = 8, WGM = 8;

__host__ __device__ __forceinline__ int lds_byte(int r, int c) { const int st = (r >> 4) * 2 + (c >> 5), rr = r & 15, cc = c & 31, ob = rr * 64 + cc * 2; return st * 1024 + (ob ^ (((ob >> 9) & 1) << 5)); }
__host__ __device__ __forceinline__ void stage_rc(int b, int& R, int& C) { const int st = b / 1024, sb = b % 1024, swz = sb ^ (((sb >> 9) & 1) << 5); R = (st >> 1) * 16 + swz / 64; C = (st & 1) * 32 + (swz % 64) / 2; }
__host__ __device__ __forceinline__ int perm32(int rho) { const int n = rho >> 4, i = rho & 15; return 8 * (i >> 2) + 4 * n + (i & 3); }

struct Unit { int pm, pn, kind; const char* A; const char* B; };
struct Gemm { int lda, ldb, K; };

__device__ __forceinline__ bool static_tile(int i, int G, int c, int nM, int nN, int& pm, int& pn) {
    const int nwg = nM * nN; const long L = (long)i * G + c; if (L >= nwg) return false;
    int wgid = (int)L; { const int q = nwg / NXCD, r = nwg % NXCD, xcd = wgid % NXCD, off = wgid / NXCD; wgid = (xcd < r ? xcd * (q + 1) : r * (q + 1) + (xcd - r) * q) + off; }
    const int nig = WGM * nN, gid = wgid / nig, fm = gid * WGM, gsz = (nM - fm) < WGM ? (nM - fm) : WGM;
    pm = fm + ((wgid % nig) % gsz); pn = (wgid % nig) / gsz; return true;
}
struct GridOrder {
    int nM, nN, G, c; const char* A; const char* B; size_t tA, tB;
    __device__ __forceinline__ bool next(int i, Unit& u) const { int pm, pn; if (!static_tile(i, G, c, nM, nN, pm, pn)) return false; u.pm = pm; u.pn = pn; u.kind = 0; u.A = A + (size_t)pm * tA; u.B = B + (size_t)pn * tB; return true; }
    __device__ __forceinline__ void a_ready(const Unit&) const {}
    __device__ __forceinline__ void done(const Unit&) const {}
};

__device__ __forceinline__ unsigned cvt_pk_bf16(float lo, float hi) { unsigned r; asm volatile("v_cvt_pk_bf16_f32 %0, %1, %2" : "=v"(r) : "v"(lo), "v"(hi)); return r; }

template <class Epi, class Sched>
__device__ __forceinline__ void gemm_phase(PG8_LAS unsigned char* lds, const int wid  , const Gemm g, const Sched& S, const Epi& E) {
    const int lane = lane_id_opaque(), tid = wid * 64 + lane, wr = wid >> 2, wc = wid & 3, fr = lane & 15, fq = lane >> 4;
    const int K = g.K, nt = K / BK;
    unsigned voffA[2], voffB[2];
#pragma unroll
    for (int i = 0; i < 2; ++i) { int R, C; stage_rc(tid * 16 + i * 8192, R, C); const int Rb = (R & ~31) + perm32(R & 31);
        voffA[i] = (unsigned)(R * g.lda + C) * 2u; voffB[i] = (unsigned)(Rb * g.ldb + C) * 2u; }
    const size_t kstep = (size_t)(BK * 2);
    const size_t hstepA = (size_t)HALF * g.lda * 2, hstepB = (size_t)HALF * g.ldb * 2;
    const unsigned ldsw = (unsigned)wid * 1024u;
    const int aoff = lds_byte(wr * 64 + fr, fq * 8), boff = lds_byte(wc * 32 + fr, fq * 8);
#define PG8_SA(b, h) (((b) * 2 + (h)) * HTB)
#define PG8_SB(b, h) ((4 + (b) * 2 + (h)) * HTB)
#define PG8_STAGE(bufoff, gbase, voff) do { _Pragma("unroll") for (int _i = 0; _i < 2; ++_i) \
        __builtin_amdgcn_global_load_lds((const unsigned*)((const char*)(gbase) + (voff)[_i]), (PG8_LAS unsigned*)(lds + (bufoff) + ldsw + _i * 8192), 16, 0, 0); } while (0)
#define PG8_LDA(dst, b, h) do { _Pragma("unroll") for (int m = 0; m < 4; ++m) _Pragma("unroll") for (int k = 0; k < 2; ++k) dst[m][k] = *(const PG8_LAS bf16x8*)(lds + PG8_SA(b, h) + aoff + m * 2048 + k * 1024); } while (0)
#define PG8_LDB(dst, b, h) do { _Pragma("unroll") for (int n = 0; n < 2; ++n) _Pragma("unroll") for (int k = 0; k < 2; ++k) dst[n][k] = *(const PG8_LAS bf16x8*)(lds + PG8_SB(b, h) + boff + n * 2048 + k * 1024); } while (0)
#define PG8_MMA(ai, bj, At, Bt) do { __builtin_amdgcn_s_setprio(1); _Pragma("unroll") for (int m = 0; m < 4; ++m) _Pragma("unroll") for (int n = 0; n < 2; ++n) _Pragma("unroll") for (int k = 0; k < 2; ++k) \
        acc[ai][bj][m][n] = __builtin_amdgcn_mfma_f32_16x16x32_bf16(Bt[n][k], At[m][k], acc[ai][bj][m][n], 0, 0, 0); __builtin_amdgcn_s_setprio(0); } while (0)
#define PG8_WAIT_V(n) asm volatile("s_waitcnt vmcnt(" #n ")" ::: "memory")
#define PG8_WAIT_L(n) asm volatile("s_waitcnt lgkmcnt(" #n ")" ::: "memory")
#define PG8_BAR __builtin_amdgcn_s_barrier()
#define PG8_SCHED __builtin_amdgcn_sched_barrier(0)
    Unit cur, nxt; int ui = 0;
    if (!S.next(0, cur)) return;
    f32x4 acc[2][2][4][2];
#pragma unroll
    for (int a = 0; a < 2; ++a)
#pragma unroll
        for (int b = 0; b < 2; ++b)
#pragma unroll
            for (int m = 0; m < 4; ++m)
#pragma unroll
                for (int n = 0; n < 2; ++n) acc[a][b][m][n] = (f32x4){0.f, 0.f, 0.f, 0.f};
    bf16x8 At[4][2], B0[2][2], B1[2][2];
    const char* cA = cur.A; const char* cB = cur.B;
    S.a_ready(cur);
    PG8_STAGE(PG8_SB(0, 0), cB, voffB); PG8_STAGE(PG8_SB(0, 1), cB + hstepB, voffB); PG8_STAGE(PG8_SA(0, 0), cA, voffA); PG8_STAGE(PG8_SA(0, 1), cA + hstepA, voffA);
    if (wr == 1) PG8_BAR;
    PG8_WAIT_V(2); PG8_BAR;
    PG8_STAGE(PG8_SB(1, 0), cB + kstep, voffB); PG8_STAGE(PG8_SA(1, 0), cA + kstep, voffA); PG8_STAGE(PG8_SB(1, 1), cB + hstepB + kstep, voffB);
    PG8_WAIT_V(6); PG8_BAR;
    for (;;) {
        const bool has_next = S.next(ui + 1, nxt);
        const char* nA = has_next ? nxt.A : cA; const char* nB = has_next ? nxt.B : cB;
        for (int t = 0; t < nt; t += 2) {
            const bool last = (t == nt - 2);
            const char* a1 = cA + (size_t)(t + 1) * kstep;
            const char* a2 = last ? nA : cA + (size_t)(t + 2) * kstep; const char* b2 = last ? nB : cB + (size_t)(t + 2) * kstep;
            const char* a3 = a2 + kstep; const char* b3 = b2 + kstep;
            if (last && has_next) S.a_ready(nxt);
            PG8_LDB(B0, 0, 0); PG8_LDB(B1, 0, 1); PG8_SCHED; PG8_LDA(At, 0, 0); PG8_STAGE(PG8_SA(1, 1), a1 + hstepA, voffA);
            PG8_WAIT_V(8); PG8_WAIT_L(0); PG8_BAR; PG8_MMA(0, 0, At, B0); PG8_MMA(0, 1, At, B1); PG8_BAR; PG8_SCHED;
            PG8_LDA(At, 0, 1); PG8_STAGE(PG8_SB(0, 0), b2, voffB); PG8_STAGE(PG8_SB(0, 1), b2 + hstepB, voffB); PG8_STAGE(PG8_SA(0, 0), a2, voffA);
            PG8_WAIT_V(8); PG8_WAIT_L(0); PG8_BAR; PG8_MMA(1, 0, At, B0); PG8_MMA(1, 1, At, B1); PG8_BAR; PG8_SCHED;
            PG8_LDB(B0, 1, 0); PG8_LDB(B1, 1, 1); PG8_SCHED; PG8_LDA(At, 1, 0); PG8_STAGE(PG8_SA(0, 1), a2 + hstepA, voffA);
            PG8_WAIT_V(8); PG8_WAIT_L(0); PG8_BAR; PG8_MMA(0, 0, At, B0); PG8_MMA(0, 1, At, B1); PG8_BAR; PG8_SCHED;
            PG8_LDA(At, 1, 1); PG8_STAGE(PG8_SB(1, 0), b3, voffB); PG8_STAGE(PG8_SB(1, 1), b3 + hstepB, voffB); PG8_STAGE(PG8_SA(1, 0), a3, voffA);
            PG8_WAIT_V(8); PG8_WAIT_L(0); PG8_BAR; PG8_MMA(1, 0, At, B0); PG8_MMA(1, 1, At, B1); PG8_BAR; PG8_SCHED;
        }
        if (wr == 0) PG8_BAR;
        E(acc, cur, wr, wc); S.done(cur);
        if (!has_next) break;
#pragma unroll
        for (int a = 0; a < 2; ++a)
#pragma unroll
            for (int b = 0; b < 2; ++b)
#pragma unroll
                for (int m = 0; m < 4; ++m)
#pragma unroll
                    for (int n = 0; n < 2; ++n) acc[a][b][m][n] = (f32x4){0.f, 0.f, 0.f, 0.f};
        cur = nxt; cA = nA; cB = nB; ++ui;
        if (wr == 1) PG8_BAR;
    }
    PG8_WAIT_V(0);
    PG8_BAR;
#undef PG8_SA
#undef PG8_SB
#undef PG8_STAGE
#undef PG8_LDA
#undef PG8_LDB
#undef PG8_MMA
#undef PG8_WAIT_V
#undef PG8_WAIT_L
#undef PG8_BAR
#undef PG8_SCHED
}
}

constexpr int NWAVES = 8;
constexpr int D = 1024, BATCH = 4, SEQ = 4096, NMETA = 16, DFF = 2816, DCONV = 512, CWID = 31, DSSM = 512, HG = 16, NG = 32, PS = 64;
constexpr int DIN = 2 * DCONV + DSSM + 2 * D;
constexpr int M = BATCH * SEQ;
constexpr int NCH = M / 16;
constexpr int UXK = 384;
constexpr float EPS = 1e-6f;
constexpr int PER_PHASE = 10;
constexpr int N_LAUNCHES = MK_N_LAUNCHES;

constexpr size_t MiB = 1u << 20;
constexpr size_t WS_CTL = 0, CTL_ZERO_BYTES = 1 * MiB;
constexpr size_t WS_BS2 = 1 * MiB;
constexpr size_t WS_WSI = 7 * MiB;
constexpr size_t WS_SMALL = 9 * MiB;
constexpr size_t WS_LAMC = WS_SMALL;
constexpr size_t WS_SMETA = WS_SMALL + 16384;
constexpr size_t WS_SS0 = WS_SMALL + 32768;
constexpr size_t WS_HIDM = WS_SMALL + 32768 + 4 * 65536;
constexpr size_t WS_H1M = WS_HIDM + 16 * DFF * 4;
constexpr size_t WS_SSD = WS_H1M + 16 * D * 4;
constexpr size_t WS_W13A = 11 * MiB, WS_W2A = 22 * MiB, WS_WIN = 28 * MiB, WS_WCAT = 35 * MiB, WS_WOUT = 38 * MiB, WS_W13B = 40 * MiB, WS_W2B = 51 * MiB;
constexpr size_t WS_AB = 57 * MiB;
constexpr size_t WS_H1 = 89 * MiB;
constexpr size_t WS_HID = 153 * MiB;
constexpr size_t WS_Z = WS_HID;
constexpr size_t WS_UX = WS_HID + 17 * MiB;
constexpr size_t WS_ZC = WS_HID + 42 * MiB;
constexpr size_t WS_Y = WS_HID + 58 * MiB;
constexpr size_t WS_MC = WS_HID;
constexpr size_t WS_S = WS_HID + 74 * MiB;
constexpr size_t WS_END = 256 * MiB;
static_assert(WS_SSD + 65536 <= WS_W13A, "small tables");
static_assert(WS_W2B + (size_t)D * DFF * 2 <= WS_AB && WS_AB + (size_t)M * D * 2 <= WS_H1 && WS_H1 + (size_t)M * D * 4 <= WS_HID, "ws map 1");
static_assert(WS_Z + (size_t)(M + 16) * DCONV * 2 <= WS_UX && WS_UX + (size_t)NG * (NCH + 1) * UXK * 2 <= WS_ZC && WS_ZC + (size_t)M * DCONV * 2 <= WS_Y && WS_Y + (size_t)M * DSSM * 2 <= WS_S, "ws map 2");
static_assert(WS_MC + (size_t)M * D * 2 <= WS_ZC, "MC overlay");
static_assert(WS_HID + (size_t)M * DFF * 2 <= WS_END && WS_S + (size_t)NCH * NG * 128 * 4 <= WS_END, "ws end");
static_assert(WS_W13A + (size_t)2 * DFF * D * 2 <= WS_W2A && WS_W2A + (size_t)D * DFF * 2 <= WS_WIN && WS_WIN + (size_t)DIN * D * 2 <= WS_WCAT && WS_WCAT + (size_t)3072 * 512 * 2 <= WS_WOUT && WS_WOUT + (size_t)D * D * 2 <= WS_W13B && WS_W13B + (size_t)2 * DFF * D * 2 <= WS_W2B, "weights");
static_assert(WS_BS2 + (size_t)NG * 256 * UXK * 2 <= WS_WSI && WS_WSI + (size_t)NG * 128 * 256 * 2 <= WS_SMALL, "ssm mats");
constexpr int CW_BAR = 4096;
constexpr int CW_FIN = 16384;

constexpr int RING_OFF = 0, RING_BYTES = 131072;
constexpr int LDSCTL_OFF = RING_BYTES, MISC_OFF = LDSCTL_OFF + 320;
constexpr int LDS_BYTES = 147456;

#define GAS __attribute__((address_space(1)))
#define LAS __attribute__((address_space(3)))
typedef unsigned short bf16;
typedef unsigned v4u __attribute__((ext_vector_type(4)));
typedef unsigned v2u __attribute__((ext_vector_type(2)));
typedef float f32x4 __attribute__((ext_vector_type(4)));
typedef float f32x2 __attribute__((ext_vector_type(2)));
typedef short bf16x8 __attribute__((ext_vector_type(8)));
typedef GAS unsigned gu32;
#define RLX_AGENT __ATOMIC_RELAXED, __HIP_MEMORY_SCOPE_AGENT
#define LDS_WAIT() asm volatile("s_waitcnt lgkmcnt(0)" ::: "memory")
#define VM_WAIT() asm volatile("s_waitcnt vmcnt(0)" ::: "memory")
__device__ __forceinline__ unsigned f2bf(float f) { unsigned u = __builtin_bit_cast(unsigned, f); return (u + 0x7fffu + ((u >> 16) & 1u)) >> 16; }
__device__ __forceinline__ unsigned pk2(float lo, float hi) { return f2bf(lo) | (f2bf(hi) << 16); }
__device__ __forceinline__ float bf2f(unsigned h) { return __builtin_bit_cast(float, h << 16); }
__device__ __forceinline__ float fsigmoid(float x) { return __builtin_amdgcn_rcpf(1.f + __builtin_amdgcn_exp2f(-1.44269504089f * x)); }
__device__ __forceinline__ float fsilu(float x) { return x * fsigmoid(x); }
__device__ __forceinline__ float fgelu_tanh(float x) { return x * fsigmoid(1.5957691216f * (x + 0.044715f * x * x * x)); }
__device__ __forceinline__ float wave_sum(float v) {
#pragma unroll
    for (int o = 1; o < 64; o <<= 1) v += __shfl_xor(v, o);
    return v;
}

#define XB_TMO      128
#define XB_XCNT(j)  (256  + 64 * (j))
#define XB_XSUB(j)  (1280 + 64 * (j))
#define XB_XGEN(j)  (2304 + 64 * (j))
#define XB_TOP      3328
#define XB_TOPGEN   3392
#define XCD_BAR_WORDS 3456
#define XB_SPIN_CAP (1u << 18)
__device__ __forceinline__ unsigned xb_ld(unsigned* p)              { return __hip_atomic_load(p, __ATOMIC_RELAXED, __HIP_MEMORY_SCOPE_AGENT); }
__device__ __forceinline__ unsigned xb_add(unsigned* p, unsigned v) { return __hip_atomic_fetch_add(p, v, __ATOMIC_RELAXED, __HIP_MEMORY_SCOPE_AGENT); }
__device__ __forceinline__ unsigned xb_xcc_id() { return (unsigned)__builtin_amdgcn_s_getreg((3 << 11) | 20) & 0xFu; }
#define XB_SPIN(cond, bar) do { unsigned _sp = 0; while (cond) { __builtin_amdgcn_s_sleep(1); \
    if ((++_sp & 255u) == 0u) { if (xb_ld(&(bar)[XB_TMO])) break; if (_sp > XB_SPIN_CAP) { atomicAdd(&(bar)[XB_TMO], 1u); break; } } } } while (0)
struct XcdBarrier { unsigned* bar; unsigned x; volatile LAS unsigned* st; };
__device__ __forceinline__ XcdBarrier xcd_barrier_post(unsigned* bar, volatile LAS unsigned* st) {
    XcdBarrier b; b.bar = bar; b.x = xb_xcc_id(); b.st = st;
    if (threadIdx.x == 0) (void)xb_add(&bar[XB_XCNT(b.x)], 1u);
    return b;
}
__device__ __forceinline__ void xcd_barrier_complete(unsigned* bar, unsigned x, unsigned& nloc, unsigned& nx) {
    const unsigned G = gridDim.x * gridDim.y * gridDim.z;
    unsigned sum, cnt, mine, sp = 0u;
    for (;;) {
        sum = 0u; cnt = 0u; mine = 0u;
#pragma unroll
        for (unsigned j = 0; j < 16; ++j) { const unsigned c = xb_ld(&bar[XB_XCNT(j)]); sum += c; cnt += (c > 0u) ? 1u : 0u; mine = (j == x) ? c : mine; }
        if (sum == G) break;
        __builtin_amdgcn_s_sleep(1);
        if ((++sp & 255u) == 0u) { if (xb_ld(&bar[XB_TMO])) break; if (sp > XB_SPIN_CAP) { atomicAdd(&bar[XB_TMO], 1u); break; } }
    }
    nloc = mine > 0u ? mine : 1u; nx = cnt > 0u ? cnt : 1u;
}
__device__ __forceinline__ void xcd_barrier(const XcdBarrier& b) {
    asm volatile("s_waitcnt vmcnt(0)" ::: "memory");
    __syncthreads();
    if (threadIdx.x == 0) {
        unsigned* bar = b.bar;
        __builtin_amdgcn_s_waitcnt(0);
        unsigned nloc = b.st[0], nx = b.st[1];
        if (nloc == 0u) { xcd_barrier_complete(bar, b.x, nloc, nx); b.st[0] = nloc; b.st[1] = nx; }
        const unsigned old = xb_add(&bar[XB_XSUB(b.x)], 1u);
        const unsigned gen = old / nloc;
        if (old + 1u == (gen + 1u) * nloc) {
            __builtin_amdgcn_fence(__ATOMIC_RELEASE, "agent");
            asm volatile("s_waitcnt vmcnt(0)" ::: "memory");
            const unsigned og = xb_add(&bar[XB_TOP], 1u);
            const unsigned tg = og / nx;
            if (og + 1u == (tg + 1u) * nx) xb_add(&bar[XB_TOPGEN], 1u);
            else XB_SPIN(xb_ld(&bar[XB_TOPGEN]) == tg, bar);
            __builtin_amdgcn_fence(__ATOMIC_ACQUIRE, "agent");
            xb_add(&bar[XB_XGEN(b.x)], 1u);
            asm volatile("s_waitcnt vmcnt(0)" ::: "memory");
        } else {
            XB_SPIN(xb_ld(&bar[XB_XGEN(b.x)]) == gen, bar);
            __builtin_amdgcn_fence(__ATOMIC_ACQUIRE, "agent");
            asm volatile("s_waitcnt vmcnt(0)" ::: "memory");
        }
    }
    __syncthreads();
}

struct Args { const float* in[30]; float* out; unsigned char* ws; int ph_lo, ph_hi, li, dupk; };
struct Frame {
    LAS unsigned char* lds; volatile LAS unsigned* MISC; gu32* ctl;
    int tid, lane, wave, vcu, G;
    float* out; unsigned char* ws;
};
enum { I_X = 0, I_META, I_F1N, I_F1W1, I_F1W3, I_F1W2, I_MIXN, I_WIN, I_BGATE, I_DW, I_DWB, I_LNG, I_LNB, I_CPROJ, I_LRE, I_LIM, I_LDT, I_BRE, I_BIM, I_CRE, I_CIM, I_SD, I_WV, I_WG, I_WOUT, I_F2N, I_F2W1, I_F2W3, I_F2W2, I_FINN };

using pg8::Unit; using pg8::cvt_pk_bf16;
__device__ __forceinline__ v4u pack8(const f32x4 a, const f32x4 b) { v4u w; w.x = cvt_pk_bf16(a[0], a[1]); w.y = cvt_pk_bf16(a[2], a[3]); w.z = cvt_pk_bf16(b[0], b[1]); w.w = cvt_pk_bf16(b[2], b[3]); return w; }
__device__ __forceinline__ void unpack8(const v4u w, float (&o)[8]) { o[0] = bf2f(w.x & 0xffffu); o[1] = bf2f(w.x >> 16); o[2] = bf2f(w.y & 0xffffu); o[3] = bf2f(w.y >> 16); o[4] = bf2f(w.z & 0xffffu); o[5] = bf2f(w.z >> 16); o[6] = bf2f(w.w & 0xffffu); o[7] = bf2f(w.w >> 16); }
__device__ __forceinline__ float rs_of(const float* SS, int row) { return 1.0f / sqrtf(SS[row] * (1.0f / D) + EPS); }

struct EpiSwiglu {
    bf16* HID; const float* SS;
    __device__ __forceinline__ void operator()(const f32x4 (&acc)[2][2][4][2], const Unit& u, int wr, int wc) const {
        const int lane_ = lane_id_opaque(), fr = lane_ & 15, fq = lane_ >> 4;
        const int row0 = u.pm * 256 + wr * 64 + fr, col0 = u.pn * 128 + wc * 32 + 8 * fq;
#pragma unroll
        for (int ai = 0; ai < 2; ++ai)
#pragma unroll
            for (int m = 0; m < 4; ++m) { const int row = row0 + ai * 128 + m * 16; const float rs = rs_of(SS, row);
                f32x4 o0, o1;
#pragma unroll
                for (int j = 0; j < 4; ++j) { o0[j] = fsilu(acc[ai][0][m][0][j] * rs) * (acc[ai][1][m][0][j] * rs); o1[j] = fsilu(acc[ai][0][m][1][j] * rs) * (acc[ai][1][m][1][j] * rs); }
                *(v4u*)(HID + (size_t)row * DFF + col0) = pack8(o0, o1); }
    }
};
template <bool RBF16> struct EpiResid {
    const void* R; bf16* OB; float* SS; float alpha;
    __device__ __forceinline__ void operator()(const f32x4 (&acc)[2][2][4][2], const Unit& u, int wr, int wc) const {
        const int lane_ = lane_id_opaque(), fr = lane_ & 15, fq = lane_ >> 4;
        const int row0 = u.pm * 256 + wr * 64 + fr, col0 = u.pn * 256 + wc * 32 + 8 * fq;
#pragma unroll
        for (int ai = 0; ai < 2; ++ai)
#pragma unroll
            for (int m = 0; m < 4; ++m) { const int row = row0 + ai * 128 + m * 16; float ss = 0.f;
#pragma unroll
                for (int bj = 0; bj < 2; ++bj) { const size_t off = (size_t)row * D + col0 + bj * 128; f32x4 r0, r1;
                    if (RBF16) { float t[8]; unpack8(*(const v4u*)((const bf16*)R + off), t); r0 = (f32x4){t[0], t[1], t[2], t[3]}; r1 = (f32x4){t[4], t[5], t[6], t[7]}; }
                    else { r0 = *(const f32x4*)((const float*)R + off); r1 = *(const f32x4*)((const float*)R + off + 4); }
                    const f32x4 o0 = r0 + acc[ai][bj][m][0] * alpha, o1 = r1 + acc[ai][bj][m][1] * alpha;
                    *(v4u*)(OB + off) = pack8(o0, o1);
                    ss += (o0[0] * o0[0] + o0[1] * o0[1]) + (o0[2] * o0[2] + o0[3] * o0[3]) + (o1[0] * o1[0] + o1[1] * o1[1]) + (o1[2] * o1[2] + o1[3] * o1[3]); }
                ss += __shfl_xor(ss, 16); ss += __shfl_xor(ss, 32);
                if (fq == 0) atomicAdd(SS + row, ss);
                asm volatile("" ::: "memory"); }
    }
};
struct EpiFinal {
    const bf16* R; float* OUT; float* SS; unsigned* cnt; const float* gain; float alpha;
    __device__ __forceinline__ void operator()(f32x4 (&acc)[2][2][4][2], const Unit& u, int wr, int wc) const {
        const int lane_ = lane_id_opaque(), fr = lane_ & 15, fq = lane_ >> 4;
        const int row0 = u.pm * 256 + wr * 64 + fr, col0 = u.pn * 256 + wc * 32 + 8 * fq;
#pragma unroll
        for (int ai = 0; ai < 2; ++ai)
#pragma unroll
            for (int m = 0; m < 4; ++m) { const int row = row0 + ai * 128 + m * 16; float ss = 0.f;
#pragma unroll
                for (int bj = 0; bj < 2; ++bj) { const size_t off = (size_t)row * D + col0 + bj * 128; float t[8]; unpack8(*(const v4u*)(R + off), t);
                    const f32x4 o0 = (f32x4){t[0], t[1], t[2], t[3]} + acc[ai][bj][m][0] * alpha, o1 = (f32x4){t[4], t[5], t[6], t[7]} + acc[ai][bj][m][1] * alpha;
                    acc[ai][bj][m][0] = o0; acc[ai][bj][m][1] = o1;
                    ss += (o0[0] * o0[0] + o0[1] * o0[1]) + (o0[2] * o0[2] + o0[3] * o0[3]) + (o1[0] * o1[0] + o1[1] * o1[1]) + (o1[2] * o1[2] + o1[3] * o1[3]); }
                ss += __shfl_xor(ss, 16); ss += __shfl_xor(ss, 32);
                if (fq == 0) atomicAdd(SS + row, ss);
                asm volatile("" ::: "memory"); }
        asm volatile("s_waitcnt vmcnt(0)" ::: "memory");
        unsigned* cw = cnt + 64 * u.pm;
        if (lane_ == 0) __hip_atomic_fetch_add(cw, 1u, __ATOMIC_RELAXED, __HIP_MEMORY_SCOPE_AGENT);
        { unsigned sp = 0; while ((unsigned)__builtin_amdgcn_readfirstlane((int)__hip_atomic_load(cw, __ATOMIC_RELAXED, __HIP_MEMORY_SCOPE_AGENT)) < 32u) { __builtin_amdgcn_s_sleep(2); if (++sp > (1u << 20)) break; } }
        f32x4 g[2][2];
#pragma unroll
        for (int bj = 0; bj < 2; ++bj) { g[bj][0] = *(const f32x4*)(gain + col0 + bj * 128); g[bj][1] = *(const f32x4*)(gain + col0 + bj * 128 + 4); }
#pragma unroll
        for (int ai = 0; ai < 2; ++ai)
#pragma unroll
            for (int m = 0; m < 4; ++m) { const int row = row0 + ai * 128 + m * 16;
                float tot = 0.f; if (fq == 0) tot = __hip_atomic_fetch_add(SS + row, 0.0f, __ATOMIC_RELAXED, __HIP_MEMORY_SCOPE_AGENT);
                tot = __shfl(tot, fr);
                const float rs = 1.0f / sqrtf(tot * (1.0f / D) + EPS);
#pragma unroll
                for (int bj = 0; bj < 2; ++bj) { const size_t off = (size_t)row * D + col0 + bj * 128;
                    *(f32x4*)(OUT + off) = acc[ai][bj][m][0] * rs * g[bj][0]; *(f32x4*)(OUT + off + 4) = acc[ai][bj][m][1] * rs * g[bj][1]; }
                asm volatile("" ::: "memory"); }
    }
};
struct EpiMix {
    const float* SS; bf16* Z; bf16* UX; bf16* G; const float* bgate;
    __device__ __forceinline__ void operator()(const f32x4 (&acc)[2][2][4][2], const Unit& u, int wr, int wc) const {
        const int lane_ = lane_id_opaque(), fr = lane_ & 15, fq = lane_ >> 4;
        const int row0 = u.pm * 256 + wr * 64 + fr;
        if (u.pn < 4) {
            const int col0 = u.pn * 128 + wc * 32 + 8 * fq;
#pragma unroll
            for (int ai = 0; ai < 2; ++ai)
#pragma unroll
                for (int m = 0; m < 4; ++m) { const int row = row0 + ai * 128 + m * 16; const float rs = rs_of(SS, row); f32x4 o0, o1;
#pragma unroll
                    for (int j = 0; j < 4; ++j) { o0[j] = (acc[ai][0][m][0][j] * rs) * fsigmoid(acc[ai][1][m][0][j] * rs); o1[j] = (acc[ai][0][m][1][j] * rs) * fsigmoid(acc[ai][1][m][1][j] * rs); }
                    *(v4u*)(Z + (size_t)row * DCONV + col0) = pack8(o0, o1); }
        } else if (u.pn < 6) {
#pragma unroll
            for (int ai = 0; ai < 2; ++ai)
#pragma unroll
                for (int m = 0; m < 4; ++m) { const int row = row0 + ai * 128 + m * 16; const float rs = rs_of(SS, row); const int ci = row >> 4, tt = row & 15;
#pragma unroll
                    for (int bj = 0; bj < 2; ++bj) { const int c = (u.pn - 4) * 256 + bj * 128 + wc * 32 + 8 * fq, g = c >> 4, h0 = c & 15;
                        *(v4u*)(UX + ((size_t)(g * (NCH + 1) + ci) * UXK + tt * 16 + h0)) = pack8(acc[ai][bj][m][0] * rs, acc[ai][bj][m][1] * rs); } }
        } else {
#pragma unroll
            for (int bj = 0; bj < 2; ++bj) { const int c = (u.pn - 6) * 256 + bj * 128 + wc * 32 + 8 * fq;
                const f32x4 b0 = *(const f32x4*)(bgate + c), b1 = *(const f32x4*)(bgate + c + 4);
#pragma unroll
                for (int ai = 0; ai < 2; ++ai)
#pragma unroll
                    for (int m = 0; m < 4; ++m) { const int row = row0 + ai * 128 + m * 16; const float rs = rs_of(SS, row); f32x4 o0, o1;
#pragma unroll
                        for (int j = 0; j < 4; ++j) { o0[j] = fsigmoid(acc[ai][bj][m][0][j] * rs + b0[j]); o1[j] = fsigmoid(acc[ai][bj][m][1][j] * rs + b1[j]); }
                        *(v4u*)(G + (size_t)row * 2048 + c) = pack8(o0, o1); } }
        }
    }
};
struct EpiSsmY {
    const bf16* UX; const float* dskip; bf16* Y;
    __device__ __forceinline__ void operator()(const f32x4 (&acc)[2][2][4][2], const Unit& u, int wr, int wc) const {
        const int lane_ = lane_id_opaque(), fr = lane_ & 15, fq = lane_ >> 4;
        const int b = u.pm, g = u.pn, h0 = 8 * (fq & 1);
        const f32x4 d0 = *(const f32x4*)(dskip + g * 16 + h0), d1 = *(const f32x4*)(dskip + g * 16 + h0 + 4);
#pragma unroll
        for (int ai = 0; ai < 2; ++ai)
#pragma unroll
            for (int m = 0; m < 4; ++m) { const int r = ai * 128 + wr * 64 + m * 16 + fr;
#pragma unroll
                for (int bj = 0; bj < 2; ++bj) { const int tt = 8 * bj + 2 * wc + (fq >> 1);
                    float uu[8]; unpack8(*(const v4u*)(UX + ((size_t)(g * (NCH + 1) + b * 256 + r) * UXK + tt * 16 + h0)), uu);
                    f32x4 o0, o1;
#pragma unroll
                    for (int j = 0; j < 4; ++j) { o0[j] = fgelu_tanh(acc[ai][bj][m][0][j] + d0[j] * uu[j]); o1[j] = fgelu_tanh(acc[ai][bj][m][1][j] + d1[j] * uu[4 + j]); }
                    *(v4u*)(Y + ((size_t)(b * SEQ + r * 16 + tt) * DSSM + g * 16 + h0)) = pack8(o0, o1); }
                asm volatile("" ::: "memory"); }
    }
};
struct EpiMerge {
    const bf16* G; bf16* MC; bf16* MG;
    __device__ __forceinline__ void operator()(const f32x4 (&acc)[2][2][4][2], const Unit& u, int wr, int wc) const {
        const int lane_ = lane_id_opaque(), fr = lane_ & 15, fq = lane_ >> 4;
        const int row0 = u.pm * 256 + wr * 64 + fr;
        if (u.kind == 0) {
#pragma unroll
            for (int ai = 0; ai < 2; ++ai)
#pragma unroll
                for (int m = 0; m < 4; ++m) { const int row = row0 + ai * 128 + m * 16;
#pragma unroll
                    for (int bj = 0; bj < 2; ++bj) { const int c = u.pn * 256 + bj * 128 + wc * 32 + 8 * fq;
                        float gg[8]; unpack8(*(const v4u*)(G + (size_t)row * 2048 + c), gg); f32x4 o0, o1;
#pragma unroll
                        for (int j = 0; j < 4; ++j) { o0[j] = gg[j] * acc[ai][bj][m][0][j]; o1[j] = gg[4 + j] * acc[ai][bj][m][1][j]; }
                        *(v4u*)(MC + (size_t)row * D + c) = pack8(o0, o1); } }
        } else {
            const int c = u.pn * 256 + (u.kind - 1) * 128 + wc * 32 + 8 * fq;
#pragma unroll
            for (int ai = 0; ai < 2; ++ai)
#pragma unroll
                for (int m = 0; m < 4; ++m) { const int row = row0 + ai * 128 + m * 16;
                    float gg[8], mc[8]; unpack8(*(const v4u*)(G + (size_t)row * 2048 + D + c), gg); unpack8(*(const v4u*)(MC + (size_t)row * D + c), mc); f32x4 o0, o1;
#pragma unroll
                    for (int j = 0; j < 4; ++j) { o0[j] = mc[j] + gg[j] * (acc[ai][0][m][0][j] * fsigmoid(acc[ai][1][m][0][j])); o1[j] = mc[4 + j] + gg[4 + j] * (acc[ai][0][m][1][j] * fsigmoid(acc[ai][1][m][1][j])); }
                    *(v4u*)(MG + (size_t)row * D + c) = pack8(o0, o1); }
        }
    }
};
struct SsmOrder {
    int G, c; const char* UX; const char* BS2;
    __device__ __forceinline__ bool next(int i, Unit& u) const { const int L = i * G + c; if (L >= BATCH * NG) return false; const int b = L / NG, g = L % NG; u.pm = b; u.pn = g; u.kind = 0;
        u.A = UX + ((size_t)(g * (NCH + 1) + b * 256) * UXK) * 2; u.B = BS2 + (size_t)g * 256 * UXK * 2; return true; }
    __device__ __forceinline__ void a_ready(const Unit&) const {}
    __device__ __forceinline__ void done(const Unit&) const {}
};
struct MergeOrder {
    int G, c; const char* ZC; const char* Y; const char* WCAT;
    __device__ __forceinline__ bool next(int i, Unit& u) const { int pm, pn; const int su = i / 3, k = i - 3 * su; if (!pg8::static_tile(su, G, c, M / 256, D / 256, pm, pn)) return false; u.pm = pm; u.pn = pn; u.kind = k;
        u.A = (k == 0 ? ZC : Y) + (size_t)pm * 256 * 512 * 2; u.B = WCAT + (size_t)(k == 0 ? pn * 256 : 1024 + (2 * pn + k - 1) * 256) * 512 * 2; return true; }
    __device__ __forceinline__ void a_ready(const Unit&) const {}
    __device__ __forceinline__ void done(const Unit& u) const { if (u.kind == 0) asm volatile("s_waitcnt vmcnt(0)" ::: "memory"); }
};

__device__ __forceinline__ void p0_transpose_item(const float* W, int K, int N, bf16* WT, const float* gain, LAS float* scr, int k0, int n0, int drow0, int lane) {
    float v[32];
    const float* src = W + (size_t)(k0 + (lane >> 5)) * N + n0 + (lane & 31);
#pragma unroll
    for (int i = 0; i < 32; ++i) v[i] = src[(size_t)(2 * i) * N];
#pragma unroll
    for (int i = 0; i < 32; ++i) scr[(2 * i + (lane >> 5)) * 33 + (lane & 31)] = v[i];
    LDS_WAIT(); asm volatile("" ::: "memory");
    const int c = lane & 7;
    f32x4 g0 = (f32x4){1.f, 1.f, 1.f, 1.f}, g1 = g0; if (gain) { g0 = *(const f32x4*)(gain + k0 + 8 * c); g1 = *(const f32x4*)(gain + k0 + 8 * c + 4); }
#pragma unroll
    for (int j = 0; j < 4; ++j) { const int n = (lane >> 3) + 8 * j; const LAS float* s = scr + (8 * c) * 33 + n;
        v4u o; o.x = pk2(s[0 * 33] * g0[0], s[1 * 33] * g0[1]); o.y = pk2(s[2 * 33] * g0[2], s[3 * 33] * g0[3]); o.z = pk2(s[4 * 33] * g1[0], s[5 * 33] * g1[1]); o.w = pk2(s[6 * 33] * g1[2], s[7 * 33] * g1[3]);
        *(GAS v4u*)(WT + (size_t)(drow0 + n) * K + k0 + 8 * c) = o; }
    LDS_WAIT(); asm volatile("" ::: "memory");
}
__device__ __forceinline__ int glu_row(int n) { return 256 * (n >> 7) + (n & 127); }

constexpr int I_UP = (D / 64) * (DFF / 32), I_DN = (DFF / 64) * (D / 32), I_INP = (D / 64) * (DIN / 32), I_CP = (DCONV / 64) * (D / 32), I_WO = (D / 64) * (D / 32);
constexpr int T_W13A = 2 * I_UP, T_W2A = T_W13A + I_DN, T_WIN = T_W2A + I_INP, T_WCAT = T_WIN + 3 * I_CP, T_WOUT = T_WCAT + I_WO, T_W13B = T_WOUT + 2 * I_UP, T_W2B = T_W13B + I_DN;
__device__ __forceinline__ void weight_item(const Args& args, unsigned char* ws, LAS float* scr, int it, int lane) {
    if (it < T_W13A || (it >= T_WOUT && it < T_W13B)) { const bool second = it >= T_WOUT; int r = it - (second ? T_WOUT : 0); const int which = r / I_UP; r -= which * I_UP; const int nblk = DFF / 32, k0 = 64 * (r / nblk), n0 = 32 * (r % nblk);
        const float* W = second ? (which ? args.in[I_F2W3] : args.in[I_F2W1]) : (which ? args.in[I_F1W3] : args.in[I_F1W1]);
        p0_transpose_item(W, D, DFF, (bf16*)(ws + (second ? WS_W13B : WS_W13A)), second ? args.in[I_F2N] : args.in[I_F1N], scr, k0, n0, glu_row(n0) + which * 128, lane); return; }
    if (it < T_W2A || it >= T_W13B) { const bool second = it >= T_W13B; const int r = it - (second ? T_W13B : T_W13A); const int nblk = D / 32, k0 = 64 * (r / nblk), n0 = 32 * (r % nblk);
        p0_transpose_item(second ? args.in[I_F2W2] : args.in[I_F1W2], DFF, D, (bf16*)(ws + (second ? WS_W2B : WS_W2A)), nullptr, scr, k0, n0, n0, lane); return; }
    if (it < T_WIN) { const int r = it - T_W2A; const int nblk = DIN / 32, k0 = 64 * (r / nblk), n0 = 32 * (r % nblk);
        const int dr = n0 < 512 ? glu_row(n0) : n0 < 1024 ? glu_row(n0 - 512) + 128 : n0;
        p0_transpose_item(args.in[I_WIN], D, DIN, (bf16*)(ws + WS_WIN), args.in[I_MIXN], scr, k0, n0, dr, lane); return; }
    if (it < T_WCAT) { int r = it - T_WIN; const int which = r / I_CP; r -= which * I_CP; const int nblk = D / 32, k0 = 64 * (r / nblk), n0 = 32 * (r % nblk);
        const int dr = which == 0 ? n0 : 1024 + glu_row(n0) + (which == 2 ? 128 : 0);
        p0_transpose_item(which == 0 ? args.in[I_CPROJ] : which == 1 ? args.in[I_WV] : args.in[I_WG], DCONV, D, (bf16*)(ws + WS_WCAT), nullptr, scr, k0, n0, dr, lane); return; }
    { const int r = it - T_WCAT; const int nblk = D / 32, k0 = 64 * (r / nblk), n0 = 32 * (r % nblk); p0_transpose_item(args.in[I_WOUT], D, D, (bf16*)(ws + WS_WOUT), nullptr, scr, k0, n0, n0, lane); }
}

__device__ __forceinline__ void ssm_prep_job(Frame& F, const Args& args, int g) {
    LAS f32x2* lamP = (LAS f32x2*)(F.lds + RING_OFF);
    LAS f32x2* Bb = lamP + 17 * 64;
    LAS f32x2* Cc = Bb + 64 * 16;
    LAS float* Kk = (LAS float*)(Cc + 16 * 64);
    const float* lam_re = args.in[I_LRE]; const float* lam_im = args.in[I_LIM]; const float* log_dt = args.in[I_LDT];
    const float* b_re = args.in[I_BRE]; const float* b_im = args.in[I_BIM]; const float* c_re = args.in[I_CRE]; const float* c_im = args.in[I_CIM];
    const int tid = F.tid;
    const float dt = expf(log_dt[g]);
    if (tid < 64) { const int p = tid; const float a = lam_re[g * PS + p] * dt, bb = lam_im[g * PS + p] * dt, ea = expf(a), sb = sinf(bb), cb = cosf(bb);
        const float lx = ea * cb, ly = ea * sb; float px = 1.f, py = 0.f;
        for (int k = 0; k <= 16; ++k) { lamP[k * 64 + p] = (f32x2){px, py}; const float nx = px * lx - py * ly, ny = px * ly + py * lx; px = nx; py = ny; } }
    for (int i = tid; i < 1024; i += 512) { const int p = i >> 4;
        const float lr = lam_re[g * PS + p], li = lam_im[g * PS + p], a = lr * dt, bb = li * dt, ea = expf(a), sb = sinf(bb), cb = cosf(bb), sh = sinf(0.5f * bb);
        const float nr = expm1f(a) * cb - 2.f * sh * sh, ni = ea * sb, den = 1.f / (lr * lr + li * li), fr_ = (nr * lr + ni * li) * den, fi_ = (ni * lr - nr * li) * den;
        const float br = b_re[(size_t)g * 1024 + i], bi = b_im[(size_t)g * 1024 + i];
        Bb[i] = (f32x2){fr_ * br - fi_ * bi, fr_ * bi + fi_ * br};
        Cc[i] = (f32x2){c_re[(size_t)g * 1024 + i], c_im[(size_t)g * 1024 + i]}; }
    __syncthreads();
    {
        const int k = tid >> 5, h = (tid >> 1) & 15, hh = (tid & 1) * 8; float sum[8];
#pragma unroll
        for (int j = 0; j < 8; ++j) sum[j] = 0.f;
#pragma unroll 4
        for (int p = 0; p < 64; ++p) { const f32x2 c = Cc[h * 64 + p], l = lamP[k * 64 + p]; const float er = c.x * l.x - c.y * l.y, ei = c.x * l.y + c.y * l.x;
#pragma unroll
            for (int j = 0; j < 8; j += 2) { const f32x4 bb = *(const LAS f32x4*)(Bb + p * 16 + hh + j); sum[j] += er * bb[0] - ei * bb[1]; sum[j + 1] += er * bb[2] - ei * bb[3]; } }
#pragma unroll
        for (int j = 0; j < 8; ++j) Kk[(k << 8) + (h << 4) + hh + j] = sum[j];
    }
    __syncthreads();
    GAS unsigned* bs2 = (GAS unsigned*)(F.ws + WS_BS2) + (size_t)g * 256 * (UXK / 2);
    for (int i = tid; i < 256 * (UXK / 2); i += 512) { const int n = i / (UXK / 2), kp = (i % (UXK / 2)) * 2, t = n >> 4, h = n & 15; float v0, v1;
        if (kp < 256) { const int s = kp >> 4, hp = kp & 15; const bool on = s <= t; const int kb = (((t - s) & 15) << 8) + (h << 4) + hp; v0 = on ? Kk[kb] : 0.f; v1 = on ? Kk[kb + 1] : 0.f; }
        else { const int p = (kp - 256) >> 1; const f32x2 c = Cc[h * 64 + p], l = lamP[(t + 1) * 64 + p]; v0 = c.x * l.x - c.y * l.y; v1 = -(c.x * l.y + c.y * l.x); }
        bs2[i] = pk2(v0, v1); }
    GAS unsigned* wsi = (GAS unsigned*)(F.ws + WS_WSI) + (size_t)g * 128 * 128;
    for (int i = tid; i < 128 * 128; i += 512) { const int n = i >> 7, kp = (i & 127) * 2, p = n >> 1, c = n & 1, s = kp >> 4, h = kp & 15;
        const f32x2 l = lamP[(15 - s) * 64 + p], b0 = Bb[p * 16 + h], b1 = Bb[p * 16 + h + 1];
        const float v0 = c ? (l.x * b0.y + l.y * b0.x) : (l.x * b0.x - l.y * b0.y), v1 = c ? (l.x * b1.y + l.y * b1.x) : (l.x * b1.x - l.y * b1.y);
        wsi[i] = pk2(v0, v1); }
    if (tid < 64) ((GAS f32x2*)(F.ws + WS_LAMC))[g * 64 + tid] = lamP[16 * 64 + tid];
    __syncthreads();
}

template <int NS, bool NORM, class Fn>
__device__ __forceinline__ void meta_job(Frame& F, const float* A, int K, const bf16* Bt0, const bf16* Bt1, const Fn& fn) {
    LAS float* red = (LAS float*)(F.lds + RING_OFF);
    LAS float* rsc = red + 8 * 16 * 32;
    const int lane = F.lane, w = F.wave, fr = lane & 15, fq = lane >> 4;
    if (NORM) {
#pragma unroll
        for (int rr = 0; rr < 2; ++rr) { const int row = 2 * w + rr; float s = 0.f; for (int c = lane; c < D; c += 64) { const float v = A[(size_t)row * K + c]; s += v * v; } s = wave_sum(s); if (lane == 0) rsc[row] = 1.0f / sqrtf(s * (1.0f / D) + EPS); }
    } else if (F.tid < 16) rsc[F.tid] = 1.f;
    f32x4 acc[NS];
#pragma unroll
    for (int s = 0; s < NS; ++s) acc[s] = (f32x4){0.f, 0.f, 0.f, 0.f};
    const int kw = K / 8, kbase = w * kw;
#pragma unroll 4
    for (int k = kbase; k < kbase + kw; k += 32) {
        const f32x4 a0 = *(const f32x4*)(A + (size_t)fr * K + k + 8 * fq), a1 = *(const f32x4*)(A + (size_t)fr * K + k + 8 * fq + 4);
        const v4u ap = pack8(a0, a1); const bf16x8 af = __builtin_bit_cast(bf16x8, ap);
#pragma unroll
        for (int s = 0; s < NS; ++s) { const bf16x8 bf = *(const bf16x8*)((s == 0 ? Bt0 : Bt1) + (size_t)fr * K + k + 8 * fq); acc[s] = __builtin_amdgcn_mfma_f32_16x16x32_bf16(bf, af, acc[s], 0, 0, 0); } }
#pragma unroll
    for (int s = 0; s < NS; ++s) *(LAS f32x4*)(red + (w * 16 + fr) * 32 + s * 16 + 4 * fq) = acc[s];
    __syncthreads();
    if (F.tid < 256) { const int rr = F.tid >> 4, j = F.tid & 15; float v0 = 0.f, v1 = 0.f;
#pragma unroll
        for (int ww = 0; ww < 8; ++ww) { v0 += red[(ww * 16 + rr) * 32 + j]; if (NS > 1) v1 += red[(ww * 16 + rr) * 32 + 16 + j]; }
        const float sc = rsc[rr]; fn(rr, j, v0 * sc, v1 * sc); }
    __syncthreads();
}

constexpr int WSI_PITCH = 528;
constexpr int SMETA_OFF = LDSCTL_OFF + 1024;
__device__ __forceinline__ void ssm_pre_job(Frame& F, int b, int g) {
    const int lane = F.lane, w = F.wave, tid = F.tid, fr = lane & 15, fq = lane >> 4;
    LAS unsigned char* Bl = F.lds + RING_OFF;
    LAS f32x2* Sl = (LAS f32x2*)(F.lds + RING_OFF);
    LAS float* smeta = (LAS float*)(F.lds + SMETA_OFF);
    bf16* UX = (bf16*)(F.ws + WS_UX); const bf16* Wg = (const bf16*)(F.ws + WS_WSI) + (size_t)g * 128 * 256;
    { v4u v[8];
#pragma unroll
      for (int i = 0; i < 8; ++i) { const int idx = tid + 512 * i; v[i] = *(const v4u*)(Wg + (size_t)(idx >> 5) * 256 + (idx & 31) * 8); }
#pragma unroll
      for (int i = 0; i < 8; ++i) { const int idx = tid + 512 * i; *(LAS v4u*)(Bl + (idx >> 5) * WSI_PITCH + (idx & 31) * 16) = v[i]; } }
    const bf16* Ab = UX + (size_t)(g * (NCH + 1) + 256 * b + 32 * w) * UXK;
    bf16x8 a[2][8], am[8];
#pragma unroll
    for (int mt = 0; mt < 2; ++mt)
#pragma unroll
        for (int ks = 0; ks < 8; ++ks) a[mt][ks] = *(const bf16x8*)(Ab + (size_t)(16 * mt + fr) * UXK + 32 * ks + 8 * fq);
    if (w == 7) {
#pragma unroll
        for (int ks = 0; ks < 8; ++ks) am[ks] = *(const bf16x8*)(UX + (size_t)(g * (NCH + 1) + NCH) * UXK + 32 * ks + 8 * fq); }
    f32x4 acc[2][8], accm[8];
#pragma unroll
    for (int nt = 0; nt < 8; ++nt) { acc[0][nt] = (f32x4){0.f, 0.f, 0.f, 0.f}; acc[1][nt] = acc[0][nt]; accm[nt] = acc[0][nt]; }
    __syncthreads();
#pragma unroll
    for (int ks = 0; ks < 8; ++ks)
#pragma unroll
        for (int nt = 0; nt < 8; ++nt) { const bf16x8 bfr = *(const LAS bf16x8*)(Bl + (16 * nt + fr) * WSI_PITCH + (32 * ks + 8 * fq) * 2);
            acc[0][nt] = __builtin_amdgcn_mfma_f32_16x16x32_bf16(bfr, a[0][ks], acc[0][nt], 0, 0, 0); acc[1][nt] = __builtin_amdgcn_mfma_f32_16x16x32_bf16(bfr, a[1][ks], acc[1][nt], 0, 0, 0);
            if (w == 7) accm[nt] = __builtin_amdgcn_mfma_f32_16x16x32_bf16(bfr, am[ks], accm[nt], 0, 0, 0); }
    __syncthreads();
#pragma unroll
    for (int mt = 0; mt < 2; ++mt)
#pragma unroll
        for (int nt = 0; nt < 8; ++nt) *(LAS f32x4*)(Sl + (32 * w + 16 * mt + fr) * 64 + 8 * nt + 2 * fq) = acc[mt][nt];
    if (w == 7 && fr == 0) {
#pragma unroll
        for (int nt = 0; nt < 8; ++nt) *(LAS f32x4*)(smeta + 16 * nt + 4 * fq) = accm[nt]; }
    __syncthreads();
    if (w == 0) { const f32x2 lc = ((const f32x2*)(F.ws + WS_LAMC))[g * 64 + lane]; f32x2 x = *(const LAS f32x2*)(smeta + 2 * lane);
        unsigned* xp = (unsigned*)(UX + (size_t)(g * (NCH + 1) + b * 256) * UXK + 256) + lane;
#pragma unroll 8
        for (int ci = 0; ci < 256; ++ci) { xp[(size_t)ci * (UXK / 2)] = cvt_pk_bf16(x.x, x.y); const f32x2 s = Sl[ci * 64 + lane]; const float nx = lc.x * x.x - lc.y * x.y + s.x, ny = lc.x * x.y + lc.y * x.x + s.y; x.x = nx; x.y = ny; }
        VM_WAIT(); }
    __syncthreads();
}

__device__ __forceinline__ void conv_job(Frame& F, const Args& args, int jt) {
    LAS unsigned char* zs = F.lds + RING_OFF;
    LAS float* cs = (LAS float*)(F.lds + RING_OFF + 62 * 1024);
    const bf16* Z = (const bf16*)(F.ws + WS_Z); bf16* ZC = (bf16*)(F.ws + WS_ZC);
    const int tid = F.tid, row0 = 32 * jt, b = row0 / SEQ, t0 = row0 % SEQ;
    { v4u v[8];
#pragma unroll
      for (int it = 0; it < 8; ++it) { const int i = tid + 512 * it, ri = i >> 6, cb = (i & 63) * 16, ti = t0 - 30 + ri; v[it] = (v4u){0u, 0u, 0u, 0u};
          if (i < 62 * 64) { if (ti >= 0) v[it] = *(const v4u*)((const char*)Z + (size_t)(b * SEQ + ti) * 1024 + cb); else if (ti >= -NMETA) v[it] = *(const v4u*)((const char*)Z + (size_t)(M + NMETA + ti) * 1024 + cb); } }
#pragma unroll
      for (int it = 0; it < 8; ++it) { const int i = tid + 512 * it; if (i < 62 * 64) *(LAS v4u*)(zs + (i >> 6) * 1024 + (i & 63) * 16) = v[it]; } }
    const int cp = tid & 255, th = tid >> 8;
    const float* dw = args.in[I_DW]; f32x2 wgt[CWID];
#pragma unroll
    for (int k = 0; k < CWID; ++k) wgt[k] = *(const f32x2*)(dw + k * DCONV + 2 * cp);
    const f32x2 bias = *(const f32x2*)(args.in[I_DWB] + 2 * cp);
    __syncthreads();
#pragma unroll 1
    for (int hf = 0; hf < 2; ++hf) {
        f32x2 acc[8];
#pragma unroll
        for (int t = 0; t < 8; ++t) acc[t] = bias;
        const LAS unsigned char* zb = zs + (16 * th + 8 * hf) * 1024 + 4 * cp;
#pragma unroll
        for (int i = 0; i < 38; ++i) { const unsigned zz = *(const LAS unsigned*)(zb + i * 1024); const float z0 = bf2f(zz & 0xffffu), z1 = bf2f(zz >> 16);
#pragma unroll
            for (int t = 0; t < 8; ++t) { const int k = i - t; if (k >= 0 && k < CWID) { acc[t].x += wgt[k].x * z0; acc[t].y += wgt[k].y * z1; } } }
#pragma unroll
        for (int t = 0; t < 8; ++t) *(LAS f32x2*)(cs + (16 * th + 8 * hf + t) * 512 + 2 * cp) = acc[t];
    }
    __syncthreads();
    const int lane = F.lane, w = F.wave;
    const f32x4 g0 = *(const f32x4*)(args.in[I_LNG] + 4 * lane), g1 = *(const f32x4*)(args.in[I_LNG] + 256 + 4 * lane), b0 = *(const f32x4*)(args.in[I_LNB] + 4 * lane), b1 = *(const f32x4*)(args.in[I_LNB] + 256 + 4 * lane);
#pragma unroll
    for (int q = 0; q < 4; ++q) { const int t = 4 * w + q; const f32x4 x0 = *(const LAS f32x4*)(cs + t * 512 + 4 * lane), x1 = *(const LAS f32x4*)(cs + t * 512 + 256 + 4 * lane);
        const float mu = wave_sum((x0[0] + x0[1]) + (x0[2] + x0[3]) + (x1[0] + x1[1]) + (x1[2] + x1[3])) * (1.f / DCONV);
        const f32x4 d0 = x0 - mu, d1 = x1 - mu;
        const float var = wave_sum((d0[0] * d0[0] + d0[1] * d0[1]) + (d0[2] * d0[2] + d0[3] * d0[3]) + (d1[0] * d1[0] + d1[1] * d1[1]) + (d1[2] * d1[2] + d1[3] * d1[3])) * (1.f / DCONV);
        const float rstd = 1.0f / sqrtf(var + EPS); f32x4 o0 = d0 * rstd * g0 + b0, o1 = d1 * rstd * g1 + b1;
#pragma unroll
        for (int j = 0; j < 4; ++j) { o0[j] = fsilu(o0[j]); o1[j] = fsilu(o1[j]); }
        bf16* zr = ZC + (size_t)(row0 + t) * DCONV;
        *(v2u*)(zr + 4 * lane) = (v2u){cvt_pk_bf16(o0[0], o0[1]), cvt_pk_bf16(o0[2], o0[3])}; *(v2u*)(zr + 256 + 4 * lane) = (v2u){cvt_pk_bf16(o1[0], o1[1]), cvt_pk_bf16(o1[2], o1[3])}; }
    __syncthreads();
}

__global__ void __launch_bounds__(NWAVES * 64, 2) hyb_fwd(Args args) {
    extern __shared__ __attribute__((aligned(16))) unsigned char lds[];
    Frame F;
    F.lds = (LAS unsigned char*)lds; F.MISC = (volatile LAS unsigned*)(F.lds + MISC_OFF);
    F.wave = __builtin_amdgcn_readfirstlane((int)threadIdx.x >> 6); F.lane = lane_id_opaque(); F.tid = F.wave * 64 + F.lane;
    F.G = gridDim.x; { const int bx = blockIdx.x; F.vcu = (F.G % 8 == 0) ? (bx % 8) * (F.G / 8) + bx / 8 : bx; }
    F.ws = args.ws; F.out = args.out; F.ctl = (gu32*)(args.ws + WS_CTL);
    for (int u = F.tid; u < (LDS_BYTES - LDSCTL_OFF) / 4; u += NWAVES * 64) ((LAS unsigned*)(F.lds + LDSCTL_OFF))[u] = 0u;
    __syncthreads();
    const int bli = (N_LAUNCHES == PER_PHASE) ? 0 : args.li;
    XcdBarrier bar; bar.bar = (unsigned*)(F.ctl + CW_BAR) + bli * XCD_BAR_WORDS; bar.x = 0; bar.st = nullptr;
    if (N_LAUNCHES != PER_PHASE) bar = xcd_barrier_post((unsigned*)(F.ctl + CW_BAR) + bli * XCD_BAR_WORDS, F.MISC + 8);
    const int lo = args.ph_lo, hi = args.ph_hi;
#ifndef PHMASK
#define PHMASK 0x7ff
#endif
#define IN(k) (((PHMASK >> (k)) & 1) && lo <= (k) && (k) < hi)
#define SEAM(k) do { if (IN(k) && IN((k) + 1)) xcd_barrier(bar); F.lane = lane_id_opaque(); F.tid = F.wave * 64 + F.lane; } while (0)
    unsigned char* ws = F.ws;
    bf16* W13A = (bf16*)(ws + WS_W13A); bf16* W2A = (bf16*)(ws + WS_W2A); bf16* WIN = (bf16*)(ws + WS_WIN); bf16* WCAT = (bf16*)(ws + WS_WCAT); bf16* WOUT = (bf16*)(ws + WS_WOUT);
    bf16* W13B = (bf16*)(ws + WS_W13B); bf16* W2B = (bf16*)(ws + WS_W2B);
    bf16* AB = (bf16*)(ws + WS_AB); bf16* H1B = (bf16*)(ws + WS_H1); bf16* H2B = (bf16*)(ws + WS_H1 + 32 * MiB); bf16* HID = (bf16*)(ws + WS_HID);
    bf16* Zb = (bf16*)(ws + WS_Z); bf16* UXb = (bf16*)(ws + WS_UX); bf16* ZCb = (bf16*)(ws + WS_ZC); bf16* Yb = (bf16*)(ws + WS_Y); bf16* MCb = (bf16*)(ws + WS_MC);
    float* SS0 = (float*)(ws + WS_SS0); float* SS1 = SS0 + M; float* SS2 = SS1 + M; float* SS3 = SS2 + M;
    float* HIDM = (float*)(ws + WS_HIDM); float* H1M = (float*)(ws + WS_H1M); float* SSD = (float*)(ws + WS_SSD);
    bf16* Gb = (bf16*)F.out;
    const int bx = (int)blockIdx.x;
    const int gw = F.vcu * NWAVES + F.wave, NGW = F.G * NWAVES;
    const int lb = bx - F.G / 2;
    const int lgw = lb * NWAVES + F.wave, NLGW = (F.G - F.G / 2) * NWAVES;

    if (IN(0)) {
        LAS float* scr = (LAS float*)(F.lds + RING_OFF + F.wave * 16384);
        for (int it = gw; it < T_W13A; it += NGW) weight_item(args, ws, scr, it, F.lane);
        for (int m = gw; m < M; m += NGW) { const GAS f32x4* xr = (const GAS f32x4*)(args.in[I_X] + (size_t)m * D) + F.lane; f32x4 v[4]; float s = 0.f;
#pragma unroll
            for (int j = 0; j < 4; ++j) { v[j] = xr[64 * j]; s += (v[j].x * v[j].x + v[j].y * v[j].y) + (v[j].z * v[j].z + v[j].w * v[j].w); }
            s = wave_sum(s);
            GAS v2u* o8 = (GAS v2u*)(AB + (size_t)m * D) + F.lane;
#pragma unroll
            for (int j = 0; j < 4; ++j) o8[64 * j] = (v2u){pk2(v[j].x, v[j].y), pk2(v[j].z, v[j].w)};
            if (F.lane == 0) { SS0[m] = s; SS1[m] = 0.f; SS2[m] = 0.f; SS3[m] = 0.f; } }
    }
    SEAM(0);
    if (IN(1)) {
        pg8::Gemm g{D, D, D}; pg8::GridOrder S{M / 256, 2 * DFF / 256, F.G, bx, (const char*)AB, (const char*)W13A, (size_t)256 * D * 2, (size_t)256 * D * 2};
        EpiSwiglu E{HID, SS0};
        pg8::gemm_phase(F.lds + RING_OFF, F.wave, g, S, E);
        if (lb >= 0) {
            F.lane = lane_id_opaque(); F.tid = F.wave * 64 + F.lane;
            if (lb < NG) ssm_prep_job(F, args, lb);
            for (int j = lb - NG; j >= 0 && j < DFF / 16; j += F.G - F.G / 2 - NG) { float* hm = HIDM; const int c0 = 16 * j; const bf16* b0 = W13A + (size_t)glu_row(c0) * D;
                meta_job<2, true>(F, args.in[I_META], D, b0, b0 + (size_t)128 * D, [=](int r, int jj, float a, float b) { hm[r * DFF + c0 + jj] = fsilu(a) * b; }); }
            LAS float* scr = (LAS float*)(F.lds + RING_OFF + F.wave * 16384);
            for (int it = T_W13A + lgw; it < T_WIN; it += NLGW) weight_item(args, ws, scr, it, F.lane);
        }
    }
    SEAM(1);
    if (IN(2)) {
        pg8::Gemm g{DFF, DFF, DFF}; pg8::GridOrder S{M / 256, D / 256, F.G, bx, (const char*)HID, (const char*)W2A, (size_t)256 * DFF * 2, (size_t)256 * DFF * 2};
        EpiResid<true> E{AB, H1B, (args.dupk == 2) ? SSD : SS1, 0.5f};
        pg8::gemm_phase(F.lds + RING_OFF, F.wave, g, S, E);
        F.lane = lane_id_opaque(); F.tid = F.wave * 64 + F.lane;
        for (int j = bx; j < D / 16; j += F.G) { float* hm = H1M; const float* mt = args.in[I_META]; const int c0 = 16 * j;
            meta_job<1, false>(F, HIDM, DFF, W2A + (size_t)c0 * DFF, nullptr, [=](int r, int jj, float a, float) { hm[r * D + c0 + jj] = mt[r * D + c0 + jj] + 0.5f * a; }); }
    }
    SEAM(2);
    if (IN(3)) {
        pg8::Gemm g{D, D, D}; pg8::GridOrder S{M / 256, DIN / 256, F.G, bx, (const char*)H1B, (const char*)WIN, (size_t)256 * D * 2, (size_t)256 * D * 2};
        EpiMix E{SS1, Zb, UXb, Gb, args.in[I_BGATE]};
        pg8::gemm_phase(F.lds + RING_OFF, F.wave, g, S, E);
        if (lb >= 0) {
            F.lane = lane_id_opaque(); F.tid = F.wave * 64 + F.lane;
            for (int j = lb; j < 64; j += F.G - F.G / 2) {
                if (j < 32) { bf16* zz = Zb; const int c0 = 16 * j; const bf16* b0 = WIN + (size_t)glu_row(c0) * D;
                    meta_job<2, true>(F, H1M, D, b0, b0 + (size_t)128 * D, [=](int r, int jj, float a, float b) { zz[(size_t)(M + r) * DCONV + c0 + jj] = (bf16)f2bf(a * fsigmoid(b)); });
                } else { bf16* ux = UXb; const int gg = j - 32;
                    meta_job<1, true>(F, H1M, D, WIN + (size_t)(1024 + 16 * gg) * D, nullptr, [=](int r, int jj, float a, float) { ux[(size_t)(gg * (NCH + 1) + NCH) * UXK + r * 16 + jj] = (bf16)f2bf(a); }); }
            }
            LAS float* scr = (LAS float*)(F.lds + RING_OFF + F.wave * 16384);
            for (int it = T_WIN + lgw; it < T_W2B; it += NLGW) weight_item(args, ws, scr, it, F.lane);
        }
    }
    SEAM(3);
    if (IN(4)) {
        if (bx < BATCH * NG) {
            ssm_pre_job(F, bx / NG, bx % NG);
            pg8::Gemm g{UXK, UXK, UXK}; SsmOrder S{1 << 20, bx, (const char*)UXb, (const char*)(ws + WS_BS2)};
            EpiSsmY E{UXb, args.in[I_SD], Yb};
            pg8::gemm_phase(F.lds + RING_OFF, F.wave, g, S, E);
            F.lane = lane_id_opaque(); F.tid = F.wave * 64 + F.lane;
            conv_job(F, args, bx);
        } else {
            for (int j = bx; j < 512; j += F.G - BATCH * NG) conv_job(F, args, j);
        }
    }
    SEAM(4);
    if (IN(6)) {
        pg8::Gemm g{512, 512, 512}; MergeOrder S{F.G, bx, (const char*)ZCb, (const char*)Yb, (const char*)WCAT};
        EpiMerge E{Gb, MCb, AB};
        pg8::gemm_phase(F.lds + RING_OFF, F.wave, g, S, E);
    }
    SEAM(6);
    if (IN(7)) {
        pg8::Gemm g{D, D, D}; pg8::GridOrder S{M / 256, D / 256, F.G, bx, (const char*)AB, (const char*)WOUT, (size_t)256 * D * 2, (size_t)256 * D * 2};
        EpiResid<true> E{H1B, H2B, (args.dupk == 7) ? SSD : SS2, 1.0f};
        pg8::gemm_phase(F.lds + RING_OFF, F.wave, g, S, E);
    }
    SEAM(7);
    if (IN(8)) {
        pg8::Gemm g{D, D, D}; pg8::GridOrder S{M / 256, 2 * DFF / 256, F.G, bx, (const char*)H2B, (const char*)W13B, (size_t)256 * D * 2, (size_t)256 * D * 2};
        EpiSwiglu E{HID, SS2};
        pg8::gemm_phase(F.lds + RING_OFF, F.wave, g, S, E);
    }
    SEAM(8);
    if (IN(9)) {
        pg8::Gemm g{DFF, DFF, DFF}; pg8::GridOrder S{M / 256, D / 256, F.G, bx, (const char*)HID, (const char*)W2B, (size_t)256 * DFF * 2, (size_t)256 * DFF * 2};
        const bool dup9 = args.dupk == 9;
        EpiFinal E{H2B, F.out, dup9 ? SSD : SS3, (unsigned*)(F.ctl + CW_FIN) + (dup9 ? 64 * 64 : 0), args.in[I_FINN], 0.5f};
        pg8::gemm_phase(F.lds + RING_OFF, F.wave, g, S, E);
    }
#undef IN
#undef SEAM
}

extern "C" void kernel_launch(void* const* d_in, const int* in_sizes, int n_in, void* d_out, int out_size, void* d_ws, size_t ws_size, hipStream_t stream) {
    static int grid = 0;
    if (grid == 0) {
        if (n_in != 30 || in_sizes[0] != M * D || out_size != M * D || ws_size < WS_END) { fprintf(stderr, "kernel_launch: unexpected problem shape (n_in %d, in0 %d, out %d, ws %zu); nothing launched\n", n_in, n_in > 0 ? in_sizes[0] : -1, out_size, ws_size); grid = -1; return; }
        int dev = 0, cus = 0, per_cu = 0;
        if (hipGetDevice(&dev) != hipSuccess || hipDeviceGetAttribute(&cus, hipDeviceAttributeMultiprocessorCount, dev) != hipSuccess) { grid = -1; return; }
        if (hipFuncSetAttribute((const void*)hyb_fwd, hipFuncAttributeMaxDynamicSharedMemorySize, LDS_BYTES) != hipSuccess) { fprintf(stderr, "kernel_launch: hipFuncSetAttribute failed\n"); grid = -1; return; }
        if (hipOccupancyMaxActiveBlocksPerMultiprocessor(&per_cu, (const void*)hyb_fwd, NWAVES * 64, LDS_BYTES) != hipSuccess || per_cu < 1)
            fprintf(stderr, "kernel_launch: note: occupancy query reports %d workgroups per CU\n", per_cu);
        (void)hipGetLastError();
        grid = cus;
    }
    if (grid < 0) return;
    if (hipMemsetAsync((char*)d_ws + WS_CTL, 0, CTL_ZERO_BYTES, stream) != hipSuccess) { fprintf(stderr, "kernel_launch: hipMemsetAsync failed\n"); return; }
    Args a{};
    for (int i = 0; i < 30; ++i) a.in[i] = (const float*)d_in[i];
    a.out = (float*)d_out; a.ws = (unsigned char*)d_ws;
    constexpr int NL = (DUPK >= 0) ? 2 : N_LAUNCHES;
    for (int li = 0; li < NL; ++li) {
        if (DUPK >= 0) { a.ph_lo = li == 0 ? 0 : DUPK; a.ph_hi = li == 0 ? DUPK + 1 : PER_PHASE; a.dupk = li == 0 ? DUPK : -1; }
        else { a.ph_lo = (N_LAUNCHES == PER_PHASE) ? li : 0; a.ph_hi = (N_LAUNCHES == PER_PHASE) ? li + 1 : PER_PHASE; a.dupk = -1; }
        a.li = li;
        hipLaunchKernelGGL(hyb_fwd, dim3(grid), dim3(NWAVES * 64), LDS_BYTES, stream, a);
        const hipError_t le = hipPeekAtLastError();
        if (le != hipSuccess) { fprintf(stderr, "kernel_launch: launch %d failed: %s\n", li, hipGetErrorName(le)); break; }
    }
}
```

```cpp
#include <hip/hip_runtime.h>
#include <cstdio>
#include <cstdint>

#ifndef MK_N_LAUNCHES
#define MK_N_LAUNCHES 1
#endif

__device__ __forceinline__ int lane_id_opaque() { int l; asm volatile("v_mbcnt_lo_u32_b32 %0, -1, 0\n\tv_mbcnt_hi_u32_b32 %0, -1, %0" : "=v"(l)); return l; }
namespace pg8 {
#define PG8_LAS __attribute__((address_space(3)))
typedef unsigned short bf16_t;
typedef short bf16x8 __attribute__((ext_vector_type(8)));
typedef float f32x4 __attribute__((ext_vector_type(4)));
typedef unsigned u32x4 __attribute__((ext_vector_type(4)));
constexpr int BM = 256, BK = 64, HALF = 128, HTB = HALF * BK * 2, STAGE_BYTES = 8 * HTB, NXCD = 8, WGM = 8;

__host__ __device__ __forceinline__ int lds_byte(int r, int c) { const int st = (r >> 4) * 2 + (c >> 5), rr = r & 15, cc = c & 31, ob = rr * 64 + cc * 2; return st * 1024 + (ob ^ (((ob >> 9) & 1) << 5)); }
__host__ __device__ __forceinline__ void stage_rc(int b, int& R, int& C) { const int st = b / 1024, sb = b % 1024, swz = sb ^ (((sb >> 9) & 1) << 5); R = (st >> 1) * 16 + swz / 64; C = (st & 1) * 32 + (swz % 64) / 2; }
__host__ __device__ __forceinline__ int perm32(int rho) { const int n = rho >> 4, i = rho & 15; return 8 * (i >> 2) + 4 * n + (i & 3); }

struct Unit { int pm, pn, kind; const char* A; const char* B; };
struct Gemm { int lda, ldb, K; };

__device__ __forceinline__ bool static_tile(int i, int G, int c, int nM, int nN, int& pm, int& pn) {
    const int nwg = nM * nN; const long L = (long)i * G + c; if (L >= nwg) return false;
    int wgid = (int)L; { const int q = nwg / NXCD, r = nwg % NXCD, xcd = wgid % NXCD, off = wgid / NXCD; wgid = (xcd < r ? xcd * (q + 1) : r * (q + 1) + (xcd - r) * q) + off; }
    const int nig = WGM * nN, gid = wgid / nig, fm = gid * WGM, gsz = (nM - fm) < WGM ? (nM - fm) : WGM;
    pm = fm + ((wgid % nig) % gsz); pn = (wgid % nig) / gsz; return true;
}
struct GridOrder {
    int nM, nN, G, c; const char* A; const char* B; size_t tA, tB;
    __device__ __forceinline__ bool next(int i, Unit& u) const { int pm, pn; if (!static_tile(i, G, c, nM, nN, pm, pn)) return false; u.pm = pm; u.pn = pn; u.kind = 0; u.A = A + (size_t)pm * tA; u.B = B + (size_t)pn * tB; return true; }
    __device__ __forceinline__ void a_ready(const Unit&) const {}
    __device__ __forceinline__ void done(const Unit&) const {}
};

__device__ __forceinline__ unsigned cvt_pk_bf16(float lo, float hi) { unsigned r; asm volatile("v_cvt_pk_bf16_f32 %0, %1, %2" : "=v"(r) : "v"(lo), "v"(hi)); return r; }

template <class Epi, class Sched>
__device__ __forceinline__ void gemm_phase(PG8_LAS unsigned char* lds, const int wid  , const Gemm g, const Sched& S, const Epi& E) {
    const int lane = lane_id_opaque(), tid = wid * 64 + lane, wr = wid >> 2, wc = wid & 3, fr = lane & 15, fq = lane >> 4;
    const int K = g.K, nt = K / BK;
    unsigned voffA[2], voffB[2];
#pragma unroll
    for (int i = 0; i < 2; ++i) { int R, C; stage_rc(tid * 16 + i * 8192, R, C); const int Rb = (R & ~31) + perm32(R & 31);
        voffA[i] = (unsigned)(R * g.lda + C) * 2u; voffB[i] = (unsigned)(Rb * g.ldb + C) * 2u; }
    const size_t kstep = (size_t)(BK * 2);
    const size_t hstepA = (size_t)HALF * g.lda * 2, hstepB = (size_t)HALF * g.ldb * 2;
    const unsigned ldsw = (unsigned)wid * 1024u;
    const int aoff = lds_byte(wr * 64 + fr, fq * 8), boff = lds_byte(wc * 32 + fr, fq * 8);
#define PG8_SA(b, h) (((b) * 2 + (h)) * HTB)
#define PG8_SB(b, h) ((4 + (b) * 2 + (h)) * HTB)
#define PG8_STAGE(bufoff, gbase, voff) do { _Pragma("unroll") for (int _i = 0; _i < 2; ++_i) \
        __builtin_amdgcn_global_load_lds((const unsigned*)((const char*)(gbase) + (voff)[_i]), (PG8_LAS unsigned*)(lds + (bufoff) + ldsw + _i * 8192), 16, 0, 0); } while (0)
#define PG8_LDA(dst, b, h) do { _Pragma("unroll") for (int m = 0; m < 4; ++m) _Pragma("unroll") for (int k = 0; k < 2; ++k) dst[m][k] = *(const PG8_LAS bf16x8*)(lds + PG8_SA(b, h) + aoff + m * 2048 + k * 1024); } while (0)
#define PG8_LDB(dst, b, h) do { _Pragma("unroll") for (int n = 0; n < 2; ++n) _Pragma("unroll") for (int k = 0; k < 2; ++k) dst[n][k] = *(const PG8_LAS bf16x8*)(lds + PG8_SB(b, h) + boff + n * 2048 + k * 1024); } while (0)
#define PG8_MMA(ai, bj, At, Bt) do { __builtin_amdgcn_s_setprio(1); _Pragma("unroll") for (int m = 0; m < 4; ++m) _Pragma("unroll") for (int n = 0; n < 2; ++n) _Pragma("unroll") for (int k = 0; k < 2; ++k) \
        acc[ai][bj][m][n] = __builtin_amdgcn_mfma_f32_16x16x32_bf16(Bt[n][k], At[m][k], acc[ai][bj][m][n], 0, 0, 0); __builtin_amdgcn_s_setprio(0); } while (0)
#define PG8_WAIT_V(n) asm volatile("s_waitcnt vmcnt(" #n ")" ::: "memory")
#define PG8_WAIT_L(n) asm volatile("s_waitcnt lgkmcnt(" #n ")" ::: "memory")
#define PG8_BAR __builtin_amdgcn_s_barrier()
#define PG8_SCHED __builtin_amdgcn_sched_barrier(0)
    Unit cur, nxt; int ui = 0;
    if (!S.next(0, cur)) return;
    f32x4 acc[2][2][4][2];
#pragma unroll
    for (int a = 0; a < 2; ++a)
#pragma unroll
        for (int b = 0; b < 2; ++b)
#pragma unroll
            for (int m = 0; m < 4; ++m)
#pragma unroll
                for (int n = 0; n < 2; ++n) acc[a][b][m][n] = (f32x4){0.f, 0.f, 0.f, 0.f};
    bf16x8 At[4][2], B0[2][2], B1[2][2];
    const char* cA = cur.A; const char* cB = cur.B;
    S.a_ready(cur);
    PG8_STAGE(PG8_SB(0, 0), cB, voffB); PG8_STAGE(PG8_SB(0, 1), cB + hstepB, voffB); PG8_STAGE(PG8_SA(0, 0), cA, voffA); PG8_STAGE(PG8_SA(0, 1), cA + hstepA, voffA);
    if (wr == 1) PG8_BAR;
    PG8_WAIT_V(2); PG8_BAR;
    PG8_STAGE(PG8_SB(1, 0), cB + kstep, voffB); PG8_STAGE(PG8_SA(1, 0), cA + kstep, voffA); PG8_STAGE(PG8_SB(1, 1), cB + hstepB + kstep, voffB);
    PG8_WAIT_V(6); PG8_BAR;
    for (;;) {
        const bool has_next = S.next(ui + 1, nxt);
        const char* nA = has_next ? nxt.A : cA; const char* nB = has_next ? nxt.B : cB;
        for (int t = 0; t < nt; t += 2) {
            const bool last = (t == nt - 2);
            const char* a1 = cA + (size_t)(t + 1) * kstep;
            const char* a2 = last ? nA : cA + (size_t)(t + 2) * kstep; const char* b2 = last ? nB : cB + (size_t)(t + 2) * kstep;
            const char* a3 = a2 + kstep; const char* b3 = b2 + kstep;
            if (last && has_next) S.a_ready(nxt);
            PG8_LDB(B0, 0, 0); PG8_LDB(B1, 0, 1); PG8_SCHED; PG8_LDA(At, 0, 0); PG8_STAGE(PG8_SA(1, 1), a1 + hstepA, voffA);
            PG8_WAIT_V(8); PG8_WAIT_L(0); PG8_BAR; PG8_MMA(0, 0, At, B0); PG8_MMA(0, 1, At, B1); PG8_BAR; PG8_SCHED;
            PG8_LDA(At, 0, 1); PG8_STAGE(PG8_SB(0, 0), b2, voffB); PG8_STAGE(PG8_SB(0, 1), b2 + hstepB, voffB); PG8_STAGE(PG8_SA(0, 0), a2, voffA);
            PG8_WAIT_V(8); PG8_WAIT_L(0); PG8_BAR; PG8_MMA(1, 0, At, B0); PG8_MMA(1, 1, At, B1); PG8_BAR; PG8_SCHED;
            PG8_LDB(B0, 1, 0); PG8_LDB(B1, 1, 1); PG8_SCHED; PG8_LDA(At, 1, 0); PG8_STAGE(PG8_SA(0, 1), a2 + hstepA, voffA);
            PG8_WAIT_V(8); PG8_WAIT_L(0); PG8_BAR; PG8_MMA(0, 0, At, B0); PG8_MMA(0, 1, At, B1); PG8_BAR; PG8_SCHED;
            PG8_LDA(At, 1, 1); PG8_STAGE(PG8_SB(1, 0), b3, voffB); PG8_STAGE(PG8_SB(1, 1), b3 + hstepB, voffB); PG8_STAGE(PG8_SA(1, 0), a3, voffA);
            PG8_WAIT_V(8); PG8_WAIT_L(0); PG8_BAR; PG8_MMA(1, 0, At, B0); PG8_MMA(1, 1, At, B1); PG8_BAR; PG8_SCHED;
        }
        if (wr == 0) PG8_BAR;
        E(acc, cur, wr, wc); S.done(cur);
        if (!has_next) break;
#pragma unroll
        for (int a = 0; a < 2; ++a)
#pragma unroll
            for (int b = 0; b < 2; ++b)
#pragma unroll
                for (int m = 0; m < 4; ++m)
#pragma unroll
                    for (int n = 0; n < 2; ++n) acc[a][b][m][n] = (f32x4){0.f, 0.f, 0.f, 0.f};
        cur = nxt; cA = nA; cB = nB; ++ui;
        if (wr == 1) PG8_BAR;
    }
    PG8_WAIT_V(0);
    PG8_BAR;
#undef PG8_SA
#undef PG8_SB
#undef PG8_STAGE
#undef PG8_LDA
#undef PG8_LDB
#undef PG8_MMA
#undef PG8_WAIT_V
#undef PG8_WAIT_L
#undef PG8_BAR
#undef PG8_SCHED
}
}

constexpr int NWAVES = 8;
constexpr int D = 1024, BATCH = 4, SEQ = 4096, NMETA = 16, DFF = 2816, DCONV = 512, CWID = 31, DSSM = 512, HG = 16, NG = 32, PS = 64;
constexpr int DIN = 2 * DCONV + DSSM + 2 * D;
constexpr int M = BATCH * SEQ;
constexpr int NCH = M / 16;
constexpr int UXK = 384;
constexpr float EPS = 1e-6f;
constexpr int PER_PHASE = 10;
constexpr int N_LAUNCHES = MK_N_LAUNCHES;

constexpr size_t MiB = 1u << 20;
constexpr size_t WS_CTL = 0, CTL_ZERO_BYTES = 1 * MiB;
constexpr size_t WS_BS2 = 1 * MiB;
constexpr size_t WS_WSI = 7 * MiB;
constexpr size_t WS_SMALL = 9 * MiB;
constexpr size_t WS_LAMC = WS_SMALL;
constexpr size_t WS_SMETA = WS_SMALL + 16384;
constexpr size_t WS_SS0 = WS_SMALL + 32768;
constexpr size_t WS_HIDM = WS_SMALL + 32768 + 4 * 65536;
constexpr size_t WS_H1M = WS_HIDM + 16 * DFF * 4;
constexpr size_t WS_W13A = 11 * MiB, WS_W2A = 22 * MiB, WS_WIN = 28 * MiB, WS_WCAT = 35 * MiB, WS_WOUT = 38 * MiB, WS_W13B = 40 * MiB, WS_W2B = 51 * MiB;
constexpr size_t WS_AB = 57 * MiB;
constexpr size_t WS_H1 = 89 * MiB;
constexpr size_t WS_HID = 153 * MiB;
constexpr size_t WS_Z = WS_HID;
constexpr size_t WS_UX = WS_HID + 17 * MiB;
constexpr size_t WS_ZC = WS_HID + 42 * MiB;
constexpr size_t WS_Y = WS_HID + 58 * MiB;
constexpr size_t WS_MC = WS_HID;
constexpr size_t WS_S = WS_HID + 74 * MiB;
constexpr size_t WS_END = 256 * MiB;
static_assert(WS_H1M + 16 * D * 4 <= WS_W13A, "small tables");
static_assert(WS_W2B + (size_t)D * DFF * 2 <= WS_AB && WS_AB + (size_t)M * D * 2 <= WS_H1 && WS_H1 + (size_t)M * D * 4 <= WS_HID, "ws map 1");
static_assert(WS_Z + (size_t)(M + 16) * DCONV * 2 <= WS_UX && WS_UX + (size_t)NG * (NCH + 1) * UXK * 2 <= WS_ZC && WS_ZC + (size_t)M * DCONV * 2 <= WS_Y && WS_Y + (size_t)M * DSSM * 2 <= WS_S, "ws map 2");
static_assert(WS_MC + (size_t)M * D * 2 <= WS_ZC, "MC overlay");
static_assert(WS_HID + (size_t)M * DFF * 2 <= WS_END && WS_S + (size_t)NCH * NG * 128 * 4 <= WS_END, "ws end");
static_assert(WS_W13A + (size_t)2 * DFF * D * 2 <= WS_W2A && WS_W2A + (size_t)D * DFF * 2 <= WS_WIN && WS_WIN + (size_t)DIN * D * 2 <= WS_WCAT && WS_WCAT + (size_t)3072 * 512 * 2 <= WS_WOUT && WS_WOUT + (size_t)D * D * 2 <= WS_W13B && WS_W13B + (size_t)2 * DFF * D * 2 <= WS_W2B, "weights");
static_assert(WS_BS2 + (size_t)NG * 256 * UXK * 2 <= WS_WSI && WS_WSI + (size_t)NG * 128 * 256 * 2 <= WS_SMALL, "ssm mats");
constexpr int CW_BAR = 4096;
constexpr int CW_FIN = 16384;

constexpr int RING_OFF = 0, RING_BYTES = 131072;
constexpr int LDSCTL_OFF = RING_BYTES, MISC_OFF = LDSCTL_OFF + 320;
constexpr int LDS_BYTES = 147456;

#define GAS __attribute__((address_space(1)))
#define LAS __attribute__((address_space(3)))
typedef unsigned short bf16;
typedef unsigned v4u __attribute__((ext_vector_type(4)));
typedef unsigned v2u __attribute__((ext_vector_type(2)));
typedef float f32x4 __attribute__((ext_vector_type(4)));
typedef float f32x2 __attribute__((ext_vector_type(2)));
typedef short bf16x8 __attribute__((ext_vector_type(8)));
typedef GAS unsigned gu32;
#define RLX_AGENT __ATOMIC_RELAXED, __HIP_MEMORY_SCOPE_AGENT
#define LDS_WAIT() asm volatile("s_waitcnt lgkmcnt(0)" ::: "memory")
#define VM_WAIT() asm volatile("s_waitcnt vmcnt(0)" ::: "memory")
__device__ __forceinline__ unsigned f2bf(float f) { unsigned u = __builtin_bit_cast(unsigned, f); return (u + 0x7fffu + ((u >> 16) & 1u)) >> 16; }
__device__ __forceinline__ unsigned pk2(float lo, float hi) { return f2bf(lo) | (f2bf(hi) << 16); }
__device__ __forceinline__ float bf2f(unsigned h) { return __builtin_bit_cast(float, h << 16); }
__device__ __forceinline__ float fsigmoid(float x) { return __builtin_amdgcn_rcpf(1.f + __builtin_amdgcn_exp2f(-1.44269504089f * x)); }
__device__ __forceinline__ float fsilu(float x) { return x * fsigmoid(x); }
__device__ __forceinline__ float fgelu_tanh(float x) { return x * fsigmoid(1.5957691216f * (x + 0.044715f * x * x * x)); }
__device__ __forceinline__ float wave_sum(float v) {
#pragma unroll
    for (int o = 1; o < 64; o <<= 1) v += __shfl_xor(v, o);
    return v;
}

#define XB_TMO      128
#define XB_XCNT(j)  (256  + 64 * (j))
#define XB_XSUB(j)  (1280 + 64 * (j))
#define XB_XGEN(j)  (2304 + 64 * (j))
#define XB_TOP      3328
#define XB_TOPGEN   3392
#define XCD_BAR_WORDS 3456
#define XB_SPIN_CAP (1u << 18)
__device__ __forceinline__ unsigned xb_ld(unsigned* p)              { return __hip_atomic_load(p, __ATOMIC_RELAXED, __HIP_MEMORY_SCOPE_AGENT); }
__device__ __forceinline__ unsigned xb_add(unsigned* p, unsigned v) { return __hip_atomic_fetch_add(p, v, __ATOMIC_RELAXED, __HIP_MEMORY_SCOPE_AGENT); }
__device__ __forceinline__ unsigned xb_xcc_id() { return (unsigned)__builtin_amdgcn_s_getreg((3 << 11) | 20) & 0xFu; }
#define XB_SPIN(cond, bar) do { unsigned _sp = 0; while (cond) { __builtin_amdgcn_s_sleep(1); \
    if ((++_sp & 255u) == 0u) { if (xb_ld(&(bar)[XB_TMO])) break; if (_sp > XB_SPIN_CAP) { atomicAdd(&(bar)[XB_TMO], 1u); break; } } } } while (0)
struct XcdBarrier { unsigned* bar; unsigned x; volatile LAS unsigned* st; };
__device__ __forceinline__ XcdBarrier xcd_barrier_post(unsigned* bar, volatile LAS unsigned* st) {
    XcdBarrier b; b.bar = bar; b.x = xb_xcc_id(); b.st = st;
    if (threadIdx.x == 0) (void)xb_add(&bar[XB_XCNT(b.x)], 1u);
    return b;
}
__device__ __forceinline__ void xcd_barrier_complete(unsigned* bar, unsigned x, unsigned& nloc, unsigned& nx) {
    const unsigned G = gridDim.x * gridDim.y * gridDim.z;
    unsigned sum, cnt, mine, sp = 0u;
    for (;;) {
        sum = 0u; cnt = 0u; mine = 0u;
#pragma unroll
        for (unsigned j = 0; j < 16; ++j) { const unsigned c = xb_ld(&bar[XB_XCNT(j)]); sum += c; cnt += (c > 0u) ? 1u : 0u; mine = (j == x) ? c : mine; }
        if (sum == G) break;
        __builtin_amdgcn_s_sleep(1);
        if ((++sp & 255u) == 0u) { if (xb_ld(&bar[XB_TMO])) break; if (sp > XB_SPIN_CAP) { atomicAdd(&bar[XB_TMO], 1u); break; } }
    }
    nloc = mine > 0u ? mine : 1u; nx = cnt > 0u ? cnt : 1u;
}
__device__ __forceinline__ void xcd_barrier(const XcdBarrier& b) {
    asm volatile("s_waitcnt vmcnt(0)" ::: "memory");
    __syncthreads();
    if (threadIdx.x == 0) {
        unsigned* bar = b.bar;
        __builtin_amdgcn_s_waitcnt(0);
        unsigned nloc = b.st[0], nx = b.st[1];
        if (nloc == 0u) { xcd_barrier_complete(bar, b.x, nloc, nx); b.st[0] = nloc; b.st[1] = nx; }
        const unsigned old = xb_add(&bar[XB_XSUB(b.x)], 1u);
        const unsigned gen = old / nloc;
        if (old + 1u == (gen + 1u) * nloc) {
            __builtin_amdgcn_fence(__ATOMIC_RELEASE, "agent");
            asm volatile("s_waitcnt vmcnt(0)" ::: "memory");
            const unsigned og = xb_add(&bar[XB_TOP], 1u);
            const unsigned tg = og / nx;
            if (og + 1u == (tg + 1u) * nx) xb_add(&bar[XB_TOPGEN], 1u);
            else XB_SPIN(xb_ld(&bar[XB_TOPGEN]) == tg, bar);
            __builtin_amdgcn_fence(__ATOMIC_ACQUIRE, "agent");
            xb_add(&bar[XB_XGEN(b.x)], 1u);
            asm volatile("s_waitcnt vmcnt(0)" ::: "memory");
        } else {
            XB_SPIN(xb_ld(&bar[XB_XGEN(b.x)]) == gen, bar);
            __builtin_amdgcn_fence(__ATOMIC_ACQUIRE, "agent");
            asm volatile("s_waitcnt vmcnt(0)" ::: "memory");
        }
    }
    __syncthreads();
}

struct Args { const float* in[30]; float* out; unsigned char* ws; int ph_lo, ph_hi, li, pad; };
struct Frame {
    LAS unsigned char* lds; volatile LAS unsigned* MISC; gu32* ctl;
    int tid, lane, wave, vcu, G;
    float* out; unsigned char* ws;
};
enum { I_X = 0, I_META, I_F1N, I_F1W1, I_F1W3, I_F1W2, I_MIXN, I_WIN, I_BGATE, I_DW, I_DWB, I_LNG, I_LNB, I_CPROJ, I_LRE, I_LIM, I_LDT, I_BRE, I_BIM, I_CRE, I_CIM, I_SD, I_WV, I_WG, I_WOUT, I_F2N, I_F2W1, I_F2W3, I_F2W2, I_FINN };

constexpr int CW_TKT = 32768;
__device__ __forceinline__ int wg_ticket(Frame& F, int k) {
    __syncthreads();
    if (F.tid == 0) F.MISC[16] = __hip_atomic_fetch_add((unsigned*)(F.ctl + CW_TKT + 64 * k), 1u, __ATOMIC_RELAXED, __HIP_MEMORY_SCOPE_AGENT);
    __syncthreads();
    return (int)F.MISC[16];
}
using pg8::Unit; using pg8::cvt_pk_bf16;
__device__ __forceinline__ v4u pack8(const f32x4 a, const f32x4 b) { v4u w; w.x = cvt_pk_bf16(a[0], a[1]); w.y = cvt_pk_bf16(a[2], a[3]); w.z = cvt_pk_bf16(b[0], b[1]); w.w = cvt_pk_bf16(b[2], b[3]); return w; }
__device__ __forceinline__ void unpack8(const v4u w, float (&o)[8]) { o[0] = bf2f(w.x & 0xffffu); o[1] = bf2f(w.x >> 16); o[2] = bf2f(w.y & 0xffffu); o[3] = bf2f(w.y >> 16); o[4] = bf2f(w.z & 0xffffu); o[5] = bf2f(w.z >> 16); o[6] = bf2f(w.w & 0xffffu); o[7] = bf2f(w.w >> 16); }
__device__ __forceinline__ float rs_from(float ss) { return __builtin_amdgcn_rsqf(ss * (1.0f / D) + EPS); }
__device__ __forceinline__ void load_rs8(const float* SS, int row0, float (&rs)[8]) {
#pragma unroll
    for (int i = 0; i < 8; ++i) rs[i] = SS[row0 + (i >> 2) * 128 + (i & 3) * 16];
#pragma unroll
    for (int i = 0; i < 8; ++i) rs[i] = rs_from(rs[i]);
}

struct EpiSwiglu {
    bf16* HID; const float* SS;
    __device__ __forceinline__ void operator()(const f32x4 (&acc)[2][2][4][2], const Unit& u, int wr, int wc) const {
        const int lane_ = lane_id_opaque(), fr = lane_ & 15, fq = lane_ >> 4;
        const int row0 = u.pm * 256 + wr * 64 + fr, col0 = u.pn * 128 + wc * 32 + 8 * fq;
        float rsv[8]; load_rs8(SS, row0, rsv);
#pragma unroll
        for (int ai = 0; ai < 2; ++ai)
#pragma unroll
            for (int m = 0; m < 4; ++m) { const int row = row0 + ai * 128 + m * 16; const float rs = rsv[ai * 4 + m];
                f32x4 o0, o1;
#pragma unroll
                for (int j = 0; j < 4; ++j) { o0[j] = fsilu(acc[ai][0][m][0][j] * rs) * (acc[ai][1][m][0][j] * rs); o1[j] = fsilu(acc[ai][0][m][1][j] * rs) * (acc[ai][1][m][1][j] * rs); }
                *(v4u*)(HID + (size_t)row * DFF + col0) = pack8(o0, o1); }
    }
};
template <bool RBF16> struct EpiResid {
    const void* R; bf16* OB; float* SS; float alpha;
    __device__ __forceinline__ void operator()(const f32x4 (&acc)[2][2][4][2], const Unit& u, int wr, int wc) const {
        const int lane_ = lane_id_opaque(), fr = lane_ & 15, fq = lane_ >> 4;
        const int row0 = u.pm * 256 + wr * 64 + fr, col0 = u.pn * 256 + wc * 32 + 8 * fq;
#pragma unroll
        for (int ai = 0; ai < 2; ++ai) {
            f32x4 r[4][2][2];
#pragma unroll
            for (int m = 0; m < 4; ++m)
#pragma unroll
                for (int bj = 0; bj < 2; ++bj) { const size_t off = (size_t)(row0 + ai * 128 + m * 16) * D + col0 + bj * 128;
                    if (RBF16) { const v4u w = *(const v4u*)((const bf16*)R + off); r[m][bj][0] = __builtin_bit_cast(f32x4, w); }
                    else { r[m][bj][0] = *(const f32x4*)((const float*)R + off); r[m][bj][1] = *(const f32x4*)((const float*)R + off + 4); } }
#pragma unroll
            for (int m = 0; m < 4; ++m) { const int row = row0 + ai * 128 + m * 16; float ss = 0.f;
#pragma unroll
                for (int bj = 0; bj < 2; ++bj) { const size_t off = (size_t)row * D + col0 + bj * 128; f32x4 r0, r1;
                    if (RBF16) { float t[8]; unpack8(__builtin_bit_cast(v4u, r[m][bj][0]), t); r0 = (f32x4){t[0], t[1], t[2], t[3]}; r1 = (f32x4){t[4], t[5], t[6], t[7]}; }
                    else { r0 = r[m][bj][0]; r1 = r[m][bj][1]; }
                    const f32x4 o0 = r0 + acc[ai][bj][m][0] * alpha, o1 = r1 + acc[ai][bj][m][1] * alpha;
                    *(v4u*)(OB + off) = pack8(o0, o1);
                    ss += (o0[0] * o0[0] + o0[1] * o0[1]) + (o0[2] * o0[2] + o0[3] * o0[3]) + (o1[0] * o1[0] + o1[1] * o1[1]) + (o1[2] * o1[2] + o1[3] * o1[3]); }
                ss += __shfl_xor(ss, 16); ss += __shfl_xor(ss, 32);
                if (fq == 0) atomicAdd(SS + row, ss); }
            asm volatile("" ::: "memory"); }
    }
};
struct EpiFinal {
    const bf16* R; float* OUT; float* SS; unsigned* cnt; const float* gain; float alpha;
    __device__ __forceinline__ void operator()(f32x4 (&acc)[2][2][4][2], const Unit& u, int wr, int wc) const {
        const int lane_ = lane_id_opaque(), fr = lane_ & 15, fq = lane_ >> 4;
        const int row0 = u.pm * 256 + wr * 64 + fr, col0 = u.pn * 256 + wc * 32 + 8 * fq;
#pragma unroll
        for (int ai = 0; ai < 2; ++ai) {
            v4u r[4][2];
#pragma unroll
            for (int m = 0; m < 4; ++m)
#pragma unroll
                for (int bj = 0; bj < 2; ++bj) r[m][bj] = *(const v4u*)(R + (size_t)(row0 + ai * 128 + m * 16) * D + col0 + bj * 128);
#pragma unroll
            for (int m = 0; m < 4; ++m) { const int row = row0 + ai * 128 + m * 16; float ss = 0.f;
#pragma unroll
                for (int bj = 0; bj < 2; ++bj) { float t[8]; unpack8(r[m][bj], t);
                    const f32x4 o0 = (f32x4){t[0], t[1], t[2], t[3]} + acc[ai][bj][m][0] * alpha, o1 = (f32x4){t[4], t[5], t[6], t[7]} + acc[ai][bj][m][1] * alpha;
                    acc[ai][bj][m][0] = o0; acc[ai][bj][m][1] = o1;
                    ss += (o0[0] * o0[0] + o0[1] * o0[1]) + (o0[2] * o0[2] + o0[3] * o0[3]) + (o1[0] * o1[0] + o1[1] * o1[1]) + (o1[2] * o1[2] + o1[3] * o1[3]); }
                ss += __shfl_xor(ss, 16); ss += __shfl_xor(ss, 32);
                if (fq == 0) atomicAdd(SS + row, ss); }
            asm volatile("" ::: "memory"); }
        asm volatile("s_waitcnt vmcnt(0)" ::: "memory");
        unsigned* cw = cnt + 64 * u.pm;
        if (lane_ == 0) __hip_atomic_fetch_add(cw, 1u, __ATOMIC_RELAXED, __HIP_MEMORY_SCOPE_AGENT);
        f32x4 g[2][2];
#pragma unroll
        for (int bj = 0; bj < 2; ++bj) { g[bj][0] = *(const f32x4*)(gain + col0 + bj * 128); g[bj][1] = *(const f32x4*)(gain + col0 + bj * 128 + 4); }
        { unsigned sp = 0; while ((unsigned)__builtin_amdgcn_readfirstlane((int)__hip_atomic_load(cw, __ATOMIC_RELAXED, __HIP_MEMORY_SCOPE_AGENT)) < 32u) { __builtin_amdgcn_s_sleep(2); if (++sp > (1u << 20)) break; } }
        float tot[8];
#pragma unroll
        for (int i = 0; i < 8; ++i) { tot[i] = 0.f; if (fq == 0) tot[i] = __hip_atomic_fetch_add(SS + row0 + (i >> 2) * 128 + (i & 3) * 16, 0.0f, __ATOMIC_RELAXED, __HIP_MEMORY_SCOPE_AGENT); }
#pragma unroll
        for (int ai = 0; ai < 2; ++ai)
#pragma unroll
            for (int m = 0; m < 4; ++m) { const int row = row0 + ai * 128 + m * 16;
                const float rs = rs_from(__shfl(tot[ai * 4 + m], fr));
#pragma unroll
                for (int bj = 0; bj < 2; ++bj) { const size_t off = (size_t)row * D + col0 + bj * 128;
                    *(f32x4*)(OUT + off) = acc[ai][bj][m][0] * rs * g[bj][0]; *(f32x4*)(OUT + off + 4) = acc[ai][bj][m][1] * rs * g[bj][1]; } }
    }
};
struct EpiMix {
    const float* SS; bf16* Z; bf16* UX; bf16* G; const float* bgate;
    __device__ __forceinline__ void operator()(const f32x4 (&acc)[2][2][4][2], const Unit& u, int wr, int wc) const {
        const int lane_ = lane_id_opaque(), fr = lane_ & 15, fq = lane_ >> 4;
        const int row0 = u.pm * 256 + wr * 64 + fr;
        if (u.pn < 4) {
            const int col0 = u.pn * 128 + wc * 32 + 8 * fq;
#pragma unroll
            for (int ai = 0; ai < 2; ++ai)
#pragma unroll
                for (int m = 0; m < 4; ++m) { const int row = row0 + ai * 128 + m * 16; const float rs = rs_from(SS[row]); f32x4 o0, o1;
#pragma unroll
                    for (int j = 0; j < 4; ++j) { o0[j] = (acc[ai][0][m][0][j] * rs) * fsigmoid(acc[ai][1][m][0][j] * rs); o1[j] = (acc[ai][0][m][1][j] * rs) * fsigmoid(acc[ai][1][m][1][j] * rs); }
                    *(v4u*)(Z + (size_t)row * DCONV + col0) = pack8(o0, o1); }
        } else if (u.pn < 6) {
#pragma unroll
            for (int ai = 0; ai < 2; ++ai)
#pragma unroll
                for (int m = 0; m < 4; ++m) { const int row = row0 + ai * 128 + m * 16; const float rs = rs_from(SS[row]); const int ci = row >> 4, tt = row & 15;
#pragma unroll
                    for (int bj = 0; bj < 2; ++bj) { const int c = (u.pn - 4) * 256 + bj * 128 + wc * 32 + 8 * fq, g = c >> 4, h0 = c & 15;
                        *(v4u*)(UX + ((size_t)(g * (NCH + 1) + ci) * UXK + tt * 16 + h0)) = pack8(acc[ai][bj][m][0] * rs, acc[ai][bj][m][1] * rs); } }
        } else {
#pragma unroll
            for (int bj = 0; bj < 2; ++bj) { const int c = (u.pn - 6) * 256 + bj * 128 + wc * 32 + 8 * fq;
                const f32x4 b0 = *(const f32x4*)(bgate + c), b1 = *(const f32x4*)(bgate + c + 4);
#pragma unroll
                for (int ai = 0; ai < 2; ++ai)
#pragma unroll
                    for (int m = 0; m < 4; ++m) { const int row = row0 + ai * 128 + m * 16; const float rs = rs_from(SS[row]); f32x4 o0, o1;
#pragma unroll
                        for (int j = 0; j < 4; ++j) { o0[j] = fsigmoid(acc[ai][bj][m][0][j] * rs + b0[j]); o1[j] = fsigmoid(acc[ai][bj][m][1][j] * rs + b1[j]); }
                        *(v4u*)(G + (size_t)row * 2048 + c) = pack8(o0, o1); } }
        }
    }
};
struct EpiSsmY {
    const bf16* UX; const float* dskip; bf16* Y;
    __device__ __forceinline__ void operator()(const f32x4 (&acc)[2][2][4][2], const Unit& u, int wr, int wc) const {
        const int lane_ = lane_id_opaque(), fr = lane_ & 15, fq = lane_ >> 4;
        const int b = u.pm, g = u.pn, h0 = 8 * (fq & 1);
        const f32x4 d0 = *(const f32x4*)(dskip + g * 16 + h0), d1 = *(const f32x4*)(dskip + g * 16 + h0 + 4);
#pragma unroll
        for (int ai = 0; ai < 2; ++ai) {
            v4u uw[4][2];
#pragma unroll
            for (int m = 0; m < 4; ++m)
#pragma unroll
                for (int bj = 0; bj < 2; ++bj) { const int r = ai * 128 + wr * 64 + m * 16 + fr, tt = 8 * bj + 2 * wc + (fq >> 1);
                    uw[m][bj] = *(const v4u*)(UX + ((size_t)(g * (NCH + 1) + b * 256 + r) * UXK + tt * 16 + h0)); }
#pragma unroll
            for (int m = 0; m < 4; ++m) { const int r = ai * 128 + wr * 64 + m * 16 + fr;
#pragma unroll
                for (int bj = 0; bj < 2; ++bj) { const int tt = 8 * bj + 2 * wc + (fq >> 1);
                    float uu[8]; unpack8(uw[m][bj], uu);
                    f32x4 o0, o1;
#pragma unroll
                    for (int j = 0; j < 4; ++j) { o0[j] = fgelu_tanh(acc[ai][bj][m][0][j] + d0[j] * uu[j]); o1[j] = fgelu_tanh(acc[ai][bj][m][1][j] + d1[j] * uu[4 + j]); }
                    *(v4u*)(Y + ((size_t)(b * SEQ + r * 16 + tt) * DSSM + g * 16 + h0)) = pack8(o0, o1); } }
            asm volatile("" ::: "memory"); }
    }
};
struct EpiMerge {
    const bf16* G; bf16* MC; bf16* MG;
    __device__ __forceinline__ void operator()(const f32x4 (&acc)[2][2][4][2], const Unit& u, int wr, int wc) const {
        const int lane_ = lane_id_opaque(), fr = lane_ & 15, fq = lane_ >> 4;
        const int row0 = u.pm * 256 + wr * 64 + fr;
        if (u.kind == 0) {
#pragma unroll
            for (int ai = 0; ai < 2; ++ai) {
                v4u gw[4][2];
#pragma unroll
                for (int m = 0; m < 4; ++m)
#pragma unroll
                    for (int bj = 0; bj < 2; ++bj) gw[m][bj] = *(const v4u*)(G + (size_t)(row0 + ai * 128 + m * 16) * 2048 + u.pn * 256 + bj * 128 + wc * 32 + 8 * fq);
#pragma unroll
                for (int m = 0; m < 4; ++m) { const int row = row0 + ai * 128 + m * 16;
#pragma unroll
                    for (int bj = 0; bj < 2; ++bj) { const int c = u.pn * 256 + bj * 128 + wc * 32 + 8 * fq;
                        float gg[8]; unpack8(gw[m][bj], gg); f32x4 o0, o1;
#pragma unroll
                        for (int j = 0; j < 4; ++j) { o0[j] = gg[j] * acc[ai][bj][m][0][j]; o1[j] = gg[4 + j] * acc[ai][bj][m][1][j]; }
                        *(v4u*)(MC + (size_t)row * D + c) = pack8(o0, o1); } }
                asm volatile("" ::: "memory"); }
        } else {
            const int c = u.pn * 256 + (u.kind - 1) * 128 + wc * 32 + 8 * fq;
#pragma unroll
            for (int ai = 0; ai < 2; ++ai) {
                v4u gw[4], mw[4];
#pragma unroll
                for (int m = 0; m < 4; ++m) { const int row = row0 + ai * 128 + m * 16; gw[m] = *(const v4u*)(G + (size_t)row * 2048 + D + c); mw[m] = *(const v4u*)(MC + (size_t)row * D + c); }
#pragma unroll
                for (int m = 0; m < 4; ++m) { const int row = row0 + ai * 128 + m * 16;
                    float gg[8], mc[8]; unpack8(gw[m], gg); unpack8(mw[m], mc); f32x4 o0, o1;
#pragma unroll
                    for (int j = 0; j < 4; ++j) { o0[j] = mc[j] + gg[j] * (acc[ai][0][m][0][j] * fsigmoid(acc[ai][1][m][0][j])); o1[j] = mc[4 + j] + gg[4 + j] * (acc[ai][0][m][1][j] * fsigmoid(acc[ai][1][m][1][j])); }
                    *(v4u*)(MG + (size_t)row * D + c) = pack8(o0, o1); }
                asm volatile("" ::: "memory"); }
        }
    }
};
struct SsmOrder {
    int G, c; const char* UX; const char* BS2;
    __device__ __forceinline__ bool next(int i, Unit& u) const { const int L = i * G + c; if (L >= BATCH * NG) return false; const int b = L / NG, g = L % NG; u.pm = b; u.pn = g; u.kind = 0;
        u.A = UX + ((size_t)(g * (NCH + 1) + b * 256) * UXK) * 2; u.B = BS2 + (size_t)g * 256 * UXK * 2; return true; }
    __device__ __forceinline__ void a_ready(const Unit&) const {}
    __device__ __forceinline__ void done(const Unit&) const {}
};
struct MergeOrder {
    int G, c; const char* ZC; const char* Y; const char* WCAT;
    __device__ __forceinline__ bool next(int i, Unit& u) const { int pm, pn; const int su = i / 3, k = i - 3 * su; if (!pg8::static_tile(su, G, c, M / 256, D / 256, pm, pn)) return false; u.pm = pm; u.pn = pn; u.kind = k;
        u.A = (k == 0 ? ZC : Y) + (size_t)pm * 256 * 512 * 2; u.B = WCAT + (size_t)(k == 0 ? pn * 256 : 1024 + (2 * pn + k - 1) * 256) * 512 * 2; return true; }
    __device__ __forceinline__ void a_ready(const Unit&) const {}
    __device__ __forceinline__ void done(const Unit& u) const { if (u.kind == 0) asm volatile("s_waitcnt vmcnt(0)" ::: "memory"); }
};

__device__ __forceinline__ void p0_transpose_item(const float* W, int K, int N, bf16* WT, const float* gain, LAS float* scr, int k0, int n0, int drow0, int lane) {
    float v[32];
    const float* src = W + (size_t)(k0 + (lane >> 5)) * N + n0 + (lane & 31);
#pragma unroll
    for (int i = 0; i < 32; ++i) v[i] = src[(size_t)(2 * i) * N];
#pragma unroll
    for (int i = 0; i < 32; ++i) scr[(2 * i + (lane >> 5)) * 33 + (lane & 31)] = v[i];
    LDS_WAIT(); asm volatile("" ::: "memory");
    const int c = lane & 7;
    f32x4 g0 = (f32x4){1.f, 1.f, 1.f, 1.f}, g1 = g0; if (gain) { g0 = *(const f32x4*)(gain + k0 + 8 * c); g1 = *(const f32x4*)(gain + k0 + 8 * c + 4); }
#pragma unroll
    for (int j = 0; j < 4; ++j) { const int n = (lane >> 3) + 8 * j; const LAS float* s = scr + (8 * c) * 33 + n;
        v4u o; o.x = pk2(s[0 * 33] * g0[0], s[1 * 33] * g0[1]); o.y = pk2(s[2 * 33] * g0[2], s[3 * 33] * g0[3]); o.z = pk2(s[4 * 33] * g1[0], s[5 * 33] * g1[1]); o.w = pk2(s[6 * 33] * g1[2], s[7 * 33] * g1[3]);
        *(GAS v4u*)(WT + (size_t)(drow0 + n) * K + k0 + 8 * c) = o; }
    LDS_WAIT(); asm volatile("" ::: "memory");
}
__device__ __forceinline__ int glu_row(int n) { return 256 * (n >> 7) + (n & 127); }

constexpr int I_UP = (D / 64) * (DFF / 32), I_DN = (DFF / 64) * (D / 32), I_INP = (D / 64) * (DIN / 32), I_CP = (DCONV / 64) * (D / 32), I_WO = (D / 64) * (D / 32);
constexpr int T_W13A = 2 * I_UP, T_W2A = T_W13A + I_DN, T_WIN = T_W2A + I_INP, T_WCAT = T_WIN + 3 * I_CP, T_WOUT = T_WCAT + I_WO, T_W13B = T_WOUT + 2 * I_UP, T_W2B = T_W13B + I_DN;
__device__ __forceinline__ void weight_item(const Args& args, unsigned char* ws, LAS float* scr, int it, int lane) {
    if (it < T_W13A || (it >= T_WOUT && it < T_W13B)) { const bool second = it >= T_WOUT; int r = it - (second ? T_WOUT : 0); const int which = r / I_UP; r -= which * I_UP; const int nblk = DFF / 32, k0 = 64 * (r / nblk), n0 = 32 * (r % nblk);
        const float* W = second ? (which ? args.in[I_F2W3] : args.in[I_F2W1]) : (which ? args.in[I_F1W3] : args.in[I_F1W1]);
        p0_transpose_item(W, D, DFF, (bf16*)(ws + (second ? WS_W13B : WS_W13A)), second ? args.in[I_F2N] : args.in[I_F1N], scr, k0, n0, glu_row(n0) + which * 128, lane); return; }
    if (it < T_W2A || it >= T_W13B) { const bool second = it >= T_W13B; const int r = it - (second ? T_W13B : T_W13A); const int nblk = D / 32, k0 = 64 * (r / nblk), n0 = 32 * (r % nblk);
        p0_transpose_item(second ? args.in[I_F2W2] : args.in[I_F1W2], DFF, D, (bf16*)(ws + (second ? WS_W2B : WS_W2A)), nullptr, scr, k0, n0, n0, lane); return; }
    if (it < T_WIN) { const int r = it - T_W2A; const int nblk = DIN / 32, k0 = 64 * (r / nblk), n0 = 32 * (r % nblk);
        const int dr = n0 < 512 ? glu_row(n0) : n0 < 1024 ? glu_row(n0 - 512) + 128 : n0;
        p0_transpose_item(args.in[I_WIN], D, DIN, (bf16*)(ws + WS_WIN), args.in[I_MIXN], scr, k0, n0, dr, lane); return; }
    if (it < T_WCAT) { int r = it - T_WIN; const int which = r / I_CP; r -= which * I_CP; const int nblk = D / 32, k0 = 64 * (r / nblk), n0 = 32 * (r % nblk);
        const int dr = which == 0 ? n0 : 1024 + glu_row(n0) + (which == 2 ? 128 : 0);
        p0_transpose_item(which == 0 ? args.in[I_CPROJ] : which == 1 ? args.in[I_WV] : args.in[I_WG], DCONV, D, (bf16*)(ws + WS_WCAT), nullptr, scr, k0, n0, dr, lane); return; }
    { const int r = it - T_WCAT; const int nblk = D / 32, k0 = 64 * (r / nblk), n0 = 32 * (r % nblk); p0_transpose_item(args.in[I_WOUT], D, D, (bf16*)(ws + WS_WOUT), nullptr, scr, k0, n0, n0, lane); }
}

__device__ __forceinline__ void ssm_prep_job(Frame& F, const Args& args, int g) {
    LAS f32x2* lamP = (LAS f32x2*)(F.lds + RING_OFF);
    LAS f32x2* Bb = lamP + 17 * 64;
    LAS f32x2* Cc = Bb + 64 * 16;
    LAS float* Kk = (LAS float*)(Cc + 16 * 64);
    const float* lam_re = args.in[I_LRE]; const float* lam_im = args.in[I_LIM]; const float* log_dt = args.in[I_LDT];
    const float* b_re = args.in[I_BRE]; const float* b_im = args.in[I_BIM]; const float* c_re = args.in[I_CRE]; const float* c_im = args.in[I_CIM];
    const int tid = F.tid;
    const float dt = expf(log_dt[g]);
    if (tid < 64) { const int p = tid; const float a = lam_re[g * PS + p] * dt, bb = lam_im[g * PS + p] * dt, ea = expf(a), sb = sinf(bb), cb = cosf(bb);
        const float lx = ea * cb, ly = ea * sb; float px = 1.f, py = 0.f;
        for (int k = 0; k <= 16; ++k) { lamP[k * 64 + p] = (f32x2){px, py}; const float nx = px * lx - py * ly, ny = px * ly + py * lx; px = nx; py = ny; } }
    for (int i = tid; i < 1024; i += 512) { const int p = i >> 4;
        const float lr = lam_re[g * PS + p], li = lam_im[g * PS + p], a = lr * dt, bb = li * dt, ea = expf(a), sb = sinf(bb), cb = cosf(bb), sh = sinf(0.5f * bb);
        const float nr = expm1f(a) * cb - 2.f * sh * sh, ni = ea * sb, den = 1.f / (lr * lr + li * li), fr_ = (nr * lr + ni * li) * den, fi_ = (ni * lr - nr * li) * den;
        const float br = b_re[(size_t)g * 1024 + i], bi = b_im[(size_t)g * 1024 + i];
        Bb[i] = (f32x2){fr_ * br - fi_ * bi, fr_ * bi + fi_ * br};
        Cc[i] = (f32x2){c_re[(size_t)g * 1024 + i], c_im[(size_t)g * 1024 + i]}; }
    __syncthreads();
    {
        const int k = tid >> 5, h = (tid >> 1) & 15, hh = (tid & 1) * 8; float sum[8];
#pragma unroll
        for (int j = 0; j < 8; ++j) sum[j] = 0.f;
#pragma unroll 4
        for (int p = 0; p < 64; ++p) { const f32x2 c = Cc[h * 64 + p], l = lamP[k * 64 + p]; const float er = c.x * l.x - c.y * l.y, ei = c.x * l.y + c.y * l.x;
#pragma unroll
            for (int j = 0; j < 8; j += 2) { const f32x4 bb = *(const LAS f32x4*)(Bb + p * 16 + hh + j); sum[j] += er * bb[0] - ei * bb[1]; sum[j + 1] += er * bb[2] - ei * bb[3]; } }
#pragma unroll
        for (int j = 0; j < 8; ++j) Kk[(k << 8) + (h << 4) + hh + j] = sum[j];
    }
    __syncthreads();
    GAS unsigned* bs2 = (GAS unsigned*)(F.ws + WS_BS2) + (size_t)g * 256 * (UXK / 2);
    for (int i = tid; i < 256 * (UXK / 2); i += 512) { const int n = i / (UXK / 2), kp = (i % (UXK / 2)) * 2, t = n >> 4, h = n & 15; float v0, v1;
        if (kp < 256) { const int s = kp >> 4, hp = kp & 15; const bool on = s <= t; const int kb = (((t - s) & 15) << 8) + (h << 4) + hp; v0 = on ? Kk[kb] : 0.f; v1 = on ? Kk[kb + 1] : 0.f; }
        else { const int p = (kp - 256) >> 1; const f32x2 c = Cc[h * 64 + p], l = lamP[(t + 1) * 64 + p]; v0 = c.x * l.x - c.y * l.y; v1 = -(c.x * l.y + c.y * l.x); }
        bs2[i] = pk2(v0, v1); }
    GAS unsigned* wsi = (GAS unsigned*)(F.ws + WS_WSI) + (size_t)g * 128 * 128;
    for (int i = tid; i < 128 * 128; i += 512) { const int n = i >> 7, kp = (i & 127) * 2, p = n >> 1, c = n & 1, s = kp >> 4, h = kp & 15;
        const f32x2 l = lamP[(15 - s) * 64 + p], b0 = Bb[p * 16 + h], b1 = Bb[p * 16 + h + 1];
        const float v0 = c ? (l.x * b0.y + l.y * b0.x) : (l.x * b0.x - l.y * b0.y), v1 = c ? (l.x * b1.y + l.y * b1.x) : (l.x * b1.x - l.y * b1.y);
        wsi[i] = pk2(v0, v1); }
    if (tid < 64) ((GAS f32x2*)(F.ws + WS_LAMC))[g * 64 + tid] = lamP[16 * 64 + tid];
    __syncthreads();
}

template <int NS, bool NORM, class Fn>
__device__ __forceinline__ void meta_job(Frame& F, const float* A, int K, const bf16* Bt0, const bf16* Bt1, const Fn& fn) {
    LAS float* red = (LAS float*)(F.lds + RING_OFF);
    LAS float* rsc = red + 8 * 16 * 32;
    const int lane = F.lane, w = F.wave, fr = lane & 15, fq = lane >> 4;
    if (NORM) {
#pragma unroll
        for (int rr = 0; rr < 2; ++rr) { const int row = 2 * w + rr; float s = 0.f; for (int c = lane; c < D; c += 64) { const float v = A[(size_t)row * K + c]; s += v * v; } s = wave_sum(s); if (lane == 0) rsc[row] = 1.0f / sqrtf(s * (1.0f / D) + EPS); }
    } else if (F.tid < 16) rsc[F.tid] = 1.f;
    f32x4 acc[NS];
#pragma unroll
    for (int s = 0; s < NS; ++s) acc[s] = (f32x4){0.f, 0.f, 0.f, 0.f};
    const int kw = K / 8, kbase = w * kw;
#pragma unroll 4
    for (int k = kbase; k < kbase + kw; k += 32) {
        const f32x4 a0 = *(const f32x4*)(A + (size_t)fr * K + k + 8 * fq), a1 = *(const f32x4*)(A + (size_t)fr * K + k + 8 * fq + 4);
        const v4u ap = pack8(a0, a1); const bf16x8 af = __builtin_bit_cast(bf16x8, ap);
#pragma unroll
        for (int s = 0; s < NS; ++s) { const bf16x8 bf = *(const bf16x8*)((s == 0 ? Bt0 : Bt1) + (size_t)fr * K + k + 8 * fq); acc[s] = __builtin_amdgcn_mfma_f32_16x16x32_bf16(bf, af, acc[s], 0, 0, 0); } }
#pragma unroll
    for (int s = 0; s < NS; ++s) *(LAS f32x4*)(red + (w * 16 + fr) * 32 + s * 16 + 4 * fq) = acc[s];
    __syncthreads();
    if (F.tid < 256) { const int rr = F.tid >> 4, j = F.tid & 15; float v0 = 0.f, v1 = 0.f;
#pragma unroll
        for (int ww = 0; ww < 8; ++ww) { v0 += red[(ww * 16 + rr) * 32 + j]; if (NS > 1) v1 += red[(ww * 16 + rr) * 32 + 16 + j]; }
        const float sc = rsc[rr]; fn(rr, j, v0 * sc, v1 * sc); }
    __syncthreads();
}

constexpr int WSI_PITCH = 528;
constexpr int SMETA_OFF = LDSCTL_OFF + 1024;
__device__ __forceinline__ void ssm_pre_job(Frame& F, int b, int g) {
    const int lane = F.lane, w = F.wave, tid = F.tid, fr = lane & 15, fq = lane >> 4;
    LAS unsigned char* Bl = F.lds + RING_OFF;
    LAS f32x2* Sl = (LAS f32x2*)(F.lds + RING_OFF);
    LAS float* smeta = (LAS float*)(F.lds + SMETA_OFF);
    bf16* UX = (bf16*)(F.ws + WS_UX); const bf16* Wg = (const bf16*)(F.ws + WS_WSI) + (size_t)g * 128 * 256;
    { v4u v[8];
#pragma unroll
      for (int i = 0; i < 8; ++i) { const int idx = tid + 512 * i; v[i] = *(const v4u*)(Wg + (size_t)(idx >> 5) * 256 + (idx & 31) * 8); }
#pragma unroll
      for (int i = 0; i < 8; ++i) { const int idx = tid + 512 * i; *(LAS v4u*)(Bl + (idx >> 5) * WSI_PITCH + (idx & 31) * 16) = v[i]; } }
    const bf16* Ab = UX + (size_t)(g * (NCH + 1) + 256 * b + 32 * w) * UXK;
    bf16x8 a[2][8], am[8];
#pragma unroll
    for (int mt = 0; mt < 2; ++mt)
#pragma unroll
        for (int ks = 0; ks < 8; ++ks) a[mt][ks] = *(const bf16x8*)(Ab + (size_t)(16 * mt + fr) * UXK + 32 * ks + 8 * fq);
    if (w == 7) {
#pragma unroll
        for (int ks = 0; ks < 8; ++ks) am[ks] = *(const bf16x8*)(UX + (size_t)(g * (NCH + 1) + NCH) * UXK + 32 * ks + 8 * fq); }
    f32x4 acc[2][8], accm[8];
#pragma unroll
    for (int nt = 0; nt < 8; ++nt) { acc[0][nt] = (f32x4){0.f, 0.f, 0.f, 0.f}; acc[1][nt] = acc[0][nt]; accm[nt] = acc[0][nt]; }
    __syncthreads();
#pragma unroll
    for (int ks = 0; ks < 8; ++ks)
#pragma unroll
        for (int nt = 0; nt < 8; ++nt) { const bf16x8 bfr = *(const LAS bf16x8*)(Bl + (16 * nt + fr) * WSI_PITCH + (32 * ks + 8 * fq) * 2);
            acc[0][nt] = __builtin_amdgcn_mfma_f32_16x16x32_bf16(bfr, a[0][ks], acc[0][nt], 0, 0, 0); acc[1][nt] = __builtin_amdgcn_mfma_f32_16x16x32_bf16(bfr, a[1][ks], acc[1][nt], 0, 0, 0);
            if (w == 7) accm[nt] = __builtin_amdgcn_mfma_f32_16x16x32_bf16(bfr, am[ks], accm[nt], 0, 0, 0); }
    __syncthreads();
#pragma unroll
    for (int mt = 0; mt < 2; ++mt)
#pragma unroll
        for (int nt = 0; nt < 8; ++nt) *(LAS f32x4*)(Sl + (32 * w + 16 * mt + fr) * 64 + 8 * nt + 2 * fq) = acc[mt][nt];
    if (w == 7 && fr == 0) {
#pragma unroll
        for (int nt = 0; nt < 8; ++nt) *(LAS f32x4*)(smeta + 16 * nt + 4 * fq) = accm[nt]; }
    __syncthreads();
    { const f32x2 lc = ((const f32x2*)(F.ws + WS_LAMC))[g * 64 + lane];
      LAS f32x2* Ew = (LAS f32x2*)(F.lds + SMETA_OFF + 512);
      f32x2 l = (f32x2){0.f, 0.f};
#pragma unroll 8
      for (int k = 0; k < 32; ++k) { LAS f32x2* sp = Sl + (32 * w + k) * 64 + lane; const f32x2 sv = *sp; *sp = l; const float nx = lc.x * l.x - lc.y * l.y + sv.x, ny = lc.x * l.y + lc.y * l.x + sv.y; l.x = nx; l.y = ny; }
      Ew[w * 64 + lane] = l;
      f32x2 l32 = lc;
#pragma unroll
      for (int q = 0; q < 5; ++q) { const float nx = l32.x * l32.x - l32.y * l32.y, ny = 2.f * l32.x * l32.y; l32.x = nx; l32.y = ny; }
      __syncthreads();
      f32x2 X = *(const LAS f32x2*)(smeta + 2 * lane);
      for (int v = 0; v < w; ++v) { const f32x2 e = Ew[v * 64 + lane]; const float nx = l32.x * X.x - l32.y * X.y + e.x, ny = l32.x * X.y + l32.y * X.x + e.y; X.x = nx; X.y = ny; }
      unsigned* xp = (unsigned*)(UX + (size_t)(g * (NCH + 1) + b * 256 + 32 * w) * UXK + 256) + lane;
      f32x2 pw = X;
#pragma unroll 8
      for (int k = 0; k < 32; ++k) { const f32x2 lv = Sl[(32 * w + k) * 64 + lane]; xp[(size_t)k * (UXK / 2)] = cvt_pk_bf16(pw.x + lv.x, pw.y + lv.y); const float nx = lc.x * pw.x - lc.y * pw.y, ny = lc.x * pw.y + lc.y * pw.x; pw.x = nx; pw.y = ny; }
      VM_WAIT(); }
    __syncthreads();
}

__device__ __forceinline__ void conv_worker(Frame& F, const Args& args, int wi) {
    LAS unsigned char* zs = F.lds + RING_OFF;
    LAS float* cs = (LAS float*)(F.lds + RING_OFF + 65536);
    const bf16* Z = (const bf16*)(F.ws + WS_Z); bf16* ZC = (bf16*)(F.ws + WS_ZC);
    const int tid = F.tid, lane = F.lane, w = F.wave, b = wi >> 5, T0 = (wi & 31) * 128;
    auto zrow = [&](int ti, int cb) -> v4u { v4u v = (v4u){0u, 0u, 0u, 0u};
        if (ti >= 0) v = *(const v4u*)((const char*)Z + (size_t)(b * SEQ + ti) * 1024 + cb); else if (ti >= -NMETA) v = *(const v4u*)((const char*)Z + (size_t)(M + NMETA + ti) * 1024 + cb); return v; };
    { v4u v[8];
#pragma unroll
      for (int it = 0; it < 8; ++it) { const int q = tid + 512 * it; v[it] = (v4u){0u, 0u, 0u, 0u}; if (q < 62 * 64) v[it] = zrow(T0 - 30 + (q >> 6), (q & 63) * 16); }
#pragma unroll
      for (int it = 0; it < 8; ++it) { const int q = tid + 512 * it; if (q < 62 * 64) *(LAS v4u*)(zs + (((q >> 6) + 2) & 63) * 1024 + (q & 63) * 16) = v[it]; } }
    const int cp = tid & 255, th = tid >> 8;
    const float* dw = args.in[I_DW]; f32x2 wgt[CWID];
#pragma unroll
    for (int k = 0; k < CWID; ++k) wgt[k] = *(const f32x2*)(dw + k * DCONV + 2 * cp);
    const f32x2 bias = *(const f32x2*)(args.in[I_DWB] + 2 * cp);
    const f32x4 g0 = *(const f32x4*)(args.in[I_LNG] + 4 * lane), g1 = *(const f32x4*)(args.in[I_LNG] + 256 + 4 * lane), b0 = *(const f32x4*)(args.in[I_LNB] + 4 * lane), b1 = *(const f32x4*)(args.in[I_LNB] + 256 + 4 * lane);
#pragma unroll 1
    for (int j = 0; j < 4; ++j) {
        __syncthreads();
#pragma unroll 1
        for (int hf = 0; hf < 2; ++hf) {
            f32x2 acc[8];
#pragma unroll
            for (int t = 0; t < 8; ++t) acc[t] = bias;
            const int base = 32 * j + 16 * th + 8 * hf + 2;
#pragma unroll
            for (int i = 0; i < 38; ++i) { const unsigned zz = *(const LAS unsigned*)(zs + (((base + i) & 63) << 10) + 4 * cp); const float z0 = bf2f(zz & 0xffffu), z1 = bf2f(zz >> 16);
#pragma unroll
                for (int t = 0; t < 8; ++t) { const int k = i - t; if (k >= 0 && k < CWID) { acc[t].x += wgt[k].x * z0; acc[t].y += wgt[k].y * z1; } } }
#pragma unroll
            for (int t = 0; t < 8; ++t) *(LAS f32x2*)(cs + (16 * th + 8 * hf + t) * 512 + 2 * cp) = acc[t];
        }
        __syncthreads();
        v4u nx[4];
        if (j < 3) {
#pragma unroll
            for (int it = 0; it < 4; ++it) { const int q = tid + 512 * it; nx[it] = zrow(T0 + 32 * j + 32 + (q >> 6), (q & 63) * 16); } }
#pragma unroll
        for (int q = 0; q < 4; ++q) { const int t = 4 * w + q; const f32x4 x0 = *(const LAS f32x4*)(cs + t * 512 + 4 * lane), x1 = *(const LAS f32x4*)(cs + t * 512 + 256 + 4 * lane);
            const float mu = wave_sum((x0[0] + x0[1]) + (x0[2] + x0[3]) + (x1[0] + x1[1]) + (x1[2] + x1[3])) * (1.f / DCONV);
            const f32x4 d0 = x0 - mu, d1 = x1 - mu;
            const float var = wave_sum((d0[0] * d0[0] + d0[1] * d0[1]) + (d0[2] * d0[2] + d0[3] * d0[3]) + (d1[0] * d1[0] + d1[1] * d1[1]) + (d1[2] * d1[2] + d1[3] * d1[3])) * (1.f / DCONV);
            const float rstd = __builtin_amdgcn_rsqf(var + EPS); f32x4 o0 = d0 * rstd * g0 + b0, o1 = d1 * rstd * g1 + b1;
#pragma unroll
            for (int jj = 0; jj < 4; ++jj) { o0[jj] = fsilu(o0[jj]); o1[jj] = fsilu(o1[jj]); }
            bf16* zr = ZC + (size_t)(b * SEQ + T0 + 32 * j + t) * DCONV;
            *(v2u*)(zr + 4 * lane) = (v2u){cvt_pk_bf16(o0[0], o0[1]), cvt_pk_bf16(o0[2], o0[3])}; *(v2u*)(zr + 256 + 4 * lane) = (v2u){cvt_pk_bf16(o1[0], o1[1]), cvt_pk_bf16(o1[2], o1[3])}; }
        if (j < 3) {
#pragma unroll
            for (int it = 0; it < 4; ++it) { const int q = tid + 512 * it; *(LAS v4u*)(zs + ((32 * j + 64 + (q >> 6)) & 63) * 1024 + (q & 63) * 16) = nx[it]; } }
    }
    __syncthreads();
}

__global__ void __launch_bounds__(NWAVES * 64, 2) hyb_fwd(Args args) {
    extern __shared__ __attribute__((aligned(16))) unsigned char lds[];
    Frame F;
    F.lds = (LAS unsigned char*)lds; F.MISC = (volatile LAS unsigned*)(F.lds + MISC_OFF);
    F.wave = __builtin_amdgcn_readfirstlane((int)threadIdx.x >> 6); F.lane = lane_id_opaque(); F.tid = F.wave * 64 + F.lane;
    F.G = gridDim.x; { const int bx = blockIdx.x; F.vcu = (F.G % 8 == 0) ? (bx % 8) * (F.G / 8) + bx / 8 : bx; }
    F.ws = args.ws; F.out = args.out; F.ctl = (gu32*)(args.ws + WS_CTL);
    for (int u = F.tid; u < (LDS_BYTES - LDSCTL_OFF) / 4; u += NWAVES * 64) ((LAS unsigned*)(F.lds + LDSCTL_OFF))[u] = 0u;
    __syncthreads();
    const int bli = (N_LAUNCHES == PER_PHASE) ? 0 : args.li;
    XcdBarrier bar; bar.bar = (unsigned*)(F.ctl + CW_BAR) + bli * XCD_BAR_WORDS; bar.x = 0; bar.st = nullptr;
    if (N_LAUNCHES != PER_PHASE) bar = xcd_barrier_post((unsigned*)(F.ctl + CW_BAR) + bli * XCD_BAR_WORDS, F.MISC + 8);
    const int lo = args.ph_lo, hi = args.ph_hi;
#ifndef PHMASK
#define PHMASK 0x7ff
#endif
#define IN(k) (((PHMASK >> (k)) & 1) && lo <= (k) && (k) < hi)
#define SEAM(k) do { if (IN(k) && IN((k) + 1)) xcd_barrier(bar); F.lane = lane_id_opaque(); F.tid = F.wave * 64 + F.lane; } while (0)
    unsigned char* ws = F.ws;
    bf16* W13A = (bf16*)(ws + WS_W13A); bf16* W2A = (bf16*)(ws + WS_W2A); bf16* WIN = (bf16*)(ws + WS_WIN); bf16* WCAT = (bf16*)(ws + WS_WCAT); bf16* WOUT = (bf16*)(ws + WS_WOUT);
    bf16* W13B = (bf16*)(ws + WS_W13B); bf16* W2B = (bf16*)(ws + WS_W2B);
    bf16* AB = (bf16*)(ws + WS_AB); bf16* H1B = (bf16*)(ws + WS_H1); bf16* H2B = (bf16*)(ws + WS_H1 + 32 * MiB); bf16* HID = (bf16*)(ws + WS_HID);
    bf16* Zb = (bf16*)(ws + WS_Z); bf16* UXb = (bf16*)(ws + WS_UX); bf16* ZCb = (bf16*)(ws + WS_ZC); bf16* Yb = (bf16*)(ws + WS_Y); bf16* MCb = (bf16*)(ws + WS_MC);
    float* SS0 = (float*)(ws + WS_SS0); float* SS1 = SS0 + M; float* SS2 = SS1 + M; float* SS3 = SS2 + M;
    float* HIDM = (float*)(ws + WS_HIDM); float* H1M = (float*)(ws + WS_H1M);
    bf16* Gb = (bf16*)F.out;
    const int bx = (int)blockIdx.x;
    const int gw = F.vcu * NWAVES + F.wave, NGW = F.G * NWAVES;
    const int lb = bx - F.G / 2;
    const int lgw = lb * NWAVES + F.wave, NLGW = (F.G - F.G / 2) * NWAVES;

    if (IN(0)) {
        LAS float* scr = (LAS float*)(F.lds + RING_OFF + F.wave * 16384);
        for (int it = gw; it < T_W13A; it += NGW) weight_item(args, ws, scr, it, F.lane);
        for (int m = gw; m < M; m += NGW) { const GAS f32x4* xr = (const GAS f32x4*)(args.in[I_X] + (size_t)m * D) + F.lane; f32x4 v[4]; float s = 0.f;
#pragma unroll
            for (int j = 0; j < 4; ++j) { v[j] = xr[64 * j]; s += (v[j].x * v[j].x + v[j].y * v[j].y) + (v[j].z * v[j].z + v[j].w * v[j].w); }
            s = wave_sum(s);
            GAS v2u* o8 = (GAS v2u*)(AB + (size_t)m * D) + F.lane;
#pragma unroll
            for (int j = 0; j < 4; ++j) o8[64 * j] = (v2u){pk2(v[j].x, v[j].y), pk2(v[j].z, v[j].w)};
            if (F.lane == 0) { SS0[m] = s; SS1[m] = 0.f; SS2[m] = 0.f; SS3[m] = 0.f; } }
    }
    SEAM(0);
    if (IN(1)) {
        pg8::Gemm g{D, D, D}; pg8::GridOrder S{M / 256, 2 * DFF / 256, F.G, bx, (const char*)AB, (const char*)W13A, (size_t)256 * D * 2, (size_t)256 * D * 2};
        EpiSwiglu E{HID, SS0};
        pg8::gemm_phase(F.lds + RING_OFF, F.wave, g, S, E);
        F.lane = lane_id_opaque(); F.tid = F.wave * 64 + F.lane;
        for (;;) { const int t = wg_ticket(F, 0);
            if (t < NG) { ssm_prep_job(F, args, t); continue; }
            if (t < NG + DFF / 16) { float* hm = HIDM; const int c0 = 16 * (t - NG); const bf16* b0 = W13A + (size_t)glu_row(c0) * D;
                meta_job<2, true>(F, args.in[I_META], D, b0, b0 + (size_t)128 * D, [=](int r, int jj, float a, float b) { hm[r * DFF + c0 + jj] = fsilu(a) * b; }); continue; }
            const int tj = t - (NG + DFF / 16); if (tj >= (T_WIN - T_W13A) / 16) break;
            LAS float* scr = (LAS float*)(F.lds + RING_OFF + F.wave * 16384);
            weight_item(args, ws, scr, T_W13A + 16 * tj + F.wave, F.lane); weight_item(args, ws, scr, T_W13A + 16 * tj + 8 + F.wave, F.lane);
        }
    }
    SEAM(1);
    if (IN(2)) {
        pg8::Gemm g{DFF, DFF, DFF}; pg8::GridOrder S{M / 256, D / 256, F.G, bx, (const char*)HID, (const char*)W2A, (size_t)256 * DFF * 2, (size_t)256 * DFF * 2};
        EpiResid<true> E{AB, H1B, SS1, 0.5f};
        pg8::gemm_phase(F.lds + RING_OFF, F.wave, g, S, E);
        F.lane = lane_id_opaque(); F.tid = F.wave * 64 + F.lane;
        for (int j = bx; j < D / 16; j += F.G) { float* hm = H1M; const float* mt = args.in[I_META]; const int c0 = 16 * j;
            meta_job<1, false>(F, HIDM, DFF, W2A + (size_t)c0 * DFF, nullptr, [=](int r, int jj, float a, float) { hm[r * D + c0 + jj] = mt[r * D + c0 + jj] + 0.5f * a; }); }
    }
    SEAM(2);
    if (IN(3)) {
        pg8::Gemm g{D, D, D}; pg8::GridOrder S{M / 256, DIN / 256, F.G, bx, (const char*)H1B, (const char*)WIN, (size_t)256 * D * 2, (size_t)256 * D * 2};
        EpiMix E{SS1, Zb, UXb, Gb, args.in[I_BGATE]};
        pg8::gemm_phase(F.lds + RING_OFF, F.wave, g, S, E);
        F.lane = lane_id_opaque(); F.tid = F.wave * 64 + F.lane;
        for (;;) { const int j = wg_ticket(F, 1);
            if (j < 32) { bf16* zz = Zb; const int c0 = 16 * j; const bf16* b0 = WIN + (size_t)glu_row(c0) * D;
                meta_job<2, true>(F, H1M, D, b0, b0 + (size_t)128 * D, [=](int r, int jj, float a, float b) { zz[(size_t)(M + r) * DCONV + c0 + jj] = (bf16)f2bf(a * fsigmoid(b)); }); continue; }
            if (j < 64) { bf16* ux = UXb; const int gg = j - 32;
                meta_job<1, true>(F, H1M, D, WIN + (size_t)(1024 + 16 * gg) * D, nullptr, [=](int r, int jj, float a, float) { ux[(size_t)(gg * (NCH + 1) + NCH) * UXK + r * 16 + jj] = (bf16)f2bf(a); }); continue; }
            const int tj = j - 64; if (tj >= (T_W2B - T_WIN) / 16) break;
            LAS float* scr = (LAS float*)(F.lds + RING_OFF + F.wave * 16384);
            weight_item(args, ws, scr, T_WIN + 16 * tj + F.wave, F.lane); weight_item(args, ws, scr, T_WIN + 16 * tj + 8 + F.wave, F.lane);
        }
    }
    SEAM(3);
    if (IN(4)) {
        if (bx < BATCH * NG) {
            ssm_pre_job(F, bx / NG, bx % NG);
            pg8::Gemm g{UXK, UXK, UXK}; SsmOrder S{1 << 20, bx, (const char*)UXb, (const char*)(ws + WS_BS2)};
            EpiSsmY E{UXb, args.in[I_SD], Yb};
            pg8::gemm_phase(F.lds + RING_OFF, F.wave, g, S, E);
        }
        else conv_worker(F, args, bx - BATCH * NG);
    }
    SEAM(4);
    if (IN(6)) {
        pg8::Gemm g{512, 512, 512}; MergeOrder S{F.G, bx, (const char*)ZCb, (const char*)Yb, (const char*)WCAT};
        EpiMerge E{Gb, MCb, AB};
        pg8::gemm_phase(F.lds + RING_OFF, F.wave, g, S, E);
    }
    SEAM(6);
    if (IN(7)) {
        pg8::Gemm g{D, D, D}; pg8::GridOrder S{M / 256, D / 256, F.G, bx, (const char*)AB, (const char*)WOUT, (size_t)256 * D * 2, (size_t)256 * D * 2};
        EpiResid<true> E{H1B, H2B, SS2, 1.0f};
        pg8::gemm_phase(F.lds + RING_OFF, F.wave, g, S, E);
    }
    SEAM(7);
    if (IN(8)) {
        pg8::Gemm g{D, D, D}; pg8::GridOrder S{M / 256, 2 * DFF / 256, F.G, bx, (const char*)H2B, (const char*)W13B, (size_t)256 * D * 2, (size_t)256 * D * 2};
        EpiSwiglu E{HID, SS2};
        pg8::gemm_phase(F.lds + RING_OFF, F.wave, g, S, E);
    }
    SEAM(8);
    if (IN(9)) {
        pg8::Gemm g{DFF, DFF, DFF}; pg8::GridOrder S{M / 256, D / 256, F.G, bx, (const char*)HID, (const char*)W2B, (size_t)256 * DFF * 2, (size_t)256 * DFF * 2};
        EpiFinal E{H2B, F.out, SS3, (unsigned*)(F.ctl + CW_FIN), args.in[I_FINN], 0.5f};
        pg8::gemm_phase(F.lds + RING_OFF, F.wave, g, S, E);
    }
#undef IN
#undef SEAM
}

extern "C" void kernel_launch(void* const* d_in, const int* in_sizes, int n_in, void* d_out, int out_size, void* d_ws, size_t ws_size, hipStream_t stream) {
    static int grid = 0;
    if (grid == 0) {
        if (n_in != 30 || in_sizes[0] != M * D || out_size != M * D || ws_size < WS_END) { fprintf(stderr, "kernel_launch: unexpected problem shape (n_in %d, in0 %d, out %d, ws %zu); nothing launched\n", n_in, n_in > 0 ? in_sizes[0] : -1, out_size, ws_size); grid = -1; return; }
        int dev = 0, cus = 0, per_cu = 0;
        if (hipGetDevice(&dev) != hipSuccess || hipDeviceGetAttribute(&cus, hipDeviceAttributeMultiprocessorCount, dev) != hipSuccess) { grid = -1; return; }
        if (hipFuncSetAttribute((const void*)hyb_fwd, hipFuncAttributeMaxDynamicSharedMemorySize, LDS_BYTES) != hipSuccess) { fprintf(stderr, "kernel_launch: hipFuncSetAttribute failed\n"); grid = -1; return; }
        if (hipOccupancyMaxActiveBlocksPerMultiprocessor(&per_cu, (const void*)hyb_fwd, NWAVES * 64, LDS_BYTES) != hipSuccess || per_cu < 1)
            fprintf(stderr, "kernel_launch: note: occupancy query reports %d workgroups per CU\n", per_cu);
        (void)hipGetLastError();
        grid = cus;
    }
    if (grid < 0) return;
    if (hipMemsetAsync((char*)d_ws + WS_CTL, 0, CTL_ZERO_BYTES, stream) != hipSuccess) { fprintf(stderr, "kernel_launch: hipMemsetAsync failed\n"); return; }
    Args a{};
    for (int i = 0; i < 30; ++i) a.in[i] = (const float*)d_in[i];
    a.out = (float*)d_out; a.ws = (unsigned char*)d_ws;
    for (int li = 0; li < N_LAUNCHES; ++li) {
        a.ph_lo = (N_LAUNCHES == PER_PHASE) ? li : 0; a.ph_hi = (N_LAUNCHES == PER_PHASE) ? li + 1 : PER_PHASE; a.li = li;
        hipLaunchKernelGGL(hyb_fwd, dim3(grid), dim3(NWAVES * 64), LDS_BYTES, stream, a);
        const hipError_t le = hipPeekAtLastError();
        if (le != hipSuccess) { fprintf(stderr, "kernel_launch: launch %d failed: %s\n", li, hipGetErrorName(le)); break; }
    }
}
```

```cpp
#include <hip/hip_runtime.h>
#include <cstdio>
#include <cstdint>

#ifndef MK_N_LAUNCHES
#define MK_N_LAUNCHES 1
#endif

__device__ __forceinline__ int lane_id_opaque() { int l; asm volatile("v_mbcnt_lo_u32_b32 %0, -1, 0\n\tv_mbcnt_hi_u32_b32 %0, -1, %0" : "=v"(l)); return l; }
namespace pg8 {
#define PG8_LAS __attribute__((address_space(3)))
typedef unsigned short bf16_t;
typedef short bf16x8 __attribute__((ext_vector_type(8)));
typedef float f32x4 __attribute__((ext_vector_type(4)));
typedef unsigned u32x4 __attribute__((ext_vector_type(4)));
constexpr int BM = 256, BK = 64, HALF = 128, HTB = HALF * BK * 2, STAGE_BYTES = 8 * HTB, NXCD = 8;

__host__ __device__ __forceinline__ int lds_byte(int r, int c) { const int st = (r >> 4) * 2 + (c >> 5), rr = r & 15, cc = c & 31, ob = rr * 64 + cc * 2; return st * 1024 + (ob ^ (((ob >> 9) & 1) << 5)); }
__host__ __device__ __forceinline__ void stage_rc(int b, int& R, int& C) { const int st = b / 1024, sb = b % 1024, swz = sb ^ (((sb >> 9) & 1) << 5); R = (st >> 1) * 16 + swz / 64; C = (st & 1) * 32 + (swz % 64) / 2; }
__host__ __device__ __forceinline__ int perm32(int rho) { const int n = rho >> 4, i = rho & 15; return 8 * (i >> 2) + 4 * n + (i & 3); }

struct Unit { int pm, pn, kind; const char* A; const char* B; };
struct Gemm { int lda, ldb, K; };

__device__ __forceinline__ bool static_tile(int i, int G, int c, int nM, int nN, int WGM  , int& pm, int& pn) {
    const int nwg = nM * nN; const long L = (long)i * G + c; if (L >= nwg) return false;
    int wgid = (int)L; { const int q = nwg / NXCD, r = nwg % NXCD, xcd = wgid % NXCD, off = wgid / NXCD; wgid = (xcd < r ? xcd * (q + 1) : r * (q + 1) + (xcd - r) * q) + off; }
    const int nig = WGM * nN, gid = wgid / nig, fm = gid * WGM, gsz = (nM - fm) < WGM ? (nM - fm) : WGM;
    pm = fm + ((wgid % nig) % gsz); pn = (wgid % nig) / gsz; return true;
}
struct GridOrder {
    int nM, nN, G, c; const char* A; const char* B; size_t tA, tB; int wgm;
    __device__ __forceinline__ bool next(int i, Unit& u) const { int pm, pn; if (!static_tile(i, G, c, nM, nN, wgm, pm, pn)) return false; u.pm = pm; u.pn = pn; u.kind = 0; u.A = A + (size_t)pm * tA; u.B = B + (size_t)pn * tB; return true; }
    __device__ __forceinline__ void a_ready(const Unit&) const {}
    __device__ __forceinline__ void done(const Unit&) const {}
};

__device__ __forceinline__ unsigned cvt_pk_bf16(float lo, float hi) { unsigned r; asm volatile("v_cvt_pk_bf16_f32 %0, %1, %2" : "=v"(r) : "v"(lo), "v"(hi)); return r; }

template <class Epi, class Sched>
__device__ __forceinline__ void gemm_phase(PG8_LAS unsigned char* lds, const int wid  , const Gemm g, const Sched& S, const Epi& E) {
    const int lane = lane_id_opaque(), tid = wid * 64 + lane, wr = wid >> 2, wc = wid & 3, fr = lane & 15, fq = lane >> 4;
    const int K = g.K, nt = K / BK;
    unsigned voffA[2], voffB[2];
#pragma unroll
    for (int i = 0; i < 2; ++i) { int R, C; stage_rc(tid * 16 + i * 8192, R, C); const int Rb = (R & ~31) + perm32(R & 31);
        voffA[i] = (unsigned)(R * g.lda + C) * 2u; voffB[i] = (unsigned)(Rb * g.ldb + C) * 2u; }
    const size_t kstep = (size_t)(BK * 2);
    const size_t hstepA = (size_t)HALF * g.lda * 2, hstepB = (size_t)HALF * g.ldb * 2;
    const unsigned ldsw = (unsigned)wid * 1024u;
    const int aoff = lds_byte(wr * 64 + fr, fq * 8), boff = lds_byte(wc * 32 + fr, fq * 8);
#define PG8_SA(b, h) (((b) * 2 + (h)) * HTB)
#define PG8_SB(b, h) ((4 + (b) * 2 + (h)) * HTB)
#define PG8_STAGE(bufoff, gbase, voff) do { _Pragma("unroll") for (int _i = 0; _i < 2; ++_i) \
        __builtin_amdgcn_global_load_lds((const unsigned*)((const char*)(gbase) + (voff)[_i]), (PG8_LAS unsigned*)(lds + (bufoff) + ldsw + _i * 8192), 16, 0, 0); } while (0)
#define PG8_LDA(dst, b, h) do { _Pragma("unroll") for (int m = 0; m < 4; ++m) _Pragma("unroll") for (int k = 0; k < 2; ++k) dst[m][k] = *(const PG8_LAS bf16x8*)(lds + PG8_SA(b, h) + aoff + m * 2048 + k * 1024); } while (0)
#define PG8_LDB(dst, b, h) do { _Pragma("unroll") for (int n = 0; n < 2; ++n) _Pragma("unroll") for (int k = 0; k < 2; ++k) dst[n][k] = *(const PG8_LAS bf16x8*)(lds + PG8_SB(b, h) + boff + n * 2048 + k * 1024); } while (0)
#define PG8_MMA(ai, bj, At, Bt) do { __builtin_amdgcn_s_setprio(1); _Pragma("unroll") for (int m = 0; m < 4; ++m) _Pragma("unroll") for (int n = 0; n < 2; ++n) _Pragma("unroll") for (int k = 0; k < 2; ++k) \
        acc[ai][bj][m][n] = __builtin_amdgcn_mfma_f32_16x16x32_bf16(Bt[n][k], At[m][k], acc[ai][bj][m][n], 0, 0, 0); __builtin_amdgcn_s_setprio(0); } while (0)
#define PG8_WAIT_V(n) asm volatile("s_waitcnt vmcnt(" #n ")" ::: "memory")
#define PG8_WAIT_L(n) asm volatile("s_waitcnt lgkmcnt(" #n ")" ::: "memory")
#define PG8_BAR __builtin_amdgcn_s_barrier()
#define PG8_SCHED __builtin_amdgcn_sched_barrier(0)
    Unit cur, nxt; int ui = 0;
    if (!S.next(0, cur)) return;
    f32x4 acc[2][2][4][2];
#pragma unroll
    for (int a = 0; a < 2; ++a)
#pragma unroll
        for (int b = 0; b < 2; ++b)
#pragma unroll
            for (int m = 0; m < 4; ++m)
#pragma unroll
                for (int n = 0; n < 2; ++n) acc[a][b][m][n] = (f32x4){0.f, 0.f, 0.f, 0.f};
    bf16x8 At[4][2], B0[2][2], B1[2][2];
    const char* cA = cur.A; const char* cB = cur.B;
    S.a_ready(cur);
    PG8_STAGE(PG8_SB(0, 0), cB, voffB); PG8_STAGE(PG8_SB(0, 1), cB + hstepB, voffB); PG8_STAGE(PG8_SA(0, 0), cA, voffA); PG8_STAGE(PG8_SA(0, 1), cA + hstepA, voffA);
    if (wr == 1) PG8_BAR;
    PG8_WAIT_V(2); PG8_BAR;
    PG8_STAGE(PG8_SB(1, 0), cB + kstep, voffB); PG8_STAGE(PG8_SA(1, 0), cA + kstep, voffA); PG8_STAGE(PG8_SB(1, 1), cB + hstepB + kstep, voffB);
    PG8_WAIT_V(6); PG8_BAR;
    for (;;) {
        const bool has_next = S.next(ui + 1, nxt);
        const char* nA = has_next ? nxt.A : cA; const char* nB = has_next ? nxt.B : cB;
        for (int t = 0; t < nt; t += 2) {
            const bool last = (t == nt - 2);
            const char* a1 = cA + (size_t)(t + 1) * kstep;
            const char* a2 = last ? nA : cA + (size_t)(t + 2) * kstep; const char* b2 = last ? nB : cB + (size_t)(t + 2) * kstep;
            const char* a3 = a2 + kstep; const char* b3 = b2 + kstep;
            if (last && has_next) S.a_ready(nxt);
            PG8_LDB(B0, 0, 0); PG8_LDB(B1, 0, 1); PG8_SCHED; PG8_LDA(At, 0, 0); PG8_STAGE(PG8_SA(1, 1), a1 + hstepA, voffA);
            PG8_WAIT_V(8); PG8_WAIT_L(0); PG8_BAR; PG8_MMA(0, 0, At, B0); PG8_MMA(0, 1, At, B1); PG8_BAR; PG8_SCHED;
            PG8_LDA(At, 0, 1); PG8_STAGE(PG8_SB(0, 0), b2, voffB); PG8_STAGE(PG8_SB(0, 1), b2 + hstepB, voffB); PG8_STAGE(PG8_SA(0, 0), a2, voffA);
            PG8_WAIT_V(8); PG8_WAIT_L(0); PG8_BAR; PG8_MMA(1, 0, At, B0); PG8_MMA(1, 1, At, B1); PG8_BAR; PG8_SCHED;
            PG8_LDB(B0, 1, 0); PG8_LDB(B1, 1, 1); PG8_SCHED; PG8_LDA(At, 1, 0); PG8_STAGE(PG8_SA(0, 1), a2 + hstepA, voffA);
            PG8_WAIT_V(8); PG8_WAIT_L(0); PG8_BAR; PG8_MMA(0, 0, At, B0); PG8_MMA(0, 1, At, B1); PG8_BAR; PG8_SCHED;
            PG8_LDA(At, 1, 1); PG8_STAGE(PG8_SB(1, 0), b3, voffB); PG8_STAGE(PG8_SB(1, 1), b3 + hstepB, voffB); PG8_STAGE(PG8_SA(1, 0), a3, voffA);
            PG8_WAIT_V(8); PG8_WAIT_L(0); PG8_BAR; PG8_MMA(1, 0, At, B0); PG8_MMA(1, 1, At, B1); PG8_BAR; PG8_SCHED;
        }
        if (wr == 0) PG8_BAR;
        E(acc, cur, wr, wc); S.done(cur);
        if (!has_next) break;
#pragma unroll
        for (int a = 0; a < 2; ++a)
#pragma unroll
            for (int b = 0; b < 2; ++b)
#pragma unroll
                for (int m = 0; m < 4; ++m)
#pragma unroll
                    for (int n = 0; n < 2; ++n) acc[a][b][m][n] = (f32x4){0.f, 0.f, 0.f, 0.f};
        cur = nxt; cA = nA; cB = nB; ++ui;
        if (wr == 1) PG8_BAR;
    }
    PG8_WAIT_V(0);
    PG8_BAR;
#undef PG8_SA
#undef PG8_SB
#undef PG8_STAGE
#undef PG8_LDA
#undef PG8_LDB
#undef PG8_MMA
#undef PG8_WAIT_V
#undef PG8_WAIT_L
#undef PG8_BAR
#undef PG8_SCHED
}
}

constexpr int NWAVES = 8;
constexpr int D = 1024, BATCH = 4, SEQ = 4096, NMETA = 16, DFF = 2816, DCONV = 512, CWID = 31, DSSM = 512, HG = 16, NG = 32, PS = 64;
constexpr int DIN = 2 * DCONV + DSSM + 2 * D;
constexpr int M = BATCH * SEQ;
constexpr int NCH = M / 16;
constexpr int UXK = 384;
constexpr float EPS = 1e-6f;
constexpr int PER_PHASE = 10;
#ifndef W_UP
#define W_UP 4
#endif
#ifndef W_DN
#define W_DN 8
#endif
#ifndef W_IN
#define W_IN 4
#endif
#ifndef W_MG
#define W_MG 4
#endif
#ifndef W_OUT
#define W_OUT 4
#endif
constexpr int N_LAUNCHES = MK_N_LAUNCHES;

constexpr size_t MiB = 1u << 20;
constexpr size_t WS_CTL = 0, CTL_ZERO_BYTES = 1 * MiB;
constexpr size_t WS_BS2 = 1 * MiB;
constexpr size_t WS_WSI = 7 * MiB;
constexpr size_t WS_SMALL = 9 * MiB;
constexpr size_t WS_LAMC = WS_SMALL;
constexpr size_t WS_SMETA = WS_SMALL + 16384;
constexpr size_t WS_SS0 = WS_SMALL + 32768;
constexpr size_t WS_HIDM = WS_SMALL + 32768 + 4 * 65536;
constexpr size_t WS_H1M = WS_HIDM + 16 * DFF * 4;
constexpr size_t WS_W13A = 11 * MiB, WS_W2A = 22 * MiB, WS_WIN = 28 * MiB, WS_WCAT = 35 * MiB, WS_WOUT = 38 * MiB, WS_W13B = 40 * MiB, WS_W2B = 51 * MiB;
constexpr size_t WS_AB = 57 * MiB;
constexpr size_t WS_H1 = 89 * MiB;
constexpr size_t WS_HID = 153 * MiB;
constexpr size_t WS_Z = WS_HID;
constexpr size_t WS_UX = WS_HID + 17 * MiB;
constexpr size_t WS_ZC = WS_HID + 42 * MiB;
constexpr size_t WS_Y = WS_HID + 58 * MiB;
constexpr size_t WS_MC = WS_HID;
constexpr size_t WS_S = WS_HID + 74 * MiB;
constexpr size_t WS_END = 256 * MiB;
static_assert(WS_H1M + 16 * D * 4 <= WS_W13A, "small tables");
static_assert(WS_W2B + (size_t)D * DFF * 2 <= WS_AB && WS_AB + (size_t)M * D * 2 <= WS_H1 && WS_H1 + (size_t)M * D * 4 <= WS_HID, "ws map 1");
static_assert(WS_Z + (size_t)(M + 16) * DCONV * 2 <= WS_UX && WS_UX + (size_t)NG * (NCH + 1) * UXK * 2 <= WS_ZC && WS_ZC + (size_t)M * DCONV * 2 <= WS_Y && WS_Y + (size_t)M * DSSM * 2 <= WS_S, "ws map 2");
static_assert(WS_MC + (size_t)M * D * 2 <= WS_ZC, "MC overlay");
static_assert(WS_HID + (size_t)M * DFF * 2 <= WS_END && WS_S + (size_t)NCH * NG * 128 * 4 <= WS_END, "ws end");
static_assert(WS_W13A + (size_t)2 * DFF * D * 2 <= WS_W2A && WS_W2A + (size_t)D * DFF * 2 <= WS_WIN && WS_WIN + (size_t)DIN * D * 2 <= WS_WCAT && WS_WCAT + (size_t)3072 * 512 * 2 <= WS_WOUT && WS_WOUT + (size_t)D * D * 2 <= WS_W13B && WS_W13B + (size_t)2 * DFF * D * 2 <= WS_W2B, "weights");
static_assert(WS_BS2 + (size_t)NG * 256 * UXK * 2 <= WS_WSI && WS_WSI + (size_t)NG * 128 * 256 * 2 <= WS_SMALL, "ssm mats");
constexpr int CW_BAR = 4096;
constexpr int CW_FIN = 16384;

constexpr int RING_OFF = 0, RING_BYTES = 131072;
constexpr int LDSCTL_OFF = RING_BYTES, MISC_OFF = LDSCTL_OFF + 320;
constexpr int LDS_BYTES = 147456;

#define GAS __attribute__((address_space(1)))
#define LAS __attribute__((address_space(3)))
typedef unsigned short bf16;
typedef unsigned v4u __attribute__((ext_vector_type(4)));
typedef unsigned v2u __attribute__((ext_vector_type(2)));
typedef float f32x4 __attribute__((ext_vector_type(4)));
typedef float f32x2 __attribute__((ext_vector_type(2)));
typedef short bf16x8 __attribute__((ext_vector_type(8)));
typedef GAS unsigned gu32;
#define RLX_AGENT __ATOMIC_RELAXED, __HIP_MEMORY_SCOPE_AGENT
#define LDS_WAIT() asm volatile("s_waitcnt lgkmcnt(0)" ::: "memory")
#define VM_WAIT() asm volatile("s_waitcnt vmcnt(0)" ::: "memory")
__device__ __forceinline__ unsigned f2bf(float f) { unsigned u = __builtin_bit_cast(unsigned, f); return (u + 0x7fffu + ((u >> 16) & 1u)) >> 16; }
__device__ __forceinline__ unsigned pk2(float lo, float hi) { return f2bf(lo) | (f2bf(hi) << 16); }
__device__ __forceinline__ float bf2f(unsigned h) { return __builtin_bit_cast(float, h << 16); }
__device__ __forceinline__ float fsigmoid(float x) { return __builtin_amdgcn_rcpf(1.f + __builtin_amdgcn_exp2f(-1.44269504089f * x)); }
__device__ __forceinline__ float fsilu(float x) { return x * fsigmoid(x); }
__device__ __forceinline__ float fgelu_tanh(float x) { return x * fsigmoid(1.5957691216f * (x + 0.044715f * x * x * x)); }
__device__ __forceinline__ float wave_sum(float v) {
#pragma unroll
    for (int o = 1; o < 64; o <<= 1) v += __shfl_xor(v, o);
    return v;
}

#define XB_TMO      128
#define XB_XCNT(j)  (256  + 64 * (j))
#define XB_XSUB(j)  (1280 + 64 * (j))
#define XB_XGEN(j)  (2304 + 64 * (j))
#define XB_TOP      3328
#define XB_TOPGEN   3392
#define XCD_BAR_WORDS 3456
#define XB_SPIN_CAP (1u << 18)
__device__ __forceinline__ unsigned xb_ld(unsigned* p)              { return __hip_atomic_load(p, __ATOMIC_RELAXED, __HIP_MEMORY_SCOPE_AGENT); }
__device__ __forceinline__ unsigned xb_add(unsigned* p, unsigned v) { return __hip_atomic_fetch_add(p, v, __ATOMIC_RELAXED, __HIP_MEMORY_SCOPE_AGENT); }
__device__ __forceinline__ unsigned xb_xcc_id() { return (unsigned)__builtin_amdgcn_s_getreg((3 << 11) | 20) & 0xFu; }
#define XB_SPIN(cond, bar) do { unsigned _sp = 0; while (cond) { __builtin_amdgcn_s_sleep(1); \
    if ((++_sp & 255u) == 0u) { if (xb_ld(&(bar)[XB_TMO])) break; if (_sp > XB_SPIN_CAP) { atomicAdd(&(bar)[XB_TMO], 1u); break; } } } } while (0)
struct XcdBarrier { unsigned* bar; unsigned x; volatile LAS unsigned* st; };
__device__ __forceinline__ XcdBarrier xcd_barrier_post(unsigned* bar, volatile LAS unsigned* st) {
    XcdBarrier b; b.bar = bar; b.x = xb_xcc_id(); b.st = st;
    if (threadIdx.x == 0) (void)xb_add(&bar[XB_XCNT(b.x)], 1u);
    return b;
}
__device__ __forceinline__ void xcd_barrier_complete(unsigned* bar, unsigned x, unsigned& nloc, unsigned& nx) {
    const unsigned G = gridDim.x * gridDim.y * gridDim.z;
    unsigned sum, cnt, mine, sp = 0u;
    for (;;) {
        sum = 0u; cnt = 0u; mine = 0u;
#pragma unroll
        for (unsigned j = 0; j < 16; ++j) { const unsigned c = xb_ld(&bar[XB_XCNT(j)]); sum += c; cnt += (c > 0u) ? 1u : 0u; mine = (j == x) ? c : mine; }
        if (sum == G) break;
        __builtin_amdgcn_s_sleep(1);
        if ((++sp & 255u) == 0u) { if (xb_ld(&bar[XB_TMO])) break; if (sp > XB_SPIN_CAP) { atomicAdd(&bar[XB_TMO], 1u); break; } }
    }
    nloc = mine > 0u ? mine : 1u; nx = cnt > 0u ? cnt : 1u;
}
__device__ __forceinline__ void xcd_barrier(const XcdBarrier& b) {
    asm volatile("s_waitcnt vmcnt(0)" ::: "memory");
    __syncthreads();
    if (threadIdx.x == 0) {
        unsigned* bar = b.bar;
        __builtin_amdgcn_s_waitcnt(0);
        unsigned nloc = b.st[0], nx = b.st[1];
        if (nloc == 0u) { xcd_barrier_complete(bar, b.x, nloc, nx); b.st[0] = nloc; b.st[1] = nx; }
        const unsigned old = xb_add(&bar[XB_XSUB(b.x)], 1u);
        const unsigned gen = old / nloc;
        if (old + 1u == (gen + 1u) * nloc) {
            __builtin_amdgcn_fence(__ATOMIC_RELEASE, "agent");
            asm volatile("s_waitcnt vmcnt(0)" ::: "memory");
            const unsigned og = xb_add(&bar[XB_TOP], 1u);
            const unsigned tg = og / nx;
            if (og + 1u == (tg + 1u) * nx) xb_add(&bar[XB_TOPGEN], 1u);
            else XB_SPIN(xb_ld(&bar[XB_TOPGEN]) == tg, bar);
            __builtin_amdgcn_fence(__ATOMIC_ACQUIRE, "agent");
            xb_add(&bar[XB_XGEN(b.x)], 1u);
            asm volatile("s_waitcnt vmcnt(0)" ::: "memory");
        } else {
            XB_SPIN(xb_ld(&bar[XB_XGEN(b.x)]) == gen, bar);
            __builtin_amdgcn_fence(__ATOMIC_ACQUIRE, "agent");
            asm volatile("s_waitcnt vmcnt(0)" ::: "memory");
        }
    }
    __syncthreads();
}

struct Args { const float* in[30]; float* out; unsigned char* ws; int ph_lo, ph_hi, li, pad; };
struct Frame {
    LAS unsigned char* lds; volatile LAS unsigned* MISC; gu32* ctl;
    int tid, lane, wave, vcu, G;
    float* out; unsigned char* ws;
};
enum { I_X = 0, I_META, I_F1N, I_F1W1, I_F1W3, I_F1W2, I_MIXN, I_WIN, I_BGATE, I_DW, I_DWB, I_LNG, I_LNB, I_CPROJ, I_LRE, I_LIM, I_LDT, I_BRE, I_BIM, I_CRE, I_CIM, I_SD, I_WV, I_WG, I_WOUT, I_F2N, I_F2W1, I_F2W3, I_F2W2, I_FINN };

constexpr int CW_TKT = 32768;
__device__ __forceinline__ int wg_ticket(Frame& F, int k) {
    __syncthreads();
    if (F.tid == 0) F.MISC[16] = __hip_atomic_fetch_add((unsigned*)(F.ctl + CW_TKT + 64 * k), 1u, __ATOMIC_RELAXED, __HIP_MEMORY_SCOPE_AGENT);
    __syncthreads();
    return (int)F.MISC[16];
}
using pg8::Unit; using pg8::cvt_pk_bf16;
__device__ __forceinline__ v4u pack8(const f32x4 a, const f32x4 b) { v4u w; w.x = cvt_pk_bf16(a[0], a[1]); w.y = cvt_pk_bf16(a[2], a[3]); w.z = cvt_pk_bf16(b[0], b[1]); w.w = cvt_pk_bf16(b[2], b[3]); return w; }
__device__ __forceinline__ void unpack8(const v4u w, float (&o)[8]) { o[0] = bf2f(w.x & 0xffffu); o[1] = bf2f(w.x >> 16); o[2] = bf2f(w.y & 0xffffu); o[3] = bf2f(w.y >> 16); o[4] = bf2f(w.z & 0xffffu); o[5] = bf2f(w.z >> 16); o[6] = bf2f(w.w & 0xffffu); o[7] = bf2f(w.w >> 16); }
__device__ __forceinline__ float rs_from(float ss) { return __builtin_amdgcn_rsqf(ss * (1.0f / D) + EPS); }
__device__ __forceinline__ void load_rs8(const float* SS, int row0, float (&rs)[8]) {
#pragma unroll
    for (int i = 0; i < 8; ++i) rs[i] = SS[row0 + (i >> 2) * 128 + (i & 3) * 16];
#pragma unroll
    for (int i = 0; i < 8; ++i) rs[i] = rs_from(rs[i]);
}

struct EpiSwiglu {
    bf16* HID; const float* SS;
    __device__ __forceinline__ void operator()(const f32x4 (&acc)[2][2][4][2], const Unit& u, int wr, int wc) const {
        const int lane_ = lane_id_opaque(), fr = lane_ & 15, fq = lane_ >> 4;
        const int row0 = u.pm * 256 + wr * 64 + fr, col0 = u.pn * 128 + wc * 32 + 8 * fq;
        float rsv[8]; load_rs8(SS, row0, rsv);
#pragma unroll
        for (int ai = 0; ai < 2; ++ai)
#pragma unroll
            for (int m = 0; m < 4; ++m) { const int row = row0 + ai * 128 + m * 16; const float rs = rsv[ai * 4 + m];
                f32x4 o0, o1;
#pragma unroll
                for (int j = 0; j < 4; ++j) { o0[j] = fsilu(acc[ai][0][m][0][j] * rs) * (acc[ai][1][m][0][j] * rs); o1[j] = fsilu(acc[ai][0][m][1][j] * rs) * (acc[ai][1][m][1][j] * rs); }
                *(v4u*)(HID + (size_t)row * DFF + col0) = pack8(o0, o1); }
    }
};
template <bool RBF16> struct EpiResid {
    const void* R; bf16* OB; float* SS; float alpha;
    __device__ __forceinline__ void operator()(const f32x4 (&acc)[2][2][4][2], const Unit& u, int wr, int wc) const {
        const int lane_ = lane_id_opaque(), fr = lane_ & 15, fq = lane_ >> 4;
        const int row0 = u.pm * 256 + wr * 64 + fr, col0 = u.pn * 256 + wc * 32 + 8 * fq;
#pragma unroll
        for (int ai = 0; ai < 2; ++ai) {
            f32x4 r[4][2][2];
#pragma unroll
            for (int m = 0; m < 4; ++m)
#pragma unroll
                for (int bj = 0; bj < 2; ++bj) { const size_t off = (size_t)(row0 + ai * 128 + m * 16) * D + col0 + bj * 128;
                    if (RBF16) { const v4u w = *(const v4u*)((const bf16*)R + off); r[m][bj][0] = __builtin_bit_cast(f32x4, w); }
                    else { r[m][bj][0] = *(const f32x4*)((const float*)R + off); r[m][bj][1] = *(const f32x4*)((const float*)R + off + 4); } }
#pragma unroll
            for (int m = 0; m < 4; ++m) { const int row = row0 + ai * 128 + m * 16; float ss = 0.f;
#pragma unroll
                for (int bj = 0; bj < 2; ++bj) { const size_t off = (size_t)row * D + col0 + bj * 128; f32x4 r0, r1;
                    if (RBF16) { float t[8]; unpack8(__builtin_bit_cast(v4u, r[m][bj][0]), t); r0 = (f32x4){t[0], t[1], t[2], t[3]}; r1 = (f32x4){t[4], t[5], t[6], t[7]}; }
                    else { r0 = r[m][bj][0]; r1 = r[m][bj][1]; }
                    const f32x4 o0 = r0 + acc[ai][bj][m][0] * alpha, o1 = r1 + acc[ai][bj][m][1] * alpha;
                    *(v4u*)(OB + off) = pack8(o0, o1);
                    ss += (o0[0] * o0[0] + o0[1] * o0[1]) + (o0[2] * o0[2] + o0[3] * o0[3]) + (o1[0] * o1[0] + o1[1] * o1[1]) + (o1[2] * o1[2] + o1[3] * o1[3]); }
                ss += __shfl_xor(ss, 16); ss += __shfl_xor(ss, 32);
                if (fq == 0) atomicAdd(SS + row, ss); }
            asm volatile("" ::: "memory"); }
    }
};
struct EpiFinal {
    const bf16* R; float* OUT; float* SS; unsigned* cnt; const float* gain; float alpha;
    __device__ __forceinline__ void operator()(f32x4 (&acc)[2][2][4][2], const Unit& u, int wr, int wc) const {
        const int lane_ = lane_id_opaque(), fr = lane_ & 15, fq = lane_ >> 4;
        const int row0 = u.pm * 256 + wr * 64 + fr, col0 = u.pn * 256 + wc * 32 + 8 * fq;
#pragma unroll
        for (int ai = 0; ai < 2; ++ai) {
            v4u r[4][2];
#pragma unroll
            for (int m = 0; m < 4; ++m)
#pragma unroll
                for (int bj = 0; bj < 2; ++bj) r[m][bj] = *(const v4u*)(R + (size_t)(row0 + ai * 128 + m * 16) * D + col0 + bj * 128);
#pragma unroll
            for (int m = 0; m < 4; ++m) { const int row = row0 + ai * 128 + m * 16; float ss = 0.f;
#pragma unroll
                for (int bj = 0; bj < 2; ++bj) { float t[8]; unpack8(r[m][bj], t);
                    const f32x4 o0 = (f32x4){t[0], t[1], t[2], t[3]} + acc[ai][bj][m][0] * alpha, o1 = (f32x4){t[4], t[5], t[6], t[7]} + acc[ai][bj][m][1] * alpha;
                    acc[ai][bj][m][0] = o0; acc[ai][bj][m][1] = o1;
                    ss += (o0[0] * o0[0] + o0[1] * o0[1]) + (o0[2] * o0[2] + o0[3] * o0[3]) + (o1[0] * o1[0] + o1[1] * o1[1]) + (o1[2] * o1[2] + o1[3] * o1[3]); }
                ss += __shfl_xor(ss, 16); ss += __shfl_xor(ss, 32);
                if (fq == 0) atomicAdd(SS + row, ss); }
            asm volatile("" ::: "memory"); }
        asm volatile("s_waitcnt vmcnt(0)" ::: "memory");
        unsigned* cw = cnt + 64 * u.pm;
        if (lane_ == 0) __hip_atomic_fetch_add(cw, 1u, __ATOMIC_RELAXED, __HIP_MEMORY_SCOPE_AGENT);
        f32x4 g[2][2];
#pragma unroll
        for (int bj = 0; bj < 2; ++bj) { g[bj][0] = *(const f32x4*)(gain + col0 + bj * 128); g[bj][1] = *(const f32x4*)(gain + col0 + bj * 128 + 4); }
        { unsigned sp = 0; while ((unsigned)__builtin_amdgcn_readfirstlane((int)__hip_atomic_load(cw, __ATOMIC_RELAXED, __HIP_MEMORY_SCOPE_AGENT)) < 32u) { __builtin_amdgcn_s_sleep(2); if (++sp > (1u << 20)) break; } }
        float tot[8];
#pragma unroll
        for (int i = 0; i < 8; ++i) { tot[i] = 0.f; if (fq == 0) tot[i] = __hip_atomic_fetch_add(SS + row0 + (i >> 2) * 128 + (i & 3) * 16, 0.0f, __ATOMIC_RELAXED, __HIP_MEMORY_SCOPE_AGENT); }
#pragma unroll
        for (int ai = 0; ai < 2; ++ai)
#pragma unroll
            for (int m = 0; m < 4; ++m) { const int row = row0 + ai * 128 + m * 16;
                const float rs = rs_from(__shfl(tot[ai * 4 + m], fr));
#pragma unroll
                for (int bj = 0; bj < 2; ++bj) { const size_t off = (size_t)row * D + col0 + bj * 128;
                    *(f32x4*)(OUT + off) = acc[ai][bj][m][0] * rs * g[bj][0]; *(f32x4*)(OUT + off + 4) = acc[ai][bj][m][1] * rs * g[bj][1]; } }
    }
};
struct EpiMix {
    const float* SS; bf16* Z; bf16* UX; bf16* G; const float* bgate;
    __device__ __forceinline__ void operator()(const f32x4 (&acc)[2][2][4][2], const Unit& u, int wr, int wc) const {
        const int lane_ = lane_id_opaque(), fr = lane_ & 15, fq = lane_ >> 4;
        const int row0 = u.pm * 256 + wr * 64 + fr;
        if (u.pn < 4) {
            const int col0 = u.pn * 128 + wc * 32 + 8 * fq;
#pragma unroll
            for (int ai = 0; ai < 2; ++ai)
#pragma unroll
                for (int m = 0; m < 4; ++m) { const int row = row0 + ai * 128 + m * 16; const float rs = rs_from(SS[row]); f32x4 o0, o1;
#pragma unroll
                    for (int j = 0; j < 4; ++j) { o0[j] = (acc[ai][0][m][0][j] * rs) * fsigmoid(acc[ai][1][m][0][j] * rs); o1[j] = (acc[ai][0][m][1][j] * rs) * fsigmoid(acc[ai][1][m][1][j] * rs); }
                    *(v4u*)(Z + (size_t)row * DCONV + col0) = pack8(o0, o1); }
        } else if (u.pn < 6) {
#pragma unroll
            for (int ai = 0; ai < 2; ++ai)
#pragma unroll
                for (int m = 0; m < 4; ++m) { const int row = row0 + ai * 128 + m * 16; const float rs = rs_from(SS[row]); const int ci = row >> 4, tt = row & 15;
#pragma unroll
                    for (int bj = 0; bj < 2; ++bj) { const int c = (u.pn - 4) * 256 + bj * 128 + wc * 32 + 8 * fq, g = c >> 4, h0 = c & 15;
                        *(v4u*)(UX + ((size_t)(g * (NCH + 1) + ci) * UXK + tt * 16 + h0)) = pack8(acc[ai][bj][m][0] * rs, acc[ai][bj][m][1] * rs); } }
        } else {
#pragma unroll
            for (int bj = 0; bj < 2; ++bj) { const int c = (u.pn - 6) * 256 + bj * 128 + wc * 32 + 8 * fq;
                const f32x4 b0 = *(const f32x4*)(bgate + c), b1 = *(const f32x4*)(bgate + c + 4);
#pragma unroll
                for (int ai = 0; ai < 2; ++ai)
#pragma unroll
                    for (int m = 0; m < 4; ++m) { const int row = row0 + ai * 128 + m * 16; const float rs = rs_from(SS[row]); f32x4 o0, o1;
#pragma unroll
                        for (int j = 0; j < 4; ++j) { o0[j] = fsigmoid(acc[ai][bj][m][0][j] * rs + b0[j]); o1[j] = fsigmoid(acc[ai][bj][m][1][j] * rs + b1[j]); }
                        *(v4u*)(G + (size_t)row * 2048 + c) = pack8(o0, o1); } }
        }
    }
};
struct EpiSsmY {
    const bf16* UX; const float* dskip; bf16* Y;
    __device__ __forceinline__ void operator()(const f32x4 (&acc)[2][2][4][2], const Unit& u, int wr, int wc) const {
        const int lane_ = lane_id_opaque(), fr = lane_ & 15, fq = lane_ >> 4;
        const int b = u.pm, g = u.pn, h0 = 8 * (fq & 1);
        const f32x4 d0 = *(const f32x4*)(dskip + g * 16 + h0), d1 = *(const f32x4*)(dskip + g * 16 + h0 + 4);
#pragma unroll
        for (int ai = 0; ai < 2; ++ai) {
            v4u uw[4][2];
#pragma unroll
            for (int m = 0; m < 4; ++m)
#pragma unroll
                for (int bj = 0; bj < 2; ++bj) { const int r = ai * 128 + wr * 64 + m * 16 + fr, tt = 8 * bj + 2 * wc + (fq >> 1);
                    uw[m][bj] = *(const v4u*)(UX + ((size_t)(g * (NCH + 1) + b * 256 + r) * UXK + tt * 16 + h0)); }
#pragma unroll
            for (int m = 0; m < 4; ++m) { const int r = ai * 128 + wr * 64 + m * 16 + fr;
#pragma unroll
                for (int bj = 0; bj < 2; ++bj) { const int tt = 8 * bj + 2 * wc + (fq >> 1);
                    float uu[8]; unpack8(uw[m][bj], uu);
                    f32x4 o0, o1;
#pragma unroll
                    for (int j = 0; j < 4; ++j) { o0[j] = fgelu_tanh(acc[ai][bj][m][0][j] + d0[j] * uu[j]); o1[j] = fgelu_tanh(acc[ai][bj][m][1][j] + d1[j] * uu[4 + j]); }
                    *(v4u*)(Y + ((size_t)(b * SEQ + r * 16 + tt) * DSSM + g * 16 + h0)) = pack8(o0, o1); } }
            asm volatile("" ::: "memory"); }
    }
};
struct EpiMerge {
    const bf16* G; bf16* MC; bf16* MG;
    __device__ __forceinline__ void operator()(const f32x4 (&acc)[2][2][4][2], const Unit& u, int wr, int wc) const {
        const int lane_ = lane_id_opaque(), fr = lane_ & 15, fq = lane_ >> 4;
        const int row0 = u.pm * 256 + wr * 64 + fr;
        if (u.kind == 0) {
#pragma unroll
            for (int ai = 0; ai < 2; ++ai) {
                v4u gw[4][2];
#pragma unroll
                for (int m = 0; m < 4; ++m)
#pragma unroll
                    for (int bj = 0; bj < 2; ++bj) gw[m][bj] = *(const v4u*)(G + (size_t)(row0 + ai * 128 + m * 16) * 2048 + u.pn * 256 + bj * 128 + wc * 32 + 8 * fq);
#pragma unroll
                for (int m = 0; m < 4; ++m) { const int row = row0 + ai * 128 + m * 16;
#pragma unroll
                    for (int bj = 0; bj < 2; ++bj) { const int c = u.pn * 256 + bj * 128 + wc * 32 + 8 * fq;
                        float gg[8]; unpack8(gw[m][bj], gg); f32x4 o0, o1;
#pragma unroll
                        for (int j = 0; j < 4; ++j) { o0[j] = gg[j] * acc[ai][bj][m][0][j]; o1[j] = gg[4 + j] * acc[ai][bj][m][1][j]; }
                        *(v4u*)(MC + (size_t)row * D + c) = pack8(o0, o1); } }
                asm volatile("" ::: "memory"); }
        } else {
            const int c = u.pn * 256 + (u.kind - 1) * 128 + wc * 32 + 8 * fq;
#pragma unroll
            for (int ai = 0; ai < 2; ++ai) {
                v4u gw[4], mw[4];
#pragma unroll
                for (int m = 0; m < 4; ++m) { const int row = row0 + ai * 128 + m * 16; gw[m] = *(const v4u*)(G + (size_t)row * 2048 + D + c); mw[m] = *(const v4u*)(MC + (size_t)row * D + c); }
#pragma unroll
                for (int m = 0; m < 4; ++m) { const int row = row0 + ai * 128 + m * 16;
                    float gg[8], mc[8]; unpack8(gw[m], gg); unpack8(mw[m], mc); f32x4 o0, o1;
#pragma unroll
                    for (int j = 0; j < 4; ++j) { o0[j] = mc[j] + gg[j] * (acc[ai][0][m][0][j] * fsigmoid(acc[ai][1][m][0][j])); o1[j] = mc[4 + j] + gg[4 + j] * (acc[ai][0][m][1][j] * fsigmoid(acc[ai][1][m][1][j])); }
                    *(v4u*)(MG + (size_t)row * D + c) = pack8(o0, o1); }
                asm volatile("" ::: "memory"); }
        }
    }
};
struct SsmOrder {
    int G, c; const char* UX; const char* BS2;
    __device__ __forceinline__ bool next(int i, Unit& u) const { const int L = i * G + c; if (L >= BATCH * NG) return false; const int b = L / NG, g = L % NG; u.pm = b; u.pn = g; u.kind = 0;
        u.A = UX + ((size_t)(g * (NCH + 1) + b * 256) * UXK) * 2; u.B = BS2 + (size_t)g * 256 * UXK * 2; return true; }
    __device__ __forceinline__ void a_ready(const Unit&) const {}
    __device__ __forceinline__ void done(const Unit&) const {}
};
struct MergeOrder {
    int G, c; const char* ZC; const char* Y; const char* WCAT;
    __device__ __forceinline__ bool next(int i, Unit& u) const { int pm, pn; const int su = i / 3, k = i - 3 * su; if (!pg8::static_tile(su, G, c, M / 256, D / 256, W_MG, pm, pn)) return false; u.pm = pm; u.pn = pn; u.kind = k;
        u.A = (k == 0 ? ZC : Y) + (size_t)pm * 256 * 512 * 2; u.B = WCAT + (size_t)(k == 0 ? pn * 256 : 1024 + (2 * pn + k - 1) * 256) * 512 * 2; return true; }
    __device__ __forceinline__ void a_ready(const Unit&) const {}
    __device__ __forceinline__ void done(const Unit& u) const { if (u.kind == 0) asm volatile("s_waitcnt vmcnt(0)" ::: "memory"); }
};

__device__ __forceinline__ void p0_transpose_item(const float* W, int K, int N, bf16* WT, const float* gain, LAS float* scr, int k0, int n0, int drow0, int lane) {
    float v[32];
    const float* src = W + (size_t)(k0 + (lane >> 5)) * N + n0 + (lane & 31);
#pragma unroll
    for (int i = 0; i < 32; ++i) v[i] = src[(size_t)(2 * i) * N];
#pragma unroll
    for (int i = 0; i < 32; ++i) scr[(2 * i + (lane >> 5)) * 33 + (lane & 31)] = v[i];
    LDS_WAIT(); asm volatile("" ::: "memory");
    const int c = lane & 7;
    f32x4 g0 = (f32x4){1.f, 1.f, 1.f, 1.f}, g1 = g0; if (gain) { g0 = *(const f32x4*)(gain + k0 + 8 * c); g1 = *(const f32x4*)(gain + k0 + 8 * c + 4); }
#pragma unroll
    for (int j = 0; j < 4; ++j) { const int n = (lane >> 3) + 8 * j; const LAS float* s = scr + (8 * c) * 33 + n;
        v4u o; o.x = pk2(s[0 * 33] * g0[0], s[1 * 33] * g0[1]); o.y = pk2(s[2 * 33] * g0[2], s[3 * 33] * g0[3]); o.z = pk2(s[4 * 33] * g1[0], s[5 * 33] * g1[1]); o.w = pk2(s[6 * 33] * g1[2], s[7 * 33] * g1[3]);
        *(GAS v4u*)(WT + (size_t)(drow0 + n) * K + k0 + 8 * c) = o; }
    LDS_WAIT(); asm volatile("" ::: "memory");
}
__device__ __forceinline__ int glu_row(int n) { return 256 * (n >> 7) + (n & 127); }

constexpr int I_UP = (D / 64) * (DFF / 32), I_DN = (DFF / 64) * (D / 32), I_INP = (D / 64) * (DIN / 32), I_CP = (DCONV / 64) * (D / 32), I_WO = (D / 64) * (D / 32);
constexpr int T_W13A = 2 * I_UP, T_W2A = T_W13A + I_DN, T_WIN = T_W2A + I_INP, T_WCAT = T_WIN + 3 * I_CP, T_WOUT = T_WCAT + I_WO, T_W13B = T_WOUT + 2 * I_UP, T_W2B = T_W13B + I_DN;
__device__ __forceinline__ void weight_item(const Args& args, unsigned char* ws, LAS float* scr, int it, int lane) {
    if (it < T_W13A || (it >= T_WOUT && it < T_W13B)) { const bool second = it >= T_WOUT; int r = it - (second ? T_WOUT : 0); const int which = r / I_UP; r -= which * I_UP; const int nblk = DFF / 32, k0 = 64 * (r / nblk), n0 = 32 * (r % nblk);
        const float* W = second ? (which ? args.in[I_F2W3] : args.in[I_F2W1]) : (which ? args.in[I_F1W3] : args.in[I_F1W1]);
        p0_transpose_item(W, D, DFF, (bf16*)(ws + (second ? WS_W13B : WS_W13A)), second ? args.in[I_F2N] : args.in[I_F1N], scr, k0, n0, glu_row(n0) + which * 128, lane); return; }
    if (it < T_W2A || it >= T_W13B) { const bool second = it >= T_W13B; const int r = it - (second ? T_W13B : T_W13A); const int nblk = D / 32, k0 = 64 * (r / nblk), n0 = 32 * (r % nblk);
        p0_transpose_item(second ? args.in[I_F2W2] : args.in[I_F1W2], DFF, D, (bf16*)(ws + (second ? WS_W2B : WS_W2A)), nullptr, scr, k0, n0, n0, lane); return; }
    if (it < T_WIN) { const int r = it - T_W2A; const int nblk = DIN / 32, k0 = 64 * (r / nblk), n0 = 32 * (r % nblk);
        const int dr = n0 < 512 ? glu_row(n0) : n0 < 1024 ? glu_row(n0 - 512) + 128 : n0;
        p0_transpose_item(args.in[I_WIN], D, DIN, (bf16*)(ws + WS_WIN), args.in[I_MIXN], scr, k0, n0, dr, lane); return; }
    if (it < T_WCAT) { int r = it - T_WIN; const int which = r / I_CP; r -= which * I_CP; const int nblk = D / 32, k0 = 64 * (r / nblk), n0 = 32 * (r % nblk);
        const int dr = which == 0 ? n0 : 1024 + glu_row(n0) + (which == 2 ? 128 : 0);
        p0_transpose_item(which == 0 ? args.in[I_CPROJ] : which == 1 ? args.in[I_WV] : args.in[I_WG], DCONV, D, (bf16*)(ws + WS_WCAT), nullptr, scr, k0, n0, dr, lane); return; }
    { const int r = it - T_WCAT; const int nblk = D / 32, k0 = 64 * (r / nblk), n0 = 32 * (r % nblk); p0_transpose_item(args.in[I_WOUT], D, D, (bf16*)(ws + WS_WOUT), nullptr, scr, k0, n0, n0, lane); }
}

__device__ __forceinline__ void ssm_prep_job(Frame& F, const Args& args, int g) {
    LAS f32x2* lamP = (LAS f32x2*)(F.lds + RING_OFF);
    LAS f32x2* Bb = lamP + 17 * 64;
    LAS f32x2* Cc = Bb + 64 * 16;
    LAS float* Kk = (LAS float*)(Cc + 16 * 64);
    const float* lam_re = args.in[I_LRE]; const float* lam_im = args.in[I_LIM]; const float* log_dt = args.in[I_LDT];
    const float* b_re = args.in[I_BRE]; const float* b_im = args.in[I_BIM]; const float* c_re = args.in[I_CRE]; const float* c_im = args.in[I_CIM];
    const int tid = F.tid;
    const float dt = expf(log_dt[g]);
    if (tid < 64) { const int p = tid; const float a = lam_re[g * PS + p] * dt, bb = lam_im[g * PS + p] * dt, ea = expf(a), sb = sinf(bb), cb = cosf(bb);
        const float lx = ea * cb, ly = ea * sb; float px = 1.f, py = 0.f;
        for (int k = 0; k <= 16; ++k) { lamP[k * 64 + p] = (f32x2){px, py}; const float nx = px * lx - py * ly, ny = px * ly + py * lx; px = nx; py = ny; } }
    for (int i = tid; i < 1024; i += 512) { const int p = i >> 4;
        const float lr = lam_re[g * PS + p], li = lam_im[g * PS + p], a = lr * dt, bb = li * dt, ea = expf(a), sb = sinf(bb), cb = cosf(bb), sh = sinf(0.5f * bb);
        const float nr = expm1f(a) * cb - 2.f * sh * sh, ni = ea * sb, den = 1.f / (lr * lr + li * li), fr_ = (nr * lr + ni * li) * den, fi_ = (ni * lr - nr * li) * den;
        const float br = b_re[(size_t)g * 1024 + i], bi = b_im[(size_t)g * 1024 + i];
        Bb[i] = (f32x2){fr_ * br - fi_ * bi, fr_ * bi + fi_ * br};
        Cc[i] = (f32x2){c_re[(size_t)g * 1024 + i], c_im[(size_t)g * 1024 + i]}; }
    __syncthreads();
    {
        const int k = tid >> 5, h = (tid >> 1) & 15, hh = (tid & 1) * 8; float sum[8];
#pragma unroll
        for (int j = 0; j < 8; ++j) sum[j] = 0.f;
#pragma unroll 4
        for (int p = 0; p < 64; ++p) { const f32x2 c = Cc[h * 64 + p], l = lamP[k * 64 + p]; const float er = c.x * l.x - c.y * l.y, ei = c.x * l.y + c.y * l.x;
#pragma unroll
            for (int j = 0; j < 8; j += 2) { const f32x4 bb = *(const LAS f32x4*)(Bb + p * 16 + hh + j); sum[j] += er * bb[0] - ei * bb[1]; sum[j + 1] += er * bb[2] - ei * bb[3]; } }
#pragma unroll
        for (int j = 0; j < 8; ++j) Kk[(k << 8) + (h << 4) + hh + j] = sum[j];
    }
    __syncthreads();
    GAS unsigned* bs2 = (GAS unsigned*)(F.ws + WS_BS2) + (size_t)g * 256 * (UXK / 2);
    for (int i = tid; i < 256 * (UXK / 2); i += 512) { const int n = i / (UXK / 2), kp = (i % (UXK / 2)) * 2, t = n >> 4, h = n & 15; float v0, v1;
        if (kp < 256) { const int s = kp >> 4, hp = kp & 15; const bool on = s <= t; const int kb = (((t - s) & 15) << 8) + (h << 4) + hp; v0 = on ? Kk[kb] : 0.f; v1 = on ? Kk[kb + 1] : 0.f; }
        else { const int p = (kp - 256) >> 1; const f32x2 c = Cc[h * 64 + p], l = lamP[(t + 1) * 64 + p]; v0 = c.x * l.x - c.y * l.y; v1 = -(c.x * l.y + c.y * l.x); }
        bs2[i] = pk2(v0, v1); }
    GAS unsigned* wsi = (GAS unsigned*)(F.ws + WS_WSI) + (size_t)g * 128 * 128;
    for (int i = tid; i < 128 * 128; i += 512) { const int n = i >> 7, kp = (i & 127) * 2, p = n >> 1, c = n & 1, s = kp >> 4, h = kp & 15;
        const f32x2 l = lamP[(15 - s) * 64 + p], b0 = Bb[p * 16 + h], b1 = Bb[p * 16 + h + 1];
        const float v0 = c ? (l.x * b0.y + l.y * b0.x) : (l.x * b0.x - l.y * b0.y), v1 = c ? (l.x * b1.y + l.y * b1.x) : (l.x * b1.x - l.y * b1.y);
        wsi[i] = pk2(v0, v1); }
    if (tid < 64) ((GAS f32x2*)(F.ws + WS_LAMC))[g * 64 + tid] = lamP[16 * 64 + tid];
    __syncthreads();
}

template <int NS, bool NORM, class Fn>
__device__ __forceinline__ void meta_job(Frame& F, const float* A, int K, const bf16* Bt0, const bf16* Bt1, const Fn& fn) {
    LAS float* red = (LAS float*)(F.lds + RING_OFF);
    LAS float* rsc = red + 8 * 16 * 32;
    const int lane = F.lane, w = F.wave, fr = lane & 15, fq = lane >> 4;
    if (NORM) {
#pragma unroll
        for (int rr = 0; rr < 2; ++rr) { const int row = 2 * w + rr; float s = 0.f; for (int c = lane; c < D; c += 64) { const float v = A[(size_t)row * K + c]; s += v * v; } s = wave_sum(s); if (lane == 0) rsc[row] = 1.0f / sqrtf(s * (1.0f / D) + EPS); }
    } else if (F.tid < 16) rsc[F.tid] = 1.f;
    f32x4 acc[NS];
#pragma unroll
    for (int s = 0; s < NS; ++s) acc[s] = (f32x4){0.f, 0.f, 0.f, 0.f};
    const int kw = K / 8, kbase = w * kw;
#pragma unroll 4
    for (int k = kbase; k < kbase + kw; k += 32) {
        const f32x4 a0 = *(const f32x4*)(A + (size_t)fr * K + k + 8 * fq), a1 = *(const f32x4*)(A + (size_t)fr * K + k + 8 * fq + 4);
        const v4u ap = pack8(a0, a1); const bf16x8 af = __builtin_bit_cast(bf16x8, ap);
#pragma unroll
        for (int s = 0; s < NS; ++s) { const bf16x8 bf = *(const bf16x8*)((s == 0 ? Bt0 : Bt1) + (size_t)fr * K + k + 8 * fq); acc[s] = __builtin_amdgcn_mfma_f32_16x16x32_bf16(bf, af, acc[s], 0, 0, 0); } }
#pragma unroll
    for (int s = 0; s < NS; ++s) *(LAS f32x4*)(red + (w * 16 + fr) * 32 + s * 16 + 4 * fq) = acc[s];
    __syncthreads();
    if (F.tid < 256) { const int rr = F.tid >> 4, j = F.tid & 15; float v0 = 0.f, v1 = 0.f;
#pragma unroll
        for (int ww = 0; ww < 8; ++ww) { v0 += red[(ww * 16 + rr) * 32 + j]; if (NS > 1) v1 += red[(ww * 16 + rr) * 32 + 16 + j]; }
        const float sc = rsc[rr]; fn(rr, j, v0 * sc, v1 * sc); }
    __syncthreads();
}

constexpr int WSI_PITCH = 528;
constexpr int SMETA_OFF = LDSCTL_OFF + 1024;
__device__ __forceinline__ void ssm_pre_job(Frame& F, int b, int g) {
    const int lane = F.lane, w = F.wave, tid = F.tid, fr = lane & 15, fq = lane >> 4;
    LAS unsigned char* Bl = F.lds + RING_OFF;
    LAS f32x2* Sl = (LAS f32x2*)(F.lds + RING_OFF);
    LAS float* smeta = (LAS float*)(F.lds + SMETA_OFF);
    bf16* UX = (bf16*)(F.ws + WS_UX); const bf16* Wg = (const bf16*)(F.ws + WS_WSI) + (size_t)g * 128 * 256;
    { v4u v[8];
#pragma unroll
      for (int i = 0; i < 8; ++i) { const int idx = tid + 512 * i; v[i] = *(const v4u*)(Wg + (size_t)(idx >> 5) * 256 + (idx & 31) * 8); }
#pragma unroll
      for (int i = 0; i < 8; ++i) { const int idx = tid + 512 * i; *(LAS v4u*)(Bl + (idx >> 5) * WSI_PITCH + (idx & 31) * 16) = v[i]; } }
    const bf16* Ab = UX + (size_t)(g * (NCH + 1) + 256 * b + 32 * w) * UXK;
    bf16x8 a[2][8], am[8];
#pragma unroll
    for (int mt = 0; mt < 2; ++mt)
#pragma unroll
        for (int ks = 0; ks < 8; ++ks) a[mt][ks] = *(const bf16x8*)(Ab + (size_t)(16 * mt + fr) * UXK + 32 * ks + 8 * fq);
    if (w == 7) {
#pragma unroll
        for (int ks = 0; ks < 8; ++ks) am[ks] = *(const bf16x8*)(UX + (size_t)(g * (NCH + 1) + NCH) * UXK + 32 * ks + 8 * fq); }
    f32x4 acc[2][8], accm[8];
#pragma unroll
    for (int nt = 0; nt < 8; ++nt) { acc[0][nt] = (f32x4){0.f, 0.f, 0.f, 0.f}; acc[1][nt] = acc[0][nt]; accm[nt] = acc[0][nt]; }
    __syncthreads();
#pragma unroll
    for (int ks = 0; ks < 8; ++ks)
#pragma unroll
        for (int nt = 0; nt < 8; ++nt) { const bf16x8 bfr = *(const LAS bf16x8*)(Bl + (16 * nt + fr) * WSI_PITCH + (32 * ks + 8 * fq) * 2);
            acc[0][nt] = __builtin_amdgcn_mfma_f32_16x16x32_bf16(bfr, a[0][ks], acc[0][nt], 0, 0, 0); acc[1][nt] = __builtin_amdgcn_mfma_f32_16x16x32_bf16(bfr, a[1][ks], acc[1][nt], 0, 0, 0);
            if (w == 7) accm[nt] = __builtin_amdgcn_mfma_f32_16x16x32_bf16(bfr, am[ks], accm[nt], 0, 0, 0); }
    __syncthreads();
#pragma unroll
    for (int mt = 0; mt < 2; ++mt)
#pragma unroll
        for (int nt = 0; nt < 8; ++nt) *(LAS f32x4*)(Sl + (32 * w + 16 * mt + fr) * 64 + 8 * nt + 2 * fq) = acc[mt][nt];
    if (w == 7 && fr == 0) {
#pragma unroll
        for (int nt = 0; nt < 8; ++nt) *(LAS f32x4*)(smeta + 16 * nt + 4 * fq) = accm[nt]; }
    __syncthreads();
    { const f32x2 lc = ((const f32x2*)(F.ws + WS_LAMC))[g * 64 + lane];
      LAS f32x2* Ew = (LAS f32x2*)(F.lds + SMETA_OFF + 512);
      f32x2 l = (f32x2){0.f, 0.f};
#pragma unroll 8
      for (int k = 0; k < 32; ++k) { LAS f32x2* sp = Sl + (32 * w + k) * 64 + lane; const f32x2 sv = *sp; *sp = l; const float nx = lc.x * l.x - lc.y * l.y + sv.x, ny = lc.x * l.y + lc.y * l.x + sv.y; l.x = nx; l.y = ny; }
      Ew[w * 64 + lane] = l;
      f32x2 l32 = lc;
#pragma unroll
      for (int q = 0; q < 5; ++q) { const float nx = l32.x * l32.x - l32.y * l32.y, ny = 2.f * l32.x * l32.y; l32.x = nx; l32.y = ny; }
      __syncthreads();
      f32x2 X = *(const LAS f32x2*)(smeta + 2 * lane);
      for (int v = 0; v < w; ++v) { const f32x2 e = Ew[v * 64 + lane]; const float nx = l32.x * X.x - l32.y * X.y + e.x, ny = l32.x * X.y + l32.y * X.x + e.y; X.x = nx; X.y = ny; }
      unsigned* xp = (unsigned*)(UX + (size_t)(g * (NCH + 1) + b * 256 + 32 * w) * UXK + 256) + lane;
      f32x2 pw = X;
#pragma unroll 8
      for (int k = 0; k < 32; ++k) { const f32x2 lv = Sl[(32 * w + k) * 64 + lane]; xp[(size_t)k * (UXK / 2)] = cvt_pk_bf16(pw.x + lv.x, pw.y + lv.y); const float nx = lc.x * pw.x - lc.y * pw.y, ny = lc.x * pw.y + lc.y * pw.x; pw.x = nx; pw.y = ny; }
      VM_WAIT(); }
    __syncthreads();
}

__device__ __forceinline__ void conv_worker(Frame& F, const Args& args, int wi) {
    LAS unsigned char* zs = F.lds + RING_OFF;
    LAS float* cs = (LAS float*)(F.lds + RING_OFF + 65536);
    const bf16* Z = (const bf16*)(F.ws + WS_Z); bf16* ZC = (bf16*)(F.ws + WS_ZC);
    const int tid = F.tid, lane = F.lane, w = F.wave, b = wi >> 5, T0 = (wi & 31) * 128;
    auto zrow = [&](int ti, int cb) -> v4u { v4u v = (v4u){0u, 0u, 0u, 0u};
        if (ti >= 0) v = *(const v4u*)((const char*)Z + (size_t)(b * SEQ + ti) * 1024 + cb); else if (ti >= -NMETA) v = *(const v4u*)((const char*)Z + (size_t)(M + NMETA + ti) * 1024 + cb); return v; };
    { v4u v[8];
#pragma unroll
      for (int it = 0; it < 8; ++it) { const int q = tid + 512 * it; v[it] = (v4u){0u, 0u, 0u, 0u}; if (q < 62 * 64) v[it] = zrow(T0 - 30 + (q >> 6), (q & 63) * 16); }
#pragma unroll
      for (int it = 0; it < 8; ++it) { const int q = tid + 512 * it; if (q < 62 * 64) *(LAS v4u*)(zs + (((q >> 6) + 2) & 63) * 1024 + (q & 63) * 16) = v[it]; } }
    const int cp = tid & 255, th = tid >> 8;
    const float* dw = args.in[I_DW]; f32x2 wgt[CWID];
#pragma unroll
    for (int k = 0; k < CWID; ++k) wgt[k] = *(const f32x2*)(dw + k * DCONV + 2 * cp);
    const f32x2 bias = *(const f32x2*)(args.in[I_DWB] + 2 * cp);
    const f32x4 g0 = *(const f32x4*)(args.in[I_LNG] + 4 * lane), g1 = *(const f32x4*)(args.in[I_LNG] + 256 + 4 * lane), b0 = *(const f32x4*)(args.in[I_LNB] + 4 * lane), b1 = *(const f32x4*)(args.in[I_LNB] + 256 + 4 * lane);
#pragma unroll 1
    for (int j = 0; j < 4; ++j) {
        __syncthreads();
#pragma unroll 1
        for (int hf = 0; hf < 2; ++hf) {
            f32x2 acc[8];
#pragma unroll
            for (int t = 0; t < 8; ++t) acc[t] = bias;
            const int base = 32 * j + 16 * th + 8 * hf + 2;
#pragma unroll
            for (int i = 0; i < 38; ++i) { const unsigned zz = *(const LAS unsigned*)(zs + (((base + i) & 63) << 10) + 4 * cp); const float z0 = bf2f(zz & 0xffffu), z1 = bf2f(zz >> 16);
#pragma unroll
                for (int t = 0; t < 8; ++t) { const int k = i - t; if (k >= 0 && k < CWID) { acc[t].x += wgt[k].x * z0; acc[t].y += wgt[k].y * z1; } } }
#pragma unroll
            for (int t = 0; t < 8; ++t) *(LAS f32x2*)(cs + (16 * th + 8 * hf + t) * 512 + 2 * cp) = acc[t];
        }
        __syncthreads();
        v4u nx[4];
        if (j < 3) {
#pragma unroll
            for (int it = 0; it < 4; ++it) { const int q = tid + 512 * it; nx[it] = zrow(T0 + 32 * j + 32 + (q >> 6), (q & 63) * 16); } }
#pragma unroll
        for (int q = 0; q < 4; ++q) { const int t = 4 * w + q; const f32x4 x0 = *(const LAS f32x4*)(cs + t * 512 + 4 * lane), x1 = *(const LAS f32x4*)(cs + t * 512 + 256 + 4 * lane);
            const float mu = wave_sum((x0[0] + x0[1]) + (x0[2] + x0[3]) + (x1[0] + x1[1]) + (x1[2] + x1[3])) * (1.f / DCONV);
            const f32x4 d0 = x0 - mu, d1 = x1 - mu;
            const float var = wave_sum((d0[0] * d0[0] + d0[1] * d0[1]) + (d0[2] * d0[2] + d0[3] * d0[3]) + (d1[0] * d1[0] + d1[1] * d1[1]) + (d1[2] * d1[2] + d1[3] * d1[3])) * (1.f / DCONV);
            const float rstd = __builtin_amdgcn_rsqf(var + EPS); f32x4 o0 = d0 * rstd * g0 + b0, o1 = d1 * rstd * g1 + b1;
#pragma unroll
            for (int jj = 0; jj < 4; ++jj) { o0[jj] = fsilu(o0[jj]); o1[jj] = fsilu(o1[jj]); }
            bf16* zr = ZC + (size_t)(b * SEQ + T0 + 32 * j + t) * DCONV;
            *(v2u*)(zr + 4 * lane) = (v2u){cvt_pk_bf16(o0[0], o0[1]), cvt_pk_bf16(o0[2], o0[3])}; *(v2u*)(zr + 256 + 4 * lane) = (v2u){cvt_pk_bf16(o1[0], o1[1]), cvt_pk_bf16(o1[2], o1[3])}; }
        if (j < 3) {
#pragma unroll
            for (int it = 0; it < 4; ++it) { const int q = tid + 512 * it; *(LAS v4u*)(zs + ((32 * j + 64 + (q >> 6)) & 63) * 1024 + (q & 63) * 16) = nx[it]; } }
    }
    __syncthreads();
}

__global__ void __launch_bounds__(NWAVES * 64, 2) hyb_fwd(Args args) {
    extern __shared__ __attribute__((aligned(16))) unsigned char lds[];
    Frame F;
    F.lds = (LAS unsigned char*)lds; F.MISC = (volatile LAS unsigned*)(F.lds + MISC_OFF);
    F.wave = __builtin_amdgcn_readfirstlane((int)threadIdx.x >> 6); F.lane = lane_id_opaque(); F.tid = F.wave * 64 + F.lane;
    F.G = gridDim.x; { const int bx = blockIdx.x; F.vcu = (F.G % 8 == 0) ? (bx % 8) * (F.G / 8) + bx / 8 : bx; }
    F.ws = args.ws; F.out = args.out; F.ctl = (gu32*)(args.ws + WS_CTL);
    for (int u = F.tid; u < (LDS_BYTES - LDSCTL_OFF) / 4; u += NWAVES * 64) ((LAS unsigned*)(F.lds + LDSCTL_OFF))[u] = 0u;
    __syncthreads();
    const int bli = (N_LAUNCHES == PER_PHASE) ? 0 : args.li;
    XcdBarrier bar; bar.bar = (unsigned*)(F.ctl + CW_BAR) + bli * XCD_BAR_WORDS; bar.x = 0; bar.st = nullptr;
    if (N_LAUNCHES != PER_PHASE) bar = xcd_barrier_post((unsigned*)(F.ctl + CW_BAR) + bli * XCD_BAR_WORDS, F.MISC + 8);
    const int lo = args.ph_lo, hi = args.ph_hi;
#ifndef PHMASK
#define PHMASK 0x7ff
#endif
#define IN(k) (((PHMASK >> (k)) & 1) && lo <= (k) && (k) < hi)
#define SEAM(k) do { if (IN(k) && IN((k) + 1)) xcd_barrier(bar); F.lane = lane_id_opaque(); F.tid = F.wave * 64 + F.lane; } while (0)
    unsigned char* ws = F.ws;
    bf16* W13A = (bf16*)(ws + WS_W13A); bf16* W2A = (bf16*)(ws + WS_W2A); bf16* WIN = (bf16*)(ws + WS_WIN); bf16* WCAT = (bf16*)(ws + WS_WCAT); bf16* WOUT = (bf16*)(ws + WS_WOUT);
    bf16* W13B = (bf16*)(ws + WS_W13B); bf16* W2B = (bf16*)(ws + WS_W2B);
    bf16* AB = (bf16*)(ws + WS_AB); bf16* H1B = (bf16*)(ws + WS_H1); bf16* H2B = (bf16*)(ws + WS_H1 + 32 * MiB); bf16* HID = (bf16*)(ws + WS_HID);
    bf16* Zb = (bf16*)(ws + WS_Z); bf16* UXb = (bf16*)(ws + WS_UX); bf16* ZCb = (bf16*)(ws + WS_ZC); bf16* Yb = (bf16*)(ws + WS_Y); bf16* MCb = (bf16*)(ws + WS_MC);
    float* SS0 = (float*)(ws + WS_SS0); float* SS1 = SS0 + M; float* SS2 = SS1 + M; float* SS3 = SS2 + M;
    float* HIDM = (float*)(ws + WS_HIDM); float* H1M = (float*)(ws + WS_H1M);
    bf16* Gb = (bf16*)F.out;
    const int bx = (int)blockIdx.x;
    const int gw = F.vcu * NWAVES + F.wave, NGW = F.G * NWAVES;
    const int lb = bx - F.G / 2;
    const int lgw = lb * NWAVES + F.wave, NLGW = (F.G - F.G / 2) * NWAVES;

    if (IN(0)) {
        LAS float* scr = (LAS float*)(F.lds + RING_OFF + F.wave * 16384);
        for (int it = gw; it < T_W13A; it += NGW) weight_item(args, ws, scr, it, F.lane);
        for (int m = gw; m < M; m += NGW) { const GAS f32x4* xr = (const GAS f32x4*)(args.in[I_X] + (size_t)m * D) + F.lane; f32x4 v[4]; float s = 0.f;
#pragma unroll
            for (int j = 0; j < 4; ++j) { v[j] = xr[64 * j]; s += (v[j].x * v[j].x + v[j].y * v[j].y) + (v[j].z * v[j].z + v[j].w * v[j].w); }
            s = wave_sum(s);
            GAS v2u* o8 = (GAS v2u*)(AB + (size_t)m * D) + F.lane;
#pragma unroll
            for (int j = 0; j < 4; ++j) o8[64 * j] = (v2u){pk2(v[j].x, v[j].y), pk2(v[j].z, v[j].w)};
            if (F.lane == 0) { SS0[m] = s; SS1[m] = 0.f; SS2[m] = 0.f; SS3[m] = 0.f; } }
    }
    SEAM(0);
    if (IN(1)) {
        pg8::Gemm g{D, D, D}; pg8::GridOrder S{M / 256, 2 * DFF / 256, F.G, bx, (const char*)AB, (const char*)W13A, (size_t)256 * D * 2, (size_t)256 * D * 2, W_UP};
        EpiSwiglu E{HID, SS0};
        pg8::gemm_phase(F.lds + RING_OFF, F.wave, g, S, E);
        F.lane = lane_id_opaque(); F.tid = F.wave * 64 + F.lane;
        for (;;) { const int t = wg_ticket(F, 0);
            if (t < NG) { ssm_prep_job(F, args, t); continue; }
            if (t < NG + DFF / 16) { float* hm = HIDM; const int c0 = 16 * (t - NG); const bf16* b0 = W13A + (size_t)glu_row(c0) * D;
                meta_job<2, true>(F, args.in[I_META], D, b0, b0 + (size_t)128 * D, [=](int r, int jj, float a, float b) { hm[r * DFF + c0 + jj] = fsilu(a) * b; }); continue; }
            const int tj = t - (NG + DFF / 16); if (tj >= (T_WIN - T_W13A) / 16) break;
            LAS float* scr = (LAS float*)(F.lds + RING_OFF + F.wave * 16384);
            weight_item(args, ws, scr, T_W13A + 16 * tj + F.wave, F.lane); weight_item(args, ws, scr, T_W13A + 16 * tj + 8 + F.wave, F.lane);
        }
    }
    SEAM(1);
    if (IN(2)) {
        pg8::Gemm g{DFF, DFF, DFF}; pg8::GridOrder S{M / 256, D / 256, F.G, bx, (const char*)HID, (const char*)W2A, (size_t)256 * DFF * 2, (size_t)256 * DFF * 2, W_DN};
        EpiResid<true> E{AB, H1B, SS1, 0.5f};
        pg8::gemm_phase(F.lds + RING_OFF, F.wave, g, S, E);
        F.lane = lane_id_opaque(); F.tid = F.wave * 64 + F.lane;
        for (int j = bx; j < D / 16; j += F.G) { float* hm = H1M; const float* mt = args.in[I_META]; const int c0 = 16 * j;
            meta_job<1, false>(F, HIDM, DFF, W2A + (size_t)c0 * DFF, nullptr, [=](int r, int jj, float a, float) { hm[r * D + c0 + jj] = mt[r * D + c0 + jj] + 0.5f * a; }); }
    }
    SEAM(2);
    if (IN(3)) {
        pg8::Gemm g{D, D, D}; pg8::GridOrder S{M / 256, DIN / 256, F.G, bx, (const char*)H1B, (const char*)WIN, (size_t)256 * D * 2, (size_t)256 * D * 2, W_IN};
        EpiMix E{SS1, Zb, UXb, Gb, args.in[I_BGATE]};
        pg8::gemm_phase(F.lds + RING_OFF, F.wave, g, S, E);
        F.lane = lane_id_opaque(); F.tid = F.wave * 64 + F.lane;
        for (;;) { const int j = wg_ticket(F, 1);
            if (j < 32) { bf16* zz = Zb; const int c0 = 16 * j; const bf16* b0 = WIN + (size_t)glu_row(c0) * D;
                meta_job<2, true>(F, H1M, D, b0, b0 + (size_t)128 * D, [=](int r, int jj, float a, float b) { zz[(size_t)(M + r) * DCONV + c0 + jj] = (bf16)f2bf(a * fsigmoid(b)); }); continue; }
            if (j < 64) { bf16* ux = UXb; const int gg = j - 32;
                meta_job<1, true>(F, H1M, D, WIN + (size_t)(1024 + 16 * gg) * D, nullptr, [=](int r, int jj, float a, float) { ux[(size_t)(gg * (NCH + 1) + NCH) * UXK + r * 16 + jj] = (bf16)f2bf(a); }); continue; }
            const int tj = j - 64; if (tj >= (T_W2B - T_WIN) / 16) break;
            LAS float* scr = (LAS float*)(F.lds + RING_OFF + F.wave * 16384);
            weight_item(args, ws, scr, T_WIN + 16 * tj + F.wave, F.lane); weight_item(args, ws, scr, T_WIN + 16 * tj + 8 + F.wave, F.lane);
        }
    }
    SEAM(3);
    if (IN(4)) {
        if (bx < BATCH * NG) {
            ssm_pre_job(F, bx / NG, bx % NG);
            pg8::Gemm g{UXK, UXK, UXK}; SsmOrder S{1 << 20, bx, (const char*)UXb, (const char*)(ws + WS_BS2)};
            EpiSsmY E{UXb, args.in[I_SD], Yb};
            pg8::gemm_phase(F.lds + RING_OFF, F.wave, g, S, E);
        }
        else conv_worker(F, args, bx - BATCH * NG);
    }
    SEAM(4);
    if (IN(6)) {
        pg8::Gemm g{512, 512, 512}; MergeOrder S{F.G, bx, (const char*)ZCb, (const char*)Yb, (const char*)WCAT};
        EpiMerge E{Gb, MCb, AB};
        pg8::gemm_phase(F.lds + RING_OFF, F.wave, g, S, E);
    }
    SEAM(6);
    if (IN(7)) {
        pg8::Gemm g{D, D, D}; pg8::GridOrder S{M / 256, D / 256, F.G, bx, (const char*)AB, (const char*)WOUT, (size_t)256 * D * 2, (size_t)256 * D * 2, W_OUT};
        EpiResid<true> E{H1B, H2B, SS2, 1.0f};
        pg8::gemm_phase(F.lds + RING_OFF, F.wave, g, S, E);
    }
    SEAM(7);
    if (IN(8)) {
        pg8::Gemm g{D, D, D}; pg8::GridOrder S{M / 256, 2 * DFF / 256, F.G, bx, (const char*)H2B, (const char*)W13B, (size_t)256 * D * 2, (size_t)256 * D * 2, W_UP};
        EpiSwiglu E{HID, SS2};
        pg8::gemm_phase(F.lds + RING_OFF, F.wave, g, S, E);
    }
    SEAM(8);
    if (IN(9)) {
        pg8::Gemm g{DFF, DFF, DFF}; pg8::GridOrder S{M / 256, D / 256, F.G, bx, (const char*)HID, (const char*)W2B, (size_t)256 * DFF * 2, (size_t)256 * DFF * 2, W_DN};
        EpiFinal E{H2B, F.out, SS3, (unsigned*)(F.ctl + CW_FIN), args.in[I_FINN], 0.5f};
        pg8::gemm_phase(F.lds + RING_OFF, F.wave, g, S, E);
    }
#undef IN
#undef SEAM
}

extern "C" void kernel_launch(void* const* d_in, const int* in_sizes, int n_in, void* d_out, int out_size, void* d_ws, size_t ws_size, hipStream_t stream) {
    static int grid = 0;
    if (grid == 0) {
        if (n_in != 30 || in_sizes[0] != M * D || out_size != M * D || ws_size < WS_END) { fprintf(stderr, "kernel_launch: unexpected problem shape (n_in %d, in0 %d, out %d, ws %zu); nothing launched\n", n_in, n_in > 0 ? in_sizes[0] : -1, out_size, ws_size); grid = -1; return; }
        int dev = 0, cus = 0, per_cu = 0;
        if (hipGetDevice(&dev) != hipSuccess || hipDeviceGetAttribute(&cus, hipDeviceAttributeMultiprocessorCount, dev) != hipSuccess) { grid = -1; return; }
        if (hipFuncSetAttribute((const void*)hyb_fwd, hipFuncAttributeMaxDynamicSharedMemorySize, LDS_BYTES) != hipSuccess) { fprintf(stderr, "kernel_launch: hipFuncSetAttribute failed\n"); grid = -1; return; }
        if (hipOccupancyMaxActiveBlocksPerMultiprocessor(&per_cu, (const void*)hyb_fwd, NWAVES * 64, LDS_BYTES) != hipSuccess || per_cu < 1)
            fprintf(stderr, "kernel_launch: note: occupancy query reports %d workgroups per CU\n", per_cu);
        (void)hipGetLastError();
        grid = cus;
    }
    if (grid < 0) return;
    if (hipMemsetAsync((char*)d_ws + WS_CTL, 0, CTL_ZERO_BYTES, stream) != hipSuccess) { fprintf(stderr, "kernel_launch: hipMemsetAsync failed\n"); return; }
    Args a{};
    for (int i = 0; i < 30; ++i) a.in[i] = (const float*)d_in[i];
    a.out = (float*)d_out; a.ws = (unsigned char*)d_ws;
    for (int li = 0; li < N_LAUNCHES; ++li) {
        a.ph_lo = (N_LAUNCHES == PER_PHASE) ? li : 0; a.ph_hi = (N_LAUNCHES == PER_PHASE) ? li + 1 : PER_PHASE; a.li = li;
        hipLaunchKernelGGL(hyb_fwd, dim3(grid), dim3(NWAVES * 64), LDS_BYTES, stream, a);
        const hipError_t le = hipPeekAtLastError();
        if (le != hipSuccess) { fprintf(stderr, "kernel_launch: launch %d failed: %s\n", li, hipGetErrorName(le)); break; }
    }
}
```

```cpp
#include <hip/hip_runtime.h>
#include <cstdio>
#include <cstdint>

#ifndef MK_N_LAUNCHES
#define MK_N_LAUNCHES 1
#endif

__device__ __forceinline__ int lane_id_opaque() { int l; asm volatile("v_mbcnt_lo_u32_b32 %0, -1, 0\n\tv_mbcnt_hi_u32_b32 %0, -1, %0" : "=v"(l)); return l; }
namespace pg8 {
#define PG8_LAS __attribute__((address_space(3)))
typedef unsigned short bf16_t;
typedef short bf16x8 __attribute__((ext_vector_type(8)));
typedef float f32x4 __attribute__((ext_vector_type(4)));
typedef unsigned u32x4 __attribute__((ext_vector_type(4)));
constexpr int BM = 256, BK = 64, HALF = 128, HTB = HALF * BK * 2, STAGE_BYTES = 8 * HTB, NXCD = 8;

__host__ __device__ __forceinline__ int lds_byte(int r, int c) { const int st = (r >> 4) * 2 + (c >> 5), rr = r & 15, cc = c & 31, ob = rr * 64 + cc * 2; return st * 1024 + (ob ^ (((ob >> 9) & 1) << 5)); }
__host__ __device__ __forceinline__ void stage_rc(int b, int& R, int& C) { const int st = b / 1024, sb = b % 1024, swz = sb ^ (((sb >> 9) & 1) << 5); R = (st >> 1) * 16 + swz / 64; C = (st & 1) * 32 + (swz % 64) / 2; }
__host__ __device__ __forceinline__ int perm32(int rho) { const int n = rho >> 4, i = rho & 15; return 8 * (i >> 2) + 4 * n + (i & 3); }

struct Unit { int pm, pn, kind; const char* A; const char* B; };
struct Gemm { int lda, ldb, K; };

__device__ __forceinline__ bool static_tile(int i, int G, int c, int nM, int nN, int WGM  , int& pm, int& pn) {
    const int nwg = nM * nN; const long L = (long)i * G + c; if (L >= nwg) return false;
    int wgid = (int)L; { const int q = nwg / NXCD, r = nwg % NXCD, xcd = wgid % NXCD, off = wgid / NXCD; wgid = (xcd < r ? xcd * (q + 1) : r * (q + 1) + (xcd - r) * q) + off; }
    const int nig = WGM * nN, gid = wgid / nig, fm = gid * WGM, gsz = (nM - fm) < WGM ? (nM - fm) : WGM;
    pm = fm + ((wgid % nig) % gsz); pn = (wgid % nig) / gsz; return true;
}
struct GridOrder {
    int nM, nN, G, c; const char* A; const char* B; size_t tA, tB; int wgm;
    __device__ __forceinline__ bool next(int i, Unit& u) const { int pm, pn; if (!static_tile(i, G, c, nM, nN, wgm, pm, pn)) return false; u.pm = pm; u.pn = pn; u.kind = 0; u.A = A + (size_t)pm * tA; u.B = B + (size_t)pn * tB; return true; }
    __device__ __forceinline__ void a_ready(const Unit&) const {}
    __device__ __forceinline__ void done(const Unit&) const {}
};

__device__ __forceinline__ unsigned cvt_pk_bf16(float lo, float hi) { unsigned r; asm volatile("v_cvt_pk_bf16_f32 %0, %1, %2" : "=v"(r) : "v"(lo), "v"(hi)); return r; }

template <class Epi, class Sched>
__device__ __forceinline__ void gemm_phase(PG8_LAS unsigned char* lds, const int wid  , const Gemm g, const Sched& S, const Epi& E) {
    const int lane = lane_id_opaque(), tid = wid * 64 + lane, wr = wid >> 2, wc = wid & 3, fr = lane & 15, fq = lane >> 4;
    const int K = g.K, nt = K / BK;
    unsigned voffA[2], voffB[2];
#pragma unroll
    for (int i = 0; i < 2; ++i) { int R, C; stage_rc(tid * 16 + i * 8192, R, C); const int Rb = (R & ~31) + perm32(R & 31);
        voffA[i] = (unsigned)(R * g.lda + C) * 2u; voffB[i] = (unsigned)(Rb * g.ldb + C) * 2u; }
    const size_t kstep = (size_t)(BK * 2);
    const size_t hstepA = (size_t)HALF * g.lda * 2, hstepB = (size_t)HALF * g.ldb * 2;
    const unsigned ldsw = (unsigned)wid * 1024u;
    const int aoff = lds_byte(wr * 64 + fr, fq * 8), boff = lds_byte(wc * 32 + fr, fq * 8);
#define PG8_SA(b, h) (((b) * 2 + (h)) * HTB)
#define PG8_SB(b, h) ((4 + (b) * 2 + (h)) * HTB)
#define PG8_STAGE(bufoff, gbase, voff) do { _Pragma("unroll") for (int _i = 0; _i < 2; ++_i) \
        __builtin_amdgcn_global_load_lds((const unsigned*)((const char*)(gbase) + (voff)[_i]), (PG8_LAS unsigned*)(lds + (bufoff) + ldsw + _i * 8192), 16, 0, 0); } while (0)
#define PG8_LDA(dst, b, h) do { _Pragma("unroll") for (int m = 0; m < 4; ++m) _Pragma("unroll") for (int k = 0; k < 2; ++k) dst[m][k] = *(const PG8_LAS bf16x8*)(lds + PG8_SA(b, h) + aoff + m * 2048 + k * 1024); } while (0)
#define PG8_LDB(dst, b, h) do { _Pragma("unroll") for (int n = 0; n < 2; ++n) _Pragma("unroll") for (int k = 0; k < 2; ++k) dst[n][k] = *(const PG8_LAS bf16x8*)(lds + PG8_SB(b, h) + boff + n * 2048 + k * 1024); } while (0)
#define PG8_MMA(ai, bj, At, Bt) do { __builtin_amdgcn_s_setprio(1); _Pragma("unroll") for (int m = 0; m < 4; ++m) _Pragma("unroll") for (int n = 0; n < 2; ++n) _Pragma("unroll") for (int k = 0; k < 2; ++k) \
        acc[ai][bj][m][n] = __builtin_amdgcn_mfma_f32_16x16x32_bf16(Bt[n][k], At[m][k], acc[ai][bj][m][n], 0, 0, 0); __builtin_amdgcn_s_setprio(0); } while (0)
#define PG8_WAIT_V(n) asm volatile("s_waitcnt vmcnt(" #n ")" ::: "memory")
#define PG8_WAIT_L(n) asm volatile("s_waitcnt lgkmcnt(" #n ")" ::: "memory")
#define PG8_BAR __builtin_amdgcn_s_barrier()
#define PG8_SCHED __builtin_amdgcn_sched_barrier(0)
    Unit cur, nxt; int ui = 0;
    if (!S.next(0, cur)) return;
    f32x4 acc[2][2][4][2];
#pragma unroll
    for (int a = 0; a < 2; ++a)
#pragma unroll
        for (int b = 0; b < 2; ++b)
#pragma unroll
            for (int m = 0; m < 4; ++m)
#pragma unroll
                for (int n = 0; n < 2; ++n) acc[a][b][m][n] = (f32x4){0.f, 0.f, 0.f, 0.f};
    bf16x8 At[4][2], B0[2][2], B1[2][2];
    const char* cA = cur.A; const char* cB = cur.B;
    S.a_ready(cur);
    PG8_STAGE(PG8_SB(0, 0), cB, voffB); PG8_STAGE(PG8_SB(0, 1), cB + hstepB, voffB); PG8_STAGE(PG8_SA(0, 0), cA, voffA); PG8_STAGE(PG8_SA(0, 1), cA + hstepA, voffA);
    if (wr == 1) PG8_BAR;
    PG8_WAIT_V(2); PG8_BAR;
    PG8_STAGE(PG8_SB(1, 0), cB + kstep, voffB); PG8_STAGE(PG8_SA(1, 0), cA + kstep, voffA); PG8_STAGE(PG8_SB(1, 1), cB + hstepB + kstep, voffB);
    PG8_WAIT_V(6); PG8_BAR;
    for (;;) {
        const bool has_next = S.next(ui + 1, nxt);
        const char* nA = has_next ? nxt.A : cA; const char* nB = has_next ? nxt.B : cB;
        for (int t = 0; t < nt; t += 2) {
            const bool last = (t == nt - 2);
            const char* a1 = cA + (size_t)(t + 1) * kstep;
            const char* a2 = last ? nA : cA + (size_t)(t + 2) * kstep; const char* b2 = last ? nB : cB + (size_t)(t + 2) * kstep;
            const char* a3 = a2 + kstep; const char* b3 = b2 + kstep;
            if (last && has_next) S.a_ready(nxt);
            PG8_LDB(B0, 0, 0); PG8_LDB(B1, 0, 1); PG8_SCHED; PG8_LDA(At, 0, 0); PG8_STAGE(PG8_SA(1, 1), a1 + hstepA, voffA);
            PG8_WAIT_V(8); PG8_WAIT_L(0); PG8_BAR; PG8_MMA(0, 0, At, B0); PG8_MMA(0, 1, At, B1); PG8_BAR; PG8_SCHED;
            PG8_LDA(At, 0, 1); PG8_STAGE(PG8_SB(0, 0), b2, voffB); PG8_STAGE(PG8_SB(0, 1), b2 + hstepB, voffB); PG8_STAGE(PG8_SA(0, 0), a2, voffA);
            PG8_WAIT_V(8); PG8_WAIT_L(0); PG8_BAR; PG8_MMA(1, 0, At, B0); PG8_MMA(1, 1, At, B1); PG8_BAR; PG8_SCHED;
            PG8_LDB(B0, 1, 0); PG8_LDB(B1, 1, 1); PG8_SCHED; PG8_LDA(At, 1, 0); PG8_STAGE(PG8_SA(0, 1), a2 + hstepA, voffA);
            PG8_WAIT_V(8); PG8_WAIT_L(0); PG8_BAR; PG8_MMA(0, 0, At, B0); PG8_MMA(0, 1, At, B1); PG8_BAR; PG8_SCHED;
            PG8_LDA(At, 1, 1); PG8_STAGE(PG8_SB(1, 0), b3, voffB); PG8_STAGE(PG8_SB(1, 1), b3 + hstepB, voffB); PG8_STAGE(PG8_SA(1, 0), a3, voffA);
            PG8_WAIT_V(8); PG8_WAIT_L(0); PG8_BAR; PG8_MMA(1, 0, At, B0); PG8_MMA(1, 1, At, B1); PG8_BAR; PG8_SCHED;
        }
        if (wr == 0) PG8_BAR;
        E(acc, cur, wr, wc); S.done(cur);
        if (!has_next) break;
#pragma unroll
        for (int a = 0; a < 2; ++a)
#pragma unroll
            for (int b = 0; b < 2; ++b)
#pragma unroll
                for (int m = 0; m < 4; ++m)
#pragma unroll
                    for (int n = 0; n < 2; ++n) acc[a][b][m][n] = (f32x4){0.f, 0.f, 0.f, 0.f};
        cur = nxt; cA = nA; cB = nB; ++ui;
        if (wr == 1) PG8_BAR;
    }
    PG8_WAIT_V(0);
    PG8_BAR;
#undef PG8_SA
#undef PG8_SB
#undef PG8_STAGE
#undef PG8_LDA
#undef PG8_LDB
#undef PG8_MMA
#undef PG8_WAIT_V
#undef PG8_WAIT_L
#undef PG8_BAR
#undef PG8_SCHED
}
}

constexpr int NWAVES = 8;
constexpr int D = 1024, BATCH = 4, SEQ = 4096, NMETA = 16, DFF = 2816, DCONV = 512, CWID = 31, DSSM = 512, HG = 16, NG = 32, PS = 64;
constexpr int DIN = 2 * DCONV + DSSM + 2 * D;
constexpr int M = BATCH * SEQ;
constexpr int NCH = M / 16;
constexpr int UXK = 384;
constexpr float EPS = 1e-6f;
constexpr int PER_PHASE = 10;
#ifndef W_UP
#define W_UP 4
#endif
#ifndef W_DN
#define W_DN 8
#endif
#ifndef W_IN
#define W_IN 4
#endif
#ifndef W_MG
#define W_MG 4
#endif
#ifndef W_OUT
#define W_OUT 4
#endif
constexpr int N_LAUNCHES = MK_N_LAUNCHES;

constexpr size_t MiB = 1u << 20;
constexpr size_t WS_CTL = 0, CTL_ZERO_BYTES = 1 * MiB;
constexpr size_t WS_BS2 = 1 * MiB;
constexpr size_t WS_WSI = 7 * MiB;
constexpr size_t WS_SMALL = 9 * MiB;
constexpr size_t WS_LAMC = WS_SMALL;
constexpr size_t WS_SMETA = WS_SMALL + 16384;
constexpr size_t WS_SS0 = WS_SMALL + 32768;
constexpr size_t WS_HIDM = WS_SMALL + 32768 + 4 * 65536;
constexpr size_t WS_H1M = WS_HIDM + 16 * DFF * 4;
constexpr size_t WS_W13A = 11 * MiB, WS_W2A = 22 * MiB, WS_WIN = 28 * MiB, WS_WCAT = 35 * MiB, WS_WOUT = 38 * MiB, WS_W13B = 40 * MiB, WS_W2B = 51 * MiB;
constexpr size_t WS_AB = 57 * MiB;
constexpr size_t WS_H1 = 89 * MiB;
constexpr size_t WS_HID = 153 * MiB;
constexpr size_t WS_Z = WS_HID;
constexpr size_t WS_UX = WS_HID + 17 * MiB;
constexpr size_t WS_ZC = WS_HID + 42 * MiB;
constexpr size_t WS_Y = WS_HID + 58 * MiB;
constexpr size_t WS_MC = WS_HID;
constexpr size_t WS_S = WS_HID + 74 * MiB;
constexpr size_t WS_END = 256 * MiB;
static_assert(WS_H1M + 16 * D * 4 <= WS_W13A, "small tables");
static_assert(WS_W2B + (size_t)D * DFF * 2 <= WS_AB && WS_AB + (size_t)M * D * 2 <= WS_H1 && WS_H1 + (size_t)M * D * 4 <= WS_HID, "ws map 1");
static_assert(WS_Z + (size_t)(M + 16) * DCONV * 2 <= WS_UX && WS_UX + (size_t)NG * (NCH + 1) * UXK * 2 <= WS_ZC && WS_ZC + (size_t)M * DCONV * 2 <= WS_Y && WS_Y + (size_t)M * DSSM * 2 <= WS_S, "ws map 2");
static_assert(WS_MC + (size_t)M * D * 2 <= WS_ZC, "MC overlay");
static_assert(WS_HID + (size_t)M * DFF * 2 <= WS_END && WS_S + (size_t)NCH * NG * 128 * 4 <= WS_END, "ws end");
static_assert(WS_W13A + (size_t)2 * DFF * D * 2 <= WS_W2A && WS_W2A + (size_t)D * DFF * 2 <= WS_WIN && WS_WIN + (size_t)DIN * D * 2 <= WS_WCAT && WS_WCAT + (size_t)3072 * 512 * 2 <= WS_WOUT && WS_WOUT + (size_t)D * D * 2 <= WS_W13B && WS_W13B + (size_t)2 * DFF * D * 2 <= WS_W2B, "weights");
static_assert(WS_BS2 + (size_t)NG * 256 * UXK * 2 <= WS_WSI && WS_WSI + (size_t)NG * 128 * 256 * 2 <= WS_SMALL, "ssm mats");
constexpr int CW_BAR = 4096;
constexpr int CW_FIN = 16384;

constexpr int RING_OFF = 0, RING_BYTES = 131072;
constexpr int LDSCTL_OFF = RING_BYTES, MISC_OFF = LDSCTL_OFF + 320;
constexpr int LDS_BYTES = 147456;

#define GAS __attribute__((address_space(1)))
#define LAS __attribute__((address_space(3)))
typedef unsigned short bf16;
typedef unsigned v4u __attribute__((ext_vector_type(4)));
typedef unsigned v2u __attribute__((ext_vector_type(2)));
typedef float f32x4 __attribute__((ext_vector_type(4)));
typedef float f32x2 __attribute__((ext_vector_type(2)));
typedef short bf16x8 __attribute__((ext_vector_type(8)));
typedef GAS unsigned gu32;
#define RLX_AGENT __ATOMIC_RELAXED, __HIP_MEMORY_SCOPE_AGENT
#define LDS_WAIT() asm volatile("s_waitcnt lgkmcnt(0)" ::: "memory")
#define VM_WAIT() asm volatile("s_waitcnt vmcnt(0)" ::: "memory")
__device__ __forceinline__ unsigned f2bf(float f) { unsigned u = __builtin_bit_cast(unsigned, f); return (u + 0x7fffu + ((u >> 16) & 1u)) >> 16; }
__device__ __forceinline__ unsigned pk2(float lo, float hi) { return f2bf(lo) | (f2bf(hi) << 16); }
__device__ __forceinline__ float bf2f(unsigned h) { return __builtin_bit_cast(float, h << 16); }
__device__ __forceinline__ float fsigmoid(float x) { return __builtin_amdgcn_rcpf(1.f + __builtin_amdgcn_exp2f(-1.44269504089f * x)); }
__device__ __forceinline__ float fsilu(float x) { return x * fsigmoid(x); }
__device__ __forceinline__ float fgelu_tanh(float x) { return x * fsigmoid(1.5957691216f * (x + 0.044715f * x * x * x)); }
__device__ __forceinline__ float wave_sum(float v) {
#pragma unroll
    for (int o = 1; o < 64; o <<= 1) v += __shfl_xor(v, o);
    return v;
}

#define XB_TMO      128
#define XB_XCNT(j)  (256  + 64 * (j))
#define XB_XSUB(j)  (1280 + 64 * (j))
#define XB_XGEN(j)  (2304 + 64 * (j))
#define XB_TOP      3328
#define XB_TOPGEN   3392
#define XCD_BAR_WORDS 3456
#define XB_SPIN_CAP (1u << 18)
__device__ __forceinline__ unsigned xb_ld(unsigned* p)              { return __hip_atomic_load(p, __ATOMIC_RELAXED, __HIP_MEMORY_SCOPE_AGENT); }
__device__ __forceinline__ unsigned xb_add(unsigned* p, unsigned v) { return __hip_atomic_fetch_add(p, v, __ATOMIC_RELAXED, __HIP_MEMORY_SCOPE_AGENT); }
__device__ __forceinline__ unsigned xb_xcc_id() { return (unsigned)__builtin_amdgcn_s_getreg((3 << 11) | 20) & 0xFu; }
#define XB_SPIN(cond, bar) do { unsigned _sp = 0; while (cond) { __builtin_amdgcn_s_sleep(1); \
    if ((++_sp & 255u) == 0u) { if (xb_ld(&(bar)[XB_TMO])) break; if (_sp > XB_SPIN_CAP) { atomicAdd(&(bar)[XB_TMO], 1u); break; } } } } while (0)
struct XcdBarrier { unsigned* bar; unsigned x; volatile LAS unsigned* st; };
__device__ __forceinline__ XcdBarrier xcd_barrier_post(unsigned* bar, volatile LAS unsigned* st) {
    XcdBarrier b; b.bar = bar; b.x = xb_xcc_id(); b.st = st;
    if (threadIdx.x == 0) (void)xb_add(&bar[XB_XCNT(b.x)], 1u);
    return b;
}
__device__ __forceinline__ void xcd_barrier_complete(unsigned* bar, unsigned x, unsigned& nloc, unsigned& nx) {
    const unsigned G = gridDim.x * gridDim.y * gridDim.z;
    unsigned sum, cnt, mine, sp = 0u;
    for (;;) {
        sum = 0u; cnt = 0u; mine = 0u;
#pragma unroll
        for (unsigned j = 0; j < 16; ++j) { const unsigned c = xb_ld(&bar[XB_XCNT(j)]); sum += c; cnt += (c > 0u) ? 1u : 0u; mine = (j == x) ? c : mine; }
        if (sum == G) break;
        __builtin_amdgcn_s_sleep(1);
        if ((++sp & 255u) == 0u) { if (xb_ld(&bar[XB_TMO])) break; if (sp > XB_SPIN_CAP) { atomicAdd(&bar[XB_TMO], 1u); break; } }
    }
    nloc = mine > 0u ? mine : 1u; nx = cnt > 0u ? cnt : 1u;
}
__device__ __forceinline__ void xcd_barrier(const XcdBarrier& b) {
    asm volatile("s_waitcnt vmcnt(0)" ::: "memory");
    __syncthreads();
    if (threadIdx.x == 0) {
        unsigned* bar = b.bar;
        __builtin_amdgcn_s_waitcnt(0);
        unsigned nloc = b.st[0], nx = b.st[1];
        if (nloc == 0u) { xcd_barrier_complete(bar, b.x, nloc, nx); b.st[0] = nloc; b.st[1] = nx; }
        const unsigned old = xb_add(&bar[XB_XSUB(b.x)], 1u);
        const unsigned gen = old / nloc;
        if (old + 1u == (gen + 1u) * nloc) {
            __builtin_amdgcn_fence(__ATOMIC_RELEASE, "agent");
            asm volatile("s_waitcnt vmcnt(0)" ::: "memory");
            const unsigned og = xb_add(&bar[XB_TOP], 1u);
            const unsigned tg = og / nx;
            if (og + 1u == (tg + 1u) * nx) xb_add(&bar[XB_TOPGEN], 1u);
            else XB_SPIN(xb_ld(&bar[XB_TOPGEN]) == tg, bar);
            __builtin_amdgcn_fence(__ATOMIC_ACQUIRE, "agent");
            xb_add(&bar[XB_XGEN(b.x)], 1u);
            asm volatile("s_waitcnt vmcnt(0)" ::: "memory");
        } else {
            XB_SPIN(xb_ld(&bar[XB_XGEN(b.x)]) == gen, bar);
            __builtin_amdgcn_fence(__ATOMIC_ACQUIRE, "agent");
            asm volatile("s_waitcnt vmcnt(0)" ::: "memory");
        }
    }
    __syncthreads();
}

struct Args { const float* in[30]; float* out; unsigned char* ws; int ph_lo, ph_hi, li, pad; };
struct Frame {
    LAS unsigned char* lds; volatile LAS unsigned* MISC; gu32* ctl;
    int tid, lane, wave, vcu, G;
    float* out; unsigned char* ws;
};
enum { I_X = 0, I_META, I_F1N, I_F1W1, I_F1W3, I_F1W2, I_MIXN, I_WIN, I_BGATE, I_DW, I_DWB, I_LNG, I_LNB, I_CPROJ, I_LRE, I_LIM, I_LDT, I_BRE, I_BIM, I_CRE, I_CIM, I_SD, I_WV, I_WG, I_WOUT, I_F2N, I_F2W1, I_F2W3, I_F2W2, I_FINN };

constexpr int CW_TKT = 32768;
__device__ __forceinline__ int wg_ticket(Frame& F, int k) {
    __syncthreads();
    if (F.tid == 0) F.MISC[16] = __hip_atomic_fetch_add((unsigned*)(F.ctl + CW_TKT + 64 * k), 1u, __ATOMIC_RELAXED, __HIP_MEMORY_SCOPE_AGENT);
    __syncthreads();
    return (int)F.MISC[16];
}
constexpr int CW_MBD = 49152;
__device__ __forceinline__ void wait_mbd(Frame& F) {
    if (F.wave == 0) { unsigned* p = (unsigned*)(F.ctl + CW_MBD); unsigned sp = 0;
        while ((unsigned)__builtin_amdgcn_readfirstlane((int)__hip_atomic_load(p, __ATOMIC_RELAXED, __HIP_MEMORY_SCOPE_AGENT)) < 64u) { __builtin_amdgcn_s_sleep(2); if (++sp > (1u << 22)) break; }
        __builtin_amdgcn_fence(__ATOMIC_ACQUIRE, "agent"); asm volatile("s_waitcnt vmcnt(0)" ::: "memory"); }
    __syncthreads();
}
using pg8::Unit; using pg8::cvt_pk_bf16;
__device__ __forceinline__ v4u pack8(const f32x4 a, const f32x4 b) { v4u w; w.x = cvt_pk_bf16(a[0], a[1]); w.y = cvt_pk_bf16(a[2], a[3]); w.z = cvt_pk_bf16(b[0], b[1]); w.w = cvt_pk_bf16(b[2], b[3]); return w; }
__device__ __forceinline__ void unpack8(const v4u w, float (&o)[8]) { o[0] = bf2f(w.x & 0xffffu); o[1] = bf2f(w.x >> 16); o[2] = bf2f(w.y & 0xffffu); o[3] = bf2f(w.y >> 16); o[4] = bf2f(w.z & 0xffffu); o[5] = bf2f(w.z >> 16); o[6] = bf2f(w.w & 0xffffu); o[7] = bf2f(w.w >> 16); }
__device__ __forceinline__ float rs_from(float ss) { return __builtin_amdgcn_rsqf(ss * (1.0f / D) + EPS); }
__device__ __forceinline__ void load_rs8(const float* SS, int row0, float (&rs)[8]) {
#pragma unroll
    for (int i = 0; i < 8; ++i) rs[i] = SS[row0 + (i >> 2) * 128 + (i & 3) * 16];
#pragma unroll
    for (int i = 0; i < 8; ++i) rs[i] = rs_from(rs[i]);
}

struct EpiSwiglu {
    bf16* HID; const float* SS;
    __device__ __forceinline__ void operator()(const f32x4 (&acc)[2][2][4][2], const Unit& u, int wr, int wc) const {
        const int lane_ = lane_id_opaque(), fr = lane_ & 15, fq = lane_ >> 4;
        const int row0 = u.pm * 256 + wr * 64 + fr, col0 = u.pn * 128 + wc * 32 + 8 * fq;
        float rsv[8]; load_rs8(SS, row0, rsv);
#pragma unroll
        for (int ai = 0; ai < 2; ++ai)
#pragma unroll
            for (int m = 0; m < 4; ++m) { const int row = row0 + ai * 128 + m * 16; const float rs = rsv[ai * 4 + m];
                f32x4 o0, o1;
#pragma unroll
                for (int j = 0; j < 4; ++j) { o0[j] = fsilu(acc[ai][0][m][0][j] * rs) * (acc[ai][1][m][0][j] * rs); o1[j] = fsilu(acc[ai][0][m][1][j] * rs) * (acc[ai][1][m][1][j] * rs); }
                *(v4u*)(HID + (size_t)row * DFF + col0) = pack8(o0, o1); }
    }
};
template <bool RBF16> struct EpiResid {
    const void* R; bf16* OB; float* SS; float alpha;
    __device__ __forceinline__ void operator()(const f32x4 (&acc)[2][2][4][2], const Unit& u, int wr, int wc) const {
        const int lane_ = lane_id_opaque(), fr = lane_ & 15, fq = lane_ >> 4;
        const int row0 = u.pm * 256 + wr * 64 + fr, col0 = u.pn * 256 + wc * 32 + 8 * fq;
#pragma unroll
        for (int ai = 0; ai < 2; ++ai) {
            f32x4 r[4][2][2];
#pragma unroll
            for (int m = 0; m < 4; ++m)
#pragma unroll
                for (int bj = 0; bj < 2; ++bj) { const size_t off = (size_t)(row0 + ai * 128 + m * 16) * D + col0 + bj * 128;
                    if (RBF16) { const v4u w = *(const v4u*)((const bf16*)R + off); r[m][bj][0] = __builtin_bit_cast(f32x4, w); }
                    else { r[m][bj][0] = *(const f32x4*)((const float*)R + off); r[m][bj][1] = *(const f32x4*)((const float*)R + off + 4); } }
#pragma unroll
            for (int m = 0; m < 4; ++m) { const int row = row0 + ai * 128 + m * 16; float ss = 0.f;
#pragma unroll
                for (int bj = 0; bj < 2; ++bj) { const size_t off = (size_t)row * D + col0 + bj * 128; f32x4 r0, r1;
                    if (RBF16) { float t[8]; unpack8(__builtin_bit_cast(v4u, r[m][bj][0]), t); r0 = (f32x4){t[0], t[1], t[2], t[3]}; r1 = (f32x4){t[4], t[5], t[6], t[7]}; }
                    else { r0 = r[m][bj][0]; r1 = r[m][bj][1]; }
                    const f32x4 o0 = r0 + acc[ai][bj][m][0] * alpha, o1 = r1 + acc[ai][bj][m][1] * alpha;
                    *(v4u*)(OB + off) = pack8(o0, o1);
                    ss += (o0[0] * o0[0] + o0[1] * o0[1]) + (o0[2] * o0[2] + o0[3] * o0[3]) + (o1[0] * o1[0] + o1[1] * o1[1]) + (o1[2] * o1[2] + o1[3] * o1[3]); }
                ss += __shfl_xor(ss, 16); ss += __shfl_xor(ss, 32);
                if (fq == 0) atomicAdd(SS + row, ss); }
            asm volatile("" ::: "memory"); }
    }
};
struct EpiFinal {
    const bf16* R; float* OUT; float* SS; unsigned* cnt; const float* gain; float alpha;
    __device__ __forceinline__ void operator()(f32x4 (&acc)[2][2][4][2], const Unit& u, int wr, int wc) const {
        const int lane_ = lane_id_opaque(), fr = lane_ & 15, fq = lane_ >> 4;
        const int row0 = u.pm * 256 + wr * 64 + fr, col0 = u.pn * 256 + wc * 32 + 8 * fq;
#pragma unroll
        for (int ai = 0; ai < 2; ++ai) {
            v4u r[4][2];
#pragma unroll
            for (int m = 0; m < 4; ++m)
#pragma unroll
                for (int bj = 0; bj < 2; ++bj) r[m][bj] = *(const v4u*)(R + (size_t)(row0 + ai * 128 + m * 16) * D + col0 + bj * 128);
#pragma unroll
            for (int m = 0; m < 4; ++m) { const int row = row0 + ai * 128 + m * 16; float ss = 0.f;
#pragma unroll
                for (int bj = 0; bj < 2; ++bj) { float t[8]; unpack8(r[m][bj], t);
                    const f32x4 o0 = (f32x4){t[0], t[1], t[2], t[3]} + acc[ai][bj][m][0] * alpha, o1 = (f32x4){t[4], t[5], t[6], t[7]} + acc[ai][bj][m][1] * alpha;
                    acc[ai][bj][m][0] = o0; acc[ai][bj][m][1] = o1;
                    ss += (o0[0] * o0[0] + o0[1] * o0[1]) + (o0[2] * o0[2] + o0[3] * o0[3]) + (o1[0] * o1[0] + o1[1] * o1[1]) + (o1[2] * o1[2] + o1[3] * o1[3]); }
                ss += __shfl_xor(ss, 16); ss += __shfl_xor(ss, 32);
                if (fq == 0) atomicAdd(SS + row, ss); }
            asm volatile("" ::: "memory"); }
        asm volatile("s_waitcnt vmcnt(0)" ::: "memory");
        unsigned* cw = cnt + 64 * u.pm;
        if (lane_ == 0) __hip_atomic_fetch_add(cw, 1u, __ATOMIC_RELAXED, __HIP_MEMORY_SCOPE_AGENT);
        f32x4 g[2][2];
#pragma unroll
        for (int bj = 0; bj < 2; ++bj) { g[bj][0] = *(const f32x4*)(gain + col0 + bj * 128); g[bj][1] = *(const f32x4*)(gain + col0 + bj * 128 + 4); }
        { unsigned sp = 0; while ((unsigned)__builtin_amdgcn_readfirstlane((int)__hip_atomic_load(cw, __ATOMIC_RELAXED, __HIP_MEMORY_SCOPE_AGENT)) < 32u) { __builtin_amdgcn_s_sleep(2); if (++sp > (1u << 20)) break; } }
        float tot[8];
#pragma unroll
        for (int i = 0; i < 8; ++i) { tot[i] = 0.f; if (fq == 0) tot[i] = __hip_atomic_fetch_add(SS + row0 + (i >> 2) * 128 + (i & 3) * 16, 0.0f, __ATOMIC_RELAXED, __HIP_MEMORY_SCOPE_AGENT); }
#pragma unroll
        for (int ai = 0; ai < 2; ++ai)
#pragma unroll
            for (int m = 0; m < 4; ++m) { const int row = row0 + ai * 128 + m * 16;
                const float rs = rs_from(__shfl(tot[ai * 4 + m], fr));
#pragma unroll
                for (int bj = 0; bj < 2; ++bj) { const size_t off = (size_t)row * D + col0 + bj * 128;
                    *(f32x4*)(OUT + off) = acc[ai][bj][m][0] * rs * g[bj][0]; *(f32x4*)(OUT + off + 4) = acc[ai][bj][m][1] * rs * g[bj][1]; } }
    }
};
struct EpiMix {
    const float* SS; bf16* Z; bf16* UX; bf16* G; const float* bgate;
    __device__ __forceinline__ void operator()(const f32x4 (&acc)[2][2][4][2], const Unit& u, int wr, int wc) const {
        const int lane_ = lane_id_opaque(), fr = lane_ & 15, fq = lane_ >> 4;
        const int row0 = u.pm * 256 + wr * 64 + fr;
        if (u.pn < 4) {
            const int col0 = u.pn * 128 + wc * 32 + 8 * fq;
#pragma unroll
            for (int ai = 0; ai < 2; ++ai)
#pragma unroll
                for (int m = 0; m < 4; ++m) { const int row = row0 + ai * 128 + m * 16; const float rs = rs_from(SS[row]); f32x4 o0, o1;
#pragma unroll
                    for (int j = 0; j < 4; ++j) { o0[j] = (acc[ai][0][m][0][j] * rs) * fsigmoid(acc[ai][1][m][0][j] * rs); o1[j] = (acc[ai][0][m][1][j] * rs) * fsigmoid(acc[ai][1][m][1][j] * rs); }
                    *(v4u*)(Z + (size_t)row * DCONV + col0) = pack8(o0, o1); }
        } else if (u.pn < 6) {
#pragma unroll
            for (int ai = 0; ai < 2; ++ai)
#pragma unroll
                for (int m = 0; m < 4; ++m) { const int row = row0 + ai * 128 + m * 16; const float rs = rs_from(SS[row]); const int ci = row >> 4, tt = row & 15;
#pragma unroll
                    for (int bj = 0; bj < 2; ++bj) { const int c = (u.pn - 4) * 256 + bj * 128 + wc * 32 + 8 * fq, g = c >> 4, h0 = c & 15;
                        *(v4u*)(UX + ((size_t)(g * (NCH + 1) + ci) * UXK + tt * 16 + h0)) = pack8(acc[ai][bj][m][0] * rs, acc[ai][bj][m][1] * rs); } }
        } else {
#pragma unroll
            for (int bj = 0; bj < 2; ++bj) { const int c = (u.pn - 6) * 256 + bj * 128 + wc * 32 + 8 * fq;
                const f32x4 b0 = *(const f32x4*)(bgate + c), b1 = *(const f32x4*)(bgate + c + 4);
#pragma unroll
                for (int ai = 0; ai < 2; ++ai)
#pragma unroll
                    for (int m = 0; m < 4; ++m) { const int row = row0 + ai * 128 + m * 16; const float rs = rs_from(SS[row]); f32x4 o0, o1;
#pragma unroll
                        for (int j = 0; j < 4; ++j) { o0[j] = fsigmoid(acc[ai][bj][m][0][j] * rs + b0[j]); o1[j] = fsigmoid(acc[ai][bj][m][1][j] * rs + b1[j]); }
                        *(v4u*)(G + (size_t)row * 2048 + c) = pack8(o0, o1); } }
        }
    }
};
struct EpiSsmY {
    const bf16* UX; const float* dskip; bf16* Y;
    __device__ __forceinline__ void operator()(const f32x4 (&acc)[2][2][4][2], const Unit& u, int wr, int wc) const {
        const int lane_ = lane_id_opaque(), fr = lane_ & 15, fq = lane_ >> 4;
        const int b = u.pm, g = u.pn, h0 = 8 * (fq & 1);
        const f32x4 d0 = *(const f32x4*)(dskip + g * 16 + h0), d1 = *(const f32x4*)(dskip + g * 16 + h0 + 4);
#pragma unroll
        for (int ai = 0; ai < 2; ++ai) {
            v4u uw[4][2];
#pragma unroll
            for (int m = 0; m < 4; ++m)
#pragma unroll
                for (int bj = 0; bj < 2; ++bj) { const int r = ai * 128 + wr * 64 + m * 16 + fr, tt = 8 * bj + 2 * wc + (fq >> 1);
                    uw[m][bj] = *(const v4u*)(UX + ((size_t)(g * (NCH + 1) + b * 256 + r) * UXK + tt * 16 + h0)); }
#pragma unroll
            for (int m = 0; m < 4; ++m) { const int r = ai * 128 + wr * 64 + m * 16 + fr;
#pragma unroll
                for (int bj = 0; bj < 2; ++bj) { const int tt = 8 * bj + 2 * wc + (fq >> 1);
                    float uu[8]; unpack8(uw[m][bj], uu);
                    f32x4 o0, o1;
#pragma unroll
                    for (int j = 0; j < 4; ++j) { o0[j] = fgelu_tanh(acc[ai][bj][m][0][j] + d0[j] * uu[j]); o1[j] = fgelu_tanh(acc[ai][bj][m][1][j] + d1[j] * uu[4 + j]); }
                    *(v4u*)(Y + ((size_t)(b * SEQ + r * 16 + tt) * DSSM + g * 16 + h0)) = pack8(o0, o1); } }
            asm volatile("" ::: "memory"); }
    }
};
struct EpiMerge {
    const bf16* G; bf16* MC; bf16* MG;
    __device__ __forceinline__ void operator()(const f32x4 (&acc)[2][2][4][2], const Unit& u, int wr, int wc) const {
        const int lane_ = lane_id_opaque(), fr = lane_ & 15, fq = lane_ >> 4;
        const int row0 = u.pm * 256 + wr * 64 + fr;
        if (u.kind == 0) {
#pragma unroll
            for (int ai = 0; ai < 2; ++ai) {
                v4u gw[4][2];
#pragma unroll
                for (int m = 0; m < 4; ++m)
#pragma unroll
                    for (int bj = 0; bj < 2; ++bj) gw[m][bj] = *(const v4u*)(G + (size_t)(row0 + ai * 128 + m * 16) * 2048 + u.pn * 256 + bj * 128 + wc * 32 + 8 * fq);
#pragma unroll
                for (int m = 0; m < 4; ++m) { const int row = row0 + ai * 128 + m * 16;
#pragma unroll
                    for (int bj = 0; bj < 2; ++bj) { const int c = u.pn * 256 + bj * 128 + wc * 32 + 8 * fq;
                        float gg[8]; unpack8(gw[m][bj], gg); f32x4 o0, o1;
#pragma unroll
                        for (int j = 0; j < 4; ++j) { o0[j] = gg[j] * acc[ai][bj][m][0][j]; o1[j] = gg[4 + j] * acc[ai][bj][m][1][j]; }
                        *(v4u*)(MC + (size_t)row * D + c) = pack8(o0, o1); } }
                asm volatile("" ::: "memory"); }
        } else {
            const int c = u.pn * 256 + (u.kind - 1) * 128 + wc * 32 + 8 * fq;
#pragma unroll
            for (int ai = 0; ai < 2; ++ai) {
                v4u gw[4], mw[4];
#pragma unroll
                for (int m = 0; m < 4; ++m) { const int row = row0 + ai * 128 + m * 16; gw[m] = *(const v4u*)(G + (size_t)row * 2048 + D + c); mw[m] = *(const v4u*)(MC + (size_t)row * D + c); }
#pragma unroll
                for (int m = 0; m < 4; ++m) { const int row = row0 + ai * 128 + m * 16;
                    float gg[8], mc[8]; unpack8(gw[m], gg); unpack8(mw[m], mc); f32x4 o0, o1;
#pragma unroll
                    for (int j = 0; j < 4; ++j) { o0[j] = mc[j] + gg[j] * (acc[ai][0][m][0][j] * fsigmoid(acc[ai][1][m][0][j])); o1[j] = mc[4 + j] + gg[4 + j] * (acc[ai][0][m][1][j] * fsigmoid(acc[ai][1][m][1][j])); }
                    *(v4u*)(MG + (size_t)row * D + c) = pack8(o0, o1); }
                asm volatile("" ::: "memory"); }
        }
    }
};
struct SsmOrder {
    int G, c; const char* UX; const char* BS2;
    __device__ __forceinline__ bool next(int i, Unit& u) const { const int L = i * G + c; if (L >= BATCH * NG) return false; const int b = L / NG, g = L % NG; u.pm = b; u.pn = g; u.kind = 0;
        u.A = UX + ((size_t)(g * (NCH + 1) + b * 256) * UXK) * 2; u.B = BS2 + (size_t)g * 256 * UXK * 2; return true; }
    __device__ __forceinline__ void a_ready(const Unit&) const {}
    __device__ __forceinline__ void done(const Unit&) const {}
};
struct MergeOrder {
    int G, c; const char* ZC; const char* Y; const char* WCAT;
    __device__ __forceinline__ bool next(int i, Unit& u) const { int pm, pn; const int su = i / 3, k = i - 3 * su; if (!pg8::static_tile(su, G, c, M / 256, D / 256, W_MG, pm, pn)) return false; u.pm = pm; u.pn = pn; u.kind = k;
        u.A = (k == 0 ? ZC : Y) + (size_t)pm * 256 * 512 * 2; u.B = WCAT + (size_t)(k == 0 ? pn * 256 : 1024 + (2 * pn + k - 1) * 256) * 512 * 2; return true; }
    __device__ __forceinline__ void a_ready(const Unit&) const {}
    __device__ __forceinline__ void done(const Unit& u) const { if (u.kind == 0) asm volatile("s_waitcnt vmcnt(0)" ::: "memory"); }
};

__device__ __forceinline__ void p0_transpose_item(const float* W, int K, int N, bf16* WT, const float* gain, LAS float* scr, int k0, int n0, int drow0, int lane) {
    float v[32];
    const float* src = W + (size_t)(k0 + (lane >> 5)) * N + n0 + (lane & 31);
#pragma unroll
    for (int i = 0; i < 32; ++i) v[i] = src[(size_t)(2 * i) * N];
#pragma unroll
    for (int i = 0; i < 32; ++i) scr[(2 * i + (lane >> 5)) * 33 + (lane & 31)] = v[i];
    LDS_WAIT(); asm volatile("" ::: "memory");
    const int c = lane & 7;
    f32x4 g0 = (f32x4){1.f, 1.f, 1.f, 1.f}, g1 = g0; if (gain) { g0 = *(const f32x4*)(gain + k0 + 8 * c); g1 = *(const f32x4*)(gain + k0 + 8 * c + 4); }
#pragma unroll
    for (int j = 0; j < 4; ++j) { const int n = (lane >> 3) + 8 * j; const LAS float* s = scr + (8 * c) * 33 + n;
        v4u o; o.x = pk2(s[0 * 33] * g0[0], s[1 * 33] * g0[1]); o.y = pk2(s[2 * 33] * g0[2], s[3 * 33] * g0[3]); o.z = pk2(s[4 * 33] * g1[0], s[5 * 33] * g1[1]); o.w = pk2(s[6 * 33] * g1[2], s[7 * 33] * g1[3]);
        *(GAS v4u*)(WT + (size_t)(drow0 + n) * K + k0 + 8 * c) = o; }
    LDS_WAIT(); asm volatile("" ::: "memory");
}
__device__ __forceinline__ int glu_row(int n) { return 256 * (n >> 7) + (n & 127); }

constexpr int I_UP = (D / 64) * (DFF / 32), I_DN = (DFF / 64) * (D / 32), I_INP = (D / 64) * (DIN / 32), I_CP = (DCONV / 64) * (D / 32), I_WO = (D / 64) * (D / 32);
constexpr int T_W13A = 2 * I_UP, T_W2A = T_W13A + I_DN, T_WIN = T_W2A + I_INP, T_WCAT = T_WIN + 3 * I_CP, T_WOUT = T_WCAT + I_WO, T_W13B = T_WOUT + 2 * I_UP, T_W2B = T_W13B + I_DN;
__device__ __forceinline__ void weight_item(const Args& args, unsigned char* ws, LAS float* scr, int it, int lane) {
    if (it < T_W13A || (it >= T_WOUT && it < T_W13B)) { const bool second = it >= T_WOUT; int r = it - (second ? T_WOUT : 0); const int which = r / I_UP; r -= which * I_UP; const int nblk = DFF / 32, k0 = 64 * (r / nblk), n0 = 32 * (r % nblk);
        const float* W = second ? (which ? args.in[I_F2W3] : args.in[I_F2W1]) : (which ? args.in[I_F1W3] : args.in[I_F1W1]);
        p0_transpose_item(W, D, DFF, (bf16*)(ws + (second ? WS_W13B : WS_W13A)), second ? args.in[I_F2N] : args.in[I_F1N], scr, k0, n0, glu_row(n0) + which * 128, lane); return; }
    if (it < T_W2A || it >= T_W13B) { const bool second = it >= T_W13B; const int r = it - (second ? T_W13B : T_W13A); const int nblk = D / 32, k0 = 64 * (r / nblk), n0 = 32 * (r % nblk);
        p0_transpose_item(second ? args.in[I_F2W2] : args.in[I_F1W2], DFF, D, (bf16*)(ws + (second ? WS_W2B : WS_W2A)), nullptr, scr, k0, n0, n0, lane); return; }
    if (it < T_WIN) { const int r = it - T_W2A; const int nblk = DIN / 32, k0 = 64 * (r / nblk), n0 = 32 * (r % nblk);
        const int dr = n0 < 512 ? glu_row(n0) : n0 < 1024 ? glu_row(n0 - 512) + 128 : n0;
        p0_transpose_item(args.in[I_WIN], D, DIN, (bf16*)(ws + WS_WIN), args.in[I_MIXN], scr, k0, n0, dr, lane); return; }
    if (it < T_WCAT) { int r = it - T_WIN; const int which = r / I_CP; r -= which * I_CP; const int nblk = D / 32, k0 = 64 * (r / nblk), n0 = 32 * (r % nblk);
        const int dr = which == 0 ? n0 : 1024 + glu_row(n0) + (which == 2 ? 128 : 0);
        p0_transpose_item(which == 0 ? args.in[I_CPROJ] : which == 1 ? args.in[I_WV] : args.in[I_WG], DCONV, D, (bf16*)(ws + WS_WCAT), nullptr, scr, k0, n0, dr, lane); return; }
    { const int r = it - T_WCAT; const int nblk = D / 32, k0 = 64 * (r / nblk), n0 = 32 * (r % nblk); p0_transpose_item(args.in[I_WOUT], D, D, (bf16*)(ws + WS_WOUT), nullptr, scr, k0, n0, n0, lane); }
}

__device__ __forceinline__ void ssm_prep_job(Frame& F, const Args& args, int g) {
    LAS f32x2* lamP = (LAS f32x2*)(F.lds + RING_OFF);
    LAS f32x2* Bb = lamP + 17 * 64;
    LAS f32x2* Cc = Bb + 64 * 16;
    LAS float* Kk = (LAS float*)(Cc + 16 * 64);
    const float* lam_re = args.in[I_LRE]; const float* lam_im = args.in[I_LIM]; const float* log_dt = args.in[I_LDT];
    const float* b_re = args.in[I_BRE]; const float* b_im = args.in[I_BIM]; const float* c_re = args.in[I_CRE]; const float* c_im = args.in[I_CIM];
    const int tid = F.tid;
    const float dt = expf(log_dt[g]);
    if (tid < 64) { const int p = tid; const float a = lam_re[g * PS + p] * dt, bb = lam_im[g * PS + p] * dt, ea = expf(a), sb = sinf(bb), cb = cosf(bb);
        const float lx = ea * cb, ly = ea * sb; float px = 1.f, py = 0.f;
        for (int k = 0; k <= 16; ++k) { lamP[k * 64 + p] = (f32x2){px, py}; const float nx = px * lx - py * ly, ny = px * ly + py * lx; px = nx; py = ny; } }
    for (int i = tid; i < 1024; i += 512) { const int p = i >> 4;
        const float lr = lam_re[g * PS + p], li = lam_im[g * PS + p], a = lr * dt, bb = li * dt, ea = expf(a), sb = sinf(bb), cb = cosf(bb), sh = sinf(0.5f * bb);
        const float nr = expm1f(a) * cb - 2.f * sh * sh, ni = ea * sb, den = 1.f / (lr * lr + li * li), fr_ = (nr * lr + ni * li) * den, fi_ = (ni * lr - nr * li) * den;
        const float br = b_re[(size_t)g * 1024 + i], bi = b_im[(size_t)g * 1024 + i];
        Bb[i] = (f32x2){fr_ * br - fi_ * bi, fr_ * bi + fi_ * br};
        Cc[i] = (f32x2){c_re[(size_t)g * 1024 + i], c_im[(size_t)g * 1024 + i]}; }
    __syncthreads();
    {
        const int k = tid >> 5, h = (tid >> 1) & 15, hh = (tid & 1) * 8; float sum[8];
#pragma unroll
        for (int j = 0; j < 8; ++j) sum[j] = 0.f;
#pragma unroll 4
        for (int p = 0; p < 64; ++p) { const f32x2 c = Cc[h * 64 + p], l = lamP[k * 64 + p]; const float er = c.x * l.x - c.y * l.y, ei = c.x * l.y + c.y * l.x;
#pragma unroll
            for (int j = 0; j < 8; j += 2) { const f32x4 bb = *(const LAS f32x4*)(Bb + p * 16 + hh + j); sum[j] += er * bb[0] - ei * bb[1]; sum[j + 1] += er * bb[2] - ei * bb[3]; } }
#pragma unroll
        for (int j = 0; j < 8; ++j) Kk[(k << 8) + (h << 4) + hh + j] = sum[j];
    }
    __syncthreads();
    GAS unsigned* bs2 = (GAS unsigned*)(F.ws + WS_BS2) + (size_t)g * 256 * (UXK / 2);
    for (int i = tid; i < 256 * (UXK / 2); i += 512) { const int n = i / (UXK / 2), kp = (i % (UXK / 2)) * 2, t = n >> 4, h = n & 15; float v0, v1;
        if (kp < 256) { const int s = kp >> 4, hp = kp & 15; const bool on = s <= t; const int kb = (((t - s) & 15) << 8) + (h << 4) + hp; v0 = on ? Kk[kb] : 0.f; v1 = on ? Kk[kb + 1] : 0.f; }
        else { const int p = (kp - 256) >> 1; const f32x2 c = Cc[h * 64 + p], l = lamP[(t + 1) * 64 + p]; v0 = c.x * l.x - c.y * l.y; v1 = -(c.x * l.y + c.y * l.x); }
        bs2[i] = pk2(v0, v1); }
    GAS unsigned* wsi = (GAS unsigned*)(F.ws + WS_WSI) + (size_t)g * 128 * 128;
    for (int i = tid; i < 128 * 128; i += 512) { const int n = i >> 7, kp = (i & 127) * 2, p = n >> 1, c = n & 1, s = kp >> 4, h = kp & 15;
        const f32x2 l = lamP[(15 - s) * 64 + p], b0 = Bb[p * 16 + h], b1 = Bb[p * 16 + h + 1];
        const float v0 = c ? (l.x * b0.y + l.y * b0.x) : (l.x * b0.x - l.y * b0.y), v1 = c ? (l.x * b1.y + l.y * b1.x) : (l.x * b1.x - l.y * b1.y);
        wsi[i] = pk2(v0, v1); }
    if (tid < 64) ((GAS f32x2*)(F.ws + WS_LAMC))[g * 64 + tid] = lamP[16 * 64 + tid];
    __syncthreads();
}

template <int NS, bool NORM, class Fn>
__device__ __forceinline__ void meta_job(Frame& F, const float* A, int K, const bf16* Bt0, const bf16* Bt1, const Fn& fn) {
    LAS float* red = (LAS float*)(F.lds + RING_OFF);
    LAS float* rsc = red + 8 * 16 * 32;
    const int lane = F.lane, w = F.wave, fr = lane & 15, fq = lane >> 4;
    if (NORM) {
#pragma unroll
        for (int rr = 0; rr < 2; ++rr) { const int row = 2 * w + rr; float s = 0.f; for (int c = lane; c < D; c += 64) { const float v = A[(size_t)row * K + c]; s += v * v; } s = wave_sum(s); if (lane == 0) rsc[row] = 1.0f / sqrtf(s * (1.0f / D) + EPS); }
    } else if (F.tid < 16) rsc[F.tid] = 1.f;
    f32x4 acc[NS];
#pragma unroll
    for (int s = 0; s < NS; ++s) acc[s] = (f32x4){0.f, 0.f, 0.f, 0.f};
    const int kw = K / 8, kbase = w * kw;
#pragma unroll 4
    for (int k = kbase; k < kbase + kw; k += 32) {
        const f32x4 a0 = *(const f32x4*)(A + (size_t)fr * K + k + 8 * fq), a1 = *(const f32x4*)(A + (size_t)fr * K + k + 8 * fq + 4);
        const v4u ap = pack8(a0, a1); const bf16x8 af = __builtin_bit_cast(bf16x8, ap);
#pragma unroll
        for (int s = 0; s < NS; ++s) { const bf16x8 bf = *(const bf16x8*)((s == 0 ? Bt0 : Bt1) + (size_t)fr * K + k + 8 * fq); acc[s] = __builtin_amdgcn_mfma_f32_16x16x32_bf16(bf, af, acc[s], 0, 0, 0); } }
#pragma unroll
    for (int s = 0; s < NS; ++s) *(LAS f32x4*)(red + (w * 16 + fr) * 32 + s * 16 + 4 * fq) = acc[s];
    __syncthreads();
    if (F.tid < 256) { const int rr = F.tid >> 4, j = F.tid & 15; float v0 = 0.f, v1 = 0.f;
#pragma unroll
        for (int ww = 0; ww < 8; ++ww) { v0 += red[(ww * 16 + rr) * 32 + j]; if (NS > 1) v1 += red[(ww * 16 + rr) * 32 + 16 + j]; }
        const float sc = rsc[rr]; fn(rr, j, v0 * sc, v1 * sc); }
    VM_WAIT();
    __syncthreads();
}

constexpr int WSI_PITCH = 528;
constexpr int SMETA_OFF = LDSCTL_OFF + 1024;
__device__ __forceinline__ void ssm_pre_job(Frame& F, int b, int g) {
    const int lane = F.lane, w = F.wave, tid = F.tid, fr = lane & 15, fq = lane >> 4;
    LAS unsigned char* Bl = F.lds + RING_OFF;
    LAS f32x2* Sl = (LAS f32x2*)(F.lds + RING_OFF);
    LAS float* smeta = (LAS float*)(F.lds + SMETA_OFF);
    bf16* UX = (bf16*)(F.ws + WS_UX); const bf16* Wg = (const bf16*)(F.ws + WS_WSI) + (size_t)g * 128 * 256;
    { v4u v[8];
#pragma unroll
      for (int i = 0; i < 8; ++i) { const int idx = tid + 512 * i; v[i] = *(const v4u*)(Wg + (size_t)(idx >> 5) * 256 + (idx & 31) * 8); }
#pragma unroll
      for (int i = 0; i < 8; ++i) { const int idx = tid + 512 * i; *(LAS v4u*)(Bl + (idx >> 5) * WSI_PITCH + (idx & 31) * 16) = v[i]; } }
    const bf16* Ab = UX + (size_t)(g * (NCH + 1) + 256 * b + 32 * w) * UXK;
    bf16x8 a[2][8], am[8];
#pragma unroll
    for (int mt = 0; mt < 2; ++mt)
#pragma unroll
        for (int ks = 0; ks < 8; ++ks) a[mt][ks] = *(const bf16x8*)(Ab + (size_t)(16 * mt + fr) * UXK + 32 * ks + 8 * fq);
    if (w == 7) {
#pragma unroll
        for (int ks = 0; ks < 8; ++ks) am[ks] = *(const bf16x8*)(UX + (size_t)(g * (NCH + 1) + NCH) * UXK + 32 * ks + 8 * fq); }
    f32x4 acc[2][8], accm[8];
#pragma unroll
    for (int nt = 0; nt < 8; ++nt) { acc[0][nt] = (f32x4){0.f, 0.f, 0.f, 0.f}; acc[1][nt] = acc[0][nt]; accm[nt] = acc[0][nt]; }
    __syncthreads();
#pragma unroll
    for (int ks = 0; ks < 8; ++ks)
#pragma unroll
        for (int nt = 0; nt < 8; ++nt) { const bf16x8 bfr = *(const LAS bf16x8*)(Bl + (16 * nt + fr) * WSI_PITCH + (32 * ks + 8 * fq) * 2);
            acc[0][nt] = __builtin_amdgcn_mfma_f32_16x16x32_bf16(bfr, a[0][ks], acc[0][nt], 0, 0, 0); acc[1][nt] = __builtin_amdgcn_mfma_f32_16x16x32_bf16(bfr, a[1][ks], acc[1][nt], 0, 0, 0);
            if (w == 7) accm[nt] = __builtin_amdgcn_mfma_f32_16x16x32_bf16(bfr, am[ks], accm[nt], 0, 0, 0); }
    __syncthreads();
#pragma unroll
    for (int mt = 0; mt < 2; ++mt)
#pragma unroll
        for (int nt = 0; nt < 8; ++nt) *(LAS f32x4*)(Sl + (32 * w + 16 * mt + fr) * 64 + 8 * nt + 2 * fq) = acc[mt][nt];
    if (w == 7 && fr == 0) {
#pragma unroll
        for (int nt = 0; nt < 8; ++nt) *(LAS f32x4*)(smeta + 16 * nt + 4 * fq) = accm[nt]; }
    __syncthreads();
    { const f32x2 lc = ((const f32x2*)(F.ws + WS_LAMC))[g * 64 + lane];
      LAS f32x2* Ew = (LAS f32x2*)(F.lds + SMETA_OFF + 512);
      f32x2 l = (f32x2){0.f, 0.f};
#pragma unroll 8
      for (int k = 0; k < 32; ++k) { LAS f32x2* sp = Sl + (32 * w + k) * 64 + lane; const f32x2 sv = *sp; *sp = l; const float nx = lc.x * l.x - lc.y * l.y + sv.x, ny = lc.x * l.y + lc.y * l.x + sv.y; l.x = nx; l.y = ny; }
      Ew[w * 64 + lane] = l;
      f32x2 l32 = lc;
#pragma unroll
      for (int q = 0; q < 5; ++q) { const float nx = l32.x * l32.x - l32.y * l32.y, ny = 2.f * l32.x * l32.y; l32.x = nx; l32.y = ny; }
      __syncthreads();
      f32x2 X = *(const LAS f32x2*)(smeta + 2 * lane);
      for (int v = 0; v < w; ++v) { const f32x2 e = Ew[v * 64 + lane]; const float nx = l32.x * X.x - l32.y * X.y + e.x, ny = l32.x * X.y + l32.y * X.x + e.y; X.x = nx; X.y = ny; }
      unsigned* xp = (unsigned*)(UX + (size_t)(g * (NCH + 1) + b * 256 + 32 * w) * UXK + 256) + lane;
      f32x2 pw = X;
#pragma unroll 8
      for (int k = 0; k < 32; ++k) { const f32x2 lv = Sl[(32 * w + k) * 64 + lane]; xp[(size_t)k * (UXK / 2)] = cvt_pk_bf16(pw.x + lv.x, pw.y + lv.y); const float nx = lc.x * pw.x - lc.y * pw.y, ny = lc.x * pw.y + lc.y * pw.x; pw.x = nx; pw.y = ny; }
      VM_WAIT(); }
    __syncthreads();
}

__device__ __forceinline__ void conv_worker(Frame& F, const Args& args, int wi) {
    LAS unsigned char* zs = F.lds + RING_OFF;
    LAS float* cs = (LAS float*)(F.lds + RING_OFF + 65536);
    const bf16* Z = (const bf16*)(F.ws + WS_Z); bf16* ZC = (bf16*)(F.ws + WS_ZC);
    const int tid = F.tid, lane = F.lane, w = F.wave, b = wi >> 5, T0 = (wi & 31) * 128;
    auto zrow = [&](int ti, int cb) -> v4u { v4u v = (v4u){0u, 0u, 0u, 0u};
        if (ti >= 0) v = *(const v4u*)((const char*)Z + (size_t)(b * SEQ + ti) * 1024 + cb); else if (ti >= -NMETA) v = *(const v4u*)((const char*)Z + (size_t)(M + NMETA + ti) * 1024 + cb); return v; };
    { v4u v[8];
#pragma unroll
      for (int it = 0; it < 8; ++it) { const int q = tid + 512 * it; v[it] = (v4u){0u, 0u, 0u, 0u}; if (q < 62 * 64) v[it] = zrow(T0 - 30 + (q >> 6), (q & 63) * 16); }
#pragma unroll
      for (int it = 0; it < 8; ++it) { const int q = tid + 512 * it; if (q < 62 * 64) *(LAS v4u*)(zs + (((q >> 6) + 2) & 63) * 1024 + (q & 63) * 16) = v[it]; } }
    const int cp = tid & 255, th = tid >> 8;
    const float* dw = args.in[I_DW]; f32x2 wgt[CWID];
#pragma unroll
    for (int k = 0; k < CWID; ++k) wgt[k] = *(const f32x2*)(dw + k * DCONV + 2 * cp);
    const f32x2 bias = *(const f32x2*)(args.in[I_DWB] + 2 * cp);
    const f32x4 g0 = *(const f32x4*)(args.in[I_LNG] + 4 * lane), g1 = *(const f32x4*)(args.in[I_LNG] + 256 + 4 * lane), b0 = *(const f32x4*)(args.in[I_LNB] + 4 * lane), b1 = *(const f32x4*)(args.in[I_LNB] + 256 + 4 * lane);
#pragma unroll 1
    for (int j = 0; j < 4; ++j) {
        __syncthreads();
#pragma unroll 1
        for (int hf = 0; hf < 2; ++hf) {
            f32x2 acc[8];
#pragma unroll
            for (int t = 0; t < 8; ++t) acc[t] = bias;
            const int base = 32 * j + 16 * th + 8 * hf + 2;
#pragma unroll
            for (int i = 0; i < 38; ++i) { const unsigned zz = *(const LAS unsigned*)(zs + (((base + i) & 63) << 10) + 4 * cp); const float z0 = bf2f(zz & 0xffffu), z1 = bf2f(zz >> 16);
#pragma unroll
                for (int t = 0; t < 8; ++t) { const int k = i - t; if (k >= 0 && k < CWID) { acc[t].x += wgt[k].x * z0; acc[t].y += wgt[k].y * z1; } } }
#pragma unroll
            for (int t = 0; t < 8; ++t) *(LAS f32x2*)(cs + (16 * th + 8 * hf + t) * 512 + 2 * cp) = acc[t];
        }
        __syncthreads();
        v4u nx[4];
        if (j < 3) {
#pragma unroll
            for (int it = 0; it < 4; ++it) { const int q = tid + 512 * it; nx[it] = zrow(T0 + 32 * j + 32 + (q >> 6), (q & 63) * 16); } }
#pragma unroll
        for (int q = 0; q < 4; ++q) { const int t = 4 * w + q; const f32x4 x0 = *(const LAS f32x4*)(cs + t * 512 + 4 * lane), x1 = *(const LAS f32x4*)(cs + t * 512 + 256 + 4 * lane);
            const float mu = wave_sum((x0[0] + x0[1]) + (x0[2] + x0[3]) + (x1[0] + x1[1]) + (x1[2] + x1[3])) * (1.f / DCONV);
            const f32x4 d0 = x0 - mu, d1 = x1 - mu;
            const float var = wave_sum((d0[0] * d0[0] + d0[1] * d0[1]) + (d0[2] * d0[2] + d0[3] * d0[3]) + (d1[0] * d1[0] + d1[1] * d1[1]) + (d1[2] * d1[2] + d1[3] * d1[3])) * (1.f / DCONV);
            const float rstd = __builtin_amdgcn_rsqf(var + EPS); f32x4 o0 = d0 * rstd * g0 + b0, o1 = d1 * rstd * g1 + b1;
#pragma unroll
            for (int jj = 0; jj < 4; ++jj) { o0[jj] = fsilu(o0[jj]); o1[jj] = fsilu(o1[jj]); }
            bf16* zr = ZC + (size_t)(b * SEQ + T0 + 32 * j + t) * DCONV;
            *(v2u*)(zr + 4 * lane) = (v2u){cvt_pk_bf16(o0[0], o0[1]), cvt_pk_bf16(o0[2], o0[3])}; *(v2u*)(zr + 256 + 4 * lane) = (v2u){cvt_pk_bf16(o1[0], o1[1]), cvt_pk_bf16(o1[2], o1[3])}; }
        if (j < 3) {
#pragma unroll
            for (int it = 0; it < 4; ++it) { const int q = tid + 512 * it; *(LAS v4u*)(zs + ((32 * j + 64 + (q >> 6)) & 63) * 1024 + (q & 63) * 16) = nx[it]; } }
    }
    __syncthreads();
}

__global__ void __launch_bounds__(NWAVES * 64, 2) hyb_fwd(Args args) {
    extern __shared__ __attribute__((aligned(16))) unsigned char lds[];
    Frame F;
    F.lds = (LAS unsigned char*)lds; F.MISC = (volatile LAS unsigned*)(F.lds + MISC_OFF);
    F.wave = __builtin_amdgcn_readfirstlane((int)threadIdx.x >> 6); F.lane = lane_id_opaque(); F.tid = F.wave * 64 + F.lane;
    F.G = gridDim.x; { const int bx = blockIdx.x; F.vcu = (F.G % 8 == 0) ? (bx % 8) * (F.G / 8) + bx / 8 : bx; }
    F.ws = args.ws; F.out = args.out; F.ctl = (gu32*)(args.ws + WS_CTL);
    for (int u = F.tid; u < (LDS_BYTES - LDSCTL_OFF) / 4; u += NWAVES * 64) ((LAS unsigned*)(F.lds + LDSCTL_OFF))[u] = 0u;
    __syncthreads();
    const int bli = (N_LAUNCHES == PER_PHASE) ? 0 : args.li;
    XcdBarrier bar; bar.bar = (unsigned*)(F.ctl + CW_BAR) + bli * XCD_BAR_WORDS; bar.x = 0; bar.st = nullptr;
    if (N_LAUNCHES != PER_PHASE) bar = xcd_barrier_post((unsigned*)(F.ctl + CW_BAR) + bli * XCD_BAR_WORDS, F.MISC + 8);
    const int lo = args.ph_lo, hi = args.ph_hi;
#ifndef PHMASK
#define PHMASK 0x7ff
#endif
#define IN(k) (((PHMASK >> (k)) & 1) && lo <= (k) && (k) < hi)
#define SEAM(k) do { if (IN(k) && IN((k) + 1)) xcd_barrier(bar); F.lane = lane_id_opaque(); F.tid = F.wave * 64 + F.lane; } while (0)
    unsigned char* ws = F.ws;
    bf16* W13A = (bf16*)(ws + WS_W13A); bf16* W2A = (bf16*)(ws + WS_W2A); bf16* WIN = (bf16*)(ws + WS_WIN); bf16* WCAT = (bf16*)(ws + WS_WCAT); bf16* WOUT = (bf16*)(ws + WS_WOUT);
    bf16* W13B = (bf16*)(ws + WS_W13B); bf16* W2B = (bf16*)(ws + WS_W2B);
    bf16* AB = (bf16*)(ws + WS_AB); bf16* H1B = (bf16*)(ws + WS_H1); bf16* H2B = (bf16*)(ws + WS_H1 + 32 * MiB); bf16* HID = (bf16*)(ws + WS_HID);
    bf16* Zb = (bf16*)(ws + WS_Z); bf16* UXb = (bf16*)(ws + WS_UX); bf16* ZCb = (bf16*)(ws + WS_ZC); bf16* Yb = (bf16*)(ws + WS_Y); bf16* MCb = (bf16*)(ws + WS_MC);
    float* SS0 = (float*)(ws + WS_SS0); float* SS1 = SS0 + M; float* SS2 = SS1 + M; float* SS3 = SS2 + M;
    float* HIDM = (float*)(ws + WS_HIDM); float* H1M = (float*)(ws + WS_H1M);
    bf16* Gb = (bf16*)F.out;
    const int bx = (int)blockIdx.x;
    const int gw = F.vcu * NWAVES + F.wave, NGW = F.G * NWAVES;
    const int lb = bx - F.G / 2;
    const int lgw = lb * NWAVES + F.wave, NLGW = (F.G - F.G / 2) * NWAVES;

    if (IN(0)) {
        LAS float* scr = (LAS float*)(F.lds + RING_OFF + F.wave * 16384);
        for (int it = gw; it < T_W13A; it += NGW) weight_item(args, ws, scr, it, F.lane);
        for (int m = gw; m < M; m += NGW) { const GAS f32x4* xr = (const GAS f32x4*)(args.in[I_X] + (size_t)m * D) + F.lane; f32x4 v[4]; float s = 0.f;
#pragma unroll
            for (int j = 0; j < 4; ++j) { v[j] = xr[64 * j]; s += (v[j].x * v[j].x + v[j].y * v[j].y) + (v[j].z * v[j].z + v[j].w * v[j].w); }
            s = wave_sum(s);
            GAS v2u* o8 = (GAS v2u*)(AB + (size_t)m * D) + F.lane;
#pragma unroll
            for (int j = 0; j < 4; ++j) o8[64 * j] = (v2u){pk2(v[j].x, v[j].y), pk2(v[j].z, v[j].w)};
            if (F.lane == 0) { SS0[m] = s; SS1[m] = 0.f; SS2[m] = 0.f; SS3[m] = 0.f; } }
    }
    SEAM(0);
    if (IN(1)) {
        pg8::Gemm g{D, D, D}; pg8::GridOrder S{M / 256, 2 * DFF / 256, F.G, bx, (const char*)AB, (const char*)W13A, (size_t)256 * D * 2, (size_t)256 * D * 2, W_UP};
        EpiSwiglu E{HID, SS0};
        pg8::gemm_phase(F.lds + RING_OFF, F.wave, g, S, E);
        F.lane = lane_id_opaque(); F.tid = F.wave * 64 + F.lane;
        for (;;) { const int t = wg_ticket(F, 0);
            if (t < NG) { ssm_prep_job(F, args, t); continue; }
            if (t < NG + DFF / 16) { float* hm = HIDM; const int c0 = 16 * (t - NG); const bf16* b0 = W13A + (size_t)glu_row(c0) * D;
                meta_job<2, true>(F, args.in[I_META], D, b0, b0 + (size_t)128 * D, [=](int r, int jj, float a, float b) { hm[r * DFF + c0 + jj] = fsilu(a) * b; }); continue; }
            const int tj = t - (NG + DFF / 16); if (tj >= (T_WIN - T_W13A) / 16) break;
            LAS float* scr = (LAS float*)(F.lds + RING_OFF + F.wave * 16384);
            weight_item(args, ws, scr, T_W13A + 16 * tj + F.wave, F.lane); weight_item(args, ws, scr, T_W13A + 16 * tj + 8 + F.wave, F.lane);
        }
    }
    SEAM(1);
    if (IN(2)) {
        pg8::Gemm g{DFF, DFF, DFF}; pg8::GridOrder S{M / 256, D / 256, F.G, bx, (const char*)HID, (const char*)W2A, (size_t)256 * DFF * 2, (size_t)256 * DFF * 2, W_DN};
        EpiResid<true> E{AB, H1B, SS1, 0.5f};
        pg8::gemm_phase(F.lds + RING_OFF, F.wave, g, S, E);
    }
    SEAM(2);
    if (IN(3)) {
        pg8::Gemm g{D, D, D}; pg8::GridOrder S{M / 256, DIN / 256, F.G, bx, (const char*)H1B, (const char*)WIN, (size_t)256 * D * 2, (size_t)256 * D * 2, W_IN};
        EpiMix E{SS1, Zb, UXb, Gb, args.in[I_BGATE]};
        pg8::gemm_phase(F.lds + RING_OFF, F.wave, g, S, E);
        F.lane = lane_id_opaque(); F.tid = F.wave * 64 + F.lane;
        for (;;) { int j = wg_ticket(F, 1);
            if (j < 64) { float* hm = H1M; const float* mt = args.in[I_META]; const int c0 = 16 * j;
                meta_job<1, false>(F, HIDM, DFF, W2A + (size_t)c0 * DFF, nullptr, [=](int r, int jj, float a, float) { __hip_atomic_store(hm + r * D + c0 + jj, mt[r * D + c0 + jj] + 0.5f * a, __ATOMIC_RELAXED, __HIP_MEMORY_SCOPE_AGENT); });
                if (F.tid == 0) __hip_atomic_fetch_add((unsigned*)(F.ctl + CW_MBD), 1u, __ATOMIC_RELAXED, __HIP_MEMORY_SCOPE_AGENT);
                continue; }
            j -= 64;
            if (j < 64) wait_mbd(F);
            if (j < 32) { bf16* zz = Zb; const int c0 = 16 * j; const bf16* b0 = WIN + (size_t)glu_row(c0) * D;
                meta_job<2, true>(F, H1M, D, b0, b0 + (size_t)128 * D, [=](int r, int jj, float a, float b) { zz[(size_t)(M + r) * DCONV + c0 + jj] = (bf16)f2bf(a * fsigmoid(b)); }); continue; }
            if (j < 64) { bf16* ux = UXb; const int gg = j - 32;
                meta_job<1, true>(F, H1M, D, WIN + (size_t)(1024 + 16 * gg) * D, nullptr, [=](int r, int jj, float a, float) { ux[(size_t)(gg * (NCH + 1) + NCH) * UXK + r * 16 + jj] = (bf16)f2bf(a); }); continue; }
            const int tj = j - 64; if (tj >= (T_W2B - T_WIN) / 16) break;
            LAS float* scr = (LAS float*)(F.lds + RING_OFF + F.wave * 16384);
            weight_item(args, ws, scr, T_WIN + 16 * tj + F.wave, F.lane); weight_item(args, ws, scr, T_WIN + 16 * tj + 8 + F.wave, F.lane);
        }
    }
    SEAM(3);
    if (IN(4)) {
        if (bx < BATCH * NG) {
            ssm_pre_job(F, bx / NG, bx % NG);
            pg8::Gemm g{UXK, UXK, UXK}; SsmOrder S{1 << 20, bx, (const char*)UXb, (const char*)(ws + WS_BS2)};
            EpiSsmY E{UXb, args.in[I_SD], Yb};
            pg8::gemm_phase(F.lds + RING_OFF, F.wave, g, S, E);
        }
        else conv_worker(F, args, bx - BATCH * NG);
    }
    SEAM(4);
    if (IN(6)) {
        pg8::Gemm g{512, 512, 512}; MergeOrder S{F.G, bx, (const char*)ZCb, (const char*)Yb, (const char*)WCAT};
        EpiMerge E{Gb, MCb, AB};
        pg8::gemm_phase(F.lds + RING_OFF, F.wave, g, S, E);
    }
    SEAM(6);
    if (IN(7)) {
        pg8::Gemm g{D, D, D}; pg8::GridOrder S{M / 256, D / 256, F.G, bx, (const char*)AB, (const char*)WOUT, (size_t)256 * D * 2, (size_t)256 * D * 2, W_OUT};
        EpiResid<true> E{H1B, H2B, SS2, 1.0f};
        pg8::gemm_phase(F.lds + RING_OFF, F.wave, g, S, E);
    }
    SEAM(7);
    if (IN(8)) {
        pg8::Gemm g{D, D, D}; pg8::GridOrder S{M / 256, 2 * DFF / 256, F.G, bx, (const char*)H2B, (const char*)W13B, (size_t)256 * D * 2, (size_t)256 * D * 2, W_UP};
        EpiSwiglu E{HID, SS2};
        pg8::gemm_phase(F.lds + RING_OFF, F.wave, g, S, E);
    }
    SEAM(8);
    if (IN(9)) {
        pg8::Gemm g{DFF, DFF, DFF}; pg8::GridOrder S{M / 256, D / 256, F.G, bx, (const char*)HID, (const char*)W2B, (size_t)256 * DFF * 2, (size_t)256 * DFF * 2, W_DN};
        EpiFinal E{H2B, F.out, SS3, (unsigned*)(F.ctl + CW_FIN), args.in[I_FINN], 0.5f};
        pg8::gemm_phase(F.lds + RING_OFF, F.wave, g, S, E);
    }
#undef IN
#undef SEAM
}

extern "C" void kernel_launch(void* const* d_in, const int* in_sizes, int n_in, void* d_out, int out_size, void* d_ws, size_t ws_size, hipStream_t stream) {
    static int grid = 0;
    if (grid == 0) {
        if (n_in != 30 || in_sizes[0] != M * D || out_size != M * D || ws_size < WS_END) { fprintf(stderr, "kernel_launch: unexpected problem shape (n_in %d, in0 %d, out %d, ws %zu); nothing launched\n", n_in, n_in > 0 ? in_sizes[0] : -1, out_size, ws_size); grid = -1; return; }
        int dev = 0, cus = 0, per_cu = 0;
        if (hipGetDevice(&dev) != hipSuccess || hipDeviceGetAttribute(&cus, hipDeviceAttributeMultiprocessorCount, dev) != hipSuccess) { grid = -1; return; }
        if (hipFuncSetAttribute((const void*)hyb_fwd, hipFuncAttributeMaxDynamicSharedMemorySize, LDS_BYTES) != hipSuccess) { fprintf(stderr, "kernel_launch: hipFuncSetAttribute failed\n"); grid = -1; return; }
        if (hipOccupancyMaxActiveBlocksPerMultiprocessor(&per_cu, (const void*)hyb_fwd, NWAVES * 64, LDS_BYTES) != hipSuccess || per_cu < 1)
            fprintf(stderr, "kernel_launch: note: occupancy query reports %d workgroups per CU\n", per_cu);
        (void)hipGetLastError();
        grid = cus;
    }
    if (grid < 0) return;
    if (hipMemsetAsync((char*)d_ws + WS_CTL, 0, CTL_ZERO_BYTES, stream) != hipSuccess) { fprintf(stderr, "kernel_launch: hipMemsetAsync failed\n"); return; }
    Args a{};
    for (int i = 0; i < 30; ++i) a.in[i] = (const float*)d_in[i];
    a.out = (float*)d_out; a.ws = (unsigned char*)d_ws;
    for (int li = 0; li < N_LAUNCHES; ++li) {
        a.ph_lo = (N_LAUNCHES == PER_PHASE) ? li : 0; a.ph_hi = (N_LAUNCHES == PER_PHASE) ? li + 1 : PER_PHASE; a.li = li;
        hipLaunchKernelGGL(hyb_fwd, dim3(grid), dim3(NWAVES * 64), LDS_BYTES, stream, a);
        const hipError_t le = hipPeekAtLastError();
        if (le != hipSuccess) { fprintf(stderr, "kernel_launch: launch %d failed: %s\n", li, hipGetErrorName(le)); break; }
    }
}
```

```cpp
#include <hip/hip_runtime.h>
#include <cstdio>
#include <cstdint>

#ifndef MK_N_LAUNCHES
#define MK_N_LAUNCHES 1
#endif
#ifndef PRIO_MODE
#define PRIO_MODE 0
#endif

__device__ __forceinline__ int lane_id_opaque() { int l; asm volatile("v_mbcnt_lo_u32_b32 %0, -1, 0\n\tv_mbcnt_hi_u32_b32 %0, -1, %0" : "=v"(l)); return l; }
namespace pg8 {
#define PG8_LAS __attribute__((address_space(3)))
typedef unsigned short bf16_t;
typedef short bf16x8 __attribute__((ext_vector_type(8)));
typedef float f32x4 __attribute__((ext_vector_type(4)));
typedef unsigned u32x4 __attribute__((ext_vector_type(4)));
constexpr int BM = 256, BK = 64, HALF = 128, HTB = HALF * BK * 2, STAGE_BYTES = 8 * HTB, NXCD = 8;

__host__ __device__ __forceinline__ int lds_byte(int r, int c) { const int st = (r >> 4) * 2 + (c >> 5), rr = r & 15, cc = c & 31, ob = rr * 64 + cc * 2; return st * 1024 + (ob ^ (((ob >> 9) & 1) << 5)); }
__host__ __device__ __forceinline__ void stage_rc(int b, int& R, int& C) { const int st = b / 1024, sb = b % 1024, swz = sb ^ (((sb >> 9) & 1) << 5); R = (st >> 1) * 16 + swz / 64; C = (st & 1) * 32 + (swz % 64) / 2; }
__host__ __device__ __forceinline__ int perm32(int rho) { const int n = rho >> 4, i = rho & 15; return 8 * (i >> 2) + 4 * n + (i & 3); }

struct Unit { int pm, pn, kind; const char* A; const char* B; };
struct Gemm { int lda, ldb, K; };

__device__ __forceinline__ bool static_tile(int i, int G, int c, int nM, int nN, int WGM  , int& pm, int& pn) {
    const int nwg = nM * nN; const long L = (long)i * G + c; if (L >= nwg) return false;
    int wgid = (int)L; { const int q = nwg / NXCD, r = nwg % NXCD, xcd = wgid % NXCD, off = wgid / NXCD; wgid = (xcd < r ? xcd * (q + 1) : r * (q + 1) + (xcd - r) * q) + off; }
    const int nig = WGM * nN, gid = wgid / nig, fm = gid * WGM, gsz = (nM - fm) < WGM ? (nM - fm) : WGM;
    pm = fm + ((wgid % nig) % gsz); pn = (wgid % nig) / gsz; return true;
}
struct GridOrder {
    int nM, nN, G, c; const char* A; const char* B; size_t tA, tB; int wgm;
    __device__ __forceinline__ bool next(int i, Unit& u) const { int pm, pn; if (!static_tile(i, G, c, nM, nN, wgm, pm, pn)) return false; u.pm = pm; u.pn = pn; u.kind = 0; u.A = A + (size_t)pm * tA; u.B = B + (size_t)pn * tB; return true; }
    __device__ __forceinline__ void a_ready(const Unit&) const {}
    __device__ __forceinline__ void done(const Unit&) const {}
};

__device__ __forceinline__ unsigned cvt_pk_bf16(float lo, float hi) { unsigned r; asm volatile("v_cvt_pk_bf16_f32 %0, %1, %2" : "=v"(r) : "v"(lo), "v"(hi)); return r; }

template <class Epi, class Sched>
__device__ __forceinline__ void gemm_phase(PG8_LAS unsigned char* lds, const int wid  , const Gemm g, const Sched& S, const Epi& E) {
    const int lane = lane_id_opaque(), tid = wid * 64 + lane, wr = wid >> 2, wc = wid & 3, fr = lane & 15, fq = lane >> 4;
    const int K = g.K, nt = K / BK;
    unsigned voffA[2], voffB[2];
#pragma unroll
    for (int i = 0; i < 2; ++i) { int R, C; stage_rc(tid * 16 + i * 8192, R, C); const int Rb = (R & ~31) + perm32(R & 31);
        voffA[i] = (unsigned)(R * g.lda + C) * 2u; voffB[i] = (unsigned)(Rb * g.ldb + C) * 2u; }
    const size_t kstep = (size_t)(BK * 2);
    const size_t hstepA = (size_t)HALF * g.lda * 2, hstepB = (size_t)HALF * g.ldb * 2;
    const unsigned ldsw = (unsigned)wid * 1024u;
    const int aoff = lds_byte(wr * 64 + fr, fq * 8), boff = lds_byte(wc * 32 + fr, fq * 8);
#define PG8_SA(b, h) (((b) * 2 + (h)) * HTB)
#define PG8_SB(b, h) ((4 + (b) * 2 + (h)) * HTB)
#define PG8_STAGE(bufoff, gbase, voff) do { _Pragma("unroll") for (int _i = 0; _i < 2; ++_i) \
        __builtin_amdgcn_global_load_lds((const unsigned*)((const char*)(gbase) + (voff)[_i]), (PG8_LAS unsigned*)(lds + (bufoff) + ldsw + _i * 8192), 16, 0, 0); } while (0)
#define PG8_LDA(dst, b, h) do { _Pragma("unroll") for (int m = 0; m < 4; ++m) _Pragma("unroll") for (int k = 0; k < 2; ++k) dst[m][k] = *(const PG8_LAS bf16x8*)(lds + PG8_SA(b, h) + aoff + m * 2048 + k * 1024); } while (0)
#define PG8_LDB(dst, b, h) do { _Pragma("unroll") for (int n = 0; n < 2; ++n) _Pragma("unroll") for (int k = 0; k < 2; ++k) dst[n][k] = *(const PG8_LAS bf16x8*)(lds + PG8_SB(b, h) + boff + n * 2048 + k * 1024); } while (0)
#define PG8_MMA(ai, bj, At, Bt) do { if (PRIO_MODE == 0) __builtin_amdgcn_s_setprio(1); _Pragma("unroll") for (int m = 0; m < 4; ++m) _Pragma("unroll") for (int n = 0; n < 2; ++n) _Pragma("unroll") for (int k = 0; k < 2; ++k) \
        acc[ai][bj][m][n] = __builtin_amdgcn_mfma_f32_16x16x32_bf16(Bt[n][k], At[m][k], acc[ai][bj][m][n], 0, 0, 0); if (PRIO_MODE == 0) __builtin_amdgcn_s_setprio(0); } while (0)
#define PG8_WAIT_V(n) asm volatile("s_waitcnt vmcnt(" #n ")" ::: "memory")
#define PG8_WAIT_L(n) asm volatile("s_waitcnt lgkmcnt(" #n ")" ::: "memory")
#define PG8_BAR __builtin_amdgcn_s_barrier()
#define PG8_SCHED __builtin_amdgcn_sched_barrier(0)
    Unit cur, nxt; int ui = 0;
    if (!S.next(0, cur)) return;
    if (PRIO_MODE == 1) { if (wid >= 4) __builtin_amdgcn_s_setprio(1); }
    f32x4 acc[2][2][4][2];
#pragma unroll
    for (int a = 0; a < 2; ++a)
#pragma unroll
        for (int b = 0; b < 2; ++b)
#pragma unroll
            for (int m = 0; m < 4; ++m)
#pragma unroll
                for (int n = 0; n < 2; ++n) acc[a][b][m][n] = (f32x4){0.f, 0.f, 0.f, 0.f};
    bf16x8 At[4][2], B0[2][2], B1[2][2];
    const char* cA = cur.A; const char* cB = cur.B;
    S.a_ready(cur);
    PG8_STAGE(PG8_SB(0, 0), cB, voffB); PG8_STAGE(PG8_SB(0, 1), cB + hstepB, voffB); PG8_STAGE(PG8_SA(0, 0), cA, voffA); PG8_STAGE(PG8_SA(0, 1), cA + hstepA, voffA);
    if (wr == 1) PG8_BAR;
    PG8_WAIT_V(2); PG8_BAR;
    PG8_STAGE(PG8_SB(1, 0), cB + kstep, voffB); PG8_STAGE(PG8_SA(1, 0), cA + kstep, voffA); PG8_STAGE(PG8_SB(1, 1), cB + hstepB + kstep, voffB);
    PG8_WAIT_V(6); PG8_BAR;
    for (;;) {
        const bool has_next = S.next(ui + 1, nxt);
        const char* nA = has_next ? nxt.A : cA; const char* nB = has_next ? nxt.B : cB;
        for (int t = 0; t < nt; t += 2) {
            const bool last = (t == nt - 2);
            const char* a1 = cA + (size_t)(t + 1) * kstep;
            const char* a2 = last ? nA : cA + (size_t)(t + 2) * kstep; const char* b2 = last ? nB : cB + (size_t)(t + 2) * kstep;
            const char* a3 = a2 + kstep; const char* b3 = b2 + kstep;
            if (last && has_next) S.a_ready(nxt);
            PG8_LDB(B0, 0, 0); PG8_LDB(B1, 0, 1); PG8_SCHED; PG8_LDA(At, 0, 0); PG8_STAGE(PG8_SA(1, 1), a1 + hstepA, voffA);
            PG8_WAIT_V(8); PG8_WAIT_L(0); PG8_BAR; PG8_MMA(0, 0, At, B0); PG8_MMA(0, 1, At, B1); PG8_BAR; PG8_SCHED;
            PG8_LDA(At, 0, 1); PG8_STAGE(PG8_SB(0, 0), b2, voffB); PG8_STAGE(PG8_SB(0, 1), b2 + hstepB, voffB); PG8_STAGE(PG8_SA(0, 0), a2, voffA);
            PG8_WAIT_V(8); PG8_WAIT_L(0); PG8_BAR; PG8_MMA(1, 0, At, B0); PG8_MMA(1, 1, At, B1); PG8_BAR; PG8_SCHED;
            PG8_LDB(B0, 1, 0); PG8_LDB(B1, 1, 1); PG8_SCHED; PG8_LDA(At, 1, 0); PG8_STAGE(PG8_SA(0, 1), a2 + hstepA, voffA);
            PG8_WAIT_V(8); PG8_WAIT_L(0); PG8_BAR; PG8_MMA(0, 0, At, B0); PG8_MMA(0, 1, At, B1); PG8_BAR; PG8_SCHED;
            PG8_LDA(At, 1, 1); PG8_STAGE(PG8_SB(1, 0), b3, voffB); PG8_STAGE(PG8_SB(1, 1), b3 + hstepB, voffB); PG8_STAGE(PG8_SA(1, 0), a3, voffA);
            PG8_WAIT_V(8); PG8_WAIT_L(0); PG8_BAR; PG8_MMA(1, 0, At, B0); PG8_MMA(1, 1, At, B1); PG8_BAR; PG8_SCHED;
        }
        if (wr == 0) PG8_BAR;
        E(acc, cur, wr, wc); S.done(cur);
        if (!has_next) break;
#pragma unroll
        for (int a = 0; a < 2; ++a)
#pragma unroll
            for (int b = 0; b < 2; ++b)
#pragma unroll
                for (int m = 0; m < 4; ++m)
#pragma unroll
                    for (int n = 0; n < 2; ++n) acc[a][b][m][n] = (f32x4){0.f, 0.f, 0.f, 0.f};
        cur = nxt; cA = nA; cB = nB; ++ui;
        if (wr == 1) PG8_BAR;
    }
    PG8_WAIT_V(0);
    PG8_BAR;
    if (PRIO_MODE == 1) __builtin_amdgcn_s_setprio(0);
#undef PG8_SA
#undef PG8_SB
#undef PG8_STAGE
#undef PG8_LDA
#undef PG8_LDB
#undef PG8_MMA
#undef PG8_WAIT_V
#undef PG8_WAIT_L
#undef PG8_BAR
#undef PG8_SCHED
}
}

constexpr int NWAVES = 8;
constexpr int D = 1024, BATCH = 4, SEQ = 4096, NMETA = 16, DFF = 2816, DCONV = 512, CWID = 31, DSSM = 512, HG = 16, NG = 32, PS = 64;
constexpr int DIN = 2 * DCONV + DSSM + 2 * D;
constexpr int M = BATCH * SEQ;
constexpr int NCH = M / 16;
constexpr int UXK = 384;
constexpr float EPS = 1e-6f;
constexpr int PER_PHASE = 10;
#ifndef W_UP
#define W_UP 4
#endif
#ifndef W_DN
#define W_DN 8
#endif
#ifndef W_IN
#define W_IN 4
#endif
#ifndef W_MG
#define W_MG 4
#endif
#ifndef W_OUT
#define W_OUT 4
#endif
constexpr int N_LAUNCHES = MK_N_LAUNCHES;

constexpr size_t MiB = 1u << 20;
constexpr size_t WS_CTL = 0, CTL_ZERO_BYTES = 1 * MiB;
constexpr size_t WS_BS2 = 1 * MiB;
constexpr size_t WS_WSI = 7 * MiB;
constexpr size_t WS_SMALL = 9 * MiB;
constexpr size_t WS_LAMC = WS_SMALL;
constexpr size_t WS_SMETA = WS_SMALL + 16384;
constexpr size_t WS_SS0 = WS_SMALL + 32768;
constexpr size_t WS_HIDM = WS_SMALL + 32768 + 4 * 65536;
constexpr size_t WS_H1M = WS_HIDM + 16 * DFF * 4;
constexpr size_t WS_W13A = 11 * MiB, WS_W2A = 22 * MiB, WS_WIN = 28 * MiB, WS_WCAT = 35 * MiB, WS_WOUT = 38 * MiB, WS_W13B = 40 * MiB, WS_W2B = 51 * MiB;
constexpr size_t WS_AB = 57 * MiB;
constexpr size_t WS_H1 = 89 * MiB;
constexpr size_t WS_HID = 153 * MiB;
constexpr size_t WS_Z = WS_HID;
constexpr size_t WS_UX = WS_HID + 17 * MiB;
constexpr size_t WS_ZC = WS_HID + 42 * MiB;
constexpr size_t WS_Y = WS_HID + 58 * MiB;
constexpr size_t WS_MC = WS_HID;
constexpr size_t WS_S = WS_HID + 74 * MiB;
constexpr size_t WS_END = 256 * MiB;
static_assert(WS_H1M + 16 * D * 4 <= WS_W13A, "small tables");
static_assert(WS_W2B + (size_t)D * DFF * 2 <= WS_AB && WS_AB + (size_t)M * D * 2 <= WS_H1 && WS_H1 + (size_t)M * D * 4 <= WS_HID, "ws map 1");
static_assert(WS_Z + (size_t)(M + 16) * DCONV * 2 <= WS_UX && WS_UX + (size_t)NG * (NCH + 1) * UXK * 2 <= WS_ZC && WS_ZC + (size_t)M * DCONV * 2 <= WS_Y && WS_Y + (size_t)M * DSSM * 2 <= WS_S, "ws map 2");
static_assert(WS_MC + (size_t)M * D * 2 <= WS_ZC, "MC overlay");
static_assert(WS_HID + (size_t)M * DFF * 2 <= WS_END && WS_S + (size_t)NCH * NG * 128 * 4 <= WS_END, "ws end");
static_assert(WS_W13A + (size_t)2 * DFF * D * 2 <= WS_W2A && WS_W2A + (size_t)D * DFF * 2 <= WS_WIN && WS_WIN + (size_t)DIN * D * 2 <= WS_WCAT && WS_WCAT + (size_t)3072 * 512 * 2 <= WS_WOUT && WS_WOUT + (size_t)D * D * 2 <= WS_W13B && WS_W13B + (size_t)2 * DFF * D * 2 <= WS_W2B, "weights");
static_assert(WS_BS2 + (size_t)NG * 256 * UXK * 2 <= WS_WSI && WS_WSI + (size_t)NG * 128 * 256 * 2 <= WS_SMALL, "ssm mats");
constexpr int CW_BAR = 4096;
constexpr int CW_FIN = 16384;

constexpr int RING_OFF = 0, RING_BYTES = 131072;
constexpr int LDSCTL_OFF = RING_BYTES, MISC_OFF = LDSCTL_OFF + 320;
constexpr int LDS_BYTES = 147456;

#define GAS __attribute__((address_space(1)))
#define LAS __attribute__((address_space(3)))
typedef unsigned short bf16;
typedef unsigned v4u __attribute__((ext_vector_type(4)));
typedef unsigned v2u __attribute__((ext_vector_type(2)));
typedef float f32x4 __attribute__((ext_vector_type(4)));
typedef float f32x2 __attribute__((ext_vector_type(2)));
typedef short bf16x8 __attribute__((ext_vector_type(8)));
typedef GAS unsigned gu32;
#define RLX_AGENT __ATOMIC_RELAXED, __HIP_MEMORY_SCOPE_AGENT
#define LDS_WAIT() asm volatile("s_waitcnt lgkmcnt(0)" ::: "memory")
#define VM_WAIT() asm volatile("s_waitcnt vmcnt(0)" ::: "memory")
__device__ __forceinline__ unsigned f2bf(float f) { unsigned u = __builtin_bit_cast(unsigned, f); return (u + 0x7fffu + ((u >> 16) & 1u)) >> 16; }
__device__ __forceinline__ unsigned pk2(float lo, float hi) { return f2bf(lo) | (f2bf(hi) << 16); }
__device__ __forceinline__ float bf2f(unsigned h) { return __builtin_bit_cast(float, h << 16); }
__device__ __forceinline__ float fsigmoid(float x) { return __builtin_amdgcn_rcpf(1.f + __builtin_amdgcn_exp2f(-1.44269504089f * x)); }
__device__ __forceinline__ float fsilu(float x) { return x * fsigmoid(x); }
__device__ __forceinline__ float fgelu_tanh(float x) { return x * fsigmoid(1.5957691216f * (x + 0.044715f * x * x * x)); }
__device__ __forceinline__ float wave_sum(float v) {
#pragma unroll
    for (int o = 1; o < 64; o <<= 1) v += __shfl_xor(v, o);
    return v;
}

#define XB_TMO      128
#define XB_XCNT(j)  (256  + 64 * (j))
#define XB_XSUB(j)  (1280 + 64 * (j))
#define XB_XGEN(j)  (2304 + 64 * (j))
#define XB_TOP      3328
#define XB_TOPGEN   3392
#define XCD_BAR_WORDS 3456
#define XB_SPIN_CAP (1u << 18)
__device__ __forceinline__ unsigned xb_ld(unsigned* p)              { return __hip_atomic_load(p, __ATOMIC_RELAXED, __HIP_MEMORY_SCOPE_AGENT); }
__device__ __forceinline__ unsigned xb_add(unsigned* p, unsigned v) { return __hip_atomic_fetch_add(p, v, __ATOMIC_RELAXED, __HIP_MEMORY_SCOPE_AGENT); }
__device__ __forceinline__ unsigned xb_xcc_id() { return (unsigned)__builtin_amdgcn_s_getreg((3 << 11) | 20) & 0xFu; }
#define XB_SPIN(cond, bar) do { unsigned _sp = 0; while (cond) { __builtin_amdgcn_s_sleep(1); \
    if ((++_sp & 255u) == 0u) { if (xb_ld(&(bar)[XB_TMO])) break; if (_sp > XB_SPIN_CAP) { atomicAdd(&(bar)[XB_TMO], 1u); break; } } } } while (0)
struct XcdBarrier { unsigned* bar; unsigned x; volatile LAS unsigned* st; };
__device__ __forceinline__ XcdBarrier xcd_barrier_post(unsigned* bar, volatile LAS unsigned* st) {
    XcdBarrier b; b.bar = bar; b.x = xb_xcc_id(); b.st = st;
    if (threadIdx.x == 0) (void)xb_add(&bar[XB_XCNT(b.x)], 1u);
    return b;
}
__device__ __forceinline__ void xcd_barrier_complete(unsigned* bar, unsigned x, unsigned& nloc, unsigned& nx) {
    const unsigned G = gridDim.x * gridDim.y * gridDim.z;
    unsigned sum, cnt, mine, sp = 0u;
    for (;;) {
        sum = 0u; cnt = 0u; mine = 0u;
#pragma unroll
        for (unsigned j = 0; j < 16; ++j) { const unsigned c = xb_ld(&bar[XB_XCNT(j)]); sum += c; cnt += (c > 0u) ? 1u : 0u; mine = (j == x) ? c : mine; }
        if (sum == G) break;
        __builtin_amdgcn_s_sleep(1);
        if ((++sp & 255u) == 0u) { if (xb_ld(&bar[XB_TMO])) break; if (sp > XB_SPIN_CAP) { atomicAdd(&bar[XB_TMO], 1u); break; } }
    }
    nloc = mine > 0u ? mine : 1u; nx = cnt > 0u ? cnt : 1u;
}
__device__ __forceinline__ void xcd_barrier(const XcdBarrier& b) {
    asm volatile("s_waitcnt vmcnt(0)" ::: "memory");
    __syncthreads();
    if (threadIdx.x == 0) {
        unsigned* bar = b.bar;
        __builtin_amdgcn_s_waitcnt(0);
        unsigned nloc = b.st[0], nx = b.st[1];
        if (nloc == 0u) { xcd_barrier_complete(bar, b.x, nloc, nx); b.st[0] = nloc; b.st[1] = nx; }
        const unsigned old = xb_add(&bar[XB_XSUB(b.x)], 1u);
        const unsigned gen = old / nloc;
        if (old + 1u == (gen + 1u) * nloc) {
            __builtin_amdgcn_fence(__ATOMIC_RELEASE, "agent");
            asm volatile("s_waitcnt vmcnt(0)" ::: "memory");
            const unsigned og = xb_add(&bar[XB_TOP], 1u);
            const unsigned tg = og / nx;
            if (og + 1u == (tg + 1u) * nx) xb_add(&bar[XB_TOPGEN], 1u);
            else XB_SPIN(xb_ld(&bar[XB_TOPGEN]) == tg, bar);
            __builtin_amdgcn_fence(__ATOMIC_ACQUIRE, "agent");
            xb_add(&bar[XB_XGEN(b.x)], 1u);
            asm volatile("s_waitcnt vmcnt(0)" ::: "memory");
        } else {
            XB_SPIN(xb_ld(&bar[XB_XGEN(b.x)]) == gen, bar);
            __builtin_amdgcn_fence(__ATOMIC_ACQUIRE, "agent");
            asm volatile("s_waitcnt vmcnt(0)" ::: "memory");
        }
    }
    __syncthreads();
}

struct Args { const float* in[30]; float* out; unsigned char* ws; int ph_lo, ph_hi, li, pad; };
struct Frame {
    LAS unsigned char* lds; volatile LAS unsigned* MISC; gu32* ctl;
    int tid, lane, wave, vcu, G;
    float* out; unsigned char* ws;
};
enum { I_X = 0, I_META, I_F1N, I_F1W1, I_F1W3, I_F1W2, I_MIXN, I_WIN, I_BGATE, I_DW, I_DWB, I_LNG, I_LNB, I_CPROJ, I_LRE, I_LIM, I_LDT, I_BRE, I_BIM, I_CRE, I_CIM, I_SD, I_WV, I_WG, I_WOUT, I_F2N, I_F2W1, I_F2W3, I_F2W2, I_FINN };

constexpr int CW_TKT = 32768;
__device__ __forceinline__ int wg_ticket(Frame& F, int k) {
    __syncthreads();
    if (F.tid == 0) F.MISC[16] = __hip_atomic_fetch_add((unsigned*)(F.ctl + CW_TKT + 64 * k), 1u, __ATOMIC_RELAXED, __HIP_MEMORY_SCOPE_AGENT);
    __syncthreads();
    return (int)F.MISC[16];
}
constexpr int CW_MBD = 49152;
__device__ __forceinline__ void wait_mbd(Frame& F) {
    if (F.wave == 0) { unsigned* p = (unsigned*)(F.ctl + CW_MBD); unsigned sp = 0;
        while ((unsigned)__builtin_amdgcn_readfirstlane((int)__hip_atomic_load(p, __ATOMIC_RELAXED, __HIP_MEMORY_SCOPE_AGENT)) < 64u) { __builtin_amdgcn_s_sleep(2); if (++sp > (1u << 22)) break; }
        __builtin_amdgcn_fence(__ATOMIC_ACQUIRE, "agent"); asm volatile("s_waitcnt vmcnt(0)" ::: "memory"); }
    __syncthreads();
}
using pg8::Unit; using pg8::cvt_pk_bf16;
__device__ __forceinline__ v4u pack8(const f32x4 a, const f32x4 b) { v4u w; w.x = cvt_pk_bf16(a[0], a[1]); w.y = cvt_pk_bf16(a[2], a[3]); w.z = cvt_pk_bf16(b[0], b[1]); w.w = cvt_pk_bf16(b[2], b[3]); return w; }
__device__ __forceinline__ void unpack8(const v4u w, float (&o)[8]) { o[0] = bf2f(w.x & 0xffffu); o[1] = bf2f(w.x >> 16); o[2] = bf2f(w.y & 0xffffu); o[3] = bf2f(w.y >> 16); o[4] = bf2f(w.z & 0xffffu); o[5] = bf2f(w.z >> 16); o[6] = bf2f(w.w & 0xffffu); o[7] = bf2f(w.w >> 16); }
__device__ __forceinline__ float rs_from(float ss) { return __builtin_amdgcn_rsqf(ss * (1.0f / D) + EPS); }
__device__ __forceinline__ void load_rs8(const float* SS, int row0, float (&rs)[8]) {
#pragma unroll
    for (int i = 0; i < 8; ++i) rs[i] = SS[row0 + (i >> 2) * 128 + (i & 3) * 16];
#pragma unroll
    for (int i = 0; i < 8; ++i) rs[i] = rs_from(rs[i]);
}

struct EpiSwiglu {
    bf16* HID; const float* SS;
    __device__ __forceinline__ void operator()(const f32x4 (&acc)[2][2][4][2], const Unit& u, int wr, int wc) const {
        const int lane_ = lane_id_opaque(), fr = lane_ & 15, fq = lane_ >> 4;
        const int row0 = u.pm * 256 + wr * 64 + fr, col0 = u.pn * 128 + wc * 32 + 8 * fq;
        float rsv[8]; load_rs8(SS, row0, rsv);
#pragma unroll
        for (int ai = 0; ai < 2; ++ai)
#pragma unroll
            for (int m = 0; m < 4; ++m) { const int row = row0 + ai * 128 + m * 16; const float rs = rsv[ai * 4 + m];
                f32x4 o0, o1;
#pragma unroll
                for (int j = 0; j < 4; ++j) { o0[j] = fsilu(acc[ai][0][m][0][j] * rs) * (acc[ai][1][m][0][j] * rs); o1[j] = fsilu(acc[ai][0][m][1][j] * rs) * (acc[ai][1][m][1][j] * rs); }
                *(v4u*)(HID + (size_t)row * DFF + col0) = pack8(o0, o1); }
    }
};
template <bool RBF16> struct EpiResid {
    const void* R; bf16* OB; float* SS; float alpha;
    __device__ __forceinline__ void operator()(const f32x4 (&acc)[2][2][4][2], const Unit& u, int wr, int wc) const {
        const int lane_ = lane_id_opaque(), fr = lane_ & 15, fq = lane_ >> 4;
        const int row0 = u.pm * 256 + wr * 64 + fr, col0 = u.pn * 256 + wc * 32 + 8 * fq;
#pragma unroll
        for (int ai = 0; ai < 2; ++ai) {
            f32x4 r[4][2][2];
#pragma unroll
            for (int m = 0; m < 4; ++m)
#pragma unroll
                for (int bj = 0; bj < 2; ++bj) { const size_t off = (size_t)(row0 + ai * 128 + m * 16) * D + col0 + bj * 128;
                    if (RBF16) { const v4u w = *(const v4u*)((const bf16*)R + off); r[m][bj][0] = __builtin_bit_cast(f32x4, w); }
                    else { r[m][bj][0] = *(const f32x4*)((const float*)R + off); r[m][bj][1] = *(const f32x4*)((const float*)R + off + 4); } }
#pragma unroll
            for (int m = 0; m < 4; ++m) { const int row = row0 + ai * 128 + m * 16; float ss = 0.f;
#pragma unroll
                for (int bj = 0; bj < 2; ++bj) { const size_t off = (size_t)row * D + col0 + bj * 128; f32x4 r0, r1;
                    if (RBF16) { float t[8]; unpack8(__builtin_bit_cast(v4u, r[m][bj][0]), t); r0 = (f32x4){t[0], t[1], t[2], t[3]}; r1 = (f32x4){t[4], t[5], t[6], t[7]}; }
                    else { r0 = r[m][bj][0]; r1 = r[m][bj][1]; }
                    const f32x4 o0 = r0 + acc[ai][bj][m][0] * alpha, o1 = r1 + acc[ai][bj][m][1] * alpha;
                    *(v4u*)(OB + off) = pack8(o0, o1);
                    ss += (o0[0] * o0[0] + o0[1] * o0[1]) + (o0[2] * o0[2] + o0[3] * o0[3]) + (o1[0] * o1[0] + o1[1] * o1[1]) + (o1[2] * o1[2] + o1[3] * o1[3]); }
                ss += __shfl_xor(ss, 16); ss += __shfl_xor(ss, 32);
                if (fq == 0) atomicAdd(SS + row, ss); }
            asm volatile("" ::: "memory"); }
    }
};
struct EpiFinal {
    const bf16* R; float* OUT; float* SS; unsigned* cnt; const float* gain; float alpha;
    __device__ __forceinline__ void operator()(f32x4 (&acc)[2][2][4][2], const Unit& u, int wr, int wc) const {
        const int lane_ = lane_id_opaque(), fr = lane_ & 15, fq = lane_ >> 4;
        const int row0 = u.pm * 256 + wr * 64 + fr, col0 = u.pn * 256 + wc * 32 + 8 * fq;
#pragma unroll
        for (int ai = 0; ai < 2; ++ai) {
            v4u r[4][2];
#pragma unroll
            for (int m = 0; m < 4; ++m)
#pragma unroll
                for (int bj = 0; bj < 2; ++bj) r[m][bj] = *(const v4u*)(R + (size_t)(row0 + ai * 128 + m * 16) * D + col0 + bj * 128);
#pragma unroll
            for (int m = 0; m < 4; ++m) { const int row = row0 + ai * 128 + m * 16; float ss = 0.f;
#pragma unroll
                for (int bj = 0; bj < 2; ++bj) { float t[8]; unpack8(r[m][bj], t);
                    const f32x4 o0 = (f32x4){t[0], t[1], t[2], t[3]} + acc[ai][bj][m][0] * alpha, o1 = (f32x4){t[4], t[5], t[6], t[7]} + acc[ai][bj][m][1] * alpha;
                    acc[ai][bj][m][0] = o0; acc[ai][bj][m][1] = o1;
                    ss += (o0[0] * o0[0] + o0[1] * o0[1]) + (o0[2] * o0[2] + o0[3] * o0[3]) + (o1[0] * o1[0] + o1[1] * o1[1]) + (o1[2] * o1[2] + o1[3] * o1[3]); }
                ss += __shfl_xor(ss, 16); ss += __shfl_xor(ss, 32);
                if (fq == 0) atomicAdd(SS + row, ss); }
            asm volatile("" ::: "memory"); }
        asm volatile("s_waitcnt vmcnt(0)" ::: "memory");
        unsigned* cw = cnt + 64 * u.pm;
        if (lane_ == 0) __hip_atomic_fetch_add(cw, 1u, __ATOMIC_RELAXED, __HIP_MEMORY_SCOPE_AGENT);
        f32x4 g[2][2];
#pragma unroll
        for (int bj = 0; bj < 2; ++bj) { g[bj][0] = *(const f32x4*)(gain + col0 + bj * 128); g[bj][1] = *(const f32x4*)(gain + col0 + bj * 128 + 4); }
        { unsigned sp = 0; while ((unsigned)__builtin_amdgcn_readfirstlane((int)__hip_atomic_load(cw, __ATOMIC_RELAXED, __HIP_MEMORY_SCOPE_AGENT)) < 32u) { __builtin_amdgcn_s_sleep(2); if (++sp > (1u << 20)) break; } }
        float tot[8];
#pragma unroll
        for (int i = 0; i < 8; ++i) { tot[i] = 0.f; if (fq == 0) tot[i] = __hip_atomic_fetch_add(SS + row0 + (i >> 2) * 128 + (i & 3) * 16, 0.0f, __ATOMIC_RELAXED, __HIP_MEMORY_SCOPE_AGENT); }
#pragma unroll
        for (int ai = 0; ai < 2; ++ai)
#pragma unroll
            for (int m = 0; m < 4; ++m) { const int row = row0 + ai * 128 + m * 16;
                const float rs = rs_from(__shfl(tot[ai * 4 + m], fr));
#pragma unroll
                for (int bj = 0; bj < 2; ++bj) { const size_t off = (size_t)row * D + col0 + bj * 128;
                    *(f32x4*)(OUT + off) = acc[ai][bj][m][0] * rs * g[bj][0]; *(f32x4*)(OUT + off + 4) = acc[ai][bj][m][1] * rs * g[bj][1]; } }
    }
};
struct EpiMix {
    const float* SS; bf16* Z; bf16* UX; bf16* G; const float* bgate;
    __device__ __forceinline__ void operator()(const f32x4 (&acc)[2][2][4][2], const Unit& u, int wr, int wc) const {
        const int lane_ = lane_id_opaque(), fr = lane_ & 15, fq = lane_ >> 4;
        const int row0 = u.pm * 256 + wr * 64 + fr;
        if (u.pn < 4) {
            const int col0 = u.pn * 128 + wc * 32 + 8 * fq;
#pragma unroll
            for (int ai = 0; ai < 2; ++ai)
#pragma unroll
                for (int m = 0; m < 4; ++m) { const int row = row0 + ai * 128 + m * 16; const float rs = rs_from(SS[row]); f32x4 o0, o1;
#pragma unroll
                    for (int j = 0; j < 4; ++j) { o0[j] = (acc[ai][0][m][0][j] * rs) * fsigmoid(acc[ai][1][m][0][j] * rs); o1[j] = (acc[ai][0][m][1][j] * rs) * fsigmoid(acc[ai][1][m][1][j] * rs); }
                    *(v4u*)(Z + (size_t)row * DCONV + col0) = pack8(o0, o1); }
        } else if (u.pn < 6) {
#pragma unroll
            for (int ai = 0; ai < 2; ++ai)
#pragma unroll
                for (int m = 0; m < 4; ++m) { const int row = row0 + ai * 128 + m * 16; const float rs = rs_from(SS[row]); const int ci = row >> 4, tt = row & 15;
#pragma unroll
                    for (int bj = 0; bj < 2; ++bj) { const int c = (u.pn - 4) * 256 + bj * 128 + wc * 32 + 8 * fq, g = c >> 4, h0 = c & 15;
                        *(v4u*)(UX + ((size_t)(g * (NCH + 1) + ci) * UXK + tt * 16 + h0)) = pack8(acc[ai][bj][m][0] * rs, acc[ai][bj][m][1] * rs); } }
        } else {
#pragma unroll
            for (int bj = 0; bj < 2; ++bj) { const int c = (u.pn - 6) * 256 + bj * 128 + wc * 32 + 8 * fq;
                const f32x4 b0 = *(const f32x4*)(bgate + c), b1 = *(const f32x4*)(bgate + c + 4);
#pragma unroll
                for (int ai = 0; ai < 2; ++ai)
#pragma unroll
                    for (int m = 0; m < 4; ++m) { const int row = row0 + ai * 128 + m * 16; const float rs = rs_from(SS[row]); f32x4 o0, o1;
#pragma unroll
                        for (int j = 0; j < 4; ++j) { o0[j] = fsigmoid(acc[ai][bj][m][0][j] * rs + b0[j]); o1[j] = fsigmoid(acc[ai][bj][m][1][j] * rs + b1[j]); }
                        *(v4u*)(G + (size_t)row * 2048 + c) = pack8(o0, o1); } }
        }
    }
};
struct EpiSsmY {
    const bf16* UX; const float* dskip; bf16* Y;
    __device__ __forceinline__ void operator()(const f32x4 (&acc)[2][2][4][2], const Unit& u, int wr, int wc) const {
        const int lane_ = lane_id_opaque(), fr = lane_ & 15, fq = lane_ >> 4;
        const int b = u.pm, g = u.pn, h0 = 8 * (fq & 1);
        const f32x4 d0 = *(const f32x4*)(dskip + g * 16 + h0), d1 = *(const f32x4*)(dskip + g * 16 + h0 + 4);
#pragma unroll
        for (int ai = 0; ai < 2; ++ai) {
            v4u uw[4][2];
#pragma unroll
            for (int m = 0; m < 4; ++m)
#pragma unroll
                for (int bj = 0; bj < 2; ++bj) { const int r = ai * 128 + wr * 64 + m * 16 + fr, tt = 8 * bj + 2 * wc + (fq >> 1);
                    uw[m][bj] = *(const v4u*)(UX + ((size_t)(g * (NCH + 1) + b * 256 + r) * UXK + tt * 16 + h0)); }
#pragma unroll
            for (int m = 0; m < 4; ++m) { const int r = ai * 128 + wr * 64 + m * 16 + fr;
#pragma unroll
                for (int bj = 0; bj < 2; ++bj) { const int tt = 8 * bj + 2 * wc + (fq >> 1);
                    float uu[8]; unpack8(uw[m][bj], uu);
                    f32x4 o0, o1;
#pragma unroll
                    for (int j = 0; j < 4; ++j) { o0[j] = fgelu_tanh(acc[ai][bj][m][0][j] + d0[j] * uu[j]); o1[j] = fgelu_tanh(acc[ai][bj][m][1][j] + d1[j] * uu[4 + j]); }
                    *(v4u*)(Y + ((size_t)(b * SEQ + r * 16 + tt) * DSSM + g * 16 + h0)) = pack8(o0, o1); } }
            asm volatile("" ::: "memory"); }
    }
};
struct EpiMerge {
    const bf16* G; bf16* MC; bf16* MG;
    __device__ __forceinline__ void operator()(const f32x4 (&acc)[2][2][4][2], const Unit& u, int wr, int wc) const {
        const int lane_ = lane_id_opaque(), fr = lane_ & 15, fq = lane_ >> 4;
        const int row0 = u.pm * 256 + wr * 64 + fr;
        if (u.kind == 0) {
#pragma unroll
            for (int ai = 0; ai < 2; ++ai) {
                v4u gw[4][2];
#pragma unroll
                for (int m = 0; m < 4; ++m)
#pragma unroll
                    for (int bj = 0; bj < 2; ++bj) gw[m][bj] = *(const v4u*)(G + (size_t)(row0 + ai * 128 + m * 16) * 2048 + u.pn * 256 + bj * 128 + wc * 32 + 8 * fq);
#pragma unroll
                for (int m = 0; m < 4; ++m) { const int row = row0 + ai * 128 + m * 16;
#pragma unroll
                    for (int bj = 0; bj < 2; ++bj) { const int c = u.pn * 256 + bj * 128 + wc * 32 + 8 * fq;
                        float gg[8]; unpack8(gw[m][bj], gg); f32x4 o0, o1;
#pragma unroll
                        for (int j = 0; j < 4; ++j) { o0[j] = gg[j] * acc[ai][bj][m][0][j]; o1[j] = gg[4 + j] * acc[ai][bj][m][1][j]; }
                        *(v4u*)(MC + (size_t)row * D + c) = pack8(o0, o1); } }
                asm volatile("" ::: "memory"); }
        } else {
            const int c = u.pn * 256 + (u.kind - 1) * 128 + wc * 32 + 8 * fq;
#pragma unroll
            for (int ai = 0; ai < 2; ++ai) {
                v4u gw[4], mw[4];
#pragma unroll
                for (int m = 0; m < 4; ++m) { const int row = row0 + ai * 128 + m * 16; gw[m] = *(const v4u*)(G + (size_t)row * 2048 + D + c); mw[m] = *(const v4u*)(MC + (size_t)row * D + c); }
#pragma unroll
                for (int m = 0; m < 4; ++m) { const int row = row0 + ai * 128 + m * 16;
                    float gg[8], mc[8]; unpack8(gw[m], gg); unpack8(mw[m], mc); f32x4 o0, o1;
#pragma unroll
                    for (int j = 0; j < 4; ++j) { o0[j] = mc[j] + gg[j] * (acc[ai][0][m][0][j] * fsigmoid(acc[ai][1][m][0][j])); o1[j] = mc[4 + j] + gg[4 + j] * (acc[ai][0][m][1][j] * fsigmoid(acc[ai][1][m][1][j])); }
                    *(v4u*)(MG + (size_t)row * D + c) = pack8(o0, o1); }
                asm volatile("" ::: "memory"); }
        }
    }
};
struct SsmOrder {
    int G, c; const char* UX; const char* BS2;
    __device__ __forceinline__ bool next(int i, Unit& u) const { const int L = i * G + c; if (L >= BATCH * NG) return false; const int b = L / NG, g = L % NG; u.pm = b; u.pn = g; u.kind = 0;
        u.A = UX + ((size_t)(g * (NCH + 1) + b * 256) * UXK) * 2; u.B = BS2 + (size_t)g * 256 * UXK * 2; return true; }
    __device__ __forceinline__ void a_ready(const Unit&) const {}
    __device__ __forceinline__ void done(const Unit&) const {}
};
struct MergeOrder {
    int G, c; const char* ZC; const char* Y; const char* WCAT;
    __device__ __forceinline__ bool next(int i, Unit& u) const { int pm, pn; const int su = i / 3, k = i - 3 * su; if (!pg8::static_tile(su, G, c, M / 256, D / 256, W_MG, pm, pn)) return false; u.pm = pm; u.pn = pn; u.kind = k;
        u.A = (k == 0 ? ZC : Y) + (size_t)pm * 256 * 512 * 2; u.B = WCAT + (size_t)(k == 0 ? pn * 256 : 1024 + (2 * pn + k - 1) * 256) * 512 * 2; return true; }
    __device__ __forceinline__ void a_ready(const Unit&) const {}
    __device__ __forceinline__ void done(const Unit& u) const { if (u.kind == 0) asm volatile("s_waitcnt vmcnt(0)" ::: "memory"); }
};

__device__ __forceinline__ void p0_transpose_item(const float* W, int K, int N, bf16* WT, const float* gain, LAS float* scr, int k0, int n0, int drow0, int lane) {
    float v[32];
    const float* src = W + (size_t)(k0 + (lane >> 5)) * N + n0 + (lane & 31);
#pragma unroll
    for (int i = 0; i < 32; ++i) v[i] = src[(size_t)(2 * i) * N];
#pragma unroll
    for (int i = 0; i < 32; ++i) scr[(2 * i + (lane >> 5)) * 33 + (lane & 31)] = v[i];
    LDS_WAIT(); asm volatile("" ::: "memory");
    const int c = lane & 7;
    f32x4 g0 = (f32x4){1.f, 1.f, 1.f, 1.f}, g1 = g0; if (gain) { g0 = *(const f32x4*)(gain + k0 + 8 * c); g1 = *(const f32x4*)(gain + k0 + 8 * c + 4); }
#pragma unroll
    for (int j = 0; j < 4; ++j) { const int n = (lane >> 3) + 8 * j; const LAS float* s = scr + (8 * c) * 33 + n;
        v4u o; o.x = pk2(s[0 * 33] * g0[0], s[1 * 33] * g0[1]); o.y = pk2(s[2 * 33] * g0[2], s[3 * 33] * g0[3]); o.z = pk2(s[4 * 33] * g1[0], s[5 * 33] * g1[1]); o.w = pk2(s[6 * 33] * g1[2], s[7 * 33] * g1[3]);
        *(GAS v4u*)(WT + (size_t)(drow0 + n) * K + k0 + 8 * c) = o; }
    LDS_WAIT(); asm volatile("" ::: "memory");
}
__device__ __forceinline__ int glu_row(int n) { return 256 * (n >> 7) + (n & 127); }

constexpr int I_UP = (D / 64) * (DFF / 32), I_DN = (DFF / 64) * (D / 32), I_INP = (D / 64) * (DIN / 32), I_CP = (DCONV / 64) * (D / 32), I_WO = (D / 64) * (D / 32);
constexpr int T_W13A = 2 * I_UP, T_W2A = T_W13A + I_DN, T_WIN = T_W2A + I_INP, T_WCAT = T_WIN + 3 * I_CP, T_WOUT = T_WCAT + I_WO, T_W13B = T_WOUT + 2 * I_UP, T_W2B = T_W13B + I_DN;
__device__ __forceinline__ void weight_item(const Args& args, unsigned char* ws, LAS float* scr, int it, int lane) {
    if (it < T_W13A || (it >= T_WOUT && it < T_W13B)) { const bool second = it >= T_WOUT; int r = it - (second ? T_WOUT : 0); const int which = r / I_UP; r -= which * I_UP; const int nblk = DFF / 32, k0 = 64 * (r / nblk), n0 = 32 * (r % nblk);
        const float* W = second ? (which ? args.in[I_F2W3] : args.in[I_F2W1]) : (which ? args.in[I_F1W3] : args.in[I_F1W1]);
        p0_transpose_item(W, D, DFF, (bf16*)(ws + (second ? WS_W13B : WS_W13A)), second ? args.in[I_F2N] : args.in[I_F1N], scr, k0, n0, glu_row(n0) + which * 128, lane); return; }
    if (it < T_W2A || it >= T_W13B) { const bool second = it >= T_W13B; const int r = it - (second ? T_W13B : T_W13A); const int nblk = D / 32, k0 = 64 * (r / nblk), n0 = 32 * (r % nblk);
        p0_transpose_item(second ? args.in[I_F2W2] : args.in[I_F1W2], DFF, D, (bf16*)(ws + (second ? WS_W2B : WS_W2A)), nullptr, scr, k0, n0, n0, lane); return; }
    if (it < T_WIN) { const int r = it - T_W2A; const int nblk = DIN / 32, k0 = 64 * (r / nblk), n0 = 32 * (r % nblk);
        const int dr = n0 < 512 ? glu_row(n0) : n0 < 1024 ? glu_row(n0 - 512) + 128 : n0;
        p0_transpose_item(args.in[I_WIN], D, DIN, (bf16*)(ws + WS_WIN), args.in[I_MIXN], scr, k0, n0, dr, lane); return; }
    if (it < T_WCAT) { int r = it - T_WIN; const int which = r / I_CP; r -= which * I_CP; const int nblk = D / 32, k0 = 64 * (r / nblk), n0 = 32 * (r % nblk);
        const int dr = which == 0 ? n0 : 1024 + glu_row(n0) + (which == 2 ? 128 : 0);
        p0_transpose_item(which == 0 ? args.in[I_CPROJ] : which == 1 ? args.in[I_WV] : args.in[I_WG], DCONV, D, (bf16*)(ws + WS_WCAT), nullptr, scr, k0, n0, dr, lane); return; }
    { const int r = it - T_WCAT; const int nblk = D / 32, k0 = 64 * (r / nblk), n0 = 32 * (r % nblk); p0_transpose_item(args.in[I_WOUT], D, D, (bf16*)(ws + WS_WOUT), nullptr, scr, k0, n0, n0, lane); }
}

__device__ __forceinline__ void ssm_prep_job(Frame& F, const Args& args, int g) {
    LAS f32x2* lamP = (LAS f32x2*)(F.lds + RING_OFF);
    LAS f32x2* Bb = lamP + 17 * 64;
    LAS f32x2* Cc = Bb + 64 * 16;
    LAS float* Kk = (LAS float*)(Cc + 16 * 64);
    const float* lam_re = args.in[I_LRE]; const float* lam_im = args.in[I_LIM]; const float* log_dt = args.in[I_LDT];
    const float* b_re = args.in[I_BRE]; const float* b_im = args.in[I_BIM]; const float* c_re = args.in[I_CRE]; const float* c_im = args.in[I_CIM];
    const int tid = F.tid;
    const float dt = expf(log_dt[g]);
    if (tid < 64) { const int p = tid; const float a = lam_re[g * PS + p] * dt, bb = lam_im[g * PS + p] * dt, ea = expf(a), sb = sinf(bb), cb = cosf(bb);
        const float lx = ea * cb, ly = ea * sb; float px = 1.f, py = 0.f;
        for (int k = 0; k <= 16; ++k) { lamP[k * 64 + p] = (f32x2){px, py}; const float nx = px * lx - py * ly, ny = px * ly + py * lx; px = nx; py = ny; } }
    for (int i = tid; i < 1024; i += 512) { const int p = i >> 4;
        const float lr = lam_re[g * PS + p], li = lam_im[g * PS + p], a = lr * dt, bb = li * dt, ea = expf(a), sb = sinf(bb), cb = cosf(bb), sh = sinf(0.5f * bb);
        const float nr = expm1f(a) * cb - 2.f * sh * sh, ni = ea * sb, den = 1.f / (lr * lr + li * li), fr_ = (nr * lr + ni * li) * den, fi_ = (ni * lr - nr * li) * den;
        const float br = b_re[(size_t)g * 1024 + i], bi = b_im[(size_t)g * 1024 + i];
        Bb[i] = (f32x2){fr_ * br - fi_ * bi, fr_ * bi + fi_ * br};
        Cc[i] = (f32x2){c_re[(size_t)g * 1024 + i], c_im[(size_t)g * 1024 + i]}; }
    __syncthreads();
    {
        const int k = tid >> 5, h = (tid >> 1) & 15, hh = (tid & 1) * 8; float sum[8];
#pragma unroll
        for (int j = 0; j < 8; ++j) sum[j] = 0.f;
#pragma unroll 4
        for (int p = 0; p < 64; ++p) { const f32x2 c = Cc[h * 64 + p], l = lamP[k * 64 + p]; const float er = c.x * l.x - c.y * l.y, ei = c.x * l.y + c.y * l.x;
#pragma unroll
            for (int j = 0; j < 8; j += 2) { const f32x4 bb = *(const LAS f32x4*)(Bb + p * 16 + hh + j); sum[j] += er * bb[0] - ei * bb[1]; sum[j + 1] += er * bb[2] - ei * bb[3]; } }
#pragma unroll
        for (int j = 0; j < 8; ++j) Kk[(k << 8) + (h << 4) + hh + j] = sum[j];
    }
    __syncthreads();
    GAS unsigned* bs2 = (GAS unsigned*)(F.ws + WS_BS2) + (size_t)g * 256 * (UXK / 2);
    for (int i = tid; i < 256 * (UXK / 2); i += 512) { const int n = i / (UXK / 2), kp = (i % (UXK / 2)) * 2, t = n >> 4, h = n & 15; float v0, v1;
        if (kp < 256) { const int s = kp >> 4, hp = kp & 15; const bool on = s <= t; const int kb = (((t - s) & 15) << 8) + (h << 4) + hp; v0 = on ? Kk[kb] : 0.f; v1 = on ? Kk[kb + 1] : 0.f; }
        else { const int p = (kp - 256) >> 1; const f32x2 c = Cc[h * 64 + p], l = lamP[(t + 1) * 64 + p]; v0 = c.x * l.x - c.y * l.y; v1 = -(c.x * l.y + c.y * l.x); }
        bs2[i] = pk2(v0, v1); }
    GAS unsigned* wsi = (GAS unsigned*)(F.ws + WS_WSI) + (size_t)g * 128 * 128;
    for (int i = tid; i < 128 * 128; i += 512) { const int n = i >> 7, kp = (i & 127) * 2, p = n >> 1, c = n & 1, s = kp >> 4, h = kp & 15;
        const f32x2 l = lamP[(15 - s) * 64 + p], b0 = Bb[p * 16 + h], b1 = Bb[p * 16 + h + 1];
        const float v0 = c ? (l.x * b0.y + l.y * b0.x) : (l.x * b0.x - l.y * b0.y), v1 = c ? (l.x * b1.y + l.y * b1.x) : (l.x * b1.x - l.y * b1.y);
        wsi[i] = pk2(v0, v1); }
    if (tid < 64) ((GAS f32x2*)(F.ws + WS_LAMC))[g * 64 + tid] = lamP[16 * 64 + tid];
    __syncthreads();
}

template <int NS, bool NORM, class Fn>
__device__ __forceinline__ void meta_job(Frame& F, const float* A, int K, const bf16* Bt0, const bf16* Bt1, const Fn& fn) {
    LAS float* red = (LAS float*)(F.lds + RING_OFF);
    LAS float* rsc = red + 8 * 16 * 32;
    const int lane = F.lane, w = F.wave, fr = lane & 15, fq = lane >> 4;
    if (NORM) {
#pragma unroll
        for (int rr = 0; rr < 2; ++rr) { const int row = 2 * w + rr; float s = 0.f; for (int c = lane; c < D; c += 64) { const float v = A[(size_t)row * K + c]; s += v * v; } s = wave_sum(s); if (lane == 0) rsc[row] = 1.0f / sqrtf(s * (1.0f / D) + EPS); }
    } else if (F.tid < 16) rsc[F.tid] = 1.f;
    f32x4 acc[NS];
#pragma unroll
    for (int s = 0; s < NS; ++s) acc[s] = (f32x4){0.f, 0.f, 0.f, 0.f};
    const int kw = K / 8, kbase = w * kw;
#pragma unroll 4
    for (int k = kbase; k < kbase + kw; k += 32) {
        const f32x4 a0 = *(const f32x4*)(A + (size_t)fr * K + k + 8 * fq), a1 = *(const f32x4*)(A + (size_t)fr * K + k + 8 * fq + 4);
        const v4u ap = pack8(a0, a1); const bf16x8 af = __builtin_bit_cast(bf16x8, ap);
#pragma unroll
        for (int s = 0; s < NS; ++s) { const bf16x8 bf = *(const bf16x8*)((s == 0 ? Bt0 : Bt1) + (size_t)fr * K + k + 8 * fq); acc[s] = __builtin_amdgcn_mfma_f32_16x16x32_bf16(bf, af, acc[s], 0, 0, 0); } }
#pragma unroll
    for (int s = 0; s < NS; ++s) *(LAS f32x4*)(red + (w * 16 + fr) * 32 + s * 16 + 4 * fq) = acc[s];
    __syncthreads();
    if (F.tid < 256) { const int rr = F.tid >> 4, j = F.tid & 15; float v0 = 0.f, v1 = 0.f;
#pragma unroll
        for (int ww = 0; ww < 8; ++ww) { v0 += red[(ww * 16 + rr) * 32 + j]; if (NS > 1) v1 += red[(ww * 16 + rr) * 32 + 16 + j]; }
        const float sc = rsc[rr]; fn(rr, j, v0 * sc, v1 * sc); }
    VM_WAIT();
    __syncthreads();
}

constexpr int WSI_PITCH = 528;
constexpr int SMETA_OFF = LDSCTL_OFF + 1024;
__device__ __forceinline__ void ssm_pre_job(Frame& F, int b, int g) {
    const int lane = F.lane, w = F.wave, tid = F.tid, fr = lane & 15, fq = lane >> 4;
    LAS unsigned char* Bl = F.lds + RING_OFF;
    LAS f32x2* Sl = (LAS f32x2*)(F.lds + RING_OFF);
    LAS float* smeta = (LAS float*)(F.lds + SMETA_OFF);
    bf16* UX = (bf16*)(F.ws + WS_UX); const bf16* Wg = (const bf16*)(F.ws + WS_WSI) + (size_t)g * 128 * 256;
    { v4u v[8];
#pragma unroll
      for (int i = 0; i < 8; ++i) { const int idx = tid + 512 * i; v[i] = *(const v4u*)(Wg + (size_t)(idx >> 5) * 256 + (idx & 31) * 8); }
#pragma unroll
      for (int i = 0; i < 8; ++i) { const int idx = tid + 512 * i; *(LAS v4u*)(Bl + (idx >> 5) * WSI_PITCH + (idx & 31) * 16) = v[i]; } }
    const bf16* Ab = UX + (size_t)(g * (NCH + 1) + 256 * b + 32 * w) * UXK;
    bf16x8 a[2][8], am[8];
#pragma unroll
    for (int mt = 0; mt < 2; ++mt)
#pragma unroll
        for (int ks = 0; ks < 8; ++ks) a[mt][ks] = *(const bf16x8*)(Ab + (size_t)(16 * mt + fr) * UXK + 32 * ks + 8 * fq);
    if (w == 7) {
#pragma unroll
        for (int ks = 0; ks < 8; ++ks) am[ks] = *(const bf16x8*)(UX + (size_t)(g * (NCH + 1) + NCH) * UXK + 32 * ks + 8 * fq); }
    f32x4 acc[2][8], accm[8];
#pragma unroll
    for (int nt = 0; nt < 8; ++nt) { acc[0][nt] = (f32x4){0.f, 0.f, 0.f, 0.f}; acc[1][nt] = acc[0][nt]; accm[nt] = acc[0][nt]; }
    __syncthreads();
#pragma unroll
    for (int ks = 0; ks < 8; ++ks)
#pragma unroll
        for (int nt = 0; nt < 8; ++nt) { const bf16x8 bfr = *(const LAS bf16x8*)(Bl + (16 * nt + fr) * WSI_PITCH + (32 * ks + 8 * fq) * 2);
            acc[0][nt] = __builtin_amdgcn_mfma_f32_16x16x32_bf16(bfr, a[0][ks], acc[0][nt], 0, 0, 0); acc[1][nt] = __builtin_amdgcn_mfma_f32_16x16x32_bf16(bfr, a[1][ks], acc[1][nt], 0, 0, 0);
            if (w == 7) accm[nt] = __builtin_amdgcn_mfma_f32_16x16x32_bf16(bfr, am[ks], accm[nt], 0, 0, 0); }
    __syncthreads();
#pragma unroll
    for (int mt = 0; mt < 2; ++mt)
#pragma unroll
        for (int nt = 0; nt < 8; ++nt) *(LAS f32x4*)(Sl + (32 * w + 16 * mt + fr) * 64 + 8 * nt + 2 * fq) = acc[mt][nt];
    if (w == 7 && fr == 0) {
#pragma unroll
        for (int nt = 0; nt < 8; ++nt) *(LAS f32x4*)(smeta + 16 * nt + 4 * fq) = accm[nt]; }
    __syncthreads();
    { const f32x2 lc = ((const f32x2*)(F.ws + WS_LAMC))[g * 64 + lane];
      LAS f32x2* Ew = (LAS f32x2*)(F.lds + SMETA_OFF + 512);
      f32x2 l = (f32x2){0.f, 0.f};
#pragma unroll 8
      for (int k = 0; k < 32; ++k) { LAS f32x2* sp = Sl + (32 * w + k) * 64 + lane; const f32x2 sv = *sp; *sp = l; const float nx = lc.x * l.x - lc.y * l.y + sv.x, ny = lc.x * l.y + lc.y * l.x + sv.y; l.x = nx; l.y = ny; }
      Ew[w * 64 + lane] = l;
      f32x2 l32 = lc;
#pragma unroll
      for (int q = 0; q < 5; ++q) { const float nx = l32.x * l32.x - l32.y * l32.y, ny = 2.f * l32.x * l32.y; l32.x = nx; l32.y = ny; }
      __syncthreads();
      f32x2 X = *(const LAS f32x2*)(smeta + 2 * lane);
      for (int v = 0; v < w; ++v) { const f32x2 e = Ew[v * 64 + lane]; const float nx = l32.x * X.x - l32.y * X.y + e.x, ny = l32.x * X.y + l32.y * X.x + e.y; X.x = nx; X.y = ny; }
      unsigned* xp = (unsigned*)(UX + (size_t)(g * (NCH + 1) + b * 256 + 32 * w) * UXK + 256) + lane;
      f32x2 pw = X;
#pragma unroll 8
      for (int k = 0; k < 32; ++k) { const f32x2 lv = Sl[(32 * w + k) * 64 + lane]; xp[(size_t)k * (UXK / 2)] = cvt_pk_bf16(pw.x + lv.x, pw.y + lv.y); const float nx = lc.x * pw.x - lc.y * pw.y, ny = lc.x * pw.y + lc.y * pw.x; pw.x = nx; pw.y = ny; }
      VM_WAIT(); }
    __syncthreads();
}

__device__ __forceinline__ void conv_worker(Frame& F, const Args& args, int wi) {
    LAS unsigned char* zs = F.lds + RING_OFF;
    LAS float* cs = (LAS float*)(F.lds + RING_OFF + 65536);
    const bf16* Z = (const bf16*)(F.ws + WS_Z); bf16* ZC = (bf16*)(F.ws + WS_ZC);
    const int tid = F.tid, lane = F.lane, w = F.wave, b = wi >> 5, T0 = (wi & 31) * 128;
    auto zrow = [&](int ti, int cb) -> v4u { v4u v = (v4u){0u, 0u, 0u, 0u};
        if (ti >= 0) v = *(const v4u*)((const char*)Z + (size_t)(b * SEQ + ti) * 1024 + cb); else if (ti >= -NMETA) v = *(const v4u*)((const char*)Z + (size_t)(M + NMETA + ti) * 1024 + cb); return v; };
    { v4u v[8];
#pragma unroll
      for (int it = 0; it < 8; ++it) { const int q = tid + 512 * it; v[it] = (v4u){0u, 0u, 0u, 0u}; if (q < 62 * 64) v[it] = zrow(T0 - 30 + (q >> 6), (q & 63) * 16); }
#pragma unroll
      for (int it = 0; it < 8; ++it) { const int q = tid + 512 * it; if (q < 62 * 64) *(LAS v4u*)(zs + (((q >> 6) + 2) & 63) * 1024 + (q & 63) * 16) = v[it]; } }
    const int cp = tid & 255, th = tid >> 8;
    const float* dw = args.in[I_DW]; f32x2 wgt[CWID];
#pragma unroll
    for (int k = 0; k < CWID; ++k) wgt[k] = *(const f32x2*)(dw + k * DCONV + 2 * cp);
    const f32x2 bias = *(const f32x2*)(args.in[I_DWB] + 2 * cp);
    const f32x4 g0 = *(const f32x4*)(args.in[I_LNG] + 4 * lane), g1 = *(const f32x4*)(args.in[I_LNG] + 256 + 4 * lane), b0 = *(const f32x4*)(args.in[I_LNB] + 4 * lane), b1 = *(const f32x4*)(args.in[I_LNB] + 256 + 4 * lane);
#pragma unroll 1
    for (int j = 0; j < 4; ++j) {
        __syncthreads();
#pragma unroll 1
        for (int hf = 0; hf < 2; ++hf) {
            f32x2 acc[8];
#pragma unroll
            for (int t = 0; t < 8; ++t) acc[t] = bias;
            const int base = 32 * j + 16 * th + 8 * hf + 2;
#pragma unroll
            for (int i = 0; i < 38; ++i) { const unsigned zz = *(const LAS unsigned*)(zs + (((base + i) & 63) << 10) + 4 * cp); const float z0 = bf2f(zz & 0xffffu), z1 = bf2f(zz >> 16);
#pragma unroll
                for (int t = 0; t < 8; ++t) { const int k = i - t; if (k >= 0 && k < CWID) { acc[t].x += wgt[k].x * z0; acc[t].y += wgt[k].y * z1; } } }
#pragma unroll
            for (int t = 0; t < 8; ++t) *(LAS f32x2*)(cs + (16 * th + 8 * hf + t) * 512 + 2 * cp) = acc[t];
        }
        __syncthreads();
        v4u nx[4];
        if (j < 3) {
#pragma unroll
            for (int it = 0; it < 4; ++it) { const int q = tid + 512 * it; nx[it] = zrow(T0 + 32 * j + 32 + (q >> 6), (q & 63) * 16); } }
#pragma unroll
        for (int q = 0; q < 4; ++q) { const int t = 4 * w + q; const f32x4 x0 = *(const LAS f32x4*)(cs + t * 512 + 4 * lane), x1 = *(const LAS f32x4*)(cs + t * 512 + 256 + 4 * lane);
            const float mu = wave_sum((x0[0] + x0[1]) + (x0[2] + x0[3]) + (x1[0] + x1[1]) + (x1[2] + x1[3])) * (1.f / DCONV);
            const f32x4 d0 = x0 - mu, d1 = x1 - mu;
            const float var = wave_sum((d0[0] * d0[0] + d0[1] * d0[1]) + (d0[2] * d0[2] + d0[3] * d0[3]) + (d1[0] * d1[0] + d1[1] * d1[1]) + (d1[2] * d1[2] + d1[3] * d1[3])) * (1.f / DCONV);
            const float rstd = __builtin_amdgcn_rsqf(var + EPS); f32x4 o0 = d0 * rstd * g0 + b0, o1 = d1 * rstd * g1 + b1;
#pragma unroll
            for (int jj = 0; jj < 4; ++jj) { o0[jj] = fsilu(o0[jj]); o1[jj] = fsilu(o1[jj]); }
            bf16* zr = ZC + (size_t)(b * SEQ + T0 + 32 * j + t) * DCONV;
            *(v2u*)(zr + 4 * lane) = (v2u){cvt_pk_bf16(o0[0], o0[1]), cvt_pk_bf16(o0[2], o0[3])}; *(v2u*)(zr + 256 + 4 * lane) = (v2u){cvt_pk_bf16(o1[0], o1[1]), cvt_pk_bf16(o1[2], o1[3])}; }
        if (j < 3) {
#pragma unroll
            for (int it = 0; it < 4; ++it) { const int q = tid + 512 * it; *(LAS v4u*)(zs + ((32 * j + 64 + (q >> 6)) & 63) * 1024 + (q & 63) * 16) = nx[it]; } }
    }
    __syncthreads();
}

__global__ void __launch_bounds__(NWAVES * 64, 2) hyb_fwd(Args args) {
    extern __shared__ __attribute__((aligned(16))) unsigned char lds[];
    Frame F;
    F.lds = (LAS unsigned char*)lds; F.MISC = (volatile LAS unsigned*)(F.lds + MISC_OFF);
    F.wave = __builtin_amdgcn_readfirstlane((int)threadIdx.x >> 6); F.lane = lane_id_opaque(); F.tid = F.wave * 64 + F.lane;
    F.G = gridDim.x; { const int bx = blockIdx.x; F.vcu = (F.G % 8 == 0) ? (bx % 8) * (F.G / 8) + bx / 8 : bx; }
    F.ws = args.ws; F.out = args.out; F.ctl = (gu32*)(args.ws + WS_CTL);
    for (int u = F.tid; u < (LDS_BYTES - LDSCTL_OFF) / 4; u += NWAVES * 64) ((LAS unsigned*)(F.lds + LDSCTL_OFF))[u] = 0u;
    __syncthreads();
    const int bli = (N_LAUNCHES == PER_PHASE) ? 0 : args.li;
    XcdBarrier bar; bar.bar = (unsigned*)(F.ctl + CW_BAR) + bli * XCD_BAR_WORDS; bar.x = 0; bar.st = nullptr;
    if (N_LAUNCHES != PER_PHASE) bar = xcd_barrier_post((unsigned*)(F.ctl + CW_BAR) + bli * XCD_BAR_WORDS, F.MISC + 8);
    const int lo = args.ph_lo, hi = args.ph_hi;
#ifndef PHMASK
#define PHMASK 0x7ff
#endif
#define IN(k) (((PHMASK >> (k)) & 1) && lo <= (k) && (k) < hi)
#define SEAM(k) do { if (IN(k) && IN((k) + 1)) xcd_barrier(bar); F.lane = lane_id_opaque(); F.tid = F.wave * 64 + F.lane; } while (0)
    unsigned char* ws = F.ws;
    bf16* W13A = (bf16*)(ws + WS_W13A); bf16* W2A = (bf16*)(ws + WS_W2A); bf16* WIN = (bf16*)(ws + WS_WIN); bf16* WCAT = (bf16*)(ws + WS_WCAT); bf16* WOUT = (bf16*)(ws + WS_WOUT);
    bf16* W13B = (bf16*)(ws + WS_W13B); bf16* W2B = (bf16*)(ws + WS_W2B);
    bf16* AB = (bf16*)(ws + WS_AB); bf16* H1B = (bf16*)(ws + WS_H1); bf16* H2B = (bf16*)(ws + WS_H1 + 32 * MiB); bf16* HID = (bf16*)(ws + WS_HID);
    bf16* Zb = (bf16*)(ws + WS_Z); bf16* UXb = (bf16*)(ws + WS_UX); bf16* ZCb = (bf16*)(ws + WS_ZC); bf16* Yb = (bf16*)(ws + WS_Y); bf16* MCb = (bf16*)(ws + WS_MC);
    float* SS0 = (float*)(ws + WS_SS0); float* SS1 = SS0 + M; float* SS2 = SS1 + M; float* SS3 = SS2 + M;
    float* HIDM = (float*)(ws + WS_HIDM); float* H1M = (float*)(ws + WS_H1M);
    bf16* Gb = (bf16*)F.out;
    const int bx = (int)blockIdx.x;
    const int gw = F.vcu * NWAVES + F.wave, NGW = F.G * NWAVES;
    const int lb = bx - F.G / 2;
    const int lgw = lb * NWAVES + F.wave, NLGW = (F.G - F.G / 2) * NWAVES;

    if (IN(0)) {
        LAS float* scr = (LAS float*)(F.lds + RING_OFF + F.wave * 16384);
        for (int it = gw; it < T_W13A; it += NGW) weight_item(args, ws, scr, it, F.lane);
        for (int q = 0; q < M / NGW; ++q) { const int m = (F.G % 8 == 0) ? (bx % 8) * (M / 8) + ((bx / 8) * NWAVES + F.wave) + q * (NGW / 8) : gw + q * NGW; const GAS f32x4* xr = (const GAS f32x4*)(args.in[I_X] + (size_t)m * D) + F.lane; f32x4 v[4]; float s = 0.f;
#pragma unroll
            for (int j = 0; j < 4; ++j) { v[j] = xr[64 * j]; s += (v[j].x * v[j].x + v[j].y * v[j].y) + (v[j].z * v[j].z + v[j].w * v[j].w); }
            s = wave_sum(s);
            GAS v2u* o8 = (GAS v2u*)(AB + (size_t)m * D) + F.lane;
#pragma unroll
            for (int j = 0; j < 4; ++j) o8[64 * j] = (v2u){pk2(v[j].x, v[j].y), pk2(v[j].z, v[j].w)};
            if (F.lane == 0) { SS0[m] = s; SS1[m] = 0.f; SS2[m] = 0.f; SS3[m] = 0.f; } }
    }
    SEAM(0);
    if (IN(1)) {
        pg8::Gemm g{D, D, D}; pg8::GridOrder S{M / 256, 2 * DFF / 256, F.G, bx, (const char*)AB, (const char*)W13A, (size_t)256 * D * 2, (size_t)256 * D * 2, W_UP};
        EpiSwiglu E{HID, SS0};
        pg8::gemm_phase(F.lds + RING_OFF, F.wave, g, S, E);
        F.lane = lane_id_opaque(); F.tid = F.wave * 64 + F.lane;
        for (;;) { const int t = wg_ticket(F, 0);
            if (t < NG) { ssm_prep_job(F, args, t); continue; }
            if (t < NG + DFF / 16) { float* hm = HIDM; const int c0 = 16 * (t - NG); const bf16* b0 = W13A + (size_t)glu_row(c0) * D;
                meta_job<2, true>(F, args.in[I_META], D, b0, b0 + (size_t)128 * D, [=](int r, int jj, float a, float b) { hm[r * DFF + c0 + jj] = fsilu(a) * b; }); continue; }
            const int tj = t - (NG + DFF / 16); if (tj >= (T_WIN - T_W13A) / 16) break;
            LAS float* scr = (LAS float*)(F.lds + RING_OFF + F.wave * 16384);
            weight_item(args, ws, scr, T_W13A + 16 * tj + F.wave, F.lane); weight_item(args, ws, scr, T_W13A + 16 * tj + 8 + F.wave, F.lane);
        }
    }
    SEAM(1);
    if (IN(2)) {
        pg8::Gemm g{DFF, DFF, DFF}; pg8::GridOrder S{M / 256, D / 256, F.G, bx, (const char*)HID, (const char*)W2A, (size_t)256 * DFF * 2, (size_t)256 * DFF * 2, W_DN};
        EpiResid<true> E{AB, H1B, SS1, 0.5f};
        pg8::gemm_phase(F.lds + RING_OFF, F.wave, g, S, E);
    }
    SEAM(2);
    if (IN(3)) {
        pg8::Gemm g{D, D, D}; pg8::GridOrder S{M / 256, DIN / 256, F.G, bx, (const char*)H1B, (const char*)WIN, (size_t)256 * D * 2, (size_t)256 * D * 2, W_IN};
        EpiMix E{SS1, Zb, UXb, Gb, args.in[I_BGATE]};
        pg8::gemm_phase(F.lds + RING_OFF, F.wave, g, S, E);
        F.lane = lane_id_opaque(); F.tid = F.wave * 64 + F.lane;
        for (;;) { int j = wg_ticket(F, 1);
            if (j < 64) { float* hm = H1M; const float* mt = args.in[I_META]; const int c0 = 16 * j;
                meta_job<1, false>(F, HIDM, DFF, W2A + (size_t)c0 * DFF, nullptr, [=](int r, int jj, float a, float) { __hip_atomic_store(hm + r * D + c0 + jj, mt[r * D + c0 + jj] + 0.5f * a, __ATOMIC_RELAXED, __HIP_MEMORY_SCOPE_AGENT); });
                if (F.tid == 0) __hip_atomic_fetch_add((unsigned*)(F.ctl + CW_MBD), 1u, __ATOMIC_RELAXED, __HIP_MEMORY_SCOPE_AGENT);
                continue; }
            j -= 64;
            if (j < 64) wait_mbd(F);
            if (j < 32) { bf16* zz = Zb; const int c0 = 16 * j; const bf16* b0 = WIN + (size_t)glu_row(c0) * D;
                meta_job<2, true>(F, H1M, D, b0, b0 + (size_t)128 * D, [=](int r, int jj, float a, float b) { zz[(size_t)(M + r) * DCONV + c0 + jj] = (bf16)f2bf(a * fsigmoid(b)); }); continue; }
            if (j < 64) { bf16* ux = UXb; const int gg = j - 32;
                meta_job<1, true>(F, H1M, D, WIN + (size_t)(1024 + 16 * gg) * D, nullptr, [=](int r, int jj, float a, float) { ux[(size_t)(gg * (NCH + 1) + NCH) * UXK + r * 16 + jj] = (bf16)f2bf(a); }); continue; }
            const int tj = j - 64; if (tj >= (T_W2B - T_WIN) / 16) break;
            LAS float* scr = (LAS float*)(F.lds + RING_OFF + F.wave * 16384);
            weight_item(args, ws, scr, T_WIN + 16 * tj + F.wave, F.lane); weight_item(args, ws, scr, T_WIN + 16 * tj + 8 + F.wave, F.lane);
        }
    }
    SEAM(3);
    if (IN(4)) {
        if (bx < BATCH * NG) {
            ssm_pre_job(F, bx / NG, bx % NG);
            pg8::Gemm g{UXK, UXK, UXK}; SsmOrder S{1 << 20, bx, (const char*)UXb, (const char*)(ws + WS_BS2)};
            EpiSsmY E{UXb, args.in[I_SD], Yb};
            pg8::gemm_phase(F.lds + RING_OFF, F.wave, g, S, E);
        }
        else conv_worker(F, args, bx - BATCH * NG);
    }
    SEAM(4);
    if (IN(6)) {
        pg8::Gemm g{512, 512, 512}; MergeOrder S{F.G, bx, (const char*)ZCb, (const char*)Yb, (const char*)WCAT};
        EpiMerge E{Gb, MCb, AB};
        pg8::gemm_phase(F.lds + RING_OFF, F.wave, g, S, E);
    }
    SEAM(6);
    if (IN(7)) {
        pg8::Gemm g{D, D, D}; pg8::GridOrder S{M / 256, D / 256, F.G, bx, (const char*)AB, (const char*)WOUT, (size_t)256 * D * 2, (size_t)256 * D * 2, W_OUT};
        EpiResid<true> E{H1B, H2B, SS2, 1.0f};
        pg8::gemm_phase(F.lds + RING_OFF, F.wave, g, S, E);
    }
    SEAM(7);
    if (IN(8)) {
        pg8::Gemm g{D, D, D}; pg8::GridOrder S{M / 256, 2 * DFF / 256, F.G, bx, (const char*)H2B, (const char*)W13B, (size_t)256 * D * 2, (size_t)256 * D * 2, W_UP};
        EpiSwiglu E{HID, SS2};
        pg8::gemm_phase(F.lds + RING_OFF, F.wave, g, S, E);
    }
    SEAM(8);
    if (IN(9)) {
        pg8::Gemm g{DFF, DFF, DFF}; pg8::GridOrder S{M / 256, D / 256, F.G, bx, (const char*)HID, (const char*)W2B, (size_t)256 * DFF * 2, (size_t)256 * DFF * 2, W_DN};
        EpiFinal E{H2B, F.out, SS3, (unsigned*)(F.ctl + CW_FIN), args.in[I_FINN], 0.5f};
        pg8::gemm_phase(F.lds + RING_OFF, F.wave, g, S, E);
    }
#undef IN
#undef SEAM
}

extern "C" void kernel_launch(void* const* d_in, const int* in_sizes, int n_in, void* d_out, int out_size, void* d_ws, size_t ws_size, hipStream_t stream) {
    static int grid = 0;
    if (grid == 0) {
        if (n_in != 30 || in_sizes[0] != M * D || out_size != M * D || ws_size < WS_END) { fprintf(stderr, "kernel_launch: unexpected problem shape (n_in %d, in0 %d, out %d, ws %zu); nothing launched\n", n_in, n_in > 0 ? in_sizes[0] : -1, out_size, ws_size); grid = -1; return; }
        int dev = 0, cus = 0, per_cu = 0;
        if (hipGetDevice(&dev) != hipSuccess || hipDeviceGetAttribute(&cus, hipDeviceAttributeMultiprocessorCount, dev) != hipSuccess) { grid = -1; return; }
        if (hipFuncSetAttribute((const void*)hyb_fwd, hipFuncAttributeMaxDynamicSharedMemorySize, LDS_BYTES) != hipSuccess) { fprintf(stderr, "kernel_launch: hipFuncSetAttribute failed\n"); grid = -1; return; }
        if (hipOccupancyMaxActiveBlocksPerMultiprocessor(&per_cu, (const void*)hyb_fwd, NWAVES * 64, LDS_BYTES) != hipSuccess || per_cu < 1)
            fprintf(stderr, "kernel_launch: note: occupancy query reports %d workgroups per CU\n", per_cu);
        (void)hipGetLastError();
        grid = cus > 256 ? 256 : cus;
        if (grid != 256) fprintf(stderr, "kernel_launch: %d CUs reported; this kernel's phase program needs a 256-workgroup grid\n", cus);
    }
    if (grid < 0) return;
    if (hipMemsetAsync((char*)d_ws + WS_CTL, 0, CTL_ZERO_BYTES, stream) != hipSuccess) { fprintf(stderr, "kernel_launch: hipMemsetAsync failed\n"); return; }
    Args a{};
    for (int i = 0; i < 30; ++i) a.in[i] = (const float*)d_in[i];
    a.out = (float*)d_out; a.ws = (unsigned char*)d_ws;
    for (int li = 0; li < N_LAUNCHES; ++li) {
        a.ph_lo = (N_LAUNCHES == PER_PHASE) ? li : 0; a.ph_hi = (N_LAUNCHES == PER_PHASE) ? li + 1 : PER_PHASE; a.li = li;
        hipLaunchKernelGGL(hyb_fwd, dim3(grid), dim3(NWAVES * 64), LDS_BYTES, stream, a);
        const hipError_t le = hipPeekAtLastError();
        if (le != hipSuccess) { fprintf(stderr, "kernel_launch: launch %d failed: %s\n", li, hipGetErrorName(le)); break; }
    }
}
```

```cpp
#include <hip/hip_runtime.h>
#include <cstdio>
#include <cstdint>

#ifndef MK_N_LAUNCHES
#define MK_N_LAUNCHES 1
#endif

__device__ __forceinline__ int lane_id_opaque() { int l; asm volatile("v_mbcnt_lo_u32_b32 %0, -1, 0\n\tv_mbcnt_hi_u32_b32 %0, -1, %0" : "=v"(l)); return l; }
namespace pg8 {
#define PG8_LAS __attribute__((address_space(3)))
typedef unsigned short bf16_t;
typedef short bf16x8 __attribute__((ext_vector_type(8)));
typedef float f32x4 __attribute__((ext_vector_type(4)));
typedef unsigned u32x4 __attribute__((ext_vector_type(4)));
constexpr int BM = 256, BK = 64, HALF = 128, HTB = HALF * BK * 2, STAGE_BYTES = 8 * HTB, NXCD = 8;

__host__ __device__ __forceinline__ int lds_byte(int r, int c) { const int st = (r >> 4) * 2 + (c >> 5), rr = r & 15, cc = c & 31, ob = rr * 64 + cc * 2; return st * 1024 + (ob ^ (((ob >> 9) & 1) << 5)); }
__host__ __device__ __forceinline__ void stage_rc(int b, int& R, int& C) { const int st = b / 1024, sb = b % 1024, swz = sb ^ (((sb >> 9) & 1) << 5); R = (st >> 1) * 16 + swz / 64; C = (st & 1) * 32 + (swz % 64) / 2; }
__host__ __device__ __forceinline__ int perm32(int rho) { const int n = rho >> 4, i = rho & 15; return 8 * (i >> 2) + 4 * n + (i & 3); }

struct Unit { int pm, pn, kind, half; const char* A; const char* B; };
struct Gemm { int lda, ldb, K; };

__device__ __forceinline__ bool static_tile(int i, int G, int c, int nM, int nN, int WGM  , int& pm, int& pn) {
    const int nwg = nM * nN; const long L = (long)i * G + c; if (L >= nwg) return false;
    int wgid = (int)L; { const int q = nwg / NXCD, r = nwg % NXCD, xcd = wgid % NXCD, off = wgid / NXCD; wgid = (xcd < r ? xcd * (q + 1) : r * (q + 1) + (xcd - r) * q) + off; }
    const int nig = WGM * nN, gid = wgid / nig, fm = gid * WGM, gsz = (nM - fm) < WGM ? (nM - fm) : WGM;
    pm = fm + ((wgid % nig) % gsz); pn = (wgid % nig) / gsz; return true;
}
struct GridOrder {
    static constexpr bool kHalf = false;
    int nM, nN, G, c; const char* A; const char* B; size_t tA, tB; int wgm;
    __device__ __forceinline__ bool next(int i, Unit& u) const { int pm, pn; if (!static_tile(i, G, c, nM, nN, wgm, pm, pn)) return false; u.pm = pm; u.pn = pn; u.kind = 0; u.half = 0; u.A = A + (size_t)pm * tA; u.B = B + (size_t)pn * tB; return true; }
    __device__ __forceinline__ void a_ready(const Unit&) const {}
    __device__ __forceinline__ void done(const Unit&) const {}
};

struct TailOrder {
    static constexpr bool kHalf = true;
    int nM, nNf, G, c; const char* A; const char* B; size_t tA, tB; int wgm;
    __device__ __forceinline__ bool next(int i, Unit& u) const { const int nfr = nM * nNf / G;
        if (i < nfr) { int pm, pn; static_tile(i, G, c, nM, nNf, wgm, pm, pn); u.pm = pm; u.pn = pn; u.kind = 0; u.half = 0; u.A = A + (size_t)pm * tA; u.B = B + (size_t)pn * tB; return true; }
        if (i > nfr) return false;
        const int x = c & 7, r = c >> 3, t = r >> 1, h = r & 1; u.pm = 8 * x + (t & 7); u.pn = nNf + (t >> 3); u.kind = h; u.half = 1;
        u.A = A + (size_t)u.pm * tA + (size_t)h * (tA / 2); u.B = B + (size_t)u.pn * tB; return true; }
    __device__ __forceinline__ void a_ready(const Unit&) const {}
    __device__ __forceinline__ void done(const Unit&) const {}
};

__device__ __forceinline__ unsigned cvt_pk_bf16(float lo, float hi) { unsigned r; asm volatile("v_cvt_pk_bf16_f32 %0, %1, %2" : "=v"(r) : "v"(lo), "v"(hi)); return r; }

template <class Epi, class Sched>
__device__ __forceinline__ void gemm_phase(PG8_LAS unsigned char* lds, const int wid  , const Gemm g, const Sched& S, const Epi& E) {
    const int lane = lane_id_opaque(), tid = wid * 64 + lane, wr = wid >> 2, wc = wid & 3, fr = lane & 15, fq = lane >> 4;
    const int K = g.K, nt = K / BK;
    unsigned voffA[2], voffB[2];
#pragma unroll
    for (int i = 0; i < 2; ++i) { int R, C; stage_rc(tid * 16 + i * 8192, R, C); const int Rb = (R & ~31) + perm32(R & 31);
        voffA[i] = (unsigned)(R * g.lda + C) * 2u; voffB[i] = (unsigned)(Rb * g.ldb + C) * 2u; }
    const size_t kstep = (size_t)(BK * 2);
    const size_t hstepA = (size_t)HALF * g.lda * 2, hstepB = (size_t)HALF * g.ldb * 2;
    const unsigned ldsw = (unsigned)wid * 1024u;
    const int aoff = lds_byte(wr * 64 + fr, fq * 8), boff = lds_byte(wc * 32 + fr, fq * 8);
#define PG8_SA(b, h) (((b) * 2 + (h)) * HTB)
#define PG8_SB(b, h) ((4 + (b) * 2 + (h)) * HTB)
#define PG8_STAGE(bufoff, gbase, voff) do { _Pragma("unroll") for (int _i = 0; _i < 2; ++_i) \
        __builtin_amdgcn_global_load_lds((const unsigned*)((const char*)(gbase) + (voff)[_i]), (PG8_LAS unsigned*)(lds + (bufoff) + ldsw + _i * 8192), 16, 0, 0); } while (0)
#define PG8_LDA(dst, b, h) do { _Pragma("unroll") for (int m = 0; m < 4; ++m) _Pragma("unroll") for (int k = 0; k < 2; ++k) dst[m][k] = *(const PG8_LAS bf16x8*)(lds + PG8_SA(b, h) + aoff + m * 2048 + k * 1024); } while (0)
#define PG8_LDB(dst, b, h) do { _Pragma("unroll") for (int n = 0; n < 2; ++n) _Pragma("unroll") for (int k = 0; k < 2; ++k) dst[n][k] = *(const PG8_LAS bf16x8*)(lds + PG8_SB(b, h) + boff + n * 2048 + k * 1024); } while (0)
#define PG8_MMA(ai, bj, At, Bt) do { __builtin_amdgcn_s_setprio(1); _Pragma("unroll") for (int m = 0; m < 4; ++m) _Pragma("unroll") for (int n = 0; n < 2; ++n) _Pragma("unroll") for (int k = 0; k < 2; ++k) \
        acc[ai][bj][m][n] = __builtin_amdgcn_mfma_f32_16x16x32_bf16(Bt[n][k], At[m][k], acc[ai][bj][m][n], 0, 0, 0); __builtin_amdgcn_s_setprio(0); } while (0)
#define PG8_WAIT_V(n) asm volatile("s_waitcnt vmcnt(" #n ")" ::: "memory")
#define PG8_WAIT_L(n) asm volatile("s_waitcnt lgkmcnt(" #n ")" ::: "memory")
#define PG8_BAR __builtin_amdgcn_s_barrier()
#define PG8_SCHED __builtin_amdgcn_sched_barrier(0)
#define PG8_KLOOP(FULL) \
        for (int t = 0; t < nt; t += 2) { \
            const bool last = (t == nt - 2); \
            const char* a1 = cA + (size_t)(t + 1) * kstep; \
            const char* a2 = last ? nA : cA + (size_t)(t + 2) * kstep; const char* b2 = last ? nB : cB + (size_t)(t + 2) * kstep; \
            const char* a3 = a2 + kstep; const char* b3 = b2 + kstep; \
            if (last && has_next) S.a_ready(nxt); \
            PG8_LDB(B0, 0, 0); PG8_LDB(B1, 0, 1); PG8_SCHED; PG8_LDA(At, 0, 0); PG8_STAGE(PG8_SA(1, 1), a1 + hstepA, voffA); \
            PG8_WAIT_V(8); PG8_WAIT_L(0); PG8_BAR; PG8_MMA(0, 0, At, B0); PG8_MMA(0, 1, At, B1); PG8_BAR; PG8_SCHED; \
            if (FULL) PG8_LDA(At, 0, 1); PG8_STAGE(PG8_SB(0, 0), b2, voffB); PG8_STAGE(PG8_SB(0, 1), b2 + hstepB, voffB); PG8_STAGE(PG8_SA(0, 0), a2, voffA); \
            PG8_WAIT_V(8); PG8_WAIT_L(0); PG8_BAR; if (FULL) { PG8_MMA(1, 0, At, B0); PG8_MMA(1, 1, At, B1); } PG8_BAR; PG8_SCHED; \
            PG8_LDB(B0, 1, 0); PG8_LDB(B1, 1, 1); PG8_SCHED; PG8_LDA(At, 1, 0); PG8_STAGE(PG8_SA(0, 1), a2 + hstepA, voffA); \
            PG8_WAIT_V(8); PG8_WAIT_L(0); PG8_BAR; PG8_MMA(0, 0, At, B0); PG8_MMA(0, 1, At, B1); PG8_BAR; PG8_SCHED; \
            if (FULL) PG8_LDA(At, 1, 1); PG8_STAGE(PG8_SB(1, 0), b3, voffB); PG8_STAGE(PG8_SB(1, 1), b3 + hstepB, voffB); PG8_STAGE(PG8_SA(1, 0), a3, voffA); \
            PG8_WAIT_V(8); PG8_WAIT_L(0); PG8_BAR; if (FULL) { PG8_MMA(1, 0, At, B0); PG8_MMA(1, 1, At, B1); } PG8_BAR; PG8_SCHED; \
        }
    Unit cur, nxt; int ui = 0;
    if (!S.next(0, cur)) return;
    f32x4 acc[2][2][4][2];
#pragma unroll
    for (int a = 0; a < 2; ++a)
#pragma unroll
        for (int b = 0; b < 2; ++b)
#pragma unroll
            for (int m = 0; m < 4; ++m)
#pragma unroll
                for (int n = 0; n < 2; ++n) acc[a][b][m][n] = (f32x4){0.f, 0.f, 0.f, 0.f};
    bf16x8 At[4][2], B0[2][2], B1[2][2];
    const char* cA = cur.A; const char* cB = cur.B;
    S.a_ready(cur);
    PG8_STAGE(PG8_SB(0, 0), cB, voffB); PG8_STAGE(PG8_SB(0, 1), cB + hstepB, voffB); PG8_STAGE(PG8_SA(0, 0), cA, voffA); PG8_STAGE(PG8_SA(0, 1), cA + hstepA, voffA);
    if (wr == 1) PG8_BAR;
    PG8_WAIT_V(2); PG8_BAR;
    PG8_STAGE(PG8_SB(1, 0), cB + kstep, voffB); PG8_STAGE(PG8_SA(1, 0), cA + kstep, voffA); PG8_STAGE(PG8_SB(1, 1), cB + hstepB + kstep, voffB);
    PG8_WAIT_V(6); PG8_BAR;
    for (;;) {
        const bool has_next = S.next(ui + 1, nxt);
        const char* nA = has_next ? nxt.A : cA; const char* nB = has_next ? nxt.B : cB;
        if (Sched::kHalf && cur.half) { PG8_KLOOP(0) } else { PG8_KLOOP(1) }
        if (wr == 0) PG8_BAR;
        E(acc, cur, wr, wc); S.done(cur);
        if (!has_next) break;
#pragma unroll
        for (int a = 0; a < 2; ++a)
#pragma unroll
            for (int b = 0; b < 2; ++b)
#pragma unroll
                for (int m = 0; m < 4; ++m)
#pragma unroll
                    for (int n = 0; n < 2; ++n) acc[a][b][m][n] = (f32x4){0.f, 0.f, 0.f, 0.f};
        cur = nxt; cA = nA; cB = nB; ++ui;
        if (wr == 1) PG8_BAR;
    }
    PG8_WAIT_V(0);
    PG8_BAR;
#undef PG8_SA
#undef PG8_SB
#undef PG8_STAGE
#undef PG8_LDA
#undef PG8_LDB
#undef PG8_MMA
#undef PG8_WAIT_V
#undef PG8_WAIT_L
#undef PG8_BAR
#undef PG8_SCHED
#undef PG8_KLOOP
}
}

constexpr int NWAVES = 8;
constexpr int D = 1024, BATCH = 4, SEQ = 4096, NMETA = 16, DFF = 2816, DCONV = 512, CWID = 31, DSSM = 512, HG = 16, NG = 32, PS = 64;
constexpr int DIN = 2 * DCONV + DSSM + 2 * D;
constexpr int M = BATCH * SEQ;
constexpr int NCH = M / 16;
constexpr int UXK = 384;
constexpr float EPS = 1e-6f;
constexpr int PER_PHASE = 10;
#ifndef W_UP
#define W_UP 4
#endif
#ifndef W_DN
#define W_DN 8
#endif
#ifndef W_IN
#define W_IN 4
#endif
#ifndef W_MG
#define W_MG 4
#endif
#ifndef W_OUT
#define W_OUT 4
#endif
constexpr int N_LAUNCHES = MK_N_LAUNCHES;

constexpr size_t MiB = 1u << 20;
constexpr size_t WS_CTL = 0, CTL_ZERO_BYTES = 1 * MiB;
constexpr size_t WS_BS2 = 1 * MiB;
constexpr size_t WS_WSI = 7 * MiB;
constexpr size_t WS_SMALL = 9 * MiB;
constexpr size_t WS_LAMC = WS_SMALL;
constexpr size_t WS_SMETA = WS_SMALL + 16384;
constexpr size_t WS_SS0 = WS_SMALL + 32768;
constexpr size_t WS_HIDM = WS_SMALL + 32768 + 4 * 65536;
constexpr size_t WS_H1M = WS_HIDM + 16 * DFF * 4;
constexpr size_t WS_W13A = 11 * MiB, WS_W2A = 22 * MiB, WS_WIN = 28 * MiB, WS_WCAT = 35 * MiB, WS_WOUT = 38 * MiB, WS_W13B = 40 * MiB, WS_W2B = 51 * MiB;
constexpr size_t WS_AB = 57 * MiB;
constexpr size_t WS_H1 = 89 * MiB;
constexpr size_t WS_HID = 153 * MiB;
constexpr size_t WS_Z = WS_HID;
constexpr size_t WS_UX = WS_HID + 17 * MiB;
constexpr size_t WS_ZC = WS_HID + 42 * MiB;
constexpr size_t WS_Y = WS_HID + 58 * MiB;
constexpr size_t WS_MC = WS_HID;
constexpr size_t WS_S = WS_HID + 74 * MiB;
constexpr size_t WS_END = 256 * MiB;
static_assert(WS_H1M + 16 * D * 4 <= WS_W13A, "small tables");
static_assert(WS_W2B + (size_t)D * DFF * 2 <= WS_AB && WS_AB + (size_t)M * D * 2 <= WS_H1 && WS_H1 + (size_t)M * D * 4 <= WS_HID, "ws map 1");
static_assert(WS_Z + (size_t)(M + 16) * DCONV * 2 <= WS_UX && WS_UX + (size_t)NG * (NCH + 1) * UXK * 2 <= WS_ZC && WS_ZC + (size_t)M * DCONV * 2 <= WS_Y && WS_Y + (size_t)M * DSSM * 2 <= WS_S, "ws map 2");
static_assert(WS_MC + (size_t)M * D * 2 <= WS_ZC, "MC overlay");
static_assert(WS_HID + (size_t)M * DFF * 2 <= WS_END && WS_S + (size_t)NCH * NG * 128 * 4 <= WS_END, "ws end");
static_assert(WS_W13A + (size_t)2 * DFF * D * 2 <= WS_W2A && WS_W2A + (size_t)D * DFF * 2 <= WS_WIN && WS_WIN + (size_t)DIN * D * 2 <= WS_WCAT && WS_WCAT + (size_t)3072 * 512 * 2 <= WS_WOUT && WS_WOUT + (size_t)D * D * 2 <= WS_W13B && WS_W13B + (size_t)2 * DFF * D * 2 <= WS_W2B, "weights");
static_assert(WS_BS2 + (size_t)NG * 256 * UXK * 2 <= WS_WSI && WS_WSI + (size_t)NG * 128 * 256 * 2 <= WS_SMALL, "ssm mats");
constexpr int CW_BAR = 4096;
constexpr int CW_FIN = 16384;

constexpr int RING_OFF = 0, RING_BYTES = 131072;
constexpr int LDSCTL_OFF = RING_BYTES, MISC_OFF = LDSCTL_OFF + 320;
constexpr int LDS_BYTES = 147456;

#define GAS __attribute__((address_space(1)))
#define LAS __attribute__((address_space(3)))
typedef unsigned short bf16;
typedef unsigned v4u __attribute__((ext_vector_type(4)));
typedef unsigned v2u __attribute__((ext_vector_type(2)));
typedef float f32x4 __attribute__((ext_vector_type(4)));
typedef float f32x2 __attribute__((ext_vector_type(2)));
typedef short bf16x8 __attribute__((ext_vector_type(8)));
typedef GAS unsigned gu32;
#define RLX_AGENT __ATOMIC_RELAXED, __HIP_MEMORY_SCOPE_AGENT
#define LDS_WAIT() asm volatile("s_waitcnt lgkmcnt(0)" ::: "memory")
#define VM_WAIT() asm volatile("s_waitcnt vmcnt(0)" ::: "memory")
__device__ __forceinline__ unsigned f2bf(float f) { unsigned u = __builtin_bit_cast(unsigned, f); return (u + 0x7fffu + ((u >> 16) & 1u)) >> 16; }
__device__ __forceinline__ unsigned pk2(float lo, float hi) { return f2bf(lo) | (f2bf(hi) << 16); }
__device__ __forceinline__ float bf2f(unsigned h) { return __builtin_bit_cast(float, h << 16); }
__device__ __forceinline__ float fsigmoid(float x) { return __builtin_amdgcn_rcpf(1.f + __builtin_amdgcn_exp2f(-1.44269504089f * x)); }
__device__ __forceinline__ float fsilu(float x) { return x * fsigmoid(x); }
__device__ __forceinline__ float fgelu_tanh(float x) { return x * fsigmoid(1.5957691216f * (x + 0.044715f * x * x * x)); }
__device__ __forceinline__ float wave_sum(float v) {
#pragma unroll
    for (int o = 1; o < 64; o <<= 1) v += __shfl_xor(v, o);
    return v;
}

#define XB_TMO      128
#define XB_XCNT(j)  (256  + 64 * (j))
#define XB_XSUB(j)  (1280 + 64 * (j))
#define XB_XGEN(j)  (2304 + 64 * (j))
#define XB_TOP      3328
#define XB_TOPGEN   3392
#define XCD_BAR_WORDS 3456
#define XB_SPIN_CAP (1u << 18)
__device__ __forceinline__ unsigned xb_ld(unsigned* p)              { return __hip_atomic_load(p, __ATOMIC_RELAXED, __HIP_MEMORY_SCOPE_AGENT); }
__device__ __forceinline__ unsigned xb_add(unsigned* p, unsigned v) { return __hip_atomic_fetch_add(p, v, __ATOMIC_RELAXED, __HIP_MEMORY_SCOPE_AGENT); }
__device__ __forceinline__ unsigned xb_xcc_id() { return (unsigned)__builtin_amdgcn_s_getreg((3 << 11) | 20) & 0xFu; }
#define XB_SPIN(cond, bar) do { unsigned _sp = 0; while (cond) { __builtin_amdgcn_s_sleep(1); \
    if ((++_sp & 255u) == 0u) { if (xb_ld(&(bar)[XB_TMO])) break; if (_sp > XB_SPIN_CAP) { atomicAdd(&(bar)[XB_TMO], 1u); break; } } } } while (0)
struct XcdBarrier { unsigned* bar; unsigned x; volatile LAS unsigned* st; };
__device__ __forceinline__ XcdBarrier xcd_barrier_post(unsigned* bar, volatile LAS unsigned* st) {
    XcdBarrier b; b.bar = bar; b.x = xb_xcc_id(); b.st = st;
    if (threadIdx.x == 0) (void)xb_add(&bar[XB_XCNT(b.x)], 1u);
    return b;
}
__device__ __forceinline__ void xcd_barrier_complete(unsigned* bar, unsigned x, unsigned& nloc, unsigned& nx) {
    const unsigned G = gridDim.x * gridDim.y * gridDim.z;
    unsigned sum, cnt, mine, sp = 0u;
    for (;;) {
        sum = 0u; cnt = 0u; mine = 0u;
#pragma unroll
        for (unsigned j = 0; j < 16; ++j) { const unsigned c = xb_ld(&bar[XB_XCNT(j)]); sum += c; cnt += (c > 0u) ? 1u : 0u; mine = (j == x) ? c : mine; }
        if (sum == G) break;
        __builtin_amdgcn_s_sleep(1);
        if ((++sp & 255u) == 0u) { if (xb_ld(&bar[XB_TMO])) break; if (sp > XB_SPIN_CAP) { atomicAdd(&bar[XB_TMO], 1u); break; } }
    }
    nloc = mine > 0u ? mine : 1u; nx = cnt > 0u ? cnt : 1u;
}
__device__ __forceinline__ void xcd_barrier(const XcdBarrier& b) {
    asm volatile("s_waitcnt vmcnt(0)" ::: "memory");
    __syncthreads();
    if (threadIdx.x == 0) {
        unsigned* bar = b.bar;
        __builtin_amdgcn_s_waitcnt(0);
        unsigned nloc = b.st[0], nx = b.st[1];
        if (nloc == 0u) { xcd_barrier_complete(bar, b.x, nloc, nx); b.st[0] = nloc; b.st[1] = nx; }
        const unsigned old = xb_add(&bar[XB_XSUB(b.x)], 1u);
        const unsigned gen = old / nloc;
        if (old + 1u == (gen + 1u) * nloc) {
            __builtin_amdgcn_fence(__ATOMIC_RELEASE, "agent");
            asm volatile("s_waitcnt vmcnt(0)" ::: "memory");
            const unsigned og = xb_add(&bar[XB_TOP], 1u);
            const unsigned tg = og / nx;
            if (og + 1u == (tg + 1u) * nx) xb_add(&bar[XB_TOPGEN], 1u);
            else XB_SPIN(xb_ld(&bar[XB_TOPGEN]) == tg, bar);
            __builtin_amdgcn_fence(__ATOMIC_ACQUIRE, "agent");
            xb_add(&bar[XB_XGEN(b.x)], 1u);
            asm volatile("s_waitcnt vmcnt(0)" ::: "memory");
        } else {
            XB_SPIN(xb_ld(&bar[XB_XGEN(b.x)]) == gen, bar);
            __builtin_amdgcn_fence(__ATOMIC_ACQUIRE, "agent");
            asm volatile("s_waitcnt vmcnt(0)" ::: "memory");
        }
    }
    __syncthreads();
}

struct Args { const float* in[30]; float* out; unsigned char* ws; int ph_lo, ph_hi, li, pad; };
struct Frame {
    LAS unsigned char* lds; volatile LAS unsigned* MISC; gu32* ctl;
    int tid, lane, wave, vcu, G;
    float* out; unsigned char* ws;
};
enum { I_X = 0, I_META, I_F1N, I_F1W1, I_F1W3, I_F1W2, I_MIXN, I_WIN, I_BGATE, I_DW, I_DWB, I_LNG, I_LNB, I_CPROJ, I_LRE, I_LIM, I_LDT, I_BRE, I_BIM, I_CRE, I_CIM, I_SD, I_WV, I_WG, I_WOUT, I_F2N, I_F2W1, I_F2W3, I_F2W2, I_FINN };

constexpr int CW_TKT = 32768;
__device__ __forceinline__ int wg_ticket(Frame& F, int k) {
    __syncthreads();
    if (F.tid == 0) F.MISC[16] = __hip_atomic_fetch_add((unsigned*)(F.ctl + CW_TKT + 64 * k), 1u, __ATOMIC_RELAXED, __HIP_MEMORY_SCOPE_AGENT);
    __syncthreads();
    return (int)F.MISC[16];
}
constexpr int CW_MBD = 49152;
__device__ __forceinline__ void wait_mbd(Frame& F) {
    if (F.wave == 0) { unsigned* p = (unsigned*)(F.ctl + CW_MBD); unsigned sp = 0;
        while ((unsigned)__builtin_amdgcn_readfirstlane((int)__hip_atomic_load(p, __ATOMIC_RELAXED, __HIP_MEMORY_SCOPE_AGENT)) < 64u) { __builtin_amdgcn_s_sleep(2); if (++sp > (1u << 22)) break; }
        __builtin_amdgcn_fence(__ATOMIC_ACQUIRE, "agent"); asm volatile("s_waitcnt vmcnt(0)" ::: "memory"); }
    __syncthreads();
}
using pg8::Unit; using pg8::cvt_pk_bf16;
__device__ __forceinline__ v4u pack8(const f32x4 a, const f32x4 b) { v4u w; w.x = cvt_pk_bf16(a[0], a[1]); w.y = cvt_pk_bf16(a[2], a[3]); w.z = cvt_pk_bf16(b[0], b[1]); w.w = cvt_pk_bf16(b[2], b[3]); return w; }
__device__ __forceinline__ void unpack8(const v4u w, float (&o)[8]) { o[0] = bf2f(w.x & 0xffffu); o[1] = bf2f(w.x >> 16); o[2] = bf2f(w.y & 0xffffu); o[3] = bf2f(w.y >> 16); o[4] = bf2f(w.z & 0xffffu); o[5] = bf2f(w.z >> 16); o[6] = bf2f(w.w & 0xffffu); o[7] = bf2f(w.w >> 16); }
__device__ __forceinline__ float rs_from(float ss) { return __builtin_amdgcn_rsqf(ss * (1.0f / D) + EPS); }
__device__ __forceinline__ void load_rs8(const float* SS, int row0, float (&rs)[8]) {
#pragma unroll
    for (int i = 0; i < 8; ++i) rs[i] = SS[row0 + (i >> 2) * 128 + (i & 3) * 16];
#pragma unroll
    for (int i = 0; i < 8; ++i) rs[i] = rs_from(rs[i]);
}

struct EpiSwiglu {
    bf16* HID; const float* SS;
    __device__ __forceinline__ void operator()(const f32x4 (&acc)[2][2][4][2], const Unit& u, int wr, int wc) const {
        const int lane_ = lane_id_opaque(), fr = lane_ & 15, fq = lane_ >> 4;
        const int row0 = u.pm * 256 + (u.half ? u.kind * 128 : 0) + wr * 64 + fr, col0 = u.pn * 128 + wc * 32 + 8 * fq;
        float rsv[8]; load_rs8(SS, row0, rsv);
#pragma unroll
        for (int ai = 0; ai < 2; ++ai) { if (u.half && ai == 1) break;
#pragma unroll
            for (int m = 0; m < 4; ++m) { const int row = row0 + ai * 128 + m * 16; const float rs = rsv[ai * 4 + m];
                f32x4 o0, o1;
#pragma unroll
                for (int j = 0; j < 4; ++j) { o0[j] = fsilu(acc[ai][0][m][0][j] * rs) * (acc[ai][1][m][0][j] * rs); o1[j] = fsilu(acc[ai][0][m][1][j] * rs) * (acc[ai][1][m][1][j] * rs); }
                *(v4u*)(HID + (size_t)row * DFF + col0) = pack8(o0, o1); } }
    }
};
template <bool RBF16> struct EpiResid {
    const void* R; bf16* OB; float* SS; float alpha;
    __device__ __forceinline__ void operator()(const f32x4 (&acc)[2][2][4][2], const Unit& u, int wr, int wc) const {
        const int lane_ = lane_id_opaque(), fr = lane_ & 15, fq = lane_ >> 4;
        const int row0 = u.pm * 256 + wr * 64 + fr, col0 = u.pn * 256 + wc * 32 + 8 * fq;
#pragma unroll
        for (int ai = 0; ai < 2; ++ai) {
            f32x4 r[4][2][2];
#pragma unroll
            for (int m = 0; m < 4; ++m)
#pragma unroll
                for (int bj = 0; bj < 2; ++bj) { const size_t off = (size_t)(row0 + ai * 128 + m * 16) * D + col0 + bj * 128;
                    if (RBF16) { const v4u w = *(const v4u*)((const bf16*)R + off); r[m][bj][0] = __builtin_bit_cast(f32x4, w); }
                    else { r[m][bj][0] = *(const f32x4*)((const float*)R + off); r[m][bj][1] = *(const f32x4*)((const float*)R + off + 4); } }
#pragma unroll
            for (int m = 0; m < 4; ++m) { const int row = row0 + ai * 128 + m * 16; float ss = 0.f;
#pragma unroll
                for (int bj = 0; bj < 2; ++bj) { const size_t off = (size_t)row * D + col0 + bj * 128; f32x4 r0, r1;
                    if (RBF16) { float t[8]; unpack8(__builtin_bit_cast(v4u, r[m][bj][0]), t); r0 = (f32x4){t[0], t[1], t[2], t[3]}; r1 = (f32x4){t[4], t[5], t[6], t[7]}; }
                    else { r0 = r[m][bj][0]; r1 = r[m][bj][1]; }
                    const f32x4 o0 = r0 + acc[ai][bj][m][0] * alpha, o1 = r1 + acc[ai][bj][m][1] * alpha;
                    *(v4u*)(OB + off) = pack8(o0, o1);
                    ss += (o0[0] * o0[0] + o0[1] * o0[1]) + (o0[2] * o0[2] + o0[3] * o0[3]) + (o1[0] * o1[0] + o1[1] * o1[1]) + (o1[2] * o1[2] + o1[3] * o1[3]); }
                ss += __shfl_xor(ss, 16); ss += __shfl_xor(ss, 32);
                if (fq == 0) atomicAdd(SS + row, ss); }
            asm volatile("" ::: "memory"); }
    }
};
struct EpiFinal {
    const bf16* R; float* OUT; float* SS; unsigned* cnt; const float* gain; float alpha;
    __device__ __forceinline__ void operator()(f32x4 (&acc)[2][2][4][2], const Unit& u, int wr, int wc) const {
        const int lane_ = lane_id_opaque(), fr = lane_ & 15, fq = lane_ >> 4;
        const int row0 = u.pm * 256 + wr * 64 + fr, col0 = u.pn * 256 + wc * 32 + 8 * fq;
#pragma unroll
        for (int ai = 0; ai < 2; ++ai) {
            v4u r[4][2];
#pragma unroll
            for (int m = 0; m < 4; ++m)
#pragma unroll
                for (int bj = 0; bj < 2; ++bj) r[m][bj] = *(const v4u*)(R + (size_t)(row0 + ai * 128 + m * 16) * D + col0 + bj * 128);
#pragma unroll
            for (int m = 0; m < 4; ++m) { const int row = row0 + ai * 128 + m * 16; float ss = 0.f;
#pragma unroll
                for (int bj = 0; bj < 2; ++bj) { float t[8]; unpack8(r[m][bj], t);
                    const f32x4 o0 = (f32x4){t[0], t[1], t[2], t[3]} + acc[ai][bj][m][0] * alpha, o1 = (f32x4){t[4], t[5], t[6], t[7]} + acc[ai][bj][m][1] * alpha;
                    acc[ai][bj][m][0] = o0; acc[ai][bj][m][1] = o1;
                    ss += (o0[0] * o0[0] + o0[1] * o0[1]) + (o0[2] * o0[2] + o0[3] * o0[3]) + (o1[0] * o1[0] + o1[1] * o1[1]) + (o1[2] * o1[2] + o1[3] * o1[3]); }
                ss += __shfl_xor(ss, 16); ss += __shfl_xor(ss, 32);
                if (fq == 0) atomicAdd(SS + row, ss); }
            asm volatile("" ::: "memory"); }
        asm volatile("s_waitcnt vmcnt(0)" ::: "memory");
        unsigned* cw = cnt + 64 * u.pm;
        if (lane_ == 0) __hip_atomic_fetch_add(cw, 1u, __ATOMIC_RELAXED, __HIP_MEMORY_SCOPE_AGENT);
        f32x4 g[2][2];
#pragma unroll
        for (int bj = 0; bj < 2; ++bj) { g[bj][0] = *(const f32x4*)(gain + col0 + bj * 128); g[bj][1] = *(const f32x4*)(gain + col0 + bj * 128 + 4); }
        { unsigned sp = 0; while ((unsigned)__builtin_amdgcn_readfirstlane((int)__hip_atomic_load(cw, __ATOMIC_RELAXED, __HIP_MEMORY_SCOPE_AGENT)) < 32u) { __builtin_amdgcn_s_sleep(2); if (++sp > (1u << 20)) break; } }
        float tot[8];
#pragma unroll
        for (int i = 0; i < 8; ++i) { tot[i] = 0.f; if (fq == 0) tot[i] = __hip_atomic_fetch_add(SS + row0 + (i >> 2) * 128 + (i & 3) * 16, 0.0f, __ATOMIC_RELAXED, __HIP_MEMORY_SCOPE_AGENT); }
#pragma unroll
        for (int ai = 0; ai < 2; ++ai)
#pragma unroll
            for (int m = 0; m < 4; ++m) { const int row = row0 + ai * 128 + m * 16;
                const float rs = rs_from(__shfl(tot[ai * 4 + m], fr));
#pragma unroll
                for (int bj = 0; bj < 2; ++bj) { const size_t off = (size_t)row * D + col0 + bj * 128;
                    *(f32x4*)(OUT + off) = acc[ai][bj][m][0] * rs * g[bj][0]; *(f32x4*)(OUT + off + 4) = acc[ai][bj][m][1] * rs * g[bj][1]; } }
    }
};
struct EpiMix {
    const float* SS; bf16* Z; bf16* UX; bf16* G; const float* bgate;
    __device__ __forceinline__ void operator()(const f32x4 (&acc)[2][2][4][2], const Unit& u, int wr, int wc) const {
        const int lane_ = lane_id_opaque(), fr = lane_ & 15, fq = lane_ >> 4;
        const int row0 = u.pm * 256 + wr * 64 + fr;
        if (u.pn < 4) {
            const int col0 = u.pn * 128 + wc * 32 + 8 * fq;
#pragma unroll
            for (int ai = 0; ai < 2; ++ai)
#pragma unroll
                for (int m = 0; m < 4; ++m) { const int row = row0 + ai * 128 + m * 16; const float rs = rs_from(SS[row]); f32x4 o0, o1;
#pragma unroll
                    for (int j = 0; j < 4; ++j) { o0[j] = (acc[ai][0][m][0][j] * rs) * fsigmoid(acc[ai][1][m][0][j] * rs); o1[j] = (acc[ai][0][m][1][j] * rs) * fsigmoid(acc[ai][1][m][1][j] * rs); }
                    *(v4u*)(Z + (size_t)row * DCONV + col0) = pack8(o0, o1); }
        } else if (u.pn < 6) {
#pragma unroll
            for (int ai = 0; ai < 2; ++ai)
#pragma unroll
                for (int m = 0; m < 4; ++m) { const int row = row0 + ai * 128 + m * 16; const float rs = rs_from(SS[row]); const int ci = row >> 4, tt = row & 15;
#pragma unroll
                    for (int bj = 0; bj < 2; ++bj) { const int c = (u.pn - 4) * 256 + bj * 128 + wc * 32 + 8 * fq, g = c >> 4, h0 = c & 15;
                        *(v4u*)(UX + ((size_t)(g * (NCH + 1) + ci) * UXK + tt * 16 + h0)) = pack8(acc[ai][bj][m][0] * rs, acc[ai][bj][m][1] * rs); } }
        } else {
#pragma unroll
            for (int bj = 0; bj < 2; ++bj) { const int c = (u.pn - 6) * 256 + bj * 128 + wc * 32 + 8 * fq;
                const f32x4 b0 = *(const f32x4*)(bgate + c), b1 = *(const f32x4*)(bgate + c + 4);
#pragma unroll
                for (int ai = 0; ai < 2; ++ai)
#pragma unroll
                    for (int m = 0; m < 4; ++m) { const int row = row0 + ai * 128 + m * 16; const float rs = rs_from(SS[row]); f32x4 o0, o1;
#pragma unroll
                        for (int j = 0; j < 4; ++j) { o0[j] = fsigmoid(acc[ai][bj][m][0][j] * rs + b0[j]); o1[j] = fsigmoid(acc[ai][bj][m][1][j] * rs + b1[j]); }
                        *(v4u*)(G + (size_t)row * 2048 + c) = pack8(o0, o1); } }
        }
    }
};
struct EpiSsmY {
    const bf16* UX; const float* dskip; bf16* Y;
    __device__ __forceinline__ void operator()(const f32x4 (&acc)[2][2][4][2], const Unit& u, int wr, int wc) const {
        const int lane_ = lane_id_opaque(), fr = lane_ & 15, fq = lane_ >> 4;
        const int b = u.pm, g = u.pn, h0 = 8 * (fq & 1);
        const f32x4 d0 = *(const f32x4*)(dskip + g * 16 + h0), d1 = *(const f32x4*)(dskip + g * 16 + h0 + 4);
#pragma unroll
        for (int ai = 0; ai < 2; ++ai) {
            v4u uw[4][2];
#pragma unroll
            for (int m = 0; m < 4; ++m)
#pragma unroll
                for (int bj = 0; bj < 2; ++bj) { const int r = ai * 128 + wr * 64 + m * 16 + fr, tt = 8 * bj + 2 * wc + (fq >> 1);
                    uw[m][bj] = *(const v4u*)(UX + ((size_t)(g * (NCH + 1) + b * 256 + r) * UXK + tt * 16 + h0)); }
#pragma unroll
            for (int m = 0; m < 4; ++m) { const int r = ai * 128 + wr * 64 + m * 16 + fr;
#pragma unroll
                for (int bj = 0; bj < 2; ++bj) { const int tt = 8 * bj + 2 * wc + (fq >> 1);
                    float uu[8]; unpack8(uw[m][bj], uu);
                    f32x4 o0, o1;
#pragma unroll
                    for (int j = 0; j < 4; ++j) { o0[j] = fgelu_tanh(acc[ai][bj][m][0][j] + d0[j] * uu[j]); o1[j] = fgelu_tanh(acc[ai][bj][m][1][j] + d1[j] * uu[4 + j]); }
                    *(v4u*)(Y + ((size_t)(b * SEQ + r * 16 + tt) * DSSM + g * 16 + h0)) = pack8(o0, o1); } }
            asm volatile("" ::: "memory"); }
    }
};
struct EpiMerge {
    const bf16* G; bf16* MC; bf16* MG;
    __device__ __forceinline__ void operator()(const f32x4 (&acc)[2][2][4][2], const Unit& u, int wr, int wc) const {
        const int lane_ = lane_id_opaque(), fr = lane_ & 15, fq = lane_ >> 4;
        const int row0 = u.pm * 256 + wr * 64 + fr;
        if (u.kind == 0) {
#pragma unroll
            for (int ai = 0; ai < 2; ++ai) {
                v4u gw[4][2];
#pragma unroll
                for (int m = 0; m < 4; ++m)
#pragma unroll
                    for (int bj = 0; bj < 2; ++bj) gw[m][bj] = *(const v4u*)(G + (size_t)(row0 + ai * 128 + m * 16) * 2048 + u.pn * 256 + bj * 128 + wc * 32 + 8 * fq);
#pragma unroll
                for (int m = 0; m < 4; ++m) { const int row = row0 + ai * 128 + m * 16;
#pragma unroll
                    for (int bj = 0; bj < 2; ++bj) { const int c = u.pn * 256 + bj * 128 + wc * 32 + 8 * fq;
                        float gg[8]; unpack8(gw[m][bj], gg); f32x4 o0, o1;
#pragma unroll
                        for (int j = 0; j < 4; ++j) { o0[j] = gg[j] * acc[ai][bj][m][0][j]; o1[j] = gg[4 + j] * acc[ai][bj][m][1][j]; }
                        *(v4u*)(MC + (size_t)row * D + c) = pack8(o0, o1); } }
                asm volatile("" ::: "memory"); }
        } else {
            const int c = u.pn * 256 + (u.kind - 1) * 128 + wc * 32 + 8 * fq;
#pragma unroll
            for (int ai = 0; ai < 2; ++ai) {
                v4u gw[4], mw[4];
#pragma unroll
                for (int m = 0; m < 4; ++m) { const int row = row0 + ai * 128 + m * 16; gw[m] = *(const v4u*)(G + (size_t)row * 2048 + D + c); mw[m] = *(const v4u*)(MC + (size_t)row * D + c); }
#pragma unroll
                for (int m = 0; m < 4; ++m) { const int row = row0 + ai * 128 + m * 16;
                    float gg[8], mc[8]; unpack8(gw[m], gg); unpack8(mw[m], mc); f32x4 o0, o1;
#pragma unroll
                    for (int j = 0; j < 4; ++j) { o0[j] = mc[j] + gg[j] * (acc[ai][0][m][0][j] * fsigmoid(acc[ai][1][m][0][j])); o1[j] = mc[4 + j] + gg[4 + j] * (acc[ai][0][m][1][j] * fsigmoid(acc[ai][1][m][1][j])); }
                    *(v4u*)(MG + (size_t)row * D + c) = pack8(o0, o1); }
                asm volatile("" ::: "memory"); }
        }
    }
};
struct SsmOrder {
    static constexpr bool kHalf = false;
    int G, c; const char* UX; const char* BS2;
    __device__ __forceinline__ bool next(int i, Unit& u) const { const int L = i * G + c; if (L >= BATCH * NG) return false; const int b = L / NG, g = L % NG; u.pm = b; u.pn = g; u.kind = 0; u.half = 0;
        u.A = UX + ((size_t)(g * (NCH + 1) + b * 256) * UXK) * 2; u.B = BS2 + (size_t)g * 256 * UXK * 2; return true; }
    __device__ __forceinline__ void a_ready(const Unit&) const {}
    __device__ __forceinline__ void done(const Unit&) const {}
};
struct MergeOrder {
    static constexpr bool kHalf = false;
    int G, c; const char* ZC; const char* Y; const char* WCAT;
    __device__ __forceinline__ bool next(int i, Unit& u) const { int pm, pn; const int su = i / 3, k = i - 3 * su; if (!pg8::static_tile(su, G, c, M / 256, D / 256, W_MG, pm, pn)) return false; u.pm = pm; u.pn = pn; u.kind = k; u.half = 0;
        u.A = (k == 0 ? ZC : Y) + (size_t)pm * 256 * 512 * 2; u.B = WCAT + (size_t)(k == 0 ? pn * 256 : 1024 + (2 * pn + k - 1) * 256) * 512 * 2; return true; }
    __device__ __forceinline__ void a_ready(const Unit&) const {}
    __device__ __forceinline__ void done(const Unit& u) const { if (u.kind == 0) asm volatile("s_waitcnt vmcnt(0)" ::: "memory"); }
};

__device__ __forceinline__ void p0_transpose_item(const float* W, int K, int N, bf16* WT, const float* gain, LAS float* scr, int k0, int n0, int drow0, int lane) {
    float v[32];
    const float* src = W + (size_t)(k0 + (lane >> 5)) * N + n0 + (lane & 31);
#pragma unroll
    for (int i = 0; i < 32; ++i) v[i] = src[(size_t)(2 * i) * N];
#pragma unroll
    for (int i = 0; i < 32; ++i) scr[(2 * i + (lane >> 5)) * 33 + (lane & 31)] = v[i];
    LDS_WAIT(); asm volatile("" ::: "memory");
    const int c = lane & 7;
    f32x4 g0 = (f32x4){1.f, 1.f, 1.f, 1.f}, g1 = g0; if (gain) { g0 = *(const f32x4*)(gain + k0 + 8 * c); g1 = *(const f32x4*)(gain + k0 + 8 * c + 4); }
#pragma unroll
    for (int j = 0; j < 4; ++j) { const int n = (lane >> 3) + 8 * j; const LAS float* s = scr + (8 * c) * 33 + n;
        v4u o; o.x = pk2(s[0 * 33] * g0[0], s[1 * 33] * g0[1]); o.y = pk2(s[2 * 33] * g0[2], s[3 * 33] * g0[3]); o.z = pk2(s[4 * 33] * g1[0], s[5 * 33] * g1[1]); o.w = pk2(s[6 * 33] * g1[2], s[7 * 33] * g1[3]);
        *(GAS v4u*)(WT + (size_t)(drow0 + n) * K + k0 + 8 * c) = o; }
    LDS_WAIT(); asm volatile("" ::: "memory");
}
__device__ __forceinline__ int glu_row(int n) { return 256 * (n >> 7) + (n & 127); }

constexpr int I_UP = (D / 64) * (DFF / 32), I_DN = (DFF / 64) * (D / 32), I_INP = (D / 64) * (DIN / 32), I_CP = (DCONV / 64) * (D / 32), I_WO = (D / 64) * (D / 32);
constexpr int T_W13A = 2 * I_UP, T_W2A = T_W13A + I_DN, T_WIN = T_W2A + I_INP, T_WCAT = T_WIN + 3 * I_CP, T_WOUT = T_WCAT + I_WO, T_W13B = T_WOUT + 2 * I_UP, T_W2B = T_W13B + I_DN;
__device__ __forceinline__ void weight_item(const Args& args, unsigned char* ws, LAS float* scr, int it, int lane) {
    if (it < T_W13A || (it >= T_WOUT && it < T_W13B)) { const bool second = it >= T_WOUT; int r = it - (second ? T_WOUT : 0); const int which = r / I_UP; r -= which * I_UP; const int nblk = DFF / 32, k0 = 64 * (r / nblk), n0 = 32 * (r % nblk);
        const float* W = second ? (which ? args.in[I_F2W3] : args.in[I_F2W1]) : (which ? args.in[I_F1W3] : args.in[I_F1W1]);
        p0_transpose_item(W, D, DFF, (bf16*)(ws + (second ? WS_W13B : WS_W13A)), second ? args.in[I_F2N] : args.in[I_F1N], scr, k0, n0, glu_row(n0) + which * 128, lane); return; }
    if (it < T_W2A || it >= T_W13B) { const bool second = it >= T_W13B; const int r = it - (second ? T_W13B : T_W13A); const int nblk = D / 32, k0 = 64 * (r / nblk), n0 = 32 * (r % nblk);
        p0_transpose_item(second ? args.in[I_F2W2] : args.in[I_F1W2], DFF, D, (bf16*)(ws + (second ? WS_W2B : WS_W2A)), nullptr, scr, k0, n0, n0, lane); return; }
    if (it < T_WIN) { const int r = it - T_W2A; const int nblk = DIN / 32, k0 = 64 * (r / nblk), n0 = 32 * (r % nblk);
        const int dr = n0 < 512 ? glu_row(n0) : n0 < 1024 ? glu_row(n0 - 512) + 128 : n0;
        p0_transpose_item(args.in[I_WIN], D, DIN, (bf16*)(ws + WS_WIN), args.in[I_MIXN], scr, k0, n0, dr, lane); return; }
    if (it < T_WCAT) { int r = it - T_WIN; const int which = r / I_CP; r -= which * I_CP; const int nblk = D / 32, k0 = 64 * (r / nblk), n0 = 32 * (r % nblk);
        const int dr = which == 0 ? n0 : 1024 + glu_row(n0) + (which == 2 ? 128 : 0);
        p0_transpose_item(which == 0 ? args.in[I_CPROJ] : which == 1 ? args.in[I_WV] : args.in[I_WG], DCONV, D, (bf16*)(ws + WS_WCAT), nullptr, scr, k0, n0, dr, lane); return; }
    { const int r = it - T_WCAT; const int nblk = D / 32, k0 = 64 * (r / nblk), n0 = 32 * (r % nblk); p0_transpose_item(args.in[I_WOUT], D, D, (bf16*)(ws + WS_WOUT), nullptr, scr, k0, n0, n0, lane); }
}

__device__ __forceinline__ void ssm_prep_job(Frame& F, const Args& args, int g) {
    LAS f32x2* lamP = (LAS f32x2*)(F.lds + RING_OFF);
    LAS f32x2* Bb = lamP + 17 * 64;
    LAS f32x2* Cc = Bb + 64 * 16;
    LAS float* Kk = (LAS float*)(Cc + 16 * 64);
    const float* lam_re = args.in[I_LRE]; const float* lam_im = args.in[I_LIM]; const float* log_dt = args.in[I_LDT];
    const float* b_re = args.in[I_BRE]; const float* b_im = args.in[I_BIM]; const float* c_re = args.in[I_CRE]; const float* c_im = args.in[I_CIM];
    const int tid = F.tid;
    const float dt = expf(log_dt[g]);
    if (tid < 64) { const int p = tid; const float a = lam_re[g * PS + p] * dt, bb = lam_im[g * PS + p] * dt, ea = expf(a), sb = sinf(bb), cb = cosf(bb);
        const float lx = ea * cb, ly = ea * sb; float px = 1.f, py = 0.f;
        for (int k = 0; k <= 16; ++k) { lamP[k * 64 + p] = (f32x2){px, py}; const float nx = px * lx - py * ly, ny = px * ly + py * lx; px = nx; py = ny; } }
    for (int i = tid; i < 1024; i += 512) { const int p = i >> 4;
        const float lr = lam_re[g * PS + p], li = lam_im[g * PS + p], a = lr * dt, bb = li * dt, ea = expf(a), sb = sinf(bb), cb = cosf(bb), sh = sinf(0.5f * bb);
        const float nr = expm1f(a) * cb - 2.f * sh * sh, ni = ea * sb, den = 1.f / (lr * lr + li * li), fr_ = (nr * lr + ni * li) * den, fi_ = (ni * lr - nr * li) * den;
        const float br = b_re[(size_t)g * 1024 + i], bi = b_im[(size_t)g * 1024 + i];
        Bb[i] = (f32x2){fr_ * br - fi_ * bi, fr_ * bi + fi_ * br};
        Cc[i] = (f32x2){c_re[(size_t)g * 1024 + i], c_im[(size_t)g * 1024 + i]}; }
    __syncthreads();
    {
        const int k = tid >> 5, h = (tid >> 1) & 15, hh = (tid & 1) * 8; float sum[8];
#pragma unroll
        for (int j = 0; j < 8; ++j) sum[j] = 0.f;
#pragma unroll 4
        for (int p = 0; p < 64; ++p) { const f32x2 c = Cc[h * 64 + p], l = lamP[k * 64 + p]; const float er = c.x * l.x - c.y * l.y, ei = c.x * l.y + c.y * l.x;
#pragma unroll
            for (int j = 0; j < 8; j += 2) { const f32x4 bb = *(const LAS f32x4*)(Bb + p * 16 + hh + j); sum[j] += er * bb[0] - ei * bb[1]; sum[j + 1] += er * bb[2] - ei * bb[3]; } }
#pragma unroll
        for (int j = 0; j < 8; ++j) Kk[(k << 8) + (h << 4) + hh + j] = sum[j];
    }
    __syncthreads();
    GAS unsigned* bs2 = (GAS unsigned*)(F.ws + WS_BS2) + (size_t)g * 256 * (UXK / 2);
    for (int i = tid; i < 256 * (UXK / 2); i += 512) { const int n = i / (UXK / 2), kp = (i % (UXK / 2)) * 2, t = n >> 4, h = n & 15; float v0, v1;
        if (kp < 256) { const int s = kp >> 4, hp = kp & 15; const bool on = s <= t; const int kb = (((t - s) & 15) << 8) + (h << 4) + hp; v0 = on ? Kk[kb] : 0.f; v1 = on ? Kk[kb + 1] : 0.f; }
        else { const int p = (kp - 256) >> 1; const f32x2 c = Cc[h * 64 + p], l = lamP[(t + 1) * 64 + p]; v0 = c.x * l.x - c.y * l.y; v1 = -(c.x * l.y + c.y * l.x); }
        bs2[i] = pk2(v0, v1); }
    GAS unsigned* wsi = (GAS unsigned*)(F.ws + WS_WSI) + (size_t)g * 128 * 128;
    for (int i = tid; i < 128 * 128; i += 512) { const int n = i >> 7, kp = (i & 127) * 2, p = n >> 1, c = n & 1, s = kp >> 4, h = kp & 15;
        const f32x2 l = lamP[(15 - s) * 64 + p], b0 = Bb[p * 16 + h], b1 = Bb[p * 16 + h + 1];
        const float v0 = c ? (l.x * b0.y + l.y * b0.x) : (l.x * b0.x - l.y * b0.y), v1 = c ? (l.x * b1.y + l.y * b1.x) : (l.x * b1.x - l.y * b1.y);
        wsi[i] = pk2(v0, v1); }
    if (tid < 64) ((GAS f32x2*)(F.ws + WS_LAMC))[g * 64 + tid] = lamP[16 * 64 + tid];
    __syncthreads();
}

template <int NS, bool NORM, class Fn>
__device__ __forceinline__ void meta_job(Frame& F, const float* A, int K, const bf16* Bt0, const bf16* Bt1, const Fn& fn) {
    LAS float* red = (LAS float*)(F.lds + RING_OFF);
    LAS float* rsc = red + 8 * 16 * 32;
    const int lane = F.lane, w = F.wave, fr = lane & 15, fq = lane >> 4;
    if (NORM) {
#pragma unroll
        for (int rr = 0; rr < 2; ++rr) { const int row = 2 * w + rr; float s = 0.f; for (int c = lane; c < D; c += 64) { const float v = A[(size_t)row * K + c]; s += v * v; } s = wave_sum(s); if (lane == 0) rsc[row] = 1.0f / sqrtf(s * (1.0f / D) + EPS); }
    } else if (F.tid < 16) rsc[F.tid] = 1.f;
    f32x4 acc[NS];
#pragma unroll
    for (int s = 0; s < NS; ++s) acc[s] = (f32x4){0.f, 0.f, 0.f, 0.f};
    const int kw = K / 8, kbase = w * kw;
#pragma unroll 4
    for (int k = kbase; k < kbase + kw; k += 32) {
        const f32x4 a0 = *(const f32x4*)(A + (size_t)fr * K + k + 8 * fq), a1 = *(const f32x4*)(A + (size_t)fr * K + k + 8 * fq + 4);
        const v4u ap = pack8(a0, a1); const bf16x8 af = __builtin_bit_cast(bf16x8, ap);
#pragma unroll
        for (int s = 0; s < NS; ++s) { const bf16x8 bf = *(const bf16x8*)((s == 0 ? Bt0 : Bt1) + (size_t)fr * K + k + 8 * fq); acc[s] = __builtin_amdgcn_mfma_f32_16x16x32_bf16(bf, af, acc[s], 0, 0, 0); } }
#pragma unroll
    for (int s = 0; s < NS; ++s) *(LAS f32x4*)(red + (w * 16 + fr) * 32 + s * 16 + 4 * fq) = acc[s];
    __syncthreads();
    if (F.tid < 256) { const int rr = F.tid >> 4, j = F.tid & 15; float v0 = 0.f, v1 = 0.f;
#pragma unroll
        for (int ww = 0; ww < 8; ++ww) { v0 += red[(ww * 16 + rr) * 32 + j]; if (NS > 1) v1 += red[(ww * 16 + rr) * 32 + 16 + j]; }
        const float sc = rsc[rr]; fn(rr, j, v0 * sc, v1 * sc); }
    VM_WAIT();
    __syncthreads();
}

constexpr int WSI_PITCH = 528;
constexpr int SMETA_OFF = LDSCTL_OFF + 1024;
__device__ __forceinline__ void ssm_pre_job(Frame& F, int b, int g) {
    const int lane = F.lane, w = F.wave, tid = F.tid, fr = lane & 15, fq = lane >> 4;
    LAS unsigned char* Bl = F.lds + RING_OFF;
    LAS f32x2* Sl = (LAS f32x2*)(F.lds + RING_OFF);
    LAS float* smeta = (LAS float*)(F.lds + SMETA_OFF);
    bf16* UX = (bf16*)(F.ws + WS_UX); const bf16* Wg = (const bf16*)(F.ws + WS_WSI) + (size_t)g * 128 * 256;
    { v4u v[8];
#pragma unroll
      for (int i = 0; i < 8; ++i) { const int idx = tid + 512 * i; v[i] = *(const v4u*)(Wg + (size_t)(idx >> 5) * 256 + (idx & 31) * 8); }
#pragma unroll
      for (int i = 0; i < 8; ++i) { const int idx = tid + 512 * i; *(LAS v4u*)(Bl + (idx >> 5) * WSI_PITCH + (idx & 31) * 16) = v[i]; } }
    const bf16* Ab = UX + (size_t)(g * (NCH + 1) + 256 * b + 32 * w) * UXK;
    bf16x8 a[2][8], am[8];
#pragma unroll
    for (int mt = 0; mt < 2; ++mt)
#pragma unroll
        for (int ks = 0; ks < 8; ++ks) a[mt][ks] = *(const bf16x8*)(Ab + (size_t)(16 * mt + fr) * UXK + 32 * ks + 8 * fq);
    if (w == 7) {
#pragma unroll
        for (int ks = 0; ks < 8; ++ks) am[ks] = *(const bf16x8*)(UX + (size_t)(g * (NCH + 1) + NCH) * UXK + 32 * ks + 8 * fq); }
    f32x4 acc[2][8], accm[8];
#pragma unroll
    for (int nt = 0; nt < 8; ++nt) { acc[0][nt] = (f32x4){0.f, 0.f, 0.f, 0.f}; acc[1][nt] = acc[0][nt]; accm[nt] = acc[0][nt]; }
    __syncthreads();
#pragma unroll
    for (int ks = 0; ks < 8; ++ks)
#pragma unroll
        for (int nt = 0; nt < 8; ++nt) { const bf16x8 bfr = *(const LAS bf16x8*)(Bl + (16 * nt + fr) * WSI_PITCH + (32 * ks + 8 * fq) * 2);
            acc[0][nt] = __builtin_amdgcn_mfma_f32_16x16x32_bf16(bfr, a[0][ks], acc[0][nt], 0, 0, 0); acc[1][nt] = __builtin_amdgcn_mfma_f32_16x16x32_bf16(bfr, a[1][ks], acc[1][nt], 0, 0, 0);
            if (w == 7) accm[nt] = __builtin_amdgcn_mfma_f32_16x16x32_bf16(bfr, am[ks], accm[nt], 0, 0, 0); }
    __syncthreads();
#pragma unroll
    for (int mt = 0; mt < 2; ++mt)
#pragma unroll
        for (int nt = 0; nt < 8; ++nt) *(LAS f32x4*)(Sl + (32 * w + 16 * mt + fr) * 64 + 8 * nt + 2 * fq) = acc[mt][nt];
    if (w == 7 && fr == 0) {
#pragma unroll
        for (int nt = 0; nt < 8; ++nt) *(LAS f32x4*)(smeta + 16 * nt + 4 * fq) = accm[nt]; }
    __syncthreads();
    { const f32x2 lc = ((const f32x2*)(F.ws + WS_LAMC))[g * 64 + lane];
      LAS f32x2* Ew = (LAS f32x2*)(F.lds + SMETA_OFF + 512);
      f32x2 l = (f32x2){0.f, 0.f};
#pragma unroll 8
      for (int k = 0; k < 32; ++k) { LAS f32x2* sp = Sl + (32 * w + k) * 64 + lane; const f32x2 sv = *sp; *sp = l; const float nx = lc.x * l.x - lc.y * l.y + sv.x, ny = lc.x * l.y + lc.y * l.x + sv.y; l.x = nx; l.y = ny; }
      Ew[w * 64 + lane] = l;
      f32x2 l32 = lc;
#pragma unroll
      for (int q = 0; q < 5; ++q) { const float nx = l32.x * l32.x - l32.y * l32.y, ny = 2.f * l32.x * l32.y; l32.x = nx; l32.y = ny; }
      __syncthreads();
      f32x2 X = *(const LAS f32x2*)(smeta + 2 * lane);
      for (int v = 0; v < w; ++v) { const f32x2 e = Ew[v * 64 + lane]; const float nx = l32.x * X.x - l32.y * X.y + e.x, ny = l32.x * X.y + l32.y * X.x + e.y; X.x = nx; X.y = ny; }
      unsigned* xp = (unsigned*)(UX + (size_t)(g * (NCH + 1) + b * 256 + 32 * w) * UXK + 256) + lane;
      f32x2 pw = X;
#pragma unroll 8
      for (int k = 0; k < 32; ++k) { const f32x2 lv = Sl[(32 * w + k) * 64 + lane]; xp[(size_t)k * (UXK / 2)] = cvt_pk_bf16(pw.x + lv.x, pw.y + lv.y); const float nx = lc.x * pw.x - lc.y * pw.y, ny = lc.x * pw.y + lc.y * pw.x; pw.x = nx; pw.y = ny; }
      VM_WAIT(); }
    __syncthreads();
}

__device__ __forceinline__ void conv_worker(Frame& F, const Args& args, int wi) {
    LAS unsigned char* zs = F.lds + RING_OFF;
    LAS float* cs = (LAS float*)(F.lds + RING_OFF + 65536);
    const bf16* Z = (const bf16*)(F.ws + WS_Z); bf16* ZC = (bf16*)(F.ws + WS_ZC);
    const int tid = F.tid, lane = F.lane, w = F.wave, b = wi >> 5, T0 = (wi & 31) * 128;
    auto zrow = [&](int ti, int cb) -> v4u { v4u v = (v4u){0u, 0u, 0u, 0u};
        if (ti >= 0) v = *(const v4u*)((const char*)Z + (size_t)(b * SEQ + ti) * 1024 + cb); else if (ti >= -NMETA) v = *(const v4u*)((const char*)Z + (size_t)(M + NMETA + ti) * 1024 + cb); return v; };
    { v4u v[8];
#pragma unroll
      for (int it = 0; it < 8; ++it) { const int q = tid + 512 * it; v[it] = (v4u){0u, 0u, 0u, 0u}; if (q < 62 * 64) v[it] = zrow(T0 - 30 + (q >> 6), (q & 63) * 16); }
#pragma unroll
      for (int it = 0; it < 8; ++it) { const int q = tid + 512 * it; if (q < 62 * 64) *(LAS v4u*)(zs + (((q >> 6) + 2) & 63) * 1024 + (q & 63) * 16) = v[it]; } }
    const int cp = tid & 255, th = tid >> 8;
    const float* dw = args.in[I_DW]; f32x2 wgt[CWID];
#pragma unroll
    for (int k = 0; k < CWID; ++k) wgt[k] = *(const f32x2*)(dw + k * DCONV + 2 * cp);
    const f32x2 bias = *(const f32x2*)(args.in[I_DWB] + 2 * cp);
    const f32x4 g0 = *(const f32x4*)(args.in[I_LNG] + 4 * lane), g1 = *(const f32x4*)(args.in[I_LNG] + 256 + 4 * lane), b0 = *(const f32x4*)(args.in[I_LNB] + 4 * lane), b1 = *(const f32x4*)(args.in[I_LNB] + 256 + 4 * lane);
#pragma unroll 1
    for (int j = 0; j < 4; ++j) {
        __syncthreads();
#pragma unroll 1
        for (int hf = 0; hf < 2; ++hf) {
            f32x2 acc[8];
#pragma unroll
            for (int t = 0; t < 8; ++t) acc[t] = bias;
            const int base = 32 * j + 16 * th + 8 * hf + 2;
#pragma unroll
            for (int i = 0; i < 38; ++i) { const unsigned zz = *(const LAS unsigned*)(zs + (((base + i) & 63) << 10) + 4 * cp); const float z0 = bf2f(zz & 0xffffu), z1 = bf2f(zz >> 16);
#pragma unroll
                for (int t = 0; t < 8; ++t) { const int k = i - t; if (k >= 0 && k < CWID) { acc[t].x += wgt[k].x * z0; acc[t].y += wgt[k].y * z1; } } }
#pragma unroll
            for (int t = 0; t < 8; ++t) *(LAS f32x2*)(cs + (16 * th + 8 * hf + t) * 512 + 2 * cp) = acc[t];
        }
        __syncthreads();
        v4u nx[4];
        if (j < 3) {
#pragma unroll
            for (int it = 0; it < 4; ++it) { const int q = tid + 512 * it; nx[it] = zrow(T0 + 32 * j + 32 + (q >> 6), (q & 63) * 16); } }
#pragma unroll
        for (int q = 0; q < 4; ++q) { const int t = 4 * w + q; const f32x4 x0 = *(const LAS f32x4*)(cs + t * 512 + 4 * lane), x1 = *(const LAS f32x4*)(cs + t * 512 + 256 + 4 * lane);
            const float mu = wave_sum((x0[0] + x0[1]) + (x0[2] + x0[3]) + (x1[0] + x1[1]) + (x1[2] + x1[3])) * (1.f / DCONV);
            const f32x4 d0 = x0 - mu, d1 = x1 - mu;
            const float var = wave_sum((d0[0] * d0[0] + d0[1] * d0[1]) + (d0[2] * d0[2] + d0[3] * d0[3]) + (d1[0] * d1[0] + d1[1] * d1[1]) + (d1[2] * d1[2] + d1[3] * d1[3])) * (1.f / DCONV);
            const float rstd = __builtin_amdgcn_rsqf(var + EPS); f32x4 o0 = d0 * rstd * g0 + b0, o1 = d1 * rstd * g1 + b1;
#pragma unroll
            for (int jj = 0; jj < 4; ++jj) { o0[jj] = fsilu(o0[jj]); o1[jj] = fsilu(o1[jj]); }
            bf16* zr = ZC + (size_t)(b * SEQ + T0 + 32 * j + t) * DCONV;
            *(v2u*)(zr + 4 * lane) = (v2u){cvt_pk_bf16(o0[0], o0[1]), cvt_pk_bf16(o0[2], o0[3])}; *(v2u*)(zr + 256 + 4 * lane) = (v2u){cvt_pk_bf16(o1[0], o1[1]), cvt_pk_bf16(o1[2], o1[3])}; }
        if (j < 3) {
#pragma unroll
            for (int it = 0; it < 4; ++it) { const int q = tid + 512 * it; *(LAS v4u*)(zs + ((32 * j + 64 + (q >> 6)) & 63) * 1024 + (q & 63) * 16) = nx[it]; } }
    }
    __syncthreads();
}

__global__ void __launch_bounds__(NWAVES * 64, 2) hyb_fwd(Args args) {
    extern __shared__ __attribute__((aligned(16))) unsigned char lds[];
    Frame F;
    F.lds = (LAS unsigned char*)lds; F.MISC = (volatile LAS unsigned*)(F.lds + MISC_OFF);
    F.wave = __builtin_amdgcn_readfirstlane((int)threadIdx.x >> 6); F.lane = lane_id_opaque(); F.tid = F.wave * 64 + F.lane;
    F.G = gridDim.x; { const int bx = blockIdx.x; F.vcu = (F.G % 8 == 0) ? (bx % 8) * (F.G / 8) + bx / 8 : bx; }
    F.ws = args.ws; F.out = args.out; F.ctl = (gu32*)(args.ws + WS_CTL);
    for (int u = F.tid; u < (LDS_BYTES - LDSCTL_OFF) / 4; u += NWAVES * 64) ((LAS unsigned*)(F.lds + LDSCTL_OFF))[u] = 0u;
    __syncthreads();
    const int bli = (N_LAUNCHES == PER_PHASE) ? 0 : args.li;
    XcdBarrier bar; bar.bar = (unsigned*)(F.ctl + CW_BAR) + bli * XCD_BAR_WORDS; bar.x = 0; bar.st = nullptr;
    if (N_LAUNCHES != PER_PHASE) bar = xcd_barrier_post((unsigned*)(F.ctl + CW_BAR) + bli * XCD_BAR_WORDS, F.MISC + 8);
    const int lo = args.ph_lo, hi = args.ph_hi;
#ifndef PHMASK
#define PHMASK 0x7ff
#endif
#define IN(k) (((PHMASK >> (k)) & 1) && lo <= (k) && (k) < hi)
#define SEAM(k) do { if (IN(k) && IN((k) + 1)) xcd_barrier(bar); F.lane = lane_id_opaque(); F.tid = F.wave * 64 + F.lane; } while (0)
    unsigned char* ws = F.ws;
    bf16* W13A = (bf16*)(ws + WS_W13A); bf16* W2A = (bf16*)(ws + WS_W2A); bf16* WIN = (bf16*)(ws + WS_WIN); bf16* WCAT = (bf16*)(ws + WS_WCAT); bf16* WOUT = (bf16*)(ws + WS_WOUT);
    bf16* W13B = (bf16*)(ws + WS_W13B); bf16* W2B = (bf16*)(ws + WS_W2B);
    bf16* AB = (bf16*)(ws + WS_AB); bf16* H1B = (bf16*)(ws + WS_H1); bf16* H2B = (bf16*)(ws + WS_H1 + 32 * MiB); bf16* HID = (bf16*)(ws + WS_HID);
    bf16* Zb = (bf16*)(ws + WS_Z); bf16* UXb = (bf16*)(ws + WS_UX); bf16* ZCb = (bf16*)(ws + WS_ZC); bf16* Yb = (bf16*)(ws + WS_Y); bf16* MCb = (bf16*)(ws + WS_MC);
    float* SS0 = (float*)(ws + WS_SS0); float* SS1 = SS0 + M; float* SS2 = SS1 + M; float* SS3 = SS2 + M;
    float* HIDM = (float*)(ws + WS_HIDM); float* H1M = (float*)(ws + WS_H1M);
    bf16* Gb = (bf16*)F.out;
    const int bx = (int)blockIdx.x;
    const int gw = F.vcu * NWAVES + F.wave, NGW = F.G * NWAVES;
    const int lb = bx - F.G / 2;
    const int lgw = lb * NWAVES + F.wave, NLGW = (F.G - F.G / 2) * NWAVES;

    if (IN(0)) {
        LAS float* scr = (LAS float*)(F.lds + RING_OFF + F.wave * 16384);
        for (int it = gw; it < T_W13A; it += NGW) weight_item(args, ws, scr, it, F.lane);
        for (int m = gw; m < M; m += NGW) { const GAS f32x4* xr = (const GAS f32x4*)(args.in[I_X] + (size_t)m * D) + F.lane; f32x4 v[4]; float s = 0.f;
#pragma unroll
            for (int j = 0; j < 4; ++j) { v[j] = xr[64 * j]; s += (v[j].x * v[j].x + v[j].y * v[j].y) + (v[j].z * v[j].z + v[j].w * v[j].w); }
            s = wave_sum(s);
            GAS v2u* o8 = (GAS v2u*)(AB + (size_t)m * D) + F.lane;
#pragma unroll
            for (int j = 0; j < 4; ++j) o8[64 * j] = (v2u){pk2(v[j].x, v[j].y), pk2(v[j].z, v[j].w)};
            if (F.lane == 0) { SS0[m] = s; SS1[m] = 0.f; SS2[m] = 0.f; SS3[m] = 0.f; } }
    }
    SEAM(0);
    if (IN(1)) {
        pg8::Gemm g{D, D, D}; pg8::GridOrder S{M / 256, 2 * DFF / 256, F.G, bx, (const char*)AB, (const char*)W13A, (size_t)256 * D * 2, (size_t)256 * D * 2, W_UP};
        EpiSwiglu E{HID, SS0};
        pg8::gemm_phase(F.lds + RING_OFF, F.wave, g, S, E);
        F.lane = lane_id_opaque(); F.tid = F.wave * 64 + F.lane;
        for (;;) { const int t = wg_ticket(F, 0);
            if (t < NG) { ssm_prep_job(F, args, t); continue; }
            if (t < NG + DFF / 16) { float* hm = HIDM; const int c0 = 16 * (t - NG); const bf16* b0 = W13A + (size_t)glu_row(c0) * D;
                meta_job<2, true>(F, args.in[I_META], D, b0, b0 + (size_t)128 * D, [=](int r, int jj, float a, float b) { hm[r * DFF + c0 + jj] = fsilu(a) * b; }); continue; }
            const int tj = t - (NG + DFF / 16); if (tj >= (T_WIN - T_W13A) / 16) break;
            LAS float* scr = (LAS float*)(F.lds + RING_OFF + F.wave * 16384);
            weight_item(args, ws, scr, T_W13A + 16 * tj + F.wave, F.lane); weight_item(args, ws, scr, T_W13A + 16 * tj + 8 + F.wave, F.lane);
        }
    }
    SEAM(1);
    if (IN(2)) {
        pg8::Gemm g{DFF, DFF, DFF}; pg8::GridOrder S{M / 256, D / 256, F.G, bx, (const char*)HID, (const char*)W2A, (size_t)256 * DFF * 2, (size_t)256 * DFF * 2, W_DN};
        EpiResid<true> E{AB, H1B, SS1, 0.5f};
        pg8::gemm_phase(F.lds + RING_OFF, F.wave, g, S, E);
    }
    SEAM(2);
    if (IN(3)) {
        pg8::Gemm g{D, D, D}; pg8::GridOrder S{M / 256, DIN / 256, F.G, bx, (const char*)H1B, (const char*)WIN, (size_t)256 * D * 2, (size_t)256 * D * 2, W_IN};
        EpiMix E{SS1, Zb, UXb, Gb, args.in[I_BGATE]};
        pg8::gemm_phase(F.lds + RING_OFF, F.wave, g, S, E);
        F.lane = lane_id_opaque(); F.tid = F.wave * 64 + F.lane;
        for (;;) { int j = wg_ticket(F, 1);
            if (j < 64) { float* hm = H1M; const float* mt = args.in[I_META]; const int c0 = 16 * j;
                meta_job<1, false>(F, HIDM, DFF, W2A + (size_t)c0 * DFF, nullptr, [=](int r, int jj, float a, float) { __hip_atomic_store(hm + r * D + c0 + jj, mt[r * D + c0 + jj] + 0.5f * a, __ATOMIC_RELAXED, __HIP_MEMORY_SCOPE_AGENT); });
                if (F.tid == 0) __hip_atomic_fetch_add((unsigned*)(F.ctl + CW_MBD), 1u, __ATOMIC_RELAXED, __HIP_MEMORY_SCOPE_AGENT);
                continue; }
            j -= 64;
            if (j < 64) wait_mbd(F);
            if (j < 32) { bf16* zz = Zb; const int c0 = 16 * j; const bf16* b0 = WIN + (size_t)glu_row(c0) * D;
                meta_job<2, true>(F, H1M, D, b0, b0 + (size_t)128 * D, [=](int r, int jj, float a, float b) { zz[(size_t)(M + r) * DCONV + c0 + jj] = (bf16)f2bf(a * fsigmoid(b)); }); continue; }
            if (j < 64) { bf16* ux = UXb; const int gg = j - 32;
                meta_job<1, true>(F, H1M, D, WIN + (size_t)(1024 + 16 * gg) * D, nullptr, [=](int r, int jj, float a, float) { ux[(size_t)(gg * (NCH + 1) + NCH) * UXK + r * 16 + jj] = (bf16)f2bf(a); }); continue; }
            const int tj = j - 64; if (tj >= (T_W2B - T_WIN) / 16) break;
            LAS float* scr = (LAS float*)(F.lds + RING_OFF + F.wave * 16384);
            weight_item(args, ws, scr, T_WIN + 16 * tj + F.wave, F.lane); weight_item(args, ws, scr, T_WIN + 16 * tj + 8 + F.wave, F.lane);
        }
    }
    SEAM(3);
    if (IN(4)) {
        if (bx < BATCH * NG) {
            ssm_pre_job(F, bx / NG, bx % NG);
            pg8::Gemm g{UXK, UXK, UXK}; SsmOrder S{1 << 20, bx, (const char*)UXb, (const char*)(ws + WS_BS2)};
            EpiSsmY E{UXb, args.in[I_SD], Yb};
            pg8::gemm_phase(F.lds + RING_OFF, F.wave, g, S, E);
        }
        else conv_worker(F, args, bx - BATCH * NG);
    }
    SEAM(4);
    if (IN(6)) {
        pg8::Gemm g{512, 512, 512}; MergeOrder S{F.G, bx, (const char*)ZCb, (const char*)Yb, (const char*)WCAT};
        EpiMerge E{Gb, MCb, AB};
        pg8::gemm_phase(F.lds + RING_OFF, F.wave, g, S, E);
    }
    SEAM(6);
    if (IN(7)) {
        pg8::Gemm g{D, D, D}; pg8::GridOrder S{M / 256, D / 256, F.G, bx, (const char*)AB, (const char*)WOUT, (size_t)256 * D * 2, (size_t)256 * D * 2, W_OUT};
        EpiResid<true> E{H1B, H2B, SS2, 1.0f};
        pg8::gemm_phase(F.lds + RING_OFF, F.wave, g, S, E);
    }
    SEAM(7);
    if (IN(8)) {
        pg8::Gemm g{D, D, D}; pg8::TailOrder S{M / 256, 2 * DFF / 256 - 2, F.G, bx, (const char*)H2B, (const char*)W13B, (size_t)256 * D * 2, (size_t)256 * D * 2, W_UP};
        EpiSwiglu E{HID, SS2};
        pg8::gemm_phase(F.lds + RING_OFF, F.wave, g, S, E);
    }
    SEAM(8);
    if (IN(9)) {
        pg8::Gemm g{DFF, DFF, DFF}; pg8::GridOrder S{M / 256, D / 256, F.G, bx, (const char*)HID, (const char*)W2B, (size_t)256 * DFF * 2, (size_t)256 * DFF * 2, W_DN};
        EpiFinal E{H2B, F.out, SS3, (unsigned*)(F.ctl + CW_FIN), args.in[I_FINN], 0.5f};
        pg8::gemm_phase(F.lds + RING_OFF, F.wave, g, S, E);
    }
#undef IN
#undef SEAM
}

extern "C" void kernel_launch(void* const* d_in, const int* in_sizes, int n_in, void* d_out, int out_size, void* d_ws, size_t ws_size, hipStream_t stream) {
    static int grid = 0;
    if (grid == 0) {
        if (n_in != 30 || in_sizes[0] != M * D || out_size != M * D || ws_size < WS_END) { fprintf(stderr, "kernel_launch: unexpected problem shape (n_in %d, in0 %d, out %d, ws %zu); nothing launched\n", n_in, n_in > 0 ? in_sizes[0] : -1, out_size, ws_size); grid = -1; return; }
        int dev = 0, cus = 0, per_cu = 0;
        if (hipGetDevice(&dev) != hipSuccess || hipDeviceGetAttribute(&cus, hipDeviceAttributeMultiprocessorCount, dev) != hipSuccess) { grid = -1; return; }
        if (hipFuncSetAttribute((const void*)hyb_fwd, hipFuncAttributeMaxDynamicSharedMemorySize, LDS_BYTES) != hipSuccess) { fprintf(stderr, "kernel_launch: hipFuncSetAttribute failed\n"); grid = -1; return; }
        if (hipOccupancyMaxActiveBlocksPerMultiprocessor(&per_cu, (const void*)hyb_fwd, NWAVES * 64, LDS_BYTES) != hipSuccess || per_cu < 1)
            fprintf(stderr, "kernel_launch: note: occupancy query reports %d workgroups per CU\n", per_cu);
        (void)hipGetLastError();
        grid = cus > 256 ? 256 : cus;
        if (grid != 256) fprintf(stderr, "kernel_launch: %d CUs reported; this kernel's phase program needs a 256-workgroup grid\n", cus);
    }
    if (grid < 0) return;
    if (hipMemsetAsync((char*)d_ws + WS_CTL, 0, CTL_ZERO_BYTES, stream) != hipSuccess) { fprintf(stderr, "kernel_launch: hipMemsetAsync failed\n"); return; }
    Args a{};
    for (int i = 0; i < 30; ++i) a.in[i] = (const float*)d_in[i];
    a.out = (float*)d_out; a.ws = (unsigned char*)d_ws;
    for (int li = 0; li < N_LAUNCHES; ++li) {
        a.ph_lo = (N_LAUNCHES == PER_PHASE) ? li : 0; a.ph_hi = (N_LAUNCHES == PER_PHASE) ? li + 1 : PER_PHASE; a.li = li;
        hipLaunchKernelGGL(hyb_fwd, dim3(grid), dim3(NWAVES * 64), LDS_BYTES, stream, a);
        const hipError_t le = hipPeekAtLastError();
        if (le != hipSuccess) { fprintf(stderr, "kernel_launch: launch %d failed: %s\n", li, hipGetErrorName(le)); break; }
    }
}
```

```cpp
#include <hip/hip_runtime.h>
#include <cstdio>
#include <cstdint>

#ifndef MK_N_LAUNCHES
#define MK_N_LAUNCHES 1
#endif

__device__ __forceinline__ int lane_id_opaque() { int l; asm volatile("v_mbcnt_lo_u32_b32 %0, -1, 0\n\tv_mbcnt_hi_u32_b32 %0, -1, %0" : "=v"(l)); return l; }
namespace pg8 {
#define PG8_LAS __attribute__((address_space(3)))
typedef unsigned short bf16_t;
typedef short bf16x8 __attribute__((ext_vector_type(8)));
typedef float f32x4 __attribute__((ext_vector_type(4)));
typedef unsigned u32x4 __attribute__((ext_vector_type(4)));
constexpr int BM = 256, BK = 64, HALF = 128, HTB = HALF * BK * 2, STAGE_BYTES = 8 * HTB, NXCD = 8;

__host__ __device__ __forceinline__ int lds_byte(int r, int c) { const int st = (r >> 4) * 2 + (c >> 5), rr = r & 15, cc = c & 31, ob = rr * 64 + cc * 2; return st * 1024 + (ob ^ (((ob >> 9) & 1) << 5)); }
__host__ __device__ __forceinline__ void stage_rc(int b, int& R, int& C) { const int st = b / 1024, sb = b % 1024, swz = sb ^ (((sb >> 9) & 1) << 5); R = (st >> 1) * 16 + swz / 64; C = (st & 1) * 32 + (swz % 64) / 2; }
__host__ __device__ __forceinline__ int perm32(int rho) { const int n = rho >> 4, i = rho & 15; return 8 * (i >> 2) + 4 * n + (i & 3); }

struct Unit { int pm, pn, kind; const char* A; const char* B; };
struct Gemm { int lda, ldb, K; };

__device__ __forceinline__ bool static_tile(int i, int G, int c, int nM, int nN, int WGM  , int& pm, int& pn) {
    const int nwg = nM * nN; const long L = (long)i * G + c; if (L >= nwg) return false;
    int wgid = (int)L; { const int q = nwg / NXCD, r = nwg % NXCD, xcd = wgid % NXCD, off = wgid / NXCD; wgid = (xcd < r ? xcd * (q + 1) : r * (q + 1) + (xcd - r) * q) + off; }
    const int nig = WGM * nN, gid = wgid / nig, fm = gid * WGM, gsz = (nM - fm) < WGM ? (nM - fm) : WGM;
    pm = fm + ((wgid % nig) % gsz); pn = (wgid % nig) / gsz; return true;
}
struct GridOrder {
    int nM, nN, G, c; const char* A; const char* B; size_t tA, tB; int wgm;
    __device__ __forceinline__ bool next(int i, Unit& u) const { int pm, pn; if (!static_tile(i, G, c, nM, nN, wgm, pm, pn)) return false; u.pm = pm; u.pn = pn; u.kind = 0; u.A = A + (size_t)pm * tA; u.B = B + (size_t)pn * tB; return true; }
    __device__ __forceinline__ void a_ready(const Unit&) const {}
    __device__ __forceinline__ void done(const Unit&) const {}
};

__device__ __forceinline__ unsigned cvt_pk_bf16(float lo, float hi) { unsigned r; asm volatile("v_cvt_pk_bf16_f32 %0, %1, %2" : "=v"(r) : "v"(lo), "v"(hi)); return r; }

template <class Epi, class Sched>
__device__ __forceinline__ void gemm_phase(PG8_LAS unsigned char* lds, const int wid  , const Gemm g, const Sched& S, const Epi& E) {
    const int lane = lane_id_opaque(), tid = wid * 64 + lane, wr = wid >> 2, wc = wid & 3, fr = lane & 15, fq = lane >> 4;
    const int K = g.K, nt = K / BK;
    unsigned voffA[2], voffB[2];
#pragma unroll
    for (int i = 0; i < 2; ++i) { int R, C; stage_rc(tid * 16 + i * 8192, R, C); const int Rb = (R & ~31) + perm32(R & 31);
        voffA[i] = (unsigned)(R * g.lda + C) * 2u; voffB[i] = (unsigned)(Rb * g.ldb + C) * 2u; }
    const size_t kstep = (size_t)(BK * 2);
    const size_t hstepA = (size_t)HALF * g.lda * 2, hstepB = (size_t)HALF * g.ldb * 2;
    const unsigned ldsw = (unsigned)wid * 1024u;
    const int aoff = lds_byte(wr * 64 + fr, fq * 8), boff = lds_byte(wc * 32 + fr, fq * 8);
#define PG8_SA(b, h) (((b) * 2 + (h)) * HTB)
#define PG8_SB(b, h) ((4 + (b) * 2 + (h)) * HTB)
#define PG8_STAGE(bufoff, gbase, voff) do { _Pragma("unroll") for (int _i = 0; _i < 2; ++_i) \
        __builtin_amdgcn_global_load_lds((const unsigned*)((const char*)(gbase) + (voff)[_i]), (PG8_LAS unsigned*)(lds + (bufoff) + ldsw + _i * 8192), 16, 0, 0); } while (0)
#define PG8_LDA(dst, b, h) do { _Pragma("unroll") for (int m = 0; m < 4; ++m) _Pragma("unroll") for (int k = 0; k < 2; ++k) dst[m][k] = *(const PG8_LAS bf16x8*)(lds + PG8_SA(b, h) + aoff + m * 2048 + k * 1024); } while (0)
#define PG8_LDB(dst, b, h) do { _Pragma("unroll") for (int n = 0; n < 2; ++n) _Pragma("unroll") for (int k = 0; k < 2; ++k) dst[n][k] = *(const PG8_LAS bf16x8*)(lds + PG8_SB(b, h) + boff + n * 2048 + k * 1024); } while (0)
#define PG8_MMA(ai, bj, At, Bt) do { __builtin_amdgcn_s_setprio(1); _Pragma("unroll") for (int m = 0; m < 4; ++m) _Pragma("unroll") for (int n = 0; n < 2; ++n) _Pragma("unroll") for (int k = 0; k < 2; ++k) \
        acc[ai][bj][m][n] = __builtin_amdgcn_mfma_f32_16x16x32_bf16(Bt[n][k], At[m][k], acc[ai][bj][m][n], 0, 0, 0); __builtin_amdgcn_s_setprio(0); } while (0)
#define PG8_WAIT_V(n) asm volatile("s_waitcnt vmcnt(" #n ")" ::: "memory")
#define PG8_WAIT_L(n) asm volatile("s_waitcnt lgkmcnt(" #n ")" ::: "memory")
#define PG8_BAR __builtin_amdgcn_s_barrier()
#define PG8_SCHED __builtin_amdgcn_sched_barrier(0)
    Unit cur, nxt; int ui = 0;
    if (!S.next(0, cur)) return;
    f32x4 acc[2][2][4][2];
#pragma unroll
    for (int a = 0; a < 2; ++a)
#pragma unroll
        for (int b = 0; b < 2; ++b)
#pragma unroll
            for (int m = 0; m < 4; ++m)
#pragma unroll
                for (int n = 0; n < 2; ++n) acc[a][b][m][n] = (f32x4){0.f, 0.f, 0.f, 0.f};
    bf16x8 At[4][2], B0[2][2], B1[2][2];
    const char* cA = cur.A; const char* cB = cur.B;
    S.a_ready(cur);
    PG8_STAGE(PG8_SB(0, 0), cB, voffB); PG8_STAGE(PG8_SB(0, 1), cB + hstepB, voffB); PG8_STAGE(PG8_SA(0, 0), cA, voffA); PG8_STAGE(PG8_SA(0, 1), cA + hstepA, voffA);
    if (wr == 1) PG8_BAR;
    PG8_WAIT_V(2); PG8_BAR;
    PG8_STAGE(PG8_SB(1, 0), cB + kstep, voffB); PG8_STAGE(PG8_SA(1, 0), cA + kstep, voffA); PG8_STAGE(PG8_SB(1, 1), cB + hstepB + kstep, voffB);
    PG8_WAIT_V(6); PG8_BAR;
    for (;;) {
        const bool has_next = S.next(ui + 1, nxt);
        const char* nA = has_next ? nxt.A : cA; const char* nB = has_next ? nxt.B : cB;
        for (int t = 0; t < nt; t += 2) {
            const bool last = (t == nt - 2);
            const char* a1 = cA + (size_t)(t + 1) * kstep;
            const char* a2 = last ? nA : cA + (size_t)(t + 2) * kstep; const char* b2 = last ? nB : cB + (size_t)(t + 2) * kstep;
            const char* a3 = a2 + kstep; const char* b3 = b2 + kstep;
            if (last && has_next) S.a_ready(nxt);
            PG8_LDB(B0, 0, 0); PG8_LDB(B1, 0, 1); PG8_SCHED; PG8_LDA(At, 0, 0); PG8_STAGE(PG8_SA(1, 1), a1 + hstepA, voffA);
            PG8_WAIT_V(8); PG8_WAIT_L(0); PG8_BAR; PG8_MMA(0, 0, At, B0); PG8_MMA(0, 1, At, B1); PG8_BAR; PG8_SCHED;
            PG8_LDA(At, 0, 1); PG8_STAGE(PG8_SB(0, 0), b2, voffB); PG8_STAGE(PG8_SB(0, 1), b2 + hstepB, voffB); PG8_STAGE(PG8_SA(0, 0), a2, voffA);
            PG8_WAIT_V(8); PG8_WAIT_L(0); PG8_BAR; PG8_MMA(1, 0, At, B0); PG8_MMA(1, 1, At, B1); PG8_BAR; PG8_SCHED;
            PG8_LDB(B0, 1, 0); PG8_LDB(B1, 1, 1); PG8_SCHED; PG8_LDA(At, 1, 0); PG8_STAGE(PG8_SA(0, 1), a2 + hstepA, voffA);
            PG8_WAIT_V(8); PG8_WAIT_L(0); PG8_BAR; PG8_MMA(0, 0, At, B0); PG8_MMA(0, 1, At, B1); PG8_BAR; PG8_SCHED;
            PG8_LDA(At, 1, 1); PG8_STAGE(PG8_SB(1, 0), b3, voffB); PG8_STAGE(PG8_SB(1, 1), b3 + hstepB, voffB); PG8_STAGE(PG8_SA(1, 0), a3, voffA);
            PG8_WAIT_V(8); PG8_WAIT_L(0); PG8_BAR; PG8_MMA(1, 0, At, B0); PG8_MMA(1, 1, At, B1); PG8_BAR; PG8_SCHED;
        }
        if (wr == 0) PG8_BAR;
        E(acc, cur, wr, wc); S.done(cur);
        if (!has_next) break;
#pragma unroll
        for (int a = 0; a < 2; ++a)
#pragma unroll
            for (int b = 0; b < 2; ++b)
#pragma unroll
                for (int m = 0; m < 4; ++m)
#pragma unroll
                    for (int n = 0; n < 2; ++n) acc[a][b][m][n] = (f32x4){0.f, 0.f, 0.f, 0.f};
        cur = nxt; cA = nA; cB = nB; ++ui;
        if (wr == 1) PG8_BAR;
    }
    PG8_WAIT_V(0);
    PG8_BAR;
#undef PG8_SA
#undef PG8_SB
#undef PG8_STAGE
#undef PG8_LDA
#undef PG8_LDB
#undef PG8_MMA
#undef PG8_WAIT_V
#undef PG8_WAIT_L
#undef PG8_BAR
#undef PG8_SCHED
}
}

constexpr int NWAVES = 8;
constexpr int D = 1024, BATCH = 4, SEQ = 4096, NMETA = 16, DFF = 2816, DCONV = 512, CWID = 31, DSSM = 512, HG = 16, NG = 32, PS = 64;
constexpr int DIN = 2 * DCONV + DSSM + 2 * D;
constexpr int M = BATCH * SEQ;
constexpr int NCH = M / 16;
constexpr int UXK = 384;
constexpr float EPS = 1e-6f;
constexpr int PER_PHASE = 10;
#ifndef W_UP
#define W_UP 4
#endif
#ifndef W_DN
#define W_DN 8
#endif
#ifndef W_IN
#define W_IN 4
#endif
#ifndef W_MG
#define W_MG 4
#endif
#ifndef W_OUT
#define W_OUT 4
#endif
constexpr int N_LAUNCHES = MK_N_LAUNCHES;

constexpr size_t MiB = 1u << 20;
constexpr size_t WS_CTL = 0, CTL_ZERO_BYTES = 1 * MiB;
constexpr size_t WS_BS2 = 1 * MiB;
constexpr size_t WS_WSI = 7 * MiB;
constexpr size_t WS_SMALL = 9 * MiB;
constexpr size_t WS_LAMC = WS_SMALL;
constexpr size_t WS_SMETA = WS_SMALL + 16384;
constexpr size_t WS_SS0 = WS_SMALL + 32768;
constexpr size_t WS_HIDM = WS_SMALL + 32768 + 4 * 65536;
constexpr size_t WS_H1M = WS_HIDM + 16 * DFF * 4;
constexpr size_t WS_W13A = 11 * MiB, WS_W2A = 22 * MiB, WS_WIN = 28 * MiB, WS_WCAT = 35 * MiB, WS_WOUT = 38 * MiB, WS_W13B = 40 * MiB, WS_W2B = 51 * MiB;
constexpr size_t WS_AB = 57 * MiB;
constexpr size_t WS_H1 = 89 * MiB;
constexpr size_t WS_HID = 153 * MiB;
constexpr size_t WS_Z = WS_HID;
constexpr size_t WS_UX = WS_HID + 17 * MiB;
constexpr size_t WS_ZC = WS_HID + 42 * MiB;
constexpr size_t WS_Y = WS_HID + 58 * MiB;
constexpr size_t WS_MC = WS_HID;
constexpr size_t WS_S = WS_HID + 74 * MiB;
constexpr size_t WS_END = 256 * MiB;
static_assert(WS_H1M + 16 * D * 4 <= WS_W13A, "small tables");
static_assert(WS_W2B + (size_t)D * DFF * 2 <= WS_AB && WS_AB + (size_t)M * D * 2 <= WS_H1 && WS_H1 + (size_t)M * D * 4 <= WS_HID, "ws map 1");
static_assert(WS_Z + (size_t)(M + 16) * DCONV * 2 <= WS_UX && WS_UX + (size_t)NG * (NCH + 1) * UXK * 2 <= WS_ZC && WS_ZC + (size_t)M * DCONV * 2 <= WS_Y && WS_Y + (size_t)M * DSSM * 2 <= WS_S, "ws map 2");
static_assert(WS_MC + (size_t)M * D * 2 <= WS_ZC, "MC overlay");
static_assert(WS_HID + (size_t)M * DFF * 2 <= WS_END && WS_S + (size_t)NCH * NG * 128 * 4 <= WS_END, "ws end");
static_assert(WS_W13A + (size_t)2 * DFF * D * 2 <= WS_W2A && WS_W2A + (size_t)D * DFF * 2 <= WS_WIN && WS_WIN + (size_t)DIN * D * 2 <= WS_WCAT && WS_WCAT + (size_t)3072 * 512 * 2 <= WS_WOUT && WS_WOUT + (size_t)D * D * 2 <= WS_W13B && WS_W13B + (size_t)2 * DFF * D * 2 <= WS_W2B, "weights");
static_assert(WS_BS2 + (size_t)NG * 256 * UXK * 2 <= WS_WSI && WS_WSI + (size_t)NG * 128 * 256 * 2 <= WS_SMALL, "ssm mats");
constexpr int CW_BAR = 4096;
constexpr int CW_FIN = 16384;

constexpr int RING_OFF = 0, RING_BYTES = 131072;
constexpr int LDSCTL_OFF = RING_BYTES, MISC_OFF = LDSCTL_OFF + 320;
constexpr int LDS_BYTES = 147456;

#define GAS __attribute__((address_space(1)))
#define LAS __attribute__((address_space(3)))
typedef unsigned short bf16;
typedef unsigned v4u __attribute__((ext_vector_type(4)));
typedef unsigned v2u __attribute__((ext_vector_type(2)));
typedef float f32x4 __attribute__((ext_vector_type(4)));
typedef float f32x2 __attribute__((ext_vector_type(2)));
typedef short bf16x8 __attribute__((ext_vector_type(8)));
typedef GAS unsigned gu32;
#define RLX_AGENT __ATOMIC_RELAXED, __HIP_MEMORY_SCOPE_AGENT
#define LDS_WAIT() asm volatile("s_waitcnt lgkmcnt(0)" ::: "memory")
#define VM_WAIT() asm volatile("s_waitcnt vmcnt(0)" ::: "memory")
__device__ __forceinline__ unsigned f2bf(float f) { unsigned u = __builtin_bit_cast(unsigned, f); return (u + 0x7fffu + ((u >> 16) & 1u)) >> 16; }
__device__ __forceinline__ unsigned pk2(float lo, float hi) { return f2bf(lo) | (f2bf(hi) << 16); }
__device__ __forceinline__ float bf2f(unsigned h) { return __builtin_bit_cast(float, h << 16); }
__device__ __forceinline__ float fsigmoid(float x) { return __builtin_amdgcn_rcpf(1.f + __builtin_amdgcn_exp2f(-1.44269504089f * x)); }
__device__ __forceinline__ float fsilu(float x) { return x * fsigmoid(x); }
__device__ __forceinline__ float fgelu_tanh(float x) { return x * fsigmoid(1.5957691216f * (x + 0.044715f * x * x * x)); }
__device__ __forceinline__ float wave_sum(float v) {
#pragma unroll
    for (int o = 1; o < 64; o <<= 1) v += __shfl_xor(v, o);
    return v;
}

#define XB_TMO      128
#define XB_XCNT(j)  (256  + 64 * (j))
#define XB_XSUB(j)  (1280 + 64 * (j))
#define XB_XGEN(j)  (2304 + 64 * (j))
#define XB_TOP      3328
#define XB_TOPGEN   3392
#define XCD_BAR_WORDS 3456
#define XB_SPIN_CAP (1u << 18)
__device__ __forceinline__ unsigned xb_ld(unsigned* p)              { return __hip_atomic_load(p, __ATOMIC_RELAXED, __HIP_MEMORY_SCOPE_AGENT); }
__device__ __forceinline__ unsigned xb_add(unsigned* p, unsigned v) { return __hip_atomic_fetch_add(p, v, __ATOMIC_RELAXED, __HIP_MEMORY_SCOPE_AGENT); }
__device__ __forceinline__ unsigned xb_xcc_id() { return (unsigned)__builtin_amdgcn_s_getreg((3 << 11) | 20) & 0xFu; }
#define XB_SPIN(cond, bar) do { unsigned _sp = 0; while (cond) { __builtin_amdgcn_s_sleep(1); \
    if ((++_sp & 255u) == 0u) { if (xb_ld(&(bar)[XB_TMO])) break; if (_sp > XB_SPIN_CAP) { atomicAdd(&(bar)[XB_TMO], 1u); break; } } } } while (0)
struct XcdBarrier { unsigned* bar; unsigned x; volatile LAS unsigned* st; };
__device__ __forceinline__ XcdBarrier xcd_barrier_post(unsigned* bar, volatile LAS unsigned* st) {
    XcdBarrier b; b.bar = bar; b.x = xb_xcc_id(); b.st = st;
    if (threadIdx.x == 0) (void)xb_add(&bar[XB_XCNT(b.x)], 1u);
    return b;
}
__device__ __forceinline__ void xcd_barrier_complete(unsigned* bar, unsigned x, unsigned& nloc, unsigned& nx) {
    const unsigned G = gridDim.x * gridDim.y * gridDim.z;
    unsigned sum, cnt, mine, sp = 0u;
    for (;;) {
        sum = 0u; cnt = 0u; mine = 0u;
#pragma unroll
        for (unsigned j = 0; j < 16; ++j) { const unsigned c = xb_ld(&bar[XB_XCNT(j)]); sum += c; cnt += (c > 0u) ? 1u : 0u; mine = (j == x) ? c : mine; }
        if (sum == G) break;
        __builtin_amdgcn_s_sleep(1);
        if ((++sp & 255u) == 0u) { if (xb_ld(&bar[XB_TMO])) break; if (sp > XB_SPIN_CAP) { atomicAdd(&bar[XB_TMO], 1u); break; } }
    }
    nloc = mine > 0u ? mine : 1u; nx = cnt > 0u ? cnt : 1u;
}
__device__ __forceinline__ void xcd_barrier(const XcdBarrier& b) {
    asm volatile("s_waitcnt vmcnt(0)" ::: "memory");
    __syncthreads();
    if (threadIdx.x == 0) {
        unsigned* bar = b.bar;
        __builtin_amdgcn_s_waitcnt(0);
        unsigned nloc = b.st[0], nx = b.st[1];
        if (nloc == 0u) { xcd_barrier_complete(bar, b.x, nloc, nx); b.st[0] = nloc; b.st[1] = nx; }
        const unsigned old = xb_add(&bar[XB_XSUB(b.x)], 1u);
        const unsigned gen = old / nloc;
        if (old + 1u == (gen + 1u) * nloc) {
            __builtin_amdgcn_fence(__ATOMIC_RELEASE, "agent");
            asm volatile("s_waitcnt vmcnt(0)" ::: "memory");
            const unsigned og = xb_add(&bar[XB_TOP], 1u);
            const unsigned tg = og / nx;
            if (og + 1u == (tg + 1u) * nx) xb_add(&bar[XB_TOPGEN], 1u);
            else XB_SPIN(xb_ld(&bar[XB_TOPGEN]) == tg, bar);
            __builtin_amdgcn_fence(__ATOMIC_ACQUIRE, "agent");
            asm volatile("s_waitcnt vmcnt(0)" ::: "memory");
            xb_add(&bar[XB_XGEN(b.x)], 1u);
            asm volatile("s_waitcnt vmcnt(0)" ::: "memory");
        } else {
            __builtin_amdgcn_fence(__ATOMIC_ACQUIRE, "agent");
            XB_SPIN(xb_ld(&bar[XB_XGEN(b.x)]) == gen, bar);
            asm volatile("s_waitcnt vmcnt(0)" ::: "memory");
        }
    }
    __syncthreads();
}

struct Args { const float* in[30]; float* out; unsigned char* ws; int ph_lo, ph_hi, li, pad; };
struct Frame {
    LAS unsigned char* lds; volatile LAS unsigned* MISC; gu32* ctl;
    int tid, lane, wave, vcu, G;
    float* out; unsigned char* ws;
};
enum { I_X = 0, I_META, I_F1N, I_F1W1, I_F1W3, I_F1W2, I_MIXN, I_WIN, I_BGATE, I_DW, I_DWB, I_LNG, I_LNB, I_CPROJ, I_LRE, I_LIM, I_LDT, I_BRE, I_BIM, I_CRE, I_CIM, I_SD, I_WV, I_WG, I_WOUT, I_F2N, I_F2W1, I_F2W3, I_F2W2, I_FINN };

constexpr int CW_TKT = 32768;
__device__ __forceinline__ int wg_ticket(Frame& F, int k) {
    __syncthreads();
    if (F.tid == 0) F.MISC[16] = __hip_atomic_fetch_add((unsigned*)(F.ctl + CW_TKT + 64 * k), 1u, __ATOMIC_RELAXED, __HIP_MEMORY_SCOPE_AGENT);
    __syncthreads();
    return (int)F.MISC[16];
}
constexpr int CW_MBD = 49152;
__device__ __forceinline__ void wait_mbd(Frame& F) {
    if (F.wave == 0) { unsigned* p = (unsigned*)(F.ctl + CW_MBD); unsigned sp = 0;
        while ((unsigned)__builtin_amdgcn_readfirstlane((int)__hip_atomic_load(p, __ATOMIC_RELAXED, __HIP_MEMORY_SCOPE_AGENT)) < 64u) { __builtin_amdgcn_s_sleep(2); if (++sp > (1u << 22)) break; }
        __builtin_amdgcn_fence(__ATOMIC_ACQUIRE, "agent"); asm volatile("s_waitcnt vmcnt(0)" ::: "memory"); }
    __syncthreads();
}
using pg8::Unit; using pg8::cvt_pk_bf16;
__device__ __forceinline__ v4u pack8(const f32x4 a, const f32x4 b) { v4u w; w.x = cvt_pk_bf16(a[0], a[1]); w.y = cvt_pk_bf16(a[2], a[3]); w.z = cvt_pk_bf16(b[0], b[1]); w.w = cvt_pk_bf16(b[2], b[3]); return w; }
__device__ __forceinline__ void unpack8(const v4u w, float (&o)[8]) { o[0] = bf2f(w.x & 0xffffu); o[1] = bf2f(w.x >> 16); o[2] = bf2f(w.y & 0xffffu); o[3] = bf2f(w.y >> 16); o[4] = bf2f(w.z & 0xffffu); o[5] = bf2f(w.z >> 16); o[6] = bf2f(w.w & 0xffffu); o[7] = bf2f(w.w >> 16); }
__device__ __forceinline__ float rs_from(float ss) { return __builtin_amdgcn_rsqf(ss * (1.0f / D) + EPS); }
__device__ __forceinline__ void load_rs8(const float* SS, int row0, float (&rs)[8]) {
#pragma unroll
    for (int i = 0; i < 8; ++i) rs[i] = SS[row0 + (i >> 2) * 128 + (i & 3) * 16];
#pragma unroll
    for (int i = 0; i < 8; ++i) rs[i] = rs_from(rs[i]);
}

struct EpiSwiglu {
    bf16* HID; const float* SS;
    __device__ __forceinline__ void operator()(const f32x4 (&acc)[2][2][4][2], const Unit& u, int wr, int wc) const {
        const int lane_ = lane_id_opaque(), fr = lane_ & 15, fq = lane_ >> 4;
        const int row0 = u.pm * 256 + wr * 64 + fr, col0 = u.pn * 128 + wc * 32 + 8 * fq;
        float rsv[8]; load_rs8(SS, row0, rsv);
#pragma unroll
        for (int ai = 0; ai < 2; ++ai)
#pragma unroll
            for (int m = 0; m < 4; ++m) { const int row = row0 + ai * 128 + m * 16; const float rs = rsv[ai * 4 + m];
                f32x4 o0, o1;
#pragma unroll
                for (int j = 0; j < 4; ++j) { o0[j] = fsilu(acc[ai][0][m][0][j] * rs) * (acc[ai][1][m][0][j] * rs); o1[j] = fsilu(acc[ai][0][m][1][j] * rs) * (acc[ai][1][m][1][j] * rs); }
                *(v4u*)(HID + (size_t)row * DFF + col0) = pack8(o0, o1); }
    }
};
template <bool RBF16> struct EpiResid {
    const void* R; bf16* OB; float* SS; float alpha;
    __device__ __forceinline__ void operator()(const f32x4 (&acc)[2][2][4][2], const Unit& u, int wr, int wc) const {
        const int lane_ = lane_id_opaque(), fr = lane_ & 15, fq = lane_ >> 4;
        const int row0 = u.pm * 256 + wr * 64 + fr, col0 = u.pn * 256 + wc * 32 + 8 * fq;
#pragma unroll
        for (int ai = 0; ai < 2; ++ai) {
            f32x4 r[4][2][2];
#pragma unroll
            for (int m = 0; m < 4; ++m)
#pragma unroll
                for (int bj = 0; bj < 2; ++bj) { const size_t off = (size_t)(row0 + ai * 128 + m * 16) * D + col0 + bj * 128;
                    if (RBF16) { const v4u w = *(const v4u*)((const bf16*)R + off); r[m][bj][0] = __builtin_bit_cast(f32x4, w); }
                    else { r[m][bj][0] = *(const f32x4*)((const float*)R + off); r[m][bj][1] = *(const f32x4*)((const float*)R + off + 4); } }
#pragma unroll
            for (int m = 0; m < 4; ++m) { const int row = row0 + ai * 128 + m * 16; float ss = 0.f;
#pragma unroll
                for (int bj = 0; bj < 2; ++bj) { const size_t off = (size_t)row * D + col0 + bj * 128; f32x4 r0, r1;
                    if (RBF16) { float t[8]; unpack8(__builtin_bit_cast(v4u, r[m][bj][0]), t); r0 = (f32x4){t[0], t[1], t[2], t[3]}; r1 = (f32x4){t[4], t[5], t[6], t[7]}; }
                    else { r0 = r[m][bj][0]; r1 = r[m][bj][1]; }
                    const f32x4 o0 = r0 + acc[ai][bj][m][0] * alpha, o1 = r1 + acc[ai][bj][m][1] * alpha;
                    *(v4u*)(OB + off) = pack8(o0, o1);
                    ss += (o0[0] * o0[0] + o0[1] * o0[1]) + (o0[2] * o0[2] + o0[3] * o0[3]) + (o1[0] * o1[0] + o1[1] * o1[1]) + (o1[2] * o1[2] + o1[3] * o1[3]); }
                ss += __shfl_xor(ss, 16); ss += __shfl_xor(ss, 32);
                if (fq == 0) atomicAdd(SS + row, ss); }
            asm volatile("" ::: "memory"); }
    }
};
struct EpiFinal {
    const bf16* R; float* OUT; float* SS; unsigned* cnt; const float* gain; float alpha;
    __device__ __forceinline__ void operator()(f32x4 (&acc)[2][2][4][2], const Unit& u, int wr, int wc) const {
        const int lane_ = lane_id_opaque(), fr = lane_ & 15, fq = lane_ >> 4;
        const int row0 = u.pm * 256 + wr * 64 + fr, col0 = u.pn * 256 + wc * 32 + 8 * fq;
#pragma unroll
        for (int ai = 0; ai < 2; ++ai) {
            v4u r[4][2];
#pragma unroll
            for (int m = 0; m < 4; ++m)
#pragma unroll
                for (int bj = 0; bj < 2; ++bj) r[m][bj] = *(const v4u*)(R + (size_t)(row0 + ai * 128 + m * 16) * D + col0 + bj * 128);
#pragma unroll
            for (int m = 0; m < 4; ++m) { const int row = row0 + ai * 128 + m * 16; float ss = 0.f;
#pragma unroll
                for (int bj = 0; bj < 2; ++bj) { float t[8]; unpack8(r[m][bj], t);
                    const f32x4 o0 = (f32x4){t[0], t[1], t[2], t[3]} + acc[ai][bj][m][0] * alpha, o1 = (f32x4){t[4], t[5], t[6], t[7]} + acc[ai][bj][m][1] * alpha;
                    acc[ai][bj][m][0] = o0; acc[ai][bj][m][1] = o1;
                    ss += (o0[0] * o0[0] + o0[1] * o0[1]) + (o0[2] * o0[2] + o0[3] * o0[3]) + (o1[0] * o1[0] + o1[1] * o1[1]) + (o1[2] * o1[2] + o1[3] * o1[3]); }
                ss += __shfl_xor(ss, 16); ss += __shfl_xor(ss, 32);
                if (fq == 0) atomicAdd(SS + row, ss); }
            asm volatile("" ::: "memory"); }
        asm volatile("s_waitcnt vmcnt(0)" ::: "memory");
        unsigned* cw = cnt + 64 * u.pm;
        if (lane_ == 0) __hip_atomic_fetch_add(cw, 1u, __ATOMIC_RELAXED, __HIP_MEMORY_SCOPE_AGENT);
        f32x4 g[2][2];
#pragma unroll
        for (int bj = 0; bj < 2; ++bj) { g[bj][0] = *(const f32x4*)(gain + col0 + bj * 128); g[bj][1] = *(const f32x4*)(gain + col0 + bj * 128 + 4); }
        { unsigned sp = 0; while ((unsigned)__builtin_amdgcn_readfirstlane((int)__hip_atomic_load(cw, __ATOMIC_RELAXED, __HIP_MEMORY_SCOPE_AGENT)) < 32u) { __builtin_amdgcn_s_sleep(2); if (++sp > (1u << 20)) break; } }
        float tot[8];
#pragma unroll
        for (int i = 0; i < 8; ++i) { tot[i] = 0.f; if (fq == 0) tot[i] = __hip_atomic_fetch_add(SS + row0 + (i >> 2) * 128 + (i & 3) * 16, 0.0f, __ATOMIC_RELAXED, __HIP_MEMORY_SCOPE_AGENT); }
#pragma unroll
        for (int ai = 0; ai < 2; ++ai)
#pragma unroll
            for (int m = 0; m < 4; ++m) { const int row = row0 + ai * 128 + m * 16;
                const float rs = rs_from(__shfl(tot[ai * 4 + m], fr));
#pragma unroll
                for (int bj = 0; bj < 2; ++bj) { const size_t off = (size_t)row * D + col0 + bj * 128;
                    *(f32x4*)(OUT + off) = acc[ai][bj][m][0] * rs * g[bj][0]; *(f32x4*)(OUT + off + 4) = acc[ai][bj][m][1] * rs * g[bj][1]; } }
    }
};
struct EpiMix {
    const float* SS; bf16* Z; bf16* UX; bf16* G; const float* bgate;
    __device__ __forceinline__ void operator()(const f32x4 (&acc)[2][2][4][2], const Unit& u, int wr, int wc) const {
        const int lane_ = lane_id_opaque(), fr = lane_ & 15, fq = lane_ >> 4;
        const int row0 = u.pm * 256 + wr * 64 + fr;
        if (u.pn < 4) {
            const int col0 = u.pn * 128 + wc * 32 + 8 * fq;
#pragma unroll
            for (int ai = 0; ai < 2; ++ai)
#pragma unroll
                for (int m = 0; m < 4; ++m) { const int row = row0 + ai * 128 + m * 16; const float rs = rs_from(SS[row]); f32x4 o0, o1;
#pragma unroll
                    for (int j = 0; j < 4; ++j) { o0[j] = (acc[ai][0][m][0][j] * rs) * fsigmoid(acc[ai][1][m][0][j] * rs); o1[j] = (acc[ai][0][m][1][j] * rs) * fsigmoid(acc[ai][1][m][1][j] * rs); }
                    *(v4u*)(Z + (size_t)row * DCONV + col0) = pack8(o0, o1); }
        } else if (u.pn < 6) {
#pragma unroll
            for (int ai = 0; ai < 2; ++ai)
#pragma unroll
                for (int m = 0; m < 4; ++m) { const int row = row0 + ai * 128 + m * 16; const float rs = rs_from(SS[row]); const int ci = row >> 4, tt = row & 15;
#pragma unroll
                    for (int bj = 0; bj < 2; ++bj) { const int c = (u.pn - 4) * 256 + bj * 128 + wc * 32 + 8 * fq, g = c >> 4, h0 = c & 15;
                        *(v4u*)(UX + ((size_t)(g * (NCH + 1) + ci) * UXK + tt * 16 + h0)) = pack8(acc[ai][bj][m][0] * rs, acc[ai][bj][m][1] * rs); } }
        } else {
#pragma unroll
            for (int bj = 0; bj < 2; ++bj) { const int c = (u.pn - 6) * 256 + bj * 128 + wc * 32 + 8 * fq;
                const f32x4 b0 = *(const f32x4*)(bgate + c), b1 = *(const f32x4*)(bgate + c + 4);
#pragma unroll
                for (int ai = 0; ai < 2; ++ai)
#pragma unroll
                    for (int m = 0; m < 4; ++m) { const int row = row0 + ai * 128 + m * 16; const float rs = rs_from(SS[row]); f32x4 o0, o1;
#pragma unroll
                        for (int j = 0; j < 4; ++j) { o0[j] = fsigmoid(acc[ai][bj][m][0][j] * rs + b0[j]); o1[j] = fsigmoid(acc[ai][bj][m][1][j] * rs + b1[j]); }
                        *(v4u*)(G + (size_t)row * 2048 + c) = pack8(o0, o1); } }
        }
    }
};
struct EpiSsmY {
    const bf16* UX; const float* dskip; bf16* Y;
    __device__ __forceinline__ void operator()(const f32x4 (&acc)[2][2][4][2], const Unit& u, int wr, int wc) const {
        const int lane_ = lane_id_opaque(), fr = lane_ & 15, fq = lane_ >> 4;
        const int b = u.pm, g = u.pn, h0 = 8 * (fq & 1);
        const f32x4 d0 = *(const f32x4*)(dskip + g * 16 + h0), d1 = *(const f32x4*)(dskip + g * 16 + h0 + 4);
#pragma unroll
        for (int ai = 0; ai < 2; ++ai) {
            v4u uw[4][2];
#pragma unroll
            for (int m = 0; m < 4; ++m)
#pragma unroll
                for (int bj = 0; bj < 2; ++bj) { const int r = ai * 128 + wr * 64 + m * 16 + fr, tt = 8 * bj + 2 * wc + (fq >> 1);
                    uw[m][bj] = *(const v4u*)(UX + ((size_t)(g * (NCH + 1) + b * 256 + r) * UXK + tt * 16 + h0)); }
#pragma unroll
            for (int m = 0; m < 4; ++m) { const int r = ai * 128 + wr * 64 + m * 16 + fr;
#pragma unroll
                for (int bj = 0; bj < 2; ++bj) { const int tt = 8 * bj + 2 * wc + (fq >> 1);
                    float uu[8]; unpack8(uw[m][bj], uu);
                    f32x4 o0, o1;
#pragma unroll
                    for (int j = 0; j < 4; ++j) { o0[j] = fgelu_tanh(acc[ai][bj][m][0][j] + d0[j] * uu[j]); o1[j] = fgelu_tanh(acc[ai][bj][m][1][j] + d1[j] * uu[4 + j]); }
                    *(v4u*)(Y + ((size_t)(b * SEQ + r * 16 + tt) * DSSM + g * 16 + h0)) = pack8(o0, o1); } }
            asm volatile("" ::: "memory"); }
    }
};
struct EpiMerge {
    const bf16* G; bf16* MC; bf16* MG;
    __device__ __forceinline__ void operator()(const f32x4 (&acc)[2][2][4][2], const Unit& u, int wr, int wc) const {
        const int lane_ = lane_id_opaque(), fr = lane_ & 15, fq = lane_ >> 4;
        const int row0 = u.pm * 256 + wr * 64 + fr;
        if (u.kind == 0) {
#pragma unroll
            for (int ai = 0; ai < 2; ++ai) {
                v4u gw[4][2];
#pragma unroll
                for (int m = 0; m < 4; ++m)
#pragma unroll
                    for (int bj = 0; bj < 2; ++bj) gw[m][bj] = *(const v4u*)(G + (size_t)(row0 + ai * 128 + m * 16) * 2048 + u.pn * 256 + bj * 128 + wc * 32 + 8 * fq);
#pragma unroll
                for (int m = 0; m < 4; ++m) { const int row = row0 + ai * 128 + m * 16;
#pragma unroll
                    for (int bj = 0; bj < 2; ++bj) { const int c = u.pn * 256 + bj * 128 + wc * 32 + 8 * fq;
                        float gg[8]; unpack8(gw[m][bj], gg); f32x4 o0, o1;
#pragma unroll
                        for (int j = 0; j < 4; ++j) { o0[j] = gg[j] * acc[ai][bj][m][0][j]; o1[j] = gg[4 + j] * acc[ai][bj][m][1][j]; }
                        *(v4u*)(MC + (size_t)row * D + c) = pack8(o0, o1); } }
                asm volatile("" ::: "memory"); }
        } else {
            const int c = u.pn * 256 + (u.kind - 1) * 128 + wc * 32 + 8 * fq;
#pragma unroll
            for (int ai = 0; ai < 2; ++ai) {
                v4u gw[4], mw[4];
#pragma unroll
                for (int m = 0; m < 4; ++m) { const int row = row0 + ai * 128 + m * 16; gw[m] = *(const v4u*)(G + (size_t)row * 2048 + D + c); mw[m] = *(const v4u*)(MC + (size_t)row * D + c); }
#pragma unroll
                for (int m = 0; m < 4; ++m) { const int row = row0 + ai * 128 + m * 16;
                    float gg[8], mc[8]; unpack8(gw[m], gg); unpack8(mw[m], mc); f32x4 o0, o1;
#pragma unroll
                    for (int j = 0; j < 4; ++j) { o0[j] = mc[j] + gg[j] * (acc[ai][0][m][0][j] * fsigmoid(acc[ai][1][m][0][j])); o1[j] = mc[4 + j] + gg[4 + j] * (acc[ai][0][m][1][j] * fsigmoid(acc[ai][1][m][1][j])); }
                    *(v4u*)(MG + (size_t)row * D + c) = pack8(o0, o1); }
                asm volatile("" ::: "memory"); }
        }
    }
};
struct SsmOrder {
    int G, c; const char* UX; const char* BS2;
    __device__ __forceinline__ bool next(int i, Unit& u) const { const int L = i * G + c; if (L >= BATCH * NG) return false; const int b = L / NG, g = L % NG; u.pm = b; u.pn = g; u.kind = 0;
        u.A = UX + ((size_t)(g * (NCH + 1) + b * 256) * UXK) * 2; u.B = BS2 + (size_t)g * 256 * UXK * 2; return true; }
    __device__ __forceinline__ void a_ready(const Unit&) const {}
    __device__ __forceinline__ void done(const Unit&) const {}
};
struct MergeOrder {
    int G, c; const char* ZC; const char* Y; const char* WCAT;
    __device__ __forceinline__ bool next(int i, Unit& u) const { int pm, pn; const int su = i / 3, k = i - 3 * su; if (!pg8::static_tile(su, G, c, M / 256, D / 256, W_MG, pm, pn)) return false; u.pm = pm; u.pn = pn; u.kind = k;
        u.A = (k == 0 ? ZC : Y) + (size_t)pm * 256 * 512 * 2; u.B = WCAT + (size_t)(k == 0 ? pn * 256 : 1024 + (2 * pn + k - 1) * 256) * 512 * 2; return true; }
    __device__ __forceinline__ void a_ready(const Unit&) const {}
    __device__ __forceinline__ void done(const Unit& u) const { if (u.kind == 0) asm volatile("s_waitcnt vmcnt(0)" ::: "memory"); }
};

__device__ __forceinline__ void p0_transpose_item(const float* W, int K, int N, bf16* WT, const float* gain, LAS float* scr, int k0, int n0, int drow0, int lane) {
    float v[32];
    const float* src = W + (size_t)(k0 + (lane >> 5)) * N + n0 + (lane & 31);
#pragma unroll
    for (int i = 0; i < 32; ++i) v[i] = src[(size_t)(2 * i) * N];
#pragma unroll
    for (int i = 0; i < 32; ++i) scr[(2 * i + (lane >> 5)) * 33 + (lane & 31)] = v[i];
    LDS_WAIT(); asm volatile("" ::: "memory");
    const int c = lane & 7;
    f32x4 g0 = (f32x4){1.f, 1.f, 1.f, 1.f}, g1 = g0; if (gain) { g0 = *(const f32x4*)(gain + k0 + 8 * c); g1 = *(const f32x4*)(gain + k0 + 8 * c + 4); }
#pragma unroll
    for (int j = 0; j < 4; ++j) { const int n = (lane >> 3) + 8 * j; const LAS float* s = scr + (8 * c) * 33 + n;
        v4u o; o.x = pk2(s[0 * 33] * g0[0], s[1 * 33] * g0[1]); o.y = pk2(s[2 * 33] * g0[2], s[3 * 33] * g0[3]); o.z = pk2(s[4 * 33] * g1[0], s[5 * 33] * g1[1]); o.w = pk2(s[6 * 33] * g1[2], s[7 * 33] * g1[3]);
        *(GAS v4u*)(WT + (size_t)(drow0 + n) * K + k0 + 8 * c) = o; }
    LDS_WAIT(); asm volatile("" ::: "memory");
}
__device__ __forceinline__ int glu_row(int n) { return 256 * (n >> 7) + (n & 127); }

constexpr int I_UP = (D / 64) * (DFF / 32), I_DN = (DFF / 64) * (D / 32), I_INP = (D / 64) * (DIN / 32), I_CP = (DCONV / 64) * (D / 32), I_WO = (D / 64) * (D / 32);
constexpr int T_W13A = 2 * I_UP, T_W2A = T_W13A + I_DN, T_WIN = T_W2A + I_INP, T_WCAT = T_WIN + 3 * I_CP, T_WOUT = T_WCAT + I_WO, T_W13B = T_WOUT + 2 * I_UP, T_W2B = T_W13B + I_DN;
__device__ __forceinline__ void weight_item(const Args& args, unsigned char* ws, LAS float* scr, int it, int lane) {
    if (it < T_W13A || (it >= T_WOUT && it < T_W13B)) { const bool second = it >= T_WOUT; int r = it - (second ? T_WOUT : 0); const int which = r / I_UP; r -= which * I_UP; const int nblk = DFF / 32, k0 = 64 * (r / nblk), n0 = 32 * (r % nblk);
        const float* W = second ? (which ? args.in[I_F2W3] : args.in[I_F2W1]) : (which ? args.in[I_F1W3] : args.in[I_F1W1]);
        p0_transpose_item(W, D, DFF, (bf16*)(ws + (second ? WS_W13B : WS_W13A)), second ? args.in[I_F2N] : args.in[I_F1N], scr, k0, n0, glu_row(n0) + which * 128, lane); return; }
    if (it < T_W2A || it >= T_W13B) { const bool second = it >= T_W13B; const int r = it - (second ? T_W13B : T_W13A); const int nblk = D / 32, k0 = 64 * (r / nblk), n0 = 32 * (r % nblk);
        p0_transpose_item(second ? args.in[I_F2W2] : args.in[I_F1W2], DFF, D, (bf16*)(ws + (second ? WS_W2B : WS_W2A)), nullptr, scr, k0, n0, n0, lane); return; }
    if (it < T_WIN) { const int r = it - T_W2A; const int nblk = DIN / 32, k0 = 64 * (r / nblk), n0 = 32 * (r % nblk);
        const int dr = n0 < 512 ? glu_row(n0) : n0 < 1024 ? glu_row(n0 - 512) + 128 : n0;
        p0_transpose_item(args.in[I_WIN], D, DIN, (bf16*)(ws + WS_WIN), args.in[I_MIXN], scr, k0, n0, dr, lane); return; }
    if (it < T_WCAT) { int r = it - T_WIN; const int which = r / I_CP; r -= which * I_CP; const int nblk = D / 32, k0 = 64 * (r / nblk), n0 = 32 * (r % nblk);
        const int dr = which == 0 ? n0 : 1024 + glu_row(n0) + (which == 2 ? 128 : 0);
        p0_transpose_item(which == 0 ? args.in[I_CPROJ] : which == 1 ? args.in[I_WV] : args.in[I_WG], DCONV, D, (bf16*)(ws + WS_WCAT), nullptr, scr, k0, n0, dr, lane); return; }
    { const int r = it - T_WCAT; const int nblk = D / 32, k0 = 64 * (r / nblk), n0 = 32 * (r % nblk); p0_transpose_item(args.in[I_WOUT], D, D, (bf16*)(ws + WS_WOUT), nullptr, scr, k0, n0, n0, lane); }
}

__device__ __forceinline__ void ssm_prep_job(Frame& F, const Args& args, int g) {
    LAS f32x2* lamP = (LAS f32x2*)(F.lds + RING_OFF);
    LAS f32x2* Bb = lamP + 17 * 64;
    LAS f32x2* Cc = Bb + 64 * 16;
    LAS float* Kk = (LAS float*)(Cc + 16 * 64);
    const float* lam_re = args.in[I_LRE]; const float* lam_im = args.in[I_LIM]; const float* log_dt = args.in[I_LDT];
    const float* b_re = args.in[I_BRE]; const float* b_im = args.in[I_BIM]; const float* c_re = args.in[I_CRE]; const float* c_im = args.in[I_CIM];
    const int tid = F.tid;
    const float dt = expf(log_dt[g]);
    if (tid < 64) { const int p = tid; const float a = lam_re[g * PS + p] * dt, bb = lam_im[g * PS + p] * dt, ea = expf(a), sb = sinf(bb), cb = cosf(bb);
        const float lx = ea * cb, ly = ea * sb; float px = 1.f, py = 0.f;
        for (int k = 0; k <= 16; ++k) { lamP[k * 64 + p] = (f32x2){px, py}; const float nx = px * lx - py * ly, ny = px * ly + py * lx; px = nx; py = ny; } }
    for (int i = tid; i < 1024; i += 512) { const int p = i >> 4;
        const float lr = lam_re[g * PS + p], li = lam_im[g * PS + p], a = lr * dt, bb = li * dt, ea = expf(a), sb = sinf(bb), cb = cosf(bb), sh = sinf(0.5f * bb);
        const float nr = expm1f(a) * cb - 2.f * sh * sh, ni = ea * sb, den = 1.f / (lr * lr + li * li), fr_ = (nr * lr + ni * li) * den, fi_ = (ni * lr - nr * li) * den;
        const float br = b_re[(size_t)g * 1024 + i], bi = b_im[(size_t)g * 1024 + i];
        Bb[i] = (f32x2){fr_ * br - fi_ * bi, fr_ * bi + fi_ * br};
        Cc[i] = (f32x2){c_re[(size_t)g * 1024 + i], c_im[(size_t)g * 1024 + i]}; }
    __syncthreads();
    {
        const int k = tid >> 5, h = (tid >> 1) & 15, hh = (tid & 1) * 8; float sum[8];
#pragma unroll
        for (int j = 0; j < 8; ++j) sum[j] = 0.f;
#pragma unroll 4
        for (int p = 0; p < 64; ++p) { const f32x2 c = Cc[h * 64 + p], l = lamP[k * 64 + p]; const float er = c.x * l.x - c.y * l.y, ei = c.x * l.y + c.y * l.x;
#pragma unroll
            for (int j = 0; j < 8; j += 2) { const f32x4 bb = *(const LAS f32x4*)(Bb + p * 16 + hh + j); sum[j] += er * bb[0] - ei * bb[1]; sum[j + 1] += er * bb[2] - ei * bb[3]; } }
#pragma unroll
        for (int j = 0; j < 8; ++j) Kk[(k << 8) + (h << 4) + hh + j] = sum[j];
    }
    __syncthreads();
    GAS unsigned* bs2 = (GAS unsigned*)(F.ws + WS_BS2) + (size_t)g * 256 * (UXK / 2);
    for (int i = tid; i < 256 * (UXK / 2); i += 512) { const int n = i / (UXK / 2), kp = (i % (UXK / 2)) * 2, t = n >> 4, h = n & 15; float v0, v1;
        if (kp < 256) { const int s = kp >> 4, hp = kp & 15; const bool on = s <= t; const int kb = (((t - s) & 15) << 8) + (h << 4) + hp; v0 = on ? Kk[kb] : 0.f; v1 = on ? Kk[kb + 1] : 0.f; }
        else { const int p = (kp - 256) >> 1; const f32x2 c = Cc[h * 64 + p], l = lamP[(t + 1) * 64 + p]; v0 = c.x * l.x - c.y * l.y; v1 = -(c.x * l.y + c.y * l.x); }
        bs2[i] = pk2(v0, v1); }
    GAS unsigned* wsi = (GAS unsigned*)(F.ws + WS_WSI) + (size_t)g * 128 * 128;
    for (int i = tid; i < 128 * 128; i += 512) { const int n = i >> 7, kp = (i & 127) * 2, p = n >> 1, c = n & 1, s = kp >> 4, h = kp & 15;
        const f32x2 l = lamP[(15 - s) * 64 + p], b0 = Bb[p * 16 + h], b1 = Bb[p * 16 + h + 1];
        const float v0 = c ? (l.x * b0.y + l.y * b0.x) : (l.x * b0.x - l.y * b0.y), v1 = c ? (l.x * b1.y + l.y * b1.x) : (l.x * b1.x - l.y * b1.y);
        wsi[i] = pk2(v0, v1); }
    if (tid < 64) ((GAS f32x2*)(F.ws + WS_LAMC))[g * 64 + tid] = lamP[16 * 64 + tid];
    __syncthreads();
}

template <int NS, bool NORM, class Fn>
__device__ __forceinline__ void meta_job(Frame& F, const float* A, int K, const bf16* Bt0, const bf16* Bt1, const Fn& fn) {
    LAS float* red = (LAS float*)(F.lds + RING_OFF);
    LAS float* rsc = red + 8 * 16 * 32;
    const int lane = F.lane, w = F.wave, fr = lane & 15, fq = lane >> 4;
    if (NORM) {
#pragma unroll
        for (int rr = 0; rr < 2; ++rr) { const int row = 2 * w + rr; float s = 0.f; for (int c = lane; c < D; c += 64) { const float v = A[(size_t)row * K + c]; s += v * v; } s = wave_sum(s); if (lane == 0) rsc[row] = 1.0f / sqrtf(s * (1.0f / D) + EPS); }
    } else if (F.tid < 16) rsc[F.tid] = 1.f;
    f32x4 acc[NS];
#pragma unroll
    for (int s = 0; s < NS; ++s) acc[s] = (f32x4){0.f, 0.f, 0.f, 0.f};
    const int kw = K / 8, kbase = w * kw;
#pragma unroll 4
    for (int k = kbase; k < kbase + kw; k += 32) {
        const f32x4 a0 = *(const f32x4*)(A + (size_t)fr * K + k + 8 * fq), a1 = *(const f32x4*)(A + (size_t)fr * K + k + 8 * fq + 4);
        const v4u ap = pack8(a0, a1); const bf16x8 af = __builtin_bit_cast(bf16x8, ap);
#pragma unroll
        for (int s = 0; s < NS; ++s) { const bf16x8 bf = *(const bf16x8*)((s == 0 ? Bt0 : Bt1) + (size_t)fr * K + k + 8 * fq); acc[s] = __builtin_amdgcn_mfma_f32_16x16x32_bf16(bf, af, acc[s], 0, 0, 0); } }
#pragma unroll
    for (int s = 0; s < NS; ++s) *(LAS f32x4*)(red + (w * 16 + fr) * 32 + s * 16 + 4 * fq) = acc[s];
    __syncthreads();
    if (F.tid < 256) { const int rr = F.tid >> 4, j = F.tid & 15; float v0 = 0.f, v1 = 0.f;
#pragma unroll
        for (int ww = 0; ww < 8; ++ww) { v0 += red[(ww * 16 + rr) * 32 + j]; if (NS > 1) v1 += red[(ww * 16 + rr) * 32 + 16 + j]; }
        const float sc = rsc[rr]; fn(rr, j, v0 * sc, v1 * sc); }
    VM_WAIT();
    __syncthreads();
}

constexpr int WSI_PITCH = 528;
constexpr int SMETA_OFF = LDSCTL_OFF + 1024;
__device__ __forceinline__ void ssm_pre_job(Frame& F, int b, int g) {
    const int lane = F.lane, w = F.wave, tid = F.tid, fr = lane & 15, fq = lane >> 4;
    LAS unsigned char* Bl = F.lds + RING_OFF;
    LAS f32x2* Sl = (LAS f32x2*)(F.lds + RING_OFF);
    LAS float* smeta = (LAS float*)(F.lds + SMETA_OFF);
    bf16* UX = (bf16*)(F.ws + WS_UX); const bf16* Wg = (const bf16*)(F.ws + WS_WSI) + (size_t)g * 128 * 256;
    { v4u v[8];
#pragma unroll
      for (int i = 0; i < 8; ++i) { const int idx = tid + 512 * i; v[i] = *(const v4u*)(Wg + (size_t)(idx >> 5) * 256 + (idx & 31) * 8); }
#pragma unroll
      for (int i = 0; i < 8; ++i) { const int idx = tid + 512 * i; *(LAS v4u*)(Bl + (idx >> 5) * WSI_PITCH + (idx & 31) * 16) = v[i]; } }
    const bf16* Ab = UX + (size_t)(g * (NCH + 1) + 256 * b + 32 * w) * UXK;
    bf16x8 a[2][8], am[8];
#pragma unroll
    for (int mt = 0; mt < 2; ++mt)
#pragma unroll
        for (int ks = 0; ks < 8; ++ks) a[mt][ks] = *(const bf16x8*)(Ab + (size_t)(16 * mt + fr) * UXK + 32 * ks + 8 * fq);
    if (w == 7) {
#pragma unroll
        for (int ks = 0; ks < 8; ++ks) am[ks] = *(const bf16x8*)(UX + (size_t)(g * (NCH + 1) + NCH) * UXK + 32 * ks + 8 * fq); }
    f32x4 acc[2][8], accm[8];
#pragma unroll
    for (int nt = 0; nt < 8; ++nt) { acc[0][nt] = (f32x4){0.f, 0.f, 0.f, 0.f}; acc[1][nt] = acc[0][nt]; accm[nt] = acc[0][nt]; }
    __syncthreads();
#pragma unroll
    for (int ks = 0; ks < 8; ++ks)
#pragma unroll
        for (int nt = 0; nt < 8; ++nt) { const bf16x8 bfr = *(const LAS bf16x8*)(Bl + (16 * nt + fr) * WSI_PITCH + (32 * ks + 8 * fq) * 2);
            acc[0][nt] = __builtin_amdgcn_mfma_f32_16x16x32_bf16(bfr, a[0][ks], acc[0][nt], 0, 0, 0); acc[1][nt] = __builtin_amdgcn_mfma_f32_16x16x32_bf16(bfr, a[1][ks], acc[1][nt], 0, 0, 0);
            if (w == 7) accm[nt] = __builtin_amdgcn_mfma_f32_16x16x32_bf16(bfr, am[ks], accm[nt], 0, 0, 0); }
    __syncthreads();
#pragma unroll
    for (int mt = 0; mt < 2; ++mt)
#pragma unroll
        for (int nt = 0; nt < 8; ++nt) *(LAS f32x4*)(Sl + (32 * w + 16 * mt + fr) * 64 + 8 * nt + 2 * fq) = acc[mt][nt];
    if (w == 7 && fr == 0) {
#pragma unroll
        for (int nt = 0; nt < 8; ++nt) *(LAS f32x4*)(smeta + 16 * nt + 4 * fq) = accm[nt]; }
    __syncthreads();
    { const f32x2 lc = ((const f32x2*)(F.ws + WS_LAMC))[g * 64 + lane];
      LAS f32x2* Ew = (LAS f32x2*)(F.lds + SMETA_OFF + 512);
      f32x2 l = (f32x2){0.f, 0.f};
#pragma unroll 8
      for (int k = 0; k < 32; ++k) { LAS f32x2* sp = Sl + (32 * w + k) * 64 + lane; const f32x2 sv = *sp; *sp = l; const float nx = lc.x * l.x - lc.y * l.y + sv.x, ny = lc.x * l.y + lc.y * l.x + sv.y; l.x = nx; l.y = ny; }
      Ew[w * 64 + lane] = l;
      f32x2 l32 = lc;
#pragma unroll
      for (int q = 0; q < 5; ++q) { const float nx = l32.x * l32.x - l32.y * l32.y, ny = 2.f * l32.x * l32.y; l32.x = nx; l32.y = ny; }
      __syncthreads();
      f32x2 X = *(const LAS f32x2*)(smeta + 2 * lane);
      for (int v = 0; v < w; ++v) { const f32x2 e = Ew[v * 64 + lane]; const float nx = l32.x * X.x - l32.y * X.y + e.x, ny = l32.x * X.y + l32.y * X.x + e.y; X.x = nx; X.y = ny; }
      unsigned* xp = (unsigned*)(UX + (size_t)(g * (NCH + 1) + b * 256 + 32 * w) * UXK + 256) + lane;
      f32x2 pw = X;
#pragma unroll 8
      for (int k = 0; k < 32; ++k) { const f32x2 lv = Sl[(32 * w + k) * 64 + lane]; xp[(size_t)k * (UXK / 2)] = cvt_pk_bf16(pw.x + lv.x, pw.y + lv.y); const float nx = lc.x * pw.x - lc.y * pw.y, ny = lc.x * pw.y + lc.y * pw.x; pw.x = nx; pw.y = ny; }
      VM_WAIT(); }
    __syncthreads();
}

__device__ __forceinline__ void conv_worker(Frame& F, const Args& args, int wi) {
    LAS unsigned char* zs = F.lds + RING_OFF;
    LAS float* cs = (LAS float*)(F.lds + RING_OFF + 65536);
    const bf16* Z = (const bf16*)(F.ws + WS_Z); bf16* ZC = (bf16*)(F.ws + WS_ZC);
    const int tid = F.tid, lane = F.lane, w = F.wave, b = wi >> 5, T0 = (wi & 31) * 128;
    auto zrow = [&](int ti, int cb) -> v4u { v4u v = (v4u){0u, 0u, 0u, 0u};
        if (ti >= 0) v = *(const v4u*)((const char*)Z + (size_t)(b * SEQ + ti) * 1024 + cb); else if (ti >= -NMETA) v = *(const v4u*)((const char*)Z + (size_t)(M + NMETA + ti) * 1024 + cb); return v; };
    { v4u v[8];
#pragma unroll
      for (int it = 0; it < 8; ++it) { const int q = tid + 512 * it; v[it] = (v4u){0u, 0u, 0u, 0u}; if (q < 62 * 64) v[it] = zrow(T0 - 30 + (q >> 6), (q & 63) * 16); }
#pragma unroll
      for (int it = 0; it < 8; ++it) { const int q = tid + 512 * it; if (q < 62 * 64) *(LAS v4u*)(zs + (((q >> 6) + 2) & 63) * 1024 + (q & 63) * 16) = v[it]; } }
    const int cp = tid & 255, th = tid >> 8;
    const float* dw = args.in[I_DW]; f32x2 wgt[CWID];
#pragma unroll
    for (int k = 0; k < CWID; ++k) wgt[k] = *(const f32x2*)(dw + k * DCONV + 2 * cp);
    const f32x2 bias = *(const f32x2*)(args.in[I_DWB] + 2 * cp);
    const f32x4 g0 = *(const f32x4*)(args.in[I_LNG] + 4 * lane), g1 = *(const f32x4*)(args.in[I_LNG] + 256 + 4 * lane), b0 = *(const f32x4*)(args.in[I_LNB] + 4 * lane), b1 = *(const f32x4*)(args.in[I_LNB] + 256 + 4 * lane);
#pragma unroll 1
    for (int j = 0; j < 4; ++j) {
        __syncthreads();
#pragma unroll 1
        for (int hf = 0; hf < 2; ++hf) {
            f32x2 acc[8];
#pragma unroll
            for (int t = 0; t < 8; ++t) acc[t] = bias;
            const int base = 32 * j + 16 * th + 8 * hf + 2;
#pragma unroll
            for (int i = 0; i < 38; ++i) { const unsigned zz = *(const LAS unsigned*)(zs + (((base + i) & 63) << 10) + 4 * cp); const float z0 = bf2f(zz & 0xffffu), z1 = bf2f(zz >> 16);
#pragma unroll
                for (int t = 0; t < 8; ++t) { const int k = i - t; if (k >= 0 && k < CWID) { acc[t].x += wgt[k].x * z0; acc[t].y += wgt[k].y * z1; } } }
#pragma unroll
            for (int t = 0; t < 8; ++t) *(LAS f32x2*)(cs + (16 * th + 8 * hf + t) * 512 + 2 * cp) = acc[t];
        }
        __syncthreads();
        v4u nx[4];
        if (j < 3) {
#pragma unroll
            for (int it = 0; it < 4; ++it) { const int q = tid + 512 * it; nx[it] = zrow(T0 + 32 * j + 32 + (q >> 6), (q & 63) * 16); } }
#pragma unroll
        for (int q = 0; q < 4; ++q) { const int t = 4 * w + q; const f32x4 x0 = *(const LAS f32x4*)(cs + t * 512 + 4 * lane), x1 = *(const LAS f32x4*)(cs + t * 512 + 256 + 4 * lane);
            const float mu = wave_sum((x0[0] + x0[1]) + (x0[2] + x0[3]) + (x1[0] + x1[1]) + (x1[2] + x1[3])) * (1.f / DCONV);
            const f32x4 d0 = x0 - mu, d1 = x1 - mu;
            const float var = wave_sum((d0[0] * d0[0] + d0[1] * d0[1]) + (d0[2] * d0[2] + d0[3] * d0[3]) + (d1[0] * d1[0] + d1[1] * d1[1]) + (d1[2] * d1[2] + d1[3] * d1[3])) * (1.f / DCONV);
            const float rstd = __builtin_amdgcn_rsqf(var + EPS); f32x4 o0 = d0 * rstd * g0 + b0, o1 = d1 * rstd * g1 + b1;
#pragma unroll
            for (int jj = 0; jj < 4; ++jj) { o0[jj] = fsilu(o0[jj]); o1[jj] = fsilu(o1[jj]); }
            bf16* zr = ZC + (size_t)(b * SEQ + T0 + 32 * j + t) * DCONV;
            *(v2u*)(zr + 4 * lane) = (v2u){cvt_pk_bf16(o0[0], o0[1]), cvt_pk_bf16(o0[2], o0[3])}; *(v2u*)(zr + 256 + 4 * lane) = (v2u){cvt_pk_bf16(o1[0], o1[1]), cvt_pk_bf16(o1[2], o1[3])}; }
        if (j < 3) {
#pragma unroll
            for (int it = 0; it < 4; ++it) { const int q = tid + 512 * it; *(LAS v4u*)(zs + ((32 * j + 64 + (q >> 6)) & 63) * 1024 + (q & 63) * 16) = nx[it]; } }
    }
    __syncthreads();
}

__global__ void __launch_bounds__(NWAVES * 64, 2) hyb_fwd(Args args) {
    extern __shared__ __attribute__((aligned(16))) unsigned char lds[];
    Frame F;
    F.lds = (LAS unsigned char*)lds; F.MISC = (volatile LAS unsigned*)(F.lds + MISC_OFF);
    F.wave = __builtin_amdgcn_readfirstlane((int)threadIdx.x >> 6); F.lane = lane_id_opaque(); F.tid = F.wave * 64 + F.lane;
    F.G = gridDim.x; { const int bx = blockIdx.x; F.vcu = (F.G % 8 == 0) ? (bx % 8) * (F.G / 8) + bx / 8 : bx; }
    F.ws = args.ws; F.out = args.out; F.ctl = (gu32*)(args.ws + WS_CTL);
    for (int u = F.tid; u < (LDS_BYTES - LDSCTL_OFF) / 4; u += NWAVES * 64) ((LAS unsigned*)(F.lds + LDSCTL_OFF))[u] = 0u;
    __syncthreads();
    const int bli = (N_LAUNCHES == PER_PHASE) ? 0 : args.li;
    XcdBarrier bar; bar.bar = (unsigned*)(F.ctl + CW_BAR) + bli * XCD_BAR_WORDS; bar.x = 0; bar.st = nullptr;
    if (N_LAUNCHES != PER_PHASE) bar = xcd_barrier_post((unsigned*)(F.ctl + CW_BAR) + bli * XCD_BAR_WORDS, F.MISC + 8);
    const int lo = args.ph_lo, hi = args.ph_hi;
#ifndef PHMASK
#define PHMASK 0x7ff
#endif
#define IN(k) (((PHMASK >> (k)) & 1) && lo <= (k) && (k) < hi)
#define SEAM(k) do { if (IN(k) && IN((k) + 1)) xcd_barrier(bar); F.lane = lane_id_opaque(); F.tid = F.wave * 64 + F.lane; } while (0)
    unsigned char* ws = F.ws;
    bf16* W13A = (bf16*)(ws + WS_W13A); bf16* W2A = (bf16*)(ws + WS_W2A); bf16* WIN = (bf16*)(ws + WS_WIN); bf16* WCAT = (bf16*)(ws + WS_WCAT); bf16* WOUT = (bf16*)(ws + WS_WOUT);
    bf16* W13B = (bf16*)(ws + WS_W13B); bf16* W2B = (bf16*)(ws + WS_W2B);
    bf16* AB = (bf16*)(ws + WS_AB); bf16* H1B = (bf16*)(ws + WS_H1); bf16* H2B = (bf16*)(ws + WS_H1 + 32 * MiB); bf16* HID = (bf16*)(ws + WS_HID);
    bf16* Zb = (bf16*)(ws + WS_Z); bf16* UXb = (bf16*)(ws + WS_UX); bf16* ZCb = (bf16*)(ws + WS_ZC); bf16* Yb = (bf16*)(ws + WS_Y); bf16* MCb = (bf16*)(ws + WS_MC);
    float* SS0 = (float*)(ws + WS_SS0); float* SS1 = SS0 + M; float* SS2 = SS1 + M; float* SS3 = SS2 + M;
    float* HIDM = (float*)(ws + WS_HIDM); float* H1M = (float*)(ws + WS_H1M);
    bf16* Gb = (bf16*)F.out;
    const int bx = (int)blockIdx.x;
    const int gw = F.vcu * NWAVES + F.wave, NGW = F.G * NWAVES;
    const int lb = bx - F.G / 2;
    const int lgw = lb * NWAVES + F.wave, NLGW = (F.G - F.G / 2) * NWAVES;

    if (IN(0)) {
        LAS float* scr = (LAS float*)(F.lds + RING_OFF + F.wave * 16384);
        for (int it = gw; it < T_W13A; it += NGW) weight_item(args, ws, scr, it, F.lane);
        for (int m = gw; m < M; m += NGW) { const GAS f32x4* xr = (const GAS f32x4*)(args.in[I_X] + (size_t)m * D) + F.lane; f32x4 v[4]; float s = 0.f;
#pragma unroll
            for (int j = 0; j < 4; ++j) { v[j] = xr[64 * j]; s += (v[j].x * v[j].x + v[j].y * v[j].y) + (v[j].z * v[j].z + v[j].w * v[j].w); }
            s = wave_sum(s);
            GAS v2u* o8 = (GAS v2u*)(AB + (size_t)m * D) + F.lane;
#pragma unroll
            for (int j = 0; j < 4; ++j) o8[64 * j] = (v2u){pk2(v[j].x, v[j].y), pk2(v[j].z, v[j].w)};
            if (F.lane == 0) { SS0[m] = s; SS1[m] = 0.f; SS2[m] = 0.f; SS3[m] = 0.f; } }
    }
    SEAM(0);
    if (IN(1)) {
        pg8::Gemm g{D, D, D}; pg8::GridOrder S{M / 256, 2 * DFF / 256, F.G, bx, (const char*)AB, (const char*)W13A, (size_t)256 * D * 2, (size_t)256 * D * 2, W_UP};
        EpiSwiglu E{HID, SS0};
        pg8::gemm_phase(F.lds + RING_OFF, F.wave, g, S, E);
        F.lane = lane_id_opaque(); F.tid = F.wave * 64 + F.lane;
        for (;;) { const int t = wg_ticket(F, 0);
            if (t < NG) { ssm_prep_job(F, args, t); continue; }
            if (t < NG + DFF / 16) { float* hm = HIDM; const int c0 = 16 * (t - NG); const bf16* b0 = W13A + (size_t)glu_row(c0) * D;
                meta_job<2, true>(F, args.in[I_META], D, b0, b0 + (size_t)128 * D, [=](int r, int jj, float a, float b) { hm[r * DFF + c0 + jj] = fsilu(a) * b; }); continue; }
            const int tj = t - (NG + DFF / 16); if (tj >= (T_WIN - T_W13A) / 16) break;
            LAS float* scr = (LAS float*)(F.lds + RING_OFF + F.wave * 16384);
            weight_item(args, ws, scr, T_W13A + 16 * tj + F.wave, F.lane); weight_item(args, ws, scr, T_W13A + 16 * tj + 8 + F.wave, F.lane);
        }
    }
    SEAM(1);
    if (IN(2)) {
        pg8::Gemm g{DFF, DFF, DFF}; pg8::GridOrder S{M / 256, D / 256, F.G, bx, (const char*)HID, (const char*)W2A, (size_t)256 * DFF * 2, (size_t)256 * DFF * 2, W_DN};
        EpiResid<true> E{AB, H1B, SS1, 0.5f};
        pg8::gemm_phase(F.lds + RING_OFF, F.wave, g, S, E);
    }
    SEAM(2);
    if (IN(3)) {
        pg8::Gemm g{D, D, D}; pg8::GridOrder S{M / 256, DIN / 256, F.G, bx, (const char*)H1B, (const char*)WIN, (size_t)256 * D * 2, (size_t)256 * D * 2, W_IN};
        EpiMix E{SS1, Zb, UXb, Gb, args.in[I_BGATE]};
        pg8::gemm_phase(F.lds + RING_OFF, F.wave, g, S, E);
        F.lane = lane_id_opaque(); F.tid = F.wave * 64 + F.lane;
        for (;;) { int j = wg_ticket(F, 1);
            if (j < 64) { float* hm = H1M; const float* mt = args.in[I_META]; const int c0 = 16 * j;
                meta_job<1, false>(F, HIDM, DFF, W2A + (size_t)c0 * DFF, nullptr, [=](int r, int jj, float a, float) { __hip_atomic_store(hm + r * D + c0 + jj, mt[r * D + c0 + jj] + 0.5f * a, __ATOMIC_RELAXED, __HIP_MEMORY_SCOPE_AGENT); });
                if (F.tid == 0) __hip_atomic_fetch_add((unsigned*)(F.ctl + CW_MBD), 1u, __ATOMIC_RELAXED, __HIP_MEMORY_SCOPE_AGENT);
                continue; }
            j -= 64;
            if (j < 64) wait_mbd(F);
            if (j < 32) { bf16* zz = Zb; const int c0 = 16 * j; const bf16* b0 = WIN + (size_t)glu_row(c0) * D;
                meta_job<2, true>(F, H1M, D, b0, b0 + (size_t)128 * D, [=](int r, int jj, float a, float b) { zz[(size_t)(M + r) * DCONV + c0 + jj] = (bf16)f2bf(a * fsigmoid(b)); }); continue; }
            if (j < 64) { bf16* ux = UXb; const int gg = j - 32;
                meta_job<1, true>(F, H1M, D, WIN + (size_t)(1024 + 16 * gg) * D, nullptr, [=](int r, int jj, float a, float) { ux[(size_t)(gg * (NCH + 1) + NCH) * UXK + r * 16 + jj] = (bf16)f2bf(a); }); continue; }
            const int tj = j - 64; if (tj >= (T_W2B - T_WIN) / 16) break;
            LAS float* scr = (LAS float*)(F.lds + RING_OFF + F.wave * 16384);
            weight_item(args, ws, scr, T_WIN + 16 * tj + F.wave, F.lane); weight_item(args, ws, scr, T_WIN + 16 * tj + 8 + F.wave, F.lane);
        }
    }
    SEAM(3);
    if (IN(4)) {
        if (bx < BATCH * NG) {
            ssm_pre_job(F, bx / NG, bx % NG);
            pg8::Gemm g{UXK, UXK, UXK}; SsmOrder S{1 << 20, bx, (const char*)UXb, (const char*)(ws + WS_BS2)};
            EpiSsmY E{UXb, args.in[I_SD], Yb};
            pg8::gemm_phase(F.lds + RING_OFF, F.wave, g, S, E);
        }
        else conv_worker(F, args, bx - BATCH * NG);
    }
    SEAM(4);
    if (IN(6)) {
        pg8::Gemm g{512, 512, 512}; MergeOrder S{F.G, bx, (const char*)ZCb, (const char*)Yb, (const char*)WCAT};
        EpiMerge E{Gb, MCb, AB};
        pg8::gemm_phase(F.lds + RING_OFF, F.wave, g, S, E);
    }
    SEAM(6);
    if (IN(7)) {
        pg8::Gemm g{D, D, D}; pg8::GridOrder S{M / 256, D / 256, F.G, bx, (const char*)AB, (const char*)WOUT, (size_t)256 * D * 2, (size_t)256 * D * 2, W_OUT};
        EpiResid<true> E{H1B, H2B, SS2, 1.0f};
        pg8::gemm_phase(F.lds + RING_OFF, F.wave, g, S, E);
    }
    SEAM(7);
    if (IN(8)) {
        pg8::Gemm g{D, D, D}; pg8::GridOrder S{M / 256, 2 * DFF / 256, F.G, bx, (const char*)H2B, (const char*)W13B, (size_t)256 * D * 2, (size_t)256 * D * 2, W_UP};
        EpiSwiglu E{HID, SS2};
        pg8::gemm_phase(F.lds + RING_OFF, F.wave, g, S, E);
    }
    SEAM(8);
    if (IN(9)) {
        pg8::Gemm g{DFF, DFF, DFF}; pg8::GridOrder S{M / 256, D / 256, F.G, bx, (const char*)HID, (const char*)W2B, (size_t)256 * DFF * 2, (size_t)256 * DFF * 2, W_DN};
        EpiFinal E{H2B, F.out, SS3, (unsigned*)(F.ctl + CW_FIN), args.in[I_FINN], 0.5f};
        pg8::gemm_phase(F.lds + RING_OFF, F.wave, g, S, E);
    }
#undef IN
#undef SEAM
}

extern "C" void kernel_launch(void* const* d_in, const int* in_sizes, int n_in, void* d_out, int out_size, void* d_ws, size_t ws_size, hipStream_t stream) {
    static int grid = 0;
    if (grid == 0) {
        if (n_in != 30 || in_sizes[0] != M * D || out_size != M * D || ws_size < WS_END) { fprintf(stderr, "kernel_launch: unexpected problem shape (n_in %d, in0 %d, out %d, ws %zu); nothing launched\n", n_in, n_in > 0 ? in_sizes[0] : -1, out_size, ws_size); grid = -1; return; }
        int dev = 0, cus = 0, per_cu = 0;
        if (hipGetDevice(&dev) != hipSuccess || hipDeviceGetAttribute(&cus, hipDeviceAttributeMultiprocessorCount, dev) != hipSuccess) { grid = -1; return; }
        if (hipFuncSetAttribute((const void*)hyb_fwd, hipFuncAttributeMaxDynamicSharedMemorySize, LDS_BYTES) != hipSuccess) { fprintf(stderr, "kernel_launch: hipFuncSetAttribute failed\n"); grid = -1; return; }
        if (hipOccupancyMaxActiveBlocksPerMultiprocessor(&per_cu, (const void*)hyb_fwd, NWAVES * 64, LDS_BYTES) != hipSuccess || per_cu < 1)
            fprintf(stderr, "kernel_launch: note: occupancy query reports %d workgroups per CU\n", per_cu);
        (void)hipGetLastError();
        grid = cus > 256 ? 256 : cus;
        if (grid != 256) fprintf(stderr, "kernel_launch: %d CUs reported; this kernel's phase program needs a 256-workgroup grid\n", cus);
    }
    if (grid < 0) return;
    if (hipMemsetAsync((char*)d_ws + WS_CTL, 0, CTL_ZERO_BYTES, stream) != hipSuccess) { fprintf(stderr, "kernel_launch: hipMemsetAsync failed\n"); return; }
    Args a{};
    for (int i = 0; i < 30; ++i) a.in[i] = (const float*)d_in[i];
    a.out = (float*)d_out; a.ws = (unsigned char*)d_ws;
    for (int li = 0; li < N_LAUNCHES; ++li) {
        a.ph_lo = (N_LAUNCHES == PER_PHASE) ? li : 0; a.ph_hi = (N_LAUNCHES == PER_PHASE) ? li + 1 : PER_PHASE; a.li = li;
        hipLaunchKernelGGL(hyb_fwd, dim3(grid), dim3(NWAVES * 64), LDS_BYTES, stream, a);
        const hipError_t le = hipPeekAtLastError();
        if (le != hipSuccess) { fprintf(stderr, "kernel_launch: launch %d failed: %s\n", li, hipGetErrorName(le)); break; }
    }
}
```

```cpp
#include <hip/hip_runtime.h>
#include <cstdio>
#include <cstdint>

#ifndef MK_N_LAUNCHES
#define MK_N_LAUNCHES 1
#endif

__device__ __forceinline__ int lane_id_opaque() { int l; asm volatile("v_mbcnt_lo_u32_b32 %0, -1, 0\n\tv_mbcnt_hi_u32_b32 %0, -1, %0" : "=v"(l)); return l; }
namespace pg8 {
#define PG8_LAS __attribute__((address_space(3)))
typedef unsigned short bf16_t;
typedef short bf16x8 __attribute__((ext_vector_type(8)));
typedef float f32x4 __attribute__((ext_vector_type(4)));
typedef unsigned u32x4 __attribute__((ext_vector_type(4)));
constexpr int BM = 256, BK = 64, HALF = 128, HTB = HALF * BK * 2, STAGE_BYTES = 8 * HTB, NXCD = 8;

__host__ __device__ __forceinline__ int lds_byte(int r, int c) { const int st = (r >> 4) * 2 + (c >> 5), rr = r & 15, cc = c & 31, ob = rr * 64 + cc * 2; return st * 1024 + (ob ^ (((ob >> 9) & 1) << 5)); }
__host__ __device__ __forceinline__ void stage_rc(int b, int& R, int& C) { const int st = b / 1024, sb = b % 1024, swz = sb ^ (((sb >> 9) & 1) << 5); R = (st >> 1) * 16 + swz / 64; C = (st & 1) * 32 + (swz % 64) / 2; }
__host__ __device__ __forceinline__ int perm32(int rho) { const int n = rho >> 4, i = rho & 15; return 8 * (i >> 2) + 4 * n + (i & 3); }

struct Unit { int pm, pn, kind; const char* A; const char* B; };
struct Gemm { int lda, ldb, K; };

__device__ __forceinline__ bool static_tile(int i, int G, int c, int nM, int nN, int WGM  , int& pm, int& pn) {
    const int nwg = nM * nN; const long L = (long)i * G + c; if (L >= nwg) return false;
    int wgid = (int)L; { const int q = nwg / NXCD, r = nwg % NXCD, xcd = wgid % NXCD, off = wgid / NXCD; wgid = (xcd < r ? xcd * (q + 1) : r * (q + 1) + (xcd - r) * q) + off; }
    const int nig = WGM * nN, gid = wgid / nig, fm = gid * WGM, gsz = (nM - fm) < WGM ? (nM - fm) : WGM;
    pm = fm + ((wgid % nig) % gsz); pn = (wgid % nig) / gsz; return true;
}
struct GridOrder {
    int nM, nN, G, c; const char* A; const char* B; size_t tA, tB; int wgm;
    __device__ __forceinline__ bool next(int i, Unit& u) const { int pm, pn; if (!static_tile(i, G, c, nM, nN, wgm, pm, pn)) return false; u.pm = pm; u.pn = pn; u.kind = 0; u.A = A + (size_t)pm * tA; u.B = B + (size_t)pn * tB; return true; }
    __device__ __forceinline__ void a_ready(const Unit&) const {}
    __device__ __forceinline__ void done(const Unit&) const {}
};

__device__ __forceinline__ unsigned cvt_pk_bf16(float lo, float hi) { unsigned r; asm volatile("v_cvt_pk_bf16_f32 %0, %1, %2" : "=v"(r) : "v"(lo), "v"(hi)); return r; }

template <class Epi, class Sched>
__device__ __forceinline__ void gemm_phase(PG8_LAS unsigned char* lds, const int wid  , const Gemm g, const Sched& S, const Epi& E) {
    const int lane = lane_id_opaque(), tid = wid * 64 + lane, wr = wid >> 2, wc = wid & 3, fr = lane & 15, fq = lane >> 4;
    const int K = g.K, nt = K / BK;
    unsigned voffA[2], voffB[2];
#pragma unroll
    for (int i = 0; i < 2; ++i) { int R, C; stage_rc(tid * 16 + i * 8192, R, C); const int Rb = (R & ~31) + perm32(R & 31);
        voffA[i] = (unsigned)(R * g.lda + C) * 2u; voffB[i] = (unsigned)(Rb * g.ldb + C) * 2u; }
    const size_t kstep = (size_t)(BK * 2);
    const size_t hstepA = (size_t)HALF * g.lda * 2, hstepB = (size_t)HALF * g.ldb * 2;
    const unsigned ldsw = (unsigned)wid * 1024u;
    const int aoff = lds_byte(wr * 64 + fr, fq * 8), boff = lds_byte(wc * 32 + fr, fq * 8);
#define PG8_SA(b, h) (((b) * 2 + (h)) * HTB)
#define PG8_SB(b, h) ((4 + (b) * 2 + (h)) * HTB)
#define PG8_STAGE(bufoff, gbase, voff) do { _Pragma("unroll") for (int _i = 0; _i < 2; ++_i) \
        __builtin_amdgcn_global_load_lds((const unsigned*)((const char*)(gbase) + (voff)[_i]), (PG8_LAS unsigned*)(lds + (bufoff) + ldsw + _i * 8192), 16, 0, 0); } while (0)
#define PG8_LDA(dst, b, h) do { _Pragma("unroll") for (int m = 0; m < 4; ++m) _Pragma("unroll") for (int k = 0; k < 2; ++k) dst[m][k] = *(const PG8_LAS bf16x8*)(lds + PG8_SA(b, h) + aoff + m * 2048 + k * 1024); } while (0)
#define PG8_LDB(dst, b, h) do { _Pragma("unroll") for (int n = 0; n < 2; ++n) _Pragma("unroll") for (int k = 0; k < 2; ++k) dst[n][k] = *(const PG8_LAS bf16x8*)(lds + PG8_SB(b, h) + boff + n * 2048 + k * 1024); } while (0)
#define PG8_MMA(ai, bj, At, Bt) do { __builtin_amdgcn_s_setprio(1); _Pragma("unroll") for (int m = 0; m < 4; ++m) _Pragma("unroll") for (int n = 0; n < 2; ++n) _Pragma("unroll") for (int k = 0; k < 2; ++k) \
        acc[ai][bj][m][n] = __builtin_amdgcn_mfma_f32_16x16x32_bf16(Bt[n][k], At[m][k], acc[ai][bj][m][n], 0, 0, 0); __builtin_amdgcn_s_setprio(0); } while (0)
#define PG8_WAIT_V(n) asm volatile("s_waitcnt vmcnt(" #n ")" ::: "memory")
#define PG8_WAIT_L(n) asm volatile("s_waitcnt lgkmcnt(" #n ")" ::: "memory")
#define PG8_BAR __builtin_amdgcn_s_barrier()
#define PG8_SCHED __builtin_amdgcn_sched_barrier(0)
    Unit cur, nxt; int ui = 0;
    if (!S.next(0, cur)) return;
    f32x4 acc[2][2][4][2];
#pragma unroll
    for (int a = 0; a < 2; ++a)
#pragma unroll
        for (int b = 0; b < 2; ++b)
#pragma unroll
            for (int m = 0; m < 4; ++m)
#pragma unroll
                for (int n = 0; n < 2; ++n) acc[a][b][m][n] = (f32x4){0.f, 0.f, 0.f, 0.f};
    bf16x8 At[4][2], B0[2][2], B1[2][2];
    const char* cA = cur.A; const char* cB = cur.B;
    S.a_ready(cur);
    PG8_STAGE(PG8_SB(0, 0), cB, voffB); PG8_STAGE(PG8_SB(0, 1), cB + hstepB, voffB); PG8_STAGE(PG8_SA(0, 0), cA, voffA); PG8_STAGE(PG8_SA(0, 1), cA + hstepA, voffA);
    if (wr == 1) PG8_BAR;
    PG8_WAIT_V(2); PG8_BAR;
    PG8_STAGE(PG8_SB(1, 0), cB + kstep, voffB); PG8_STAGE(PG8_SA(1, 0), cA + kstep, voffA); PG8_STAGE(PG8_SB(1, 1), cB + hstepB + kstep, voffB);
    PG8_WAIT_V(6); PG8_BAR;
    for (;;) {
        const bool has_next = S.next(ui + 1, nxt);
        const char* nA = has_next ? nxt.A : cA; const char* nB = has_next ? nxt.B : cB;
        for (int t = 0; t < nt; t += 2) {
            const bool last = (t == nt - 2);
            const char* a1 = cA + (size_t)(t + 1) * kstep;
            const char* a2 = last ? nA : cA + (size_t)(t + 2) * kstep; const char* b2 = last ? nB : cB + (size_t)(t + 2) * kstep;
            const char* a3 = a2 + kstep; const char* b3 = b2 + kstep;
            if (last && has_next) S.a_ready(nxt);
            PG8_LDB(B0, 0, 0); PG8_LDB(B1, 0, 1); PG8_SCHED; PG8_LDA(At, 0, 0); PG8_STAGE(PG8_SA(1, 1), a1 + hstepA, voffA);
            PG8_WAIT_V(8); PG8_WAIT_L(0); PG8_BAR; PG8_MMA(0, 0, At, B0); PG8_MMA(0, 1, At, B1); PG8_BAR; PG8_SCHED;
            PG8_LDA(At, 0, 1); PG8_STAGE(PG8_SB(0, 0), b2, voffB); PG8_STAGE(PG8_SB(0, 1), b2 + hstepB, voffB); PG8_STAGE(PG8_SA(0, 0), a2, voffA);
            PG8_WAIT_V(8); PG8_WAIT_L(0); PG8_BAR; PG8_MMA(1, 0, At, B0); PG8_MMA(1, 1, At, B1); PG8_BAR; PG8_SCHED;
            PG8_LDB(B0, 1, 0); PG8_LDB(B1, 1, 1); PG8_SCHED; PG8_LDA(At, 1, 0); PG8_STAGE(PG8_SA(0, 1), a2 + hstepA, voffA);
            PG8_WAIT_V(8); PG8_WAIT_L(0); PG8_BAR; PG8_MMA(0, 0, At, B0); PG8_MMA(0, 1, At, B1); PG8_BAR; PG8_SCHED;
            PG8_LDA(At, 1, 1); PG8_STAGE(PG8_SB(1, 0), b3, voffB); PG8_STAGE(PG8_SB(1, 1), b3 + hstepB, voffB); PG8_STAGE(PG8_SA(1, 0), a3, voffA);
            PG8_WAIT_V(8); PG8_WAIT_L(0); PG8_BAR; PG8_MMA(1, 0, At, B0); PG8_MMA(1, 1, At, B1); PG8_BAR; PG8_SCHED;
        }
        if (wr == 0) PG8_BAR;
        E(acc, cur, wr, wc); S.done(cur);
        if (!has_next) break;
#pragma unroll
        for (int a = 0; a < 2; ++a)
#pragma unroll
            for (int b = 0; b < 2; ++b)
#pragma unroll
                for (int m = 0; m < 4; ++m)
#pragma unroll
                    for (int n = 0; n < 2; ++n) acc[a][b][m][n] = (f32x4){0.f, 0.f, 0.f, 0.f};
        cur = nxt; cA = nA; cB = nB; ++ui;
        if (wr == 1) PG8_BAR;
    }
    PG8_WAIT_V(0);
    PG8_BAR;
#undef PG8_SA
#undef PG8_SB
#undef PG8_STAGE
#undef PG8_LDA
#undef PG8_LDB
#undef PG8_MMA
#undef PG8_WAIT_V
#undef PG8_WAIT_L
#undef PG8_BAR
#undef PG8_SCHED
}
}

constexpr int NWAVES = 8;
constexpr int D = 1024, BATCH = 4, SEQ = 4096, NMETA = 16, DFF = 2816, DCONV = 512, CWID = 31, DSSM = 512, HG = 16, NG = 32, PS = 64;
constexpr int DIN = 2 * DCONV + DSSM + 2 * D;
constexpr int M = BATCH * SEQ;
constexpr int NCH = M / 16;
constexpr int UXK = 384;
constexpr float EPS = 1e-6f;
constexpr int PER_PHASE = 10;
#ifndef W_UP
#define W_UP 4
#endif
#ifndef W_DN
#define W_DN 8
#endif
#ifndef W_IN
#define W_IN 4
#endif
#ifndef W_MG
#define W_MG 4
#endif
#ifndef W_OUT
#define W_OUT 4
#endif
constexpr int N_LAUNCHES = MK_N_LAUNCHES;

constexpr size_t MiB = 1u << 20;
constexpr size_t WS_CTL = 0, CTL_ZERO_BYTES = 1 * MiB;
constexpr size_t WS_BS2 = 1 * MiB;
constexpr size_t WS_WSI = 7 * MiB;
constexpr size_t WS_SMALL = 9 * MiB;
constexpr size_t WS_LAMC = WS_SMALL;
constexpr size_t WS_SMETA = WS_SMALL + 16384;
constexpr size_t WS_SS0 = WS_SMALL + 32768;
constexpr size_t WS_HIDM = WS_SMALL + 32768 + 4 * 65536;
constexpr size_t WS_H1M = WS_HIDM + 16 * DFF * 4;
constexpr size_t WS_W13A = 11 * MiB, WS_W2A = 22 * MiB, WS_WIN = 28 * MiB, WS_WCAT = 35 * MiB, WS_WOUT = 38 * MiB, WS_W13B = 40 * MiB, WS_W2B = 51 * MiB;
constexpr size_t WS_AB = 57 * MiB;
constexpr size_t WS_H1 = 89 * MiB;
constexpr size_t WS_HID = 153 * MiB;
constexpr size_t WS_Z = WS_HID;
constexpr size_t WS_UX = WS_HID + 17 * MiB;
constexpr size_t WS_ZC = WS_HID + 42 * MiB;
constexpr size_t WS_Y = WS_HID + 58 * MiB;
constexpr size_t WS_MC = WS_HID;
constexpr size_t WS_S = WS_HID + 74 * MiB;
constexpr size_t WS_END = 256 * MiB;
static_assert(WS_H1M + 16 * D * 4 <= WS_W13A, "small tables");
static_assert(WS_W2B + (size_t)D * DFF * 2 <= WS_AB && WS_AB + (size_t)M * D * 2 <= WS_H1 && WS_H1 + (size_t)M * D * 4 <= WS_HID, "ws map 1");
static_assert(WS_Z + (size_t)(M + 16) * DCONV * 2 <= WS_UX && WS_UX + (size_t)NG * (NCH + 1) * UXK * 2 <= WS_ZC && WS_ZC + (size_t)M * DCONV * 2 <= WS_Y && WS_Y + (size_t)M * DSSM * 2 <= WS_S, "ws map 2");
static_assert(WS_MC + (size_t)M * D * 2 <= WS_ZC, "MC overlay");
static_assert(WS_HID + (size_t)M * DFF * 2 <= WS_END && WS_S + (size_t)NCH * NG * 128 * 4 <= WS_END, "ws end");
static_assert(WS_W13A + (size_t)2 * DFF * D * 2 <= WS_W2A && WS_W2A + (size_t)D * DFF * 2 <= WS_WIN && WS_WIN + (size_t)DIN * D * 2 <= WS_WCAT && WS_WCAT + (size_t)3072 * 512 * 2 <= WS_WOUT && WS_WOUT + (size_t)D * D * 2 <= WS_W13B && WS_W13B + (size_t)2 * DFF * D * 2 <= WS_W2B, "weights");
static_assert(WS_BS2 + (size_t)NG * 256 * UXK * 2 <= WS_WSI && WS_WSI + (size_t)NG * 128 * 256 * 2 <= WS_SMALL, "ssm mats");
constexpr int CW_BAR = 4096;
constexpr int CW_FIN = 16384;

constexpr int RING_OFF = 0, RING_BYTES = 131072;
constexpr int LDSCTL_OFF = RING_BYTES, MISC_OFF = LDSCTL_OFF + 320;
constexpr int LDS_BYTES = 147456;

#define GAS __attribute__((address_space(1)))
#define LAS __attribute__((address_space(3)))
typedef unsigned short bf16;
typedef unsigned v4u __attribute__((ext_vector_type(4)));
typedef unsigned v2u __attribute__((ext_vector_type(2)));
typedef float f32x4 __attribute__((ext_vector_type(4)));
typedef float f32x2 __attribute__((ext_vector_type(2)));
typedef short bf16x8 __attribute__((ext_vector_type(8)));
typedef GAS unsigned gu32;
#define RLX_AGENT __ATOMIC_RELAXED, __HIP_MEMORY_SCOPE_AGENT
#define LDS_WAIT() asm volatile("s_waitcnt lgkmcnt(0)" ::: "memory")
#define VM_WAIT() asm volatile("s_waitcnt vmcnt(0)" ::: "memory")
__device__ __forceinline__ unsigned f2bf(float f) { unsigned u = __builtin_bit_cast(unsigned, f); return (u + 0x7fffu + ((u >> 16) & 1u)) >> 16; }
__device__ __forceinline__ unsigned pk2(float lo, float hi) { return f2bf(lo) | (f2bf(hi) << 16); }
__device__ __forceinline__ float bf2f(unsigned h) { return __builtin_bit_cast(float, h << 16); }
__device__ __forceinline__ float fsigmoid(float x) { return __builtin_amdgcn_rcpf(1.f + __builtin_amdgcn_exp2f(-1.44269504089f * x)); }
__device__ __forceinline__ float fsilu(float x) { return x * fsigmoid(x); }
__device__ __forceinline__ float fgelu_tanh(float x) { return x * fsigmoid(1.5957691216f * (x + 0.044715f * x * x * x)); }
__device__ __forceinline__ float wave_sum(float v) {
#pragma unroll
    for (int o = 1; o < 64; o <<= 1) v += __shfl_xor(v, o);
    return v;
}

#define XB_TMO      128
#define XB_XCNT(j)  (256  + 64 * (j))
#define XB_XSUB(j)  (1280 + 64 * (j))
#define XB_XGEN(j)  (2304 + 64 * (j))
#define XB_TOP      3328
#define XB_TOPGEN   3392
#define XCD_BAR_WORDS 3456
#define XB_SPIN_CAP (1u << 18)
__device__ __forceinline__ unsigned xb_ld(unsigned* p)              { return __hip_atomic_load(p, __ATOMIC_RELAXED, __HIP_MEMORY_SCOPE_AGENT); }
__device__ __forceinline__ unsigned xb_add(unsigned* p, unsigned v) { return __hip_atomic_fetch_add(p, v, __ATOMIC_RELAXED, __HIP_MEMORY_SCOPE_AGENT); }
__device__ __forceinline__ unsigned xb_xcc_id() { return (unsigned)__builtin_amdgcn_s_getreg((3 << 11) | 20) & 0xFu; }
#define XB_SPIN(cond, bar) do { unsigned _sp = 0; while (cond) { __builtin_amdgcn_s_sleep(1); \
    if ((++_sp & 255u) == 0u) { if (xb_ld(&(bar)[XB_TMO])) break; if (_sp > XB_SPIN_CAP) { atomicAdd(&(bar)[XB_TMO], 1u); break; } } } } while (0)
struct XcdBarrier { unsigned* bar; unsigned x; volatile LAS unsigned* st; };
__device__ __forceinline__ XcdBarrier xcd_barrier_post(unsigned* bar, volatile LAS unsigned* st) {
    XcdBarrier b; b.bar = bar; b.x = xb_xcc_id(); b.st = st;
    if (threadIdx.x == 0) (void)xb_add(&bar[XB_XCNT(b.x)], 1u);
    return b;
}
__device__ __forceinline__ void xcd_barrier_complete(unsigned* bar, unsigned x, unsigned& nloc, unsigned& nx) {
    const unsigned G = gridDim.x * gridDim.y * gridDim.z;
    unsigned sum, cnt, mine, sp = 0u;
    for (;;) {
        sum = 0u; cnt = 0u; mine = 0u;
#pragma unroll
        for (unsigned j = 0; j < 16; ++j) { const unsigned c = xb_ld(&bar[XB_XCNT(j)]); sum += c; cnt += (c > 0u) ? 1u : 0u; mine = (j == x) ? c : mine; }
        if (sum == G) break;
        __builtin_amdgcn_s_sleep(1);
        if ((++sp & 255u) == 0u) { if (xb_ld(&bar[XB_TMO])) break; if (sp > XB_SPIN_CAP) { atomicAdd(&bar[XB_TMO], 1u); break; } }
    }
    nloc = mine > 0u ? mine : 1u; nx = cnt > 0u ? cnt : 1u;
}
__device__ __forceinline__ void xcd_barrier(const XcdBarrier& b) {
    asm volatile("s_waitcnt vmcnt(0)" ::: "memory");
    __syncthreads();
    if (threadIdx.x == 0) {
        unsigned* bar = b.bar;
        __builtin_amdgcn_s_waitcnt(0);
        unsigned nloc = b.st[0], nx = b.st[1];
        if (nloc == 0u) { xcd_barrier_complete(bar, b.x, nloc, nx); b.st[0] = nloc; b.st[1] = nx; }
        const unsigned old = xb_add(&bar[XB_XSUB(b.x)], 1u);
        const unsigned gen = old / nloc;
        if (old + 1u == (gen + 1u) * nloc) {
            __builtin_amdgcn_fence(__ATOMIC_RELEASE, "agent");
            asm volatile("s_waitcnt vmcnt(0)" ::: "memory");
            const unsigned og = xb_add(&bar[XB_TOP], 1u);
            const unsigned tg = og / nx;
            const unsigned target = (tg + 1u) * nx;
            if (og + 1u != target) XB_SPIN((int)(xb_ld(&bar[XB_TOP]) - target) < 0, bar);
            __builtin_amdgcn_fence(__ATOMIC_ACQUIRE, "agent");
            asm volatile("s_waitcnt vmcnt(0)" ::: "memory");
            xb_add(&bar[XB_XGEN(b.x)], 1u);
            asm volatile("s_waitcnt vmcnt(0)" ::: "memory");
        } else {
            __builtin_amdgcn_fence(__ATOMIC_ACQUIRE, "agent");
            XB_SPIN(xb_ld(&bar[XB_XGEN(b.x)]) == gen, bar);
            asm volatile("s_waitcnt vmcnt(0)" ::: "memory");
        }
    }
    __syncthreads();
}

struct Args { const float* in[30]; float* out; unsigned char* ws; int ph_lo, ph_hi, li, pad; };
struct Frame {
    LAS unsigned char* lds; volatile LAS unsigned* MISC; gu32* ctl;
    int tid, lane, wave, vcu, G;
    float* out; unsigned char* ws;
};
enum { I_X = 0, I_META, I_F1N, I_F1W1, I_F1W3, I_F1W2, I_MIXN, I_WIN, I_BGATE, I_DW, I_DWB, I_LNG, I_LNB, I_CPROJ, I_LRE, I_LIM, I_LDT, I_BRE, I_BIM, I_CRE, I_CIM, I_SD, I_WV, I_WG, I_WOUT, I_F2N, I_F2W1, I_F2W3, I_F2W2, I_FINN };

constexpr int CW_TKT = 32768;
__device__ __forceinline__ int wg_ticket(Frame& F, int k) {
    __syncthreads();
    if (F.tid == 0) F.MISC[16] = __hip_atomic_fetch_add((unsigned*)(F.ctl + CW_TKT + 64 * k), 1u, __ATOMIC_RELAXED, __HIP_MEMORY_SCOPE_AGENT);
    __syncthreads();
    return (int)F.MISC[16];
}
constexpr int CW_MBD = 49152;
__device__ __forceinline__ void wait_mbd(Frame& F) {
    if (F.wave == 0) { unsigned* p = (unsigned*)(F.ctl + CW_MBD); unsigned sp = 0;
        while ((unsigned)__builtin_amdgcn_readfirstlane((int)__hip_atomic_load(p, __ATOMIC_RELAXED, __HIP_MEMORY_SCOPE_AGENT)) < 64u) { __builtin_amdgcn_s_sleep(2); if (++sp > (1u << 22)) break; }
        __builtin_amdgcn_fence(__ATOMIC_ACQUIRE, "agent"); asm volatile("s_waitcnt vmcnt(0)" ::: "memory"); }
    __syncthreads();
}
using pg8::Unit; using pg8::cvt_pk_bf16;
__device__ __forceinline__ v4u pack8(const f32x4 a, const f32x4 b) { v4u w; w.x = cvt_pk_bf16(a[0], a[1]); w.y = cvt_pk_bf16(a[2], a[3]); w.z = cvt_pk_bf16(b[0], b[1]); w.w = cvt_pk_bf16(b[2], b[3]); return w; }
__device__ __forceinline__ void unpack8(const v4u w, float (&o)[8]) { o[0] = bf2f(w.x & 0xffffu); o[1] = bf2f(w.x >> 16); o[2] = bf2f(w.y & 0xffffu); o[3] = bf2f(w.y >> 16); o[4] = bf2f(w.z & 0xffffu); o[5] = bf2f(w.z >> 16); o[6] = bf2f(w.w & 0xffffu); o[7] = bf2f(w.w >> 16); }
__device__ __forceinline__ float rs_from(float ss) { return __builtin_amdgcn_rsqf(ss * (1.0f / D) + EPS); }
__device__ __forceinline__ void load_rs8(const float* SS, int row0, float (&rs)[8]) {
#pragma unroll
    for (int i = 0; i < 8; ++i) rs[i] = SS[row0 + (i >> 2) * 128 + (i & 3) * 16];
#pragma unroll
    for (int i = 0; i < 8; ++i) rs[i] = rs_from(rs[i]);
}

struct EpiSwiglu {
    bf16* HID; const float* SS;
    __device__ __forceinline__ void operator()(const f32x4 (&acc)[2][2][4][2], const Unit& u, int wr, int wc) const {
        const int lane_ = lane_id_opaque(), fr = lane_ & 15, fq = lane_ >> 4;
        const int row0 = u.pm * 256 + wr * 64 + fr, col0 = u.pn * 128 + wc * 32 + 8 * fq;
        float rsv[8]; load_rs8(SS, row0, rsv);
#pragma unroll
        for (int ai = 0; ai < 2; ++ai)
#pragma unroll
            for (int m = 0; m < 4; ++m) { const int row = row0 + ai * 128 + m * 16; const float rs = rsv[ai * 4 + m];
                f32x4 o0, o1;
#pragma unroll
                for (int j = 0; j < 4; ++j) { o0[j] = fsilu(acc[ai][0][m][0][j] * rs) * (acc[ai][1][m][0][j] * rs); o1[j] = fsilu(acc[ai][0][m][1][j] * rs) * (acc[ai][1][m][1][j] * rs); }
                *(v4u*)(HID + (size_t)row * DFF + col0) = pack8(o0, o1); }
    }
};
template <bool RBF16> struct EpiResid {
    const void* R; bf16* OB; float* SS; float alpha;
    __device__ __forceinline__ void operator()(const f32x4 (&acc)[2][2][4][2], const Unit& u, int wr, int wc) const {
        const int lane_ = lane_id_opaque(), fr = lane_ & 15, fq = lane_ >> 4;
        const int row0 = u.pm * 256 + wr * 64 + fr, col0 = u.pn * 256 + wc * 32 + 8 * fq;
#pragma unroll
        for (int ai = 0; ai < 2; ++ai) {
            f32x4 r[4][2][2];
#pragma unroll
            for (int m = 0; m < 4; ++m)
#pragma unroll
                for (int bj = 0; bj < 2; ++bj) { const size_t off = (size_t)(row0 + ai * 128 + m * 16) * D + col0 + bj * 128;
                    if (RBF16) { const v4u w = *(const v4u*)((const bf16*)R + off); r[m][bj][0] = __builtin_bit_cast(f32x4, w); }
                    else { r[m][bj][0] = *(const f32x4*)((const float*)R + off); r[m][bj][1] = *(const f32x4*)((const float*)R + off + 4); } }
#pragma unroll
            for (int m = 0; m < 4; ++m) { const int row = row0 + ai * 128 + m * 16; float ss = 0.f;
#pragma unroll
                for (int bj = 0; bj < 2; ++bj) { const size_t off = (size_t)row * D + col0 + bj * 128; f32x4 r0, r1;
                    if (RBF16) { float t[8]; unpack8(__builtin_bit_cast(v4u, r[m][bj][0]), t); r0 = (f32x4){t[0], t[1], t[2], t[3]}; r1 = (f32x4){t[4], t[5], t[6], t[7]}; }
                    else { r0 = r[m][bj][0]; r1 = r[m][bj][1]; }
                    const f32x4 o0 = r0 + acc[ai][bj][m][0] * alpha, o1 = r1 + acc[ai][bj][m][1] * alpha;
                    *(v4u*)(OB + off) = pack8(o0, o1);
                    ss += (o0[0] * o0[0] + o0[1] * o0[1]) + (o0[2] * o0[2] + o0[3] * o0[3]) + (o1[0] * o1[0] + o1[1] * o1[1]) + (o1[2] * o1[2] + o1[3] * o1[3]); }
                ss += __shfl_xor(ss, 16); ss += __shfl_xor(ss, 32);
                if (fq == 0) atomicAdd(SS + row, ss); }
            asm volatile("" ::: "memory"); }
    }
};
struct EpiFinal {
    const bf16* R; float* OUT; float* SS; unsigned* cnt; const float* gain; float alpha;
    __device__ __forceinline__ void operator()(f32x4 (&acc)[2][2][4][2], const Unit& u, int wr, int wc) const {
        const int lane_ = lane_id_opaque(), fr = lane_ & 15, fq = lane_ >> 4;
        const int row0 = u.pm * 256 + wr * 64 + fr, col0 = u.pn * 256 + wc * 32 + 8 * fq;
#pragma unroll
        for (int ai = 0; ai < 2; ++ai) {
            v4u r[4][2];
#pragma unroll
            for (int m = 0; m < 4; ++m)
#pragma unroll
                for (int bj = 0; bj < 2; ++bj) r[m][bj] = *(const v4u*)(R + (size_t)(row0 + ai * 128 + m * 16) * D + col0 + bj * 128);
#pragma unroll
            for (int m = 0; m < 4; ++m) { const int row = row0 + ai * 128 + m * 16; float ss = 0.f;
#pragma unroll
                for (int bj = 0; bj < 2; ++bj) { float t[8]; unpack8(r[m][bj], t);
                    const f32x4 o0 = (f32x4){t[0], t[1], t[2], t[3]} + acc[ai][bj][m][0] * alpha, o1 = (f32x4){t[4], t[5], t[6], t[7]} + acc[ai][bj][m][1] * alpha;
                    acc[ai][bj][m][0] = o0; acc[ai][bj][m][1] = o1;
                    ss += (o0[0] * o0[0] + o0[1] * o0[1]) + (o0[2] * o0[2] + o0[3] * o0[3]) + (o1[0] * o1[0] + o1[1] * o1[1]) + (o1[2] * o1[2] + o1[3] * o1[3]); }
                ss += __shfl_xor(ss, 16); ss += __shfl_xor(ss, 32);
                if (fq == 0) atomicAdd(SS + row, ss); }
            asm volatile("" ::: "memory"); }
        asm volatile("s_waitcnt vmcnt(0)" ::: "memory");
        unsigned* cw = cnt + 64 * u.pm;
        if (lane_ == 0) __hip_atomic_fetch_add(cw, 1u, __ATOMIC_RELAXED, __HIP_MEMORY_SCOPE_AGENT);
        f32x4 g[2][2];
#pragma unroll
        for (int bj = 0; bj < 2; ++bj) { g[bj][0] = *(const f32x4*)(gain + col0 + bj * 128); g[bj][1] = *(const f32x4*)(gain + col0 + bj * 128 + 4); }
        { unsigned sp = 0; while ((unsigned)__builtin_amdgcn_readfirstlane((int)__hip_atomic_load(cw, __ATOMIC_RELAXED, __HIP_MEMORY_SCOPE_AGENT)) < 32u) { __builtin_amdgcn_s_sleep(2); if (++sp > (1u << 20)) break; } }
        float tot[8];
#pragma unroll
        for (int i = 0; i < 8; ++i) { tot[i] = 0.f; if (fq == 0) tot[i] = __hip_atomic_fetch_add(SS + row0 + (i >> 2) * 128 + (i & 3) * 16, 0.0f, __ATOMIC_RELAXED, __HIP_MEMORY_SCOPE_AGENT); }
#pragma unroll
        for (int ai = 0; ai < 2; ++ai)
#pragma unroll
            for (int m = 0; m < 4; ++m) { const int row = row0 + ai * 128 + m * 16;
                const float rs = rs_from(__shfl(tot[ai * 4 + m], fr));
#pragma unroll
                for (int bj = 0; bj < 2; ++bj) { const size_t off = (size_t)row * D + col0 + bj * 128;
                    *(f32x4*)(OUT + off) = acc[ai][bj][m][0] * rs * g[bj][0]; *(f32x4*)(OUT + off + 4) = acc[ai][bj][m][1] * rs * g[bj][1]; } }
    }
};
struct EpiMix {
    const float* SS; bf16* Z; bf16* UX; bf16* G; const float* bgate;
    __device__ __forceinline__ void operator()(const f32x4 (&acc)[2][2][4][2], const Unit& u, int wr, int wc) const {
        const int lane_ = lane_id_opaque(), fr = lane_ & 15, fq = lane_ >> 4;
        const int row0 = u.pm * 256 + wr * 64 + fr;
        if (u.pn < 4) {
            const int col0 = u.pn * 128 + wc * 32 + 8 * fq;
#pragma unroll
            for (int ai = 0; ai < 2; ++ai)
#pragma unroll
                for (int m = 0; m < 4; ++m) { const int row = row0 + ai * 128 + m * 16; const float rs = rs_from(SS[row]); f32x4 o0, o1;
#pragma unroll
                    for (int j = 0; j < 4; ++j) { o0[j] = (acc[ai][0][m][0][j] * rs) * fsigmoid(acc[ai][1][m][0][j] * rs); o1[j] = (acc[ai][0][m][1][j] * rs) * fsigmoid(acc[ai][1][m][1][j] * rs); }
                    *(v4u*)(Z + (size_t)row * DCONV + col0) = pack8(o0, o1); }
        } else if (u.pn < 6) {
#pragma unroll
            for (int ai = 0; ai < 2; ++ai)
#pragma unroll
                for (int m = 0; m < 4; ++m) { const int row = row0 + ai * 128 + m * 16; const float rs = rs_from(SS[row]); const int ci = row >> 4, tt = row & 15;
#pragma unroll
                    for (int bj = 0; bj < 2; ++bj) { const int c = (u.pn - 4) * 256 + bj * 128 + wc * 32 + 8 * fq, g = c >> 4, h0 = c & 15;
                        *(v4u*)(UX + ((size_t)(g * (NCH + 1) + ci) * UXK + tt * 16 + h0)) = pack8(acc[ai][bj][m][0] * rs, acc[ai][bj][m][1] * rs); } }
        } else {
#pragma unroll
            for (int bj = 0; bj < 2; ++bj) { const int c = (u.pn - 6) * 256 + bj * 128 + wc * 32 + 8 * fq;
                const f32x4 b0 = *(const f32x4*)(bgate + c), b1 = *(const f32x4*)(bgate + c + 4);
#pragma unroll
                for (int ai = 0; ai < 2; ++ai)
#pragma unroll
                    for (int m = 0; m < 4; ++m) { const int row = row0 + ai * 128 + m * 16; const float rs = rs_from(SS[row]); f32x4 o0, o1;
#pragma unroll
                        for (int j = 0; j < 4; ++j) { o0[j] = fsigmoid(acc[ai][bj][m][0][j] * rs + b0[j]); o1[j] = fsigmoid(acc[ai][bj][m][1][j] * rs + b1[j]); }
                        *(v4u*)(G + (size_t)row * 2048 + c) = pack8(o0, o1); } }
        }
    }
};
struct EpiSsmY {
    const bf16* UX; const float* dskip; bf16* Y;
    __device__ __forceinline__ void operator()(const f32x4 (&acc)[2][2][4][2], const Unit& u, int wr, int wc) const {
        const int lane_ = lane_id_opaque(), fr = lane_ & 15, fq = lane_ >> 4;
        const int b = u.pm, g = u.pn, h0 = 8 * (fq & 1);
        const f32x4 d0 = *(const f32x4*)(dskip + g * 16 + h0), d1 = *(const f32x4*)(dskip + g * 16 + h0 + 4);
#pragma unroll
        for (int ai = 0; ai < 2; ++ai) {
            v4u uw[4][2];
#pragma unroll
            for (int m = 0; m < 4; ++m)
#pragma unroll
                for (int bj = 0; bj < 2; ++bj) { const int r = ai * 128 + wr * 64 + m * 16 + fr, tt = 8 * bj + 2 * wc + (fq >> 1);
                    uw[m][bj] = *(const v4u*)(UX + ((size_t)(g * (NCH + 1) + b * 256 + r) * UXK + tt * 16 + h0)); }
#pragma unroll
            for (int m = 0; m < 4; ++m) { const int r = ai * 128 + wr * 64 + m * 16 + fr;
#pragma unroll
                for (int bj = 0; bj < 2; ++bj) { const int tt = 8 * bj + 2 * wc + (fq >> 1);
                    float uu[8]; unpack8(uw[m][bj], uu);
                    f32x4 o0, o1;
#pragma unroll
                    for (int j = 0; j < 4; ++j) { o0[j] = fgelu_tanh(acc[ai][bj][m][0][j] + d0[j] * uu[j]); o1[j] = fgelu_tanh(acc[ai][bj][m][1][j] + d1[j] * uu[4 + j]); }
                    *(v4u*)(Y + ((size_t)(b * SEQ + r * 16 + tt) * DSSM + g * 16 + h0)) = pack8(o0, o1); } }
            asm volatile("" ::: "memory"); }
    }
};
struct EpiMerge {
    const bf16* G; bf16* MC; bf16* MG;
    __device__ __forceinline__ void operator()(const f32x4 (&acc)[2][2][4][2], const Unit& u, int wr, int wc) const {
        const int lane_ = lane_id_opaque(), fr = lane_ & 15, fq = lane_ >> 4;
        const int row0 = u.pm * 256 + wr * 64 + fr;
        if (u.kind == 0) {
#pragma unroll
            for (int ai = 0; ai < 2; ++ai) {
                v4u gw[4][2];
#pragma unroll
                for (int m = 0; m < 4; ++m)
#pragma unroll
                    for (int bj = 0; bj < 2; ++bj) gw[m][bj] = *(const v4u*)(G + (size_t)(row0 + ai * 128 + m * 16) * 2048 + u.pn * 256 + bj * 128 + wc * 32 + 8 * fq);
#pragma unroll
                for (int m = 0; m < 4; ++m) { const int row = row0 + ai * 128 + m * 16;
#pragma unroll
                    for (int bj = 0; bj < 2; ++bj) { const int c = u.pn * 256 + bj * 128 + wc * 32 + 8 * fq;
                        float gg[8]; unpack8(gw[m][bj], gg); f32x4 o0, o1;
#pragma unroll
                        for (int j = 0; j < 4; ++j) { o0[j] = gg[j] * acc[ai][bj][m][0][j]; o1[j] = gg[4 + j] * acc[ai][bj][m][1][j]; }
                        *(v4u*)(MC + (size_t)row * D + c) = pack8(o0, o1); } }
                asm volatile("" ::: "memory"); }
        } else {
            const int c = u.pn * 256 + (u.kind - 1) * 128 + wc * 32 + 8 * fq;
#pragma unroll
            for (int ai = 0; ai < 2; ++ai) {
                v4u gw[4], mw[4];
#pragma unroll
                for (int m = 0; m < 4; ++m) { const int row = row0 + ai * 128 + m * 16; gw[m] = *(const v4u*)(G + (size_t)row * 2048 + D + c); mw[m] = *(const v4u*)(MC + (size_t)row * D + c); }
#pragma unroll
                for (int m = 0; m < 4; ++m) { const int row = row0 + ai * 128 + m * 16;
                    float gg[8], mc[8]; unpack8(gw[m], gg); unpack8(mw[m], mc); f32x4 o0, o1;
#pragma unroll
                    for (int j = 0; j < 4; ++j) { o0[j] = mc[j] + gg[j] * (acc[ai][0][m][0][j] * fsigmoid(acc[ai][1][m][0][j])); o1[j] = mc[4 + j] + gg[4 + j] * (acc[ai][0][m][1][j] * fsigmoid(acc[ai][1][m][1][j])); }
                    *(v4u*)(MG + (size_t)row * D + c) = pack8(o0, o1); }
                asm volatile("" ::: "memory"); }
        }
    }
};
struct SsmOrder {
    int G, c; const char* UX; const char* BS2;
    __device__ __forceinline__ bool next(int i, Unit& u) const { const int L = i * G + c; if (L >= BATCH * NG) return false; const int b = L / NG, g = L % NG; u.pm = b; u.pn = g; u.kind = 0;
        u.A = UX + ((size_t)(g * (NCH + 1) + b * 256) * UXK) * 2; u.B = BS2 + (size_t)g * 256 * UXK * 2; return true; }
    __device__ __forceinline__ void a_ready(const Unit&) const {}
    __device__ __forceinline__ void done(const Unit&) const {}
};
struct MergeOrder {
    int G, c; const char* ZC; const char* Y; const char* WCAT;
    __device__ __forceinline__ bool next(int i, Unit& u) const { int pm, pn; const int su = i / 3, k = i - 3 * su; if (!pg8::static_tile(su, G, c, M / 256, D / 256, W_MG, pm, pn)) return false; u.pm = pm; u.pn = pn; u.kind = k;
        u.A = (k == 0 ? ZC : Y) + (size_t)pm * 256 * 512 * 2; u.B = WCAT + (size_t)(k == 0 ? pn * 256 : 1024 + (2 * pn + k - 1) * 256) * 512 * 2; return true; }
    __device__ __forceinline__ void a_ready(const Unit&) const {}
    __device__ __forceinline__ void done(const Unit& u) const { if (u.kind == 0) asm volatile("s_waitcnt vmcnt(0)" ::: "memory"); }
};

__device__ __forceinline__ void p0_transpose_item(const float* W, int K, int N, bf16* WT, const float* gain, LAS float* scr, int k0, int n0, int drow0, int lane) {
    float v[32];
    const float* src = W + (size_t)(k0 + (lane >> 5)) * N + n0 + (lane & 31);
#pragma unroll
    for (int i = 0; i < 32; ++i) v[i] = src[(size_t)(2 * i) * N];
#pragma unroll
    for (int i = 0; i < 32; ++i) scr[(2 * i + (lane >> 5)) * 33 + (lane & 31)] = v[i];
    LDS_WAIT(); asm volatile("" ::: "memory");
    const int c = lane & 7;
    f32x4 g0 = (f32x4){1.f, 1.f, 1.f, 1.f}, g1 = g0; if (gain) { g0 = *(const f32x4*)(gain + k0 + 8 * c); g1 = *(const f32x4*)(gain + k0 + 8 * c + 4); }
#pragma unroll
    for (int j = 0; j < 4; ++j) { const int n = (lane >> 3) + 8 * j; const LAS float* s = scr + (8 * c) * 33 + n;
        v4u o; o.x = pk2(s[0 * 33] * g0[0], s[1 * 33] * g0[1]); o.y = pk2(s[2 * 33] * g0[2], s[3 * 33] * g0[3]); o.z = pk2(s[4 * 33] * g1[0], s[5 * 33] * g1[1]); o.w = pk2(s[6 * 33] * g1[2], s[7 * 33] * g1[3]);
        *(GAS v4u*)(WT + (size_t)(drow0 + n) * K + k0 + 8 * c) = o; }
    LDS_WAIT(); asm volatile("" ::: "memory");
}
__device__ __forceinline__ int glu_row(int n) { return 256 * (n >> 7) + (n & 127); }

constexpr int I_UP = (D / 64) * (DFF / 32), I_DN = (DFF / 64) * (D / 32), I_INP = (D / 64) * (DIN / 32), I_CP = (DCONV / 64) * (D / 32), I_WO = (D / 64) * (D / 32);
constexpr int T_W13A = 2 * I_UP, T_W2A = T_W13A + I_DN, T_WIN = T_W2A + I_INP, T_WCAT = T_WIN + 3 * I_CP, T_WOUT = T_WCAT + I_WO, T_W13B = T_WOUT + 2 * I_UP, T_W2B = T_W13B + I_DN;
__device__ __forceinline__ void weight_item(const Args& args, unsigned char* ws, LAS float* scr, int it, int lane) {
    if (it < T_W13A || (it >= T_WOUT && it < T_W13B)) { const bool second = it >= T_WOUT; int r = it - (second ? T_WOUT : 0); const int which = r / I_UP; r -= which * I_UP; const int nblk = DFF / 32, k0 = 64 * (r / nblk), n0 = 32 * (r % nblk);
        const float* W = second ? (which ? args.in[I_F2W3] : args.in[I_F2W1]) : (which ? args.in[I_F1W3] : args.in[I_F1W1]);
        p0_transpose_item(W, D, DFF, (bf16*)(ws + (second ? WS_W13B : WS_W13A)), second ? args.in[I_F2N] : args.in[I_F1N], scr, k0, n0, glu_row(n0) + which * 128, lane); return; }
    if (it < T_W2A || it >= T_W13B) { const bool second = it >= T_W13B; const int r = it - (second ? T_W13B : T_W13A); const int nblk = D / 32, k0 = 64 * (r / nblk), n0 = 32 * (r % nblk);
        p0_transpose_item(second ? args.in[I_F2W2] : args.in[I_F1W2], DFF, D, (bf16*)(ws + (second ? WS_W2B : WS_W2A)), nullptr, scr, k0, n0, n0, lane); return; }
    if (it < T_WIN) { const int r = it - T_W2A; const int nblk = DIN / 32, k0 = 64 * (r / nblk), n0 = 32 * (r % nblk);
        const int dr = n0 < 512 ? glu_row(n0) : n0 < 1024 ? glu_row(n0 - 512) + 128 : n0;
        p0_transpose_item(args.in[I_WIN], D, DIN, (bf16*)(ws + WS_WIN), args.in[I_MIXN], scr, k0, n0, dr, lane); return; }
    if (it < T_WCAT) { int r = it - T_WIN; const int which = r / I_CP; r -= which * I_CP; const int nblk = D / 32, k0 = 64 * (r / nblk), n0 = 32 * (r % nblk);
        const int dr = which == 0 ? n0 : 1024 + glu_row(n0) + (which == 2 ? 128 : 0);
        p0_transpose_item(which == 0 ? args.in[I_CPROJ] : which == 1 ? args.in[I_WV] : args.in[I_WG], DCONV, D, (bf16*)(ws + WS_WCAT), nullptr, scr, k0, n0, dr, lane); return; }
    { const int r = it - T_WCAT; const int nblk = D / 32, k0 = 64 * (r / nblk), n0 = 32 * (r % nblk); p0_transpose_item(args.in[I_WOUT], D, D, (bf16*)(ws + WS_WOUT), nullptr, scr, k0, n0, n0, lane); }
}

__device__ __forceinline__ void ssm_prep_job(Frame& F, const Args& args, int g) {
    LAS f32x2* lamP = (LAS f32x2*)(F.lds + RING_OFF);
    LAS f32x2* Bb = lamP + 17 * 64;
    LAS f32x2* Cc = Bb + 64 * 16;
    LAS float* Kk = (LAS float*)(Cc + 16 * 64);
    const float* lam_re = args.in[I_LRE]; const float* lam_im = args.in[I_LIM]; const float* log_dt = args.in[I_LDT];
    const float* b_re = args.in[I_BRE]; const float* b_im = args.in[I_BIM]; const float* c_re = args.in[I_CRE]; const float* c_im = args.in[I_CIM];
    const int tid = F.tid;
    const float dt = expf(log_dt[g]);
    if (tid < 64) { const int p = tid; const float a = lam_re[g * PS + p] * dt, bb = lam_im[g * PS + p] * dt, ea = expf(a), sb = sinf(bb), cb = cosf(bb);
        const float lx = ea * cb, ly = ea * sb; float px = 1.f, py = 0.f;
        for (int k = 0; k <= 16; ++k) { lamP[k * 64 + p] = (f32x2){px, py}; const float nx = px * lx - py * ly, ny = px * ly + py * lx; px = nx; py = ny; } }
    for (int i = tid; i < 1024; i += 512) { const int p = i >> 4;
        const float lr = lam_re[g * PS + p], li = lam_im[g * PS + p], a = lr * dt, bb = li * dt, ea = expf(a), sb = sinf(bb), cb = cosf(bb), sh = sinf(0.5f * bb);
        const float nr = expm1f(a) * cb - 2.f * sh * sh, ni = ea * sb, den = 1.f / (lr * lr + li * li), fr_ = (nr * lr + ni * li) * den, fi_ = (ni * lr - nr * li) * den;
        const float br = b_re[(size_t)g * 1024 + i], bi = b_im[(size_t)g * 1024 + i];
        Bb[i] = (f32x2){fr_ * br - fi_ * bi, fr_ * bi + fi_ * br};
        Cc[i] = (f32x2){c_re[(size_t)g * 1024 + i], c_im[(size_t)g * 1024 + i]}; }
    __syncthreads();
    {
        const int k = tid >> 5, h = (tid >> 1) & 15, hh = (tid & 1) * 8; float sum[8];
#pragma unroll
        for (int j = 0; j < 8; ++j) sum[j] = 0.f;
#pragma unroll 4
        for (int p = 0; p < 64; ++p) { const f32x2 c = Cc[h * 64 + p], l = lamP[k * 64 + p]; const float er = c.x * l.x - c.y * l.y, ei = c.x * l.y + c.y * l.x;
#pragma unroll
            for (int j = 0; j < 8; j += 2) { const f32x4 bb = *(const LAS f32x4*)(Bb + p * 16 + hh + j); sum[j] += er * bb[0] - ei * bb[1]; sum[j + 1] += er * bb[2] - ei * bb[3]; } }
#pragma unroll
        for (int j = 0; j < 8; ++j) Kk[(k << 8) + (h << 4) + hh + j] = sum[j];
    }
    __syncthreads();
    GAS unsigned* bs2 = (GAS unsigned*)(F.ws + WS_BS2) + (size_t)g * 256 * (UXK / 2);
    for (int i = tid; i < 256 * (UXK / 2); i += 512) { const int n = i / (UXK / 2), kp = (i % (UXK / 2)) * 2, t = n >> 4, h = n & 15; float v0, v1;
        if (kp < 256) { const int s = kp >> 4, hp = kp & 15; const bool on = s <= t; const int kb = (((t - s) & 15) << 8) + (h << 4) + hp; v0 = on ? Kk[kb] : 0.f; v1 = on ? Kk[kb + 1] : 0.f; }
        else { const int p = (kp - 256) >> 1; const f32x2 c = Cc[h * 64 + p], l = lamP[(t + 1) * 64 + p]; v0 = c.x * l.x - c.y * l.y; v1 = -(c.x * l.y + c.y * l.x); }
        bs2[i] = pk2(v0, v1); }
    GAS unsigned* wsi = (GAS unsigned*)(F.ws + WS_WSI) + (size_t)g * 128 * 128;
    for (int i = tid; i < 128 * 128; i += 512) { const int n = i >> 7, kp = (i & 127) * 2, p = n >> 1, c = n & 1, s = kp >> 4, h = kp & 15;
        const f32x2 l = lamP[(15 - s) * 64 + p], b0 = Bb[p * 16 + h], b1 = Bb[p * 16 + h + 1];
        const float v0 = c ? (l.x * b0.y + l.y * b0.x) : (l.x * b0.x - l.y * b0.y), v1 = c ? (l.x * b1.y + l.y * b1.x) : (l.x * b1.x - l.y * b1.y);
        wsi[i] = pk2(v0, v1); }
    if (tid < 64) ((GAS f32x2*)(F.ws + WS_LAMC))[g * 64 + tid] = lamP[16 * 64 + tid];
    __syncthreads();
}

template <int NS, bool NORM, class Fn>
__device__ __forceinline__ void meta_job(Frame& F, const float* A, int K, const bf16* Bt0, const bf16* Bt1, const Fn& fn) {
    LAS float* red = (LAS float*)(F.lds + RING_OFF);
    LAS float* rsc = red + 8 * 16 * 32;
    const int lane = F.lane, w = F.wave, fr = lane & 15, fq = lane >> 4;
    if (NORM) {
#pragma unroll
        for (int rr = 0; rr < 2; ++rr) { const int row = 2 * w + rr; float s = 0.f; for (int c = lane; c < D; c += 64) { const float v = A[(size_t)row * K + c]; s += v * v; } s = wave_sum(s); if (lane == 0) rsc[row] = 1.0f / sqrtf(s * (1.0f / D) + EPS); }
    } else if (F.tid < 16) rsc[F.tid] = 1.f;
    f32x4 acc[NS];
#pragma unroll
    for (int s = 0; s < NS; ++s) acc[s] = (f32x4){0.f, 0.f, 0.f, 0.f};
    const int kw = K / 8, kbase = w * kw;
#pragma unroll 4
    for (int k = kbase; k < kbase + kw; k += 32) {
        const f32x4 a0 = *(const f32x4*)(A + (size_t)fr * K + k + 8 * fq), a1 = *(const f32x4*)(A + (size_t)fr * K + k + 8 * fq + 4);
        const v4u ap = pack8(a0, a1); const bf16x8 af = __builtin_bit_cast(bf16x8, ap);
#pragma unroll
        for (int s = 0; s < NS; ++s) { const bf16x8 bf = *(const bf16x8*)((s == 0 ? Bt0 : Bt1) + (size_t)fr * K + k + 8 * fq); acc[s] = __builtin_amdgcn_mfma_f32_16x16x32_bf16(bf, af, acc[s], 0, 0, 0); } }
#pragma unroll
    for (int s = 0; s < NS; ++s) *(LAS f32x4*)(red + (w * 16 + fr) * 32 + s * 16 + 4 * fq) = acc[s];
    __syncthreads();
    if (F.tid < 256) { const int rr = F.tid >> 4, j = F.tid & 15; float v0 = 0.f, v1 = 0.f;
#pragma unroll
        for (int ww = 0; ww < 8; ++ww) { v0 += red[(ww * 16 + rr) * 32 + j]; if (NS > 1) v1 += red[(ww * 16 + rr) * 32 + 16 + j]; }
        const float sc = rsc[rr]; fn(rr, j, v0 * sc, v1 * sc); }
    VM_WAIT();
    __syncthreads();
}

constexpr int WSI_PITCH = 528;
constexpr int SMETA_OFF = LDSCTL_OFF + 1024;
__device__ __forceinline__ void ssm_pre_job(Frame& F, int b, int g) {
    const int lane = F.lane, w = F.wave, tid = F.tid, fr = lane & 15, fq = lane >> 4;
    LAS unsigned char* Bl = F.lds + RING_OFF;
    LAS f32x2* Sl = (LAS f32x2*)(F.lds + RING_OFF);
    LAS float* smeta = (LAS float*)(F.lds + SMETA_OFF);
    bf16* UX = (bf16*)(F.ws + WS_UX); const bf16* Wg = (const bf16*)(F.ws + WS_WSI) + (size_t)g * 128 * 256;
    { v4u v[8];
#pragma unroll
      for (int i = 0; i < 8; ++i) { const int idx = tid + 512 * i; v[i] = *(const v4u*)(Wg + (size_t)(idx >> 5) * 256 + (idx & 31) * 8); }
#pragma unroll
      for (int i = 0; i < 8; ++i) { const int idx = tid + 512 * i; *(LAS v4u*)(Bl + (idx >> 5) * WSI_PITCH + (idx & 31) * 16) = v[i]; } }
    const bf16* Ab = UX + (size_t)(g * (NCH + 1) + 256 * b + 32 * w) * UXK;
    bf16x8 a[2][8], am[8];
#pragma unroll
    for (int mt = 0; mt < 2; ++mt)
#pragma unroll
        for (int ks = 0; ks < 8; ++ks) a[mt][ks] = *(const bf16x8*)(Ab + (size_t)(16 * mt + fr) * UXK + 32 * ks + 8 * fq);
    if (w == 7) {
#pragma unroll
        for (int ks = 0; ks < 8; ++ks) am[ks] = *(const bf16x8*)(UX + (size_t)(g * (NCH + 1) + NCH) * UXK + 32 * ks + 8 * fq); }
    f32x4 acc[2][8], accm[8];
#pragma unroll
    for (int nt = 0; nt < 8; ++nt) { acc[0][nt] = (f32x4){0.f, 0.f, 0.f, 0.f}; acc[1][nt] = acc[0][nt]; accm[nt] = acc[0][nt]; }
    __syncthreads();
#pragma unroll
    for (int ks = 0; ks < 8; ++ks)
#pragma unroll
        for (int nt = 0; nt < 8; ++nt) { const bf16x8 bfr = *(const LAS bf16x8*)(Bl + (16 * nt + fr) * WSI_PITCH + (32 * ks + 8 * fq) * 2);
            acc[0][nt] = __builtin_amdgcn_mfma_f32_16x16x32_bf16(bfr, a[0][ks], acc[0][nt], 0, 0, 0); acc[1][nt] = __builtin_amdgcn_mfma_f32_16x16x32_bf16(bfr, a[1][ks], acc[1][nt], 0, 0, 0);
            if (w == 7) accm[nt] = __builtin_amdgcn_mfma_f32_16x16x32_bf16(bfr, am[ks], accm[nt], 0, 0, 0); }
    __syncthreads();
#pragma unroll
    for (int mt = 0; mt < 2; ++mt)
#pragma unroll
        for (int nt = 0; nt < 8; ++nt) *(LAS f32x4*)(Sl + (32 * w + 16 * mt + fr) * 64 + 8 * nt + 2 * fq) = acc[mt][nt];
    if (w == 7 && fr == 0) {
#pragma unroll
        for (int nt = 0; nt < 8; ++nt) *(LAS f32x4*)(smeta + 16 * nt + 4 * fq) = accm[nt]; }
    __syncthreads();
    { const f32x2 lc = ((const f32x2*)(F.ws + WS_LAMC))[g * 64 + lane];
      LAS f32x2* Ew = (LAS f32x2*)(F.lds + SMETA_OFF + 512);
      f32x2 l = (f32x2){0.f, 0.f};
#pragma unroll 8
      for (int k = 0; k < 32; ++k) { LAS f32x2* sp = Sl + (32 * w + k) * 64 + lane; const f32x2 sv = *sp; *sp = l; const float nx = lc.x * l.x - lc.y * l.y + sv.x, ny = lc.x * l.y + lc.y * l.x + sv.y; l.x = nx; l.y = ny; }
      Ew[w * 64 + lane] = l;
      f32x2 l32 = lc;
#pragma unroll
      for (int q = 0; q < 5; ++q) { const float nx = l32.x * l32.x - l32.y * l32.y, ny = 2.f * l32.x * l32.y; l32.x = nx; l32.y = ny; }
      __syncthreads();
      f32x2 X = *(const LAS f32x2*)(smeta + 2 * lane);
      for (int v = 0; v < w; ++v) { const f32x2 e = Ew[v * 64 + lane]; const float nx = l32.x * X.x - l32.y * X.y + e.x, ny = l32.x * X.y + l32.y * X.x + e.y; X.x = nx; X.y = ny; }
      unsigned* xp = (unsigned*)(UX + (size_t)(g * (NCH + 1) + b * 256 + 32 * w) * UXK + 256) + lane;
      f32x2 pw = X;
#pragma unroll 8
      for (int k = 0; k < 32; ++k) { const f32x2 lv = Sl[(32 * w + k) * 64 + lane]; xp[(size_t)k * (UXK / 2)] = cvt_pk_bf16(pw.x + lv.x, pw.y + lv.y); const float nx = lc.x * pw.x - lc.y * pw.y, ny = lc.x * pw.y + lc.y * pw.x; pw.x = nx; pw.y = ny; }
      VM_WAIT(); }
    __syncthreads();
}

__device__ __forceinline__ void conv_worker(Frame& F, const Args& args, int wi) {
    LAS unsigned char* zs = F.lds + RING_OFF;
    LAS float* cs = (LAS float*)(F.lds + RING_OFF + 65536);
    const bf16* Z = (const bf16*)(F.ws + WS_Z); bf16* ZC = (bf16*)(F.ws + WS_ZC);
    const int tid = F.tid, lane = F.lane, w = F.wave, b = wi >> 5, T0 = (wi & 31) * 128;
    auto zrow = [&](int ti, int cb) -> v4u { v4u v = (v4u){0u, 0u, 0u, 0u};
        if (ti >= 0) v = *(const v4u*)((const char*)Z + (size_t)(b * SEQ + ti) * 1024 + cb); else if (ti >= -NMETA) v = *(const v4u*)((const char*)Z + (size_t)(M + NMETA + ti) * 1024 + cb); return v; };
    { v4u v[8];
#pragma unroll
      for (int it = 0; it < 8; ++it) { const int q = tid + 512 * it; v[it] = (v4u){0u, 0u, 0u, 0u}; if (q < 62 * 64) v[it] = zrow(T0 - 30 + (q >> 6), (q & 63) * 16); }
#pragma unroll
      for (int it = 0; it < 8; ++it) { const int q = tid + 512 * it; if (q < 62 * 64) *(LAS v4u*)(zs + (((q >> 6) + 2) & 63) * 1024 + (q & 63) * 16) = v[it]; } }
    const int cp = tid & 255, th = tid >> 8;
    const float* dw = args.in[I_DW]; f32x2 wgt[CWID];
#pragma unroll
    for (int k = 0; k < CWID; ++k) wgt[k] = *(const f32x2*)(dw + k * DCONV + 2 * cp);
    const f32x2 bias = *(const f32x2*)(args.in[I_DWB] + 2 * cp);
    const f32x4 g0 = *(const f32x4*)(args.in[I_LNG] + 4 * lane), g1 = *(const f32x4*)(args.in[I_LNG] + 256 + 4 * lane), b0 = *(const f32x4*)(args.in[I_LNB] + 4 * lane), b1 = *(const f32x4*)(args.in[I_LNB] + 256 + 4 * lane);
#pragma unroll 1
    for (int j = 0; j < 4; ++j) {
        __syncthreads();
#pragma unroll 1
        for (int hf = 0; hf < 2; ++hf) {
            f32x2 acc[8];
#pragma unroll
            for (int t = 0; t < 8; ++t) acc[t] = bias;
            const int base = 32 * j + 16 * th + 8 * hf + 2;
#pragma unroll
            for (int i = 0; i < 38; ++i) { const unsigned zz = *(const LAS unsigned*)(zs + (((base + i) & 63) << 10) + 4 * cp); const float z0 = bf2f(zz & 0xffffu), z1 = bf2f(zz >> 16);
#pragma unroll
                for (int t = 0; t < 8; ++t) { const int k = i - t; if (k >= 0 && k < CWID) { acc[t].x += wgt[k].x * z0; acc[t].y += wgt[k].y * z1; } } }
#pragma unroll
            for (int t = 0; t < 8; ++t) *(LAS f32x2*)(cs + (16 * th + 8 * hf + t) * 512 + 2 * cp) = acc[t];
        }
        __syncthreads();
        v4u nx[4];
        if (j < 3) {
#pragma unroll
            for (int it = 0; it < 4; ++it) { const int q = tid + 512 * it; nx[it] = zrow(T0 + 32 * j + 32 + (q >> 6), (q & 63) * 16); } }
#pragma unroll
        for (int q = 0; q < 4; ++q) { const int t = 4 * w + q; const f32x4 x0 = *(const LAS f32x4*)(cs + t * 512 + 4 * lane), x1 = *(const LAS f32x4*)(cs + t * 512 + 256 + 4 * lane);
            const float mu = wave_sum((x0[0] + x0[1]) + (x0[2] + x0[3]) + (x1[0] + x1[1]) + (x1[2] + x1[3])) * (1.f / DCONV);
            const f32x4 d0 = x0 - mu, d1 = x1 - mu;
            const float var = wave_sum((d0[0] * d0[0] + d0[1] * d0[1]) + (d0[2] * d0[2] + d0[3] * d0[3]) + (d1[0] * d1[0] + d1[1] * d1[1]) + (d1[2] * d1[2] + d1[3] * d1[3])) * (1.f / DCONV);
            const float rstd = __builtin_amdgcn_rsqf(var + EPS); f32x4 o0 = d0 * rstd * g0 + b0, o1 = d1 * rstd * g1 + b1;
#pragma unroll
            for (int jj = 0; jj < 4; ++jj) { o0[jj] = fsilu(o0[jj]); o1[jj] = fsilu(o1[jj]); }
            bf16* zr = ZC + (size_t)(b * SEQ + T0 + 32 * j + t) * DCONV;
            *(v2u*)(zr + 4 * lane) = (v2u){cvt_pk_bf16(o0[0], o0[1]), cvt_pk_bf16(o0[2], o0[3])}; *(v2u*)(zr + 256 + 4 * lane) = (v2u){cvt_pk_bf16(o1[0], o1[1]), cvt_pk_bf16(o1[2], o1[3])}; }
        if (j < 3) {
#pragma unroll
            for (int it = 0; it < 4; ++it) { const int q = tid + 512 * it; *(LAS v4u*)(zs + ((32 * j + 64 + (q >> 6)) & 63) * 1024 + (q & 63) * 16) = nx[it]; } }
    }
    __syncthreads();
}

__global__ void __launch_bounds__(NWAVES * 64, 2) hyb_fwd(Args args) {
    extern __shared__ __attribute__((aligned(16))) unsigned char lds[];
    Frame F;
    F.lds = (LAS unsigned char*)lds; F.MISC = (volatile LAS unsigned*)(F.lds + MISC_OFF);
    F.wave = __builtin_amdgcn_readfirstlane((int)threadIdx.x >> 6); F.lane = lane_id_opaque(); F.tid = F.wave * 64 + F.lane;
    F.G = gridDim.x; { const int bx = blockIdx.x; F.vcu = (F.G % 8 == 0) ? (bx % 8) * (F.G / 8) + bx / 8 : bx; }
    F.ws = args.ws; F.out = args.out; F.ctl = (gu32*)(args.ws + WS_CTL);
    for (int u = F.tid; u < (LDS_BYTES - LDSCTL_OFF) / 4; u += NWAVES * 64) ((LAS unsigned*)(F.lds + LDSCTL_OFF))[u] = 0u;
    __syncthreads();
    const int bli = (N_LAUNCHES == PER_PHASE) ? 0 : args.li;
    XcdBarrier bar; bar.bar = (unsigned*)(F.ctl + CW_BAR) + bli * XCD_BAR_WORDS; bar.x = 0; bar.st = nullptr;
    if (N_LAUNCHES != PER_PHASE) bar = xcd_barrier_post((unsigned*)(F.ctl + CW_BAR) + bli * XCD_BAR_WORDS, F.MISC + 8);
    const int lo = args.ph_lo, hi = args.ph_hi;
#ifndef PHMASK
#define PHMASK 0x7ff
#endif
#define IN(k) (((PHMASK >> (k)) & 1) && lo <= (k) && (k) < hi)
#define SEAM(k) do { if (IN(k) && IN((k) + 1)) xcd_barrier(bar); F.lane = lane_id_opaque(); F.tid = F.wave * 64 + F.lane; } while (0)
    unsigned char* ws = F.ws;
    bf16* W13A = (bf16*)(ws + WS_W13A); bf16* W2A = (bf16*)(ws + WS_W2A); bf16* WIN = (bf16*)(ws + WS_WIN); bf16* WCAT = (bf16*)(ws + WS_WCAT); bf16* WOUT = (bf16*)(ws + WS_WOUT);
    bf16* W13B = (bf16*)(ws + WS_W13B); bf16* W2B = (bf16*)(ws + WS_W2B);
    bf16* AB = (bf16*)(ws + WS_AB); bf16* H1B = (bf16*)(ws + WS_H1); bf16* H2B = (bf16*)(ws + WS_H1 + 32 * MiB); bf16* HID = (bf16*)(ws + WS_HID);
    bf16* Zb = (bf16*)(ws + WS_Z); bf16* UXb = (bf16*)(ws + WS_UX); bf16* ZCb = (bf16*)(ws + WS_ZC); bf16* Yb = (bf16*)(ws + WS_Y); bf16* MCb = (bf16*)(ws + WS_MC);
    float* SS0 = (float*)(ws + WS_SS0); float* SS1 = SS0 + M; float* SS2 = SS1 + M; float* SS3 = SS2 + M;
    float* HIDM = (float*)(ws + WS_HIDM); float* H1M = (float*)(ws + WS_H1M);
    bf16* Gb = (bf16*)F.out;
    const int bx = (int)blockIdx.x;
    const int gw = F.vcu * NWAVES + F.wave, NGW = F.G * NWAVES;
    const int lb = bx - F.G / 2;
    const int lgw = lb * NWAVES + F.wave, NLGW = (F.G - F.G / 2) * NWAVES;

    if (IN(0)) {
        LAS float* scr = (LAS float*)(F.lds + RING_OFF + F.wave * 16384);
        for (int it = gw; it < T_W13A; it += NGW) weight_item(args, ws, scr, it, F.lane);
        for (int m = gw; m < M; m += NGW) { const GAS f32x4* xr = (const GAS f32x4*)(args.in[I_X] + (size_t)m * D) + F.lane; f32x4 v[4]; float s = 0.f;
#pragma unroll
            for (int j = 0; j < 4; ++j) { v[j] = xr[64 * j]; s += (v[j].x * v[j].x + v[j].y * v[j].y) + (v[j].z * v[j].z + v[j].w * v[j].w); }
            s = wave_sum(s);
            GAS v2u* o8 = (GAS v2u*)(AB + (size_t)m * D) + F.lane;
#pragma unroll
            for (int j = 0; j < 4; ++j) o8[64 * j] = (v2u){pk2(v[j].x, v[j].y), pk2(v[j].z, v[j].w)};
            if (F.lane == 0) { SS0[m] = s; SS1[m] = 0.f; SS2[m] = 0.f; SS3[m] = 0.f; } }
    }
    SEAM(0);
    if (IN(1)) {
        pg8::Gemm g{D, D, D}; pg8::GridOrder S{M / 256, 2 * DFF / 256, F.G, bx, (const char*)AB, (const char*)W13A, (size_t)256 * D * 2, (size_t)256 * D * 2, W_UP};
        EpiSwiglu E{HID, SS0};
        pg8::gemm_phase(F.lds + RING_OFF, F.wave, g, S, E);
        F.lane = lane_id_opaque(); F.tid = F.wave * 64 + F.lane;
        for (;;) { const int t = wg_ticket(F, 0);
            if (t < NG) { ssm_prep_job(F, args, t); continue; }
            if (t < NG + DFF / 16) { float* hm = HIDM; const int c0 = 16 * (t - NG); const bf16* b0 = W13A + (size_t)glu_row(c0) * D;
                meta_job<2, true>(F, args.in[I_META], D, b0, b0 + (size_t)128 * D, [=](int r, int jj, float a, float b) { hm[r * DFF + c0 + jj] = fsilu(a) * b; }); continue; }
            const int tj = t - (NG + DFF / 16); if (tj >= (T_WIN - T_W13A) / 16) break;
            LAS float* scr = (LAS float*)(F.lds + RING_OFF + F.wave * 16384);
            weight_item(args, ws, scr, T_W13A + 16 * tj + F.wave, F.lane); weight_item(args, ws, scr, T_W13A + 16 * tj + 8 + F.wave, F.lane);
        }
    }
    SEAM(1);
    if (IN(2)) {
        pg8::Gemm g{DFF, DFF, DFF}; pg8::GridOrder S{M / 256, D / 256, F.G, bx, (const char*)HID, (const char*)W2A, (size_t)256 * DFF * 2, (size_t)256 * DFF * 2, W_DN};
        EpiResid<true> E{AB, H1B, SS1, 0.5f};
        pg8::gemm_phase(F.lds + RING_OFF, F.wave, g, S, E);
    }
    SEAM(2);
    if (IN(3)) {
        pg8::Gemm g{D, D, D}; pg8::GridOrder S{M / 256, DIN / 256, F.G, bx, (const char*)H1B, (const char*)WIN, (size_t)256 * D * 2, (size_t)256 * D * 2, W_IN};
        EpiMix E{SS1, Zb, UXb, Gb, args.in[I_BGATE]};
        pg8::gemm_phase(F.lds + RING_OFF, F.wave, g, S, E);
        F.lane = lane_id_opaque(); F.tid = F.wave * 64 + F.lane;
        for (;;) { int j = wg_ticket(F, 1);
            if (j < 64) { float* hm = H1M; const float* mt = args.in[I_META]; const int c0 = 16 * j;
                meta_job<1, false>(F, HIDM, DFF, W2A + (size_t)c0 * DFF, nullptr, [=](int r, int jj, float a, float) { __hip_atomic_store(hm + r * D + c0 + jj, mt[r * D + c0 + jj] + 0.5f * a, __ATOMIC_RELAXED, __HIP_MEMORY_SCOPE_AGENT); });
                if (F.tid == 0) __hip_atomic_fetch_add((unsigned*)(F.ctl + CW_MBD), 1u, __ATOMIC_RELAXED, __HIP_MEMORY_SCOPE_AGENT);
                continue; }
            j -= 64;
            if (j < 64) wait_mbd(F);
            if (j < 32) { bf16* zz = Zb; const int c0 = 16 * j; const bf16* b0 = WIN + (size_t)glu_row(c0) * D;
                meta_job<2, true>(F, H1M, D, b0, b0 + (size_t)128 * D, [=](int r, int jj, float a, float b) { zz[(size_t)(M + r) * DCONV + c0 + jj] = (bf16)f2bf(a * fsigmoid(b)); }); continue; }
            if (j < 64) { bf16* ux = UXb; const int gg = j - 32;
                meta_job<1, true>(F, H1M, D, WIN + (size_t)(1024 + 16 * gg) * D, nullptr, [=](int r, int jj, float a, float) { ux[(size_t)(gg * (NCH + 1) + NCH) * UXK + r * 16 + jj] = (bf16)f2bf(a); }); continue; }
            const int tj = j - 64; if (tj >= (T_W2B - T_WIN) / 16) break;
            LAS float* scr = (LAS float*)(F.lds + RING_OFF + F.wave * 16384);
            weight_item(args, ws, scr, T_WIN + 16 * tj + F.wave, F.lane); weight_item(args, ws, scr, T_WIN + 16 * tj + 8 + F.wave, F.lane);
        }
    }
    SEAM(3);
    if (IN(4)) {
        if (bx < BATCH * NG) {
            ssm_pre_job(F, bx / NG, bx % NG);
            pg8::Gemm g{UXK, UXK, UXK}; SsmOrder S{1 << 20, bx, (const char*)UXb, (const char*)(ws + WS_BS2)};
            EpiSsmY E{UXb, args.in[I_SD], Yb};
            pg8::gemm_phase(F.lds + RING_OFF, F.wave, g, S, E);
        }
        else conv_worker(F, args, bx - BATCH * NG);
    }
    SEAM(4);
    if (IN(6)) {
        pg8::Gemm g{512, 512, 512}; MergeOrder S{F.G, bx, (const char*)ZCb, (const char*)Yb, (const char*)WCAT};
        EpiMerge E{Gb, MCb, AB};
        pg8::gemm_phase(F.lds + RING_OFF, F.wave, g, S, E);
    }
    SEAM(6);
    if (IN(7)) {
        pg8::Gemm g{D, D, D}; pg8::GridOrder S{M / 256, D / 256, F.G, bx, (const char*)AB, (const char*)WOUT, (size_t)256 * D * 2, (size_t)256 * D * 2, W_OUT};
        EpiResid<true> E{H1B, H2B, SS2, 1.0f};
        pg8::gemm_phase(F.lds + RING_OFF, F.wave, g, S, E);
    }
    SEAM(7);
    if (IN(8)) {
        pg8::Gemm g{D, D, D}; pg8::GridOrder S{M / 256, 2 * DFF / 256, F.G, bx, (const char*)H2B, (const char*)W13B, (size_t)256 * D * 2, (size_t)256 * D * 2, W_UP};
        EpiSwiglu E{HID, SS2};
        pg8::gemm_phase(F.lds + RING_OFF, F.wave, g, S, E);
    }
    SEAM(8);
    if (IN(9)) {
        pg8::Gemm g{DFF, DFF, DFF}; pg8::GridOrder S{M / 256, D / 256, F.G, bx, (const char*)HID, (const char*)W2B, (size_t)256 * DFF * 2, (size_t)256 * DFF * 2, W_DN};
        EpiFinal E{H2B, F.out, SS3, (unsigned*)(F.ctl + CW_FIN), args.in[I_FINN], 0.5f};
        pg8::gemm_phase(F.lds + RING_OFF, F.wave, g, S, E);
    }
#undef IN
#undef SEAM
}

extern "C" void kernel_launch(void* const* d_in, const int* in_sizes, int n_in, void* d_out, int out_size, void* d_ws, size_t ws_size, hipStream_t stream) {
    static int grid = 0;
    if (grid == 0) {
        if (n_in != 30 || in_sizes[0] != M * D || out_size != M * D || ws_size < WS_END) { fprintf(stderr, "kernel_launch: unexpected problem shape (n_in %d, in0 %d, out %d, ws %zu); nothing launched\n", n_in, n_in > 0 ? in_sizes[0] : -1, out_size, ws_size); grid = -1; return; }
        int dev = 0, cus = 0, per_cu = 0;
        if (hipGetDevice(&dev) != hipSuccess || hipDeviceGetAttribute(&cus, hipDeviceAttributeMultiprocessorCount, dev) != hipSuccess) { grid = -1; return; }
        if (hipFuncSetAttribute((const void*)hyb_fwd, hipFuncAttributeMaxDynamicSharedMemorySize, LDS_BYTES) != hipSuccess) { fprintf(stderr, "kernel_launch: hipFuncSetAttribute failed\n"); grid = -1; return; }
        if (hipOccupancyMaxActiveBlocksPerMultiprocessor(&per_cu, (const void*)hyb_fwd, NWAVES * 64, LDS_BYTES) != hipSuccess || per_cu < 1)
            fprintf(stderr, "kernel_launch: note: occupancy query reports %d workgroups per CU\n", per_cu);
        (void)hipGetLastError();
        grid = cus > 256 ? 256 : cus;
        if (grid != 256) fprintf(stderr, "kernel_launch: %d CUs reported; this kernel's phase program needs a 256-workgroup grid\n", cus);
    }
    if (grid < 0) return;
    if (hipMemsetAsync((char*)d_ws + WS_CTL, 0, CTL_ZERO_BYTES, stream) != hipSuccess) { fprintf(stderr, "kernel_launch: hipMemsetAsync failed\n"); return; }
    Args a{};
    for (int i = 0; i < 30; ++i) a.in[i] = (const float*)d_in[i];
    a.out = (float*)d_out; a.ws = (unsigned char*)d_ws;
    for (int li = 0; li < N_LAUNCHES; ++li) {
        a.ph_lo = (N_LAUNCHES == PER_PHASE) ? li : 0; a.ph_hi = (N_LAUNCHES == PER_PHASE) ? li + 1 : PER_PHASE; a.li = li;
        hipLaunchKernelGGL(hyb_fwd, dim3(grid), dim3(NWAVES * 64), LDS_BYTES, stream, a);
        const hipError_t le = hipPeekAtLastError();
        if (le != hipSuccess) { fprintf(stderr, "kernel_launch: launch %d failed: %s\n", li, hipGetErrorName(le)); break; }
    }
}
```
